# Optimizing an MI355X kernel written in HIP

```python
import jax, jax.numpy as jnp
from jax import lax
import numpy as np

D_MODEL = 1024
BATCH = 4
SEQ = 4096
DEPTH = 2

GLA_HEADS = 4
GLA_DK = 32
GLA_DV = 64
GLA_LOWRANK = 16
GLA_GATE_TAU = 16.0
MOBA_HEADS = 8
MOBA_HD = 64
MOBA_BLOCK = 256
MOBA_TOPK = 3
MOBA_QCHUNK = 128
ROT_DIM = MOBA_HD // 4
ROPE_THETA = 500000.0
HGRN_HEADS = 4
HGRN_DK = 64
HGRN_DV = 64
LIN_CHUNK = 16
GLA_KW = GLA_HEADS * GLA_DK
GLA_VW = GLA_HEADS * GLA_DV
MOBA_W = MOBA_HEADS * MOBA_HD
HGRN_KW = HGRN_HEADS * HGRN_DK
HGRN_VW = HGRN_HEADS * HGRN_DV
MIX_WIDTH = GLA_VW + MOBA_W + HGRN_VW
IN_SPLITS = (GLA_KW, GLA_KW, GLA_VW, GLA_VW, GLA_LOWRANK,
             MOBA_W, MOBA_W, MOBA_W,
             HGRN_KW, HGRN_KW, HGRN_VW, HGRN_VW)
IN_COLS = sum(IN_SPLITS)
MOE_GROUPS = 4
MOE_EXPERTS_PER_GROUP = 4
MOE_N_EXPERTS = MOE_GROUPS * MOE_EXPERTS_PER_GROUP
MOE_TOPK = 2
MOE_FF = 512
NORM_EPS = 1e-6

kernel_name = 'hymba_style_gla_moba_hgrn2_hmoe'


def rms_norm(x, g):
    xf = x.astype(jnp.float32)
    y = xf * lax.rsqrt(jnp.mean(xf * xf, axis=-1, keepdims=True) + NORM_EPS)
    return (y * g.astype(jnp.float32)).astype(x.dtype)


def partial_rotary(x, pos):
    half = ROT_DIM // 2
    inv_freq = ROPE_THETA ** (-(jnp.arange(0, ROT_DIM, 2, dtype=jnp.float32) / ROT_DIM))
    ang = pos.astype(jnp.float32)[:, None] * inv_freq[None, :]
    cos = jnp.cos(ang)[None, :, None, :]
    sin = jnp.sin(ang)[None, :, None, :]
    x1 = x[..., :half].astype(jnp.float32)
    x2 = x[..., half:ROT_DIM].astype(jnp.float32)
    rot = jnp.concatenate([x1 * cos - x2 * sin, x2 * cos + x1 * sin], axis=-1)
    return jnp.concatenate([rot.astype(x.dtype), x[..., ROT_DIM:]], axis=-1)


def gated_linear_chunked(q, k, v, log_a):
    B, S, H, dk = q.shape
    dv = v.shape[-1]
    C = LIN_CHUNK
    N = S // C
    f32 = jnp.float32

    def chunk(t):
        return t.astype(f32).reshape(B, N, C, H, t.shape[-1]).transpose(0, 3, 1, 2, 4)

    q, k, v, log_a = chunk(q), chunk(k), chunk(v), chunk(log_a)
    b = jnp.cumsum(log_a, axis=3)
    b_last = b[:, :, :, -1:, :]
    causal = jnp.tril(jnp.ones((C, C), dtype=bool))[:, :, None]
    diff = b[:, :, :, :, None, :] - b[:, :, :, None, :, :]
    decay = jnp.exp(jnp.where(causal, diff, -jnp.inf))
    scores = jnp.einsum('bhnik,bhnjk,bhnijk->bhnij', q, k, decay)
    o = jnp.einsum('bhnij,bhnjv->bhniv', scores, v)
    chunk_kv = jnp.einsum('bhnck,bhncv->bhnkv', k * jnp.exp(b_last - b), v)
    chunk_decay = jnp.exp(b_last[:, :, :, 0, :])

    def step(state, inp):
        a, kv = inp
        return a[..., None] * state + kv, state

    _, states = lax.scan(step, jnp.zeros((B, H, dk, dv), f32),
                         (jnp.moveaxis(chunk_decay, 2, 0), jnp.moveaxis(chunk_kv, 2, 0)))
    states = jnp.moveaxis(states, 0, 2)
    o = o + jnp.einsum('bhnck,bhnkv->bhncv', q * jnp.exp(b), states)
    return o.transpose(0, 2, 3, 1, 4).reshape(B, S, H, dv)


def moba_attention(q, k, v):
    B, S, H, D = q.shape
    BLK, Q = MOBA_BLOCK, MOBA_QCHUNK
    f32 = jnp.float32
    nb = -(-S // BLK)
    pad = nb * BLK - S
    q = q.transpose(0, 2, 1, 3)
    k = jnp.pad(k.transpose(0, 2, 1, 3), ((0, 0), (0, 0), (0, pad), (0, 0)))
    v = jnp.pad(v.transpose(0, 2, 1, 3), ((0, 0), (0, 0), (0, pad), (0, 0)))
    k_blocks = k.reshape(B, H, nb, BLK, D)
    v_blocks = v.reshape(B, H, nb, BLK, D)
    k_mean = jnp.mean(k_blocks.astype(f32), axis=3)
    pos = jnp.arange(S)
    q_blk = pos // BLK
    gate = jnp.einsum('bhsd,bhnd->bhsn', q.astype(f32), k_mean)
    fully_past = jnp.arange(nb)[None, :] < q_blk[:, None]
    gate = jnp.where(fully_past, gate, -jnp.inf)
    topk = min(MOBA_TOPK, nb)
    top_val, top_idx = lax.top_k(gate, topk)
    sel_ok = top_val > -jnp.inf
    nqc = S // Q

    def to_chunks(t):
        rest = t.shape[3:]
        t = t.reshape((B, H, nqc, Q) + rest).swapaxes(1, 2)
        return t.reshape((B * nqc, H, Q) + rest)

    b_ids = jnp.repeat(jnp.arange(B, dtype=jnp.int32), nqc)
    c_ids = jnp.tile(jnp.arange(nqc, dtype=jnp.int32), B)
    scale = D ** -0.5
    h_ar = jnp.arange(H)[:, None, None]

    def one_chunk(args):
        qc, idx, ok, bi, ci = args
        kb = k_blocks[bi]
        vb = v_blocks[bi]
        ks = kb[h_ar, idx]
        vs = vb[h_ar, idx]
        s_sel = jnp.einsum('hqd,hqjkd->hqjk', qc, ks).astype(f32) * scale
        s_sel = jnp.where(ok[..., None], s_sel, -jnp.inf).reshape(H, Q, topk * BLK)
        n_own = (ci * Q) // BLK
        k_own = lax.dynamic_index_in_dim(kb, n_own, axis=1, keepdims=False)
        v_own = lax.dynamic_index_in_dim(vb, n_own, axis=1, keepdims=False)
        s_own = jnp.einsum('hqd,hkd->hqk', qc, k_own).astype(f32) * scale
        qpos = ci * Q + jnp.arange(Q)
        kpos = n_own * BLK + jnp.arange(BLK)
        s_own = jnp.where((kpos[None, :] <= qpos[:, None])[None], s_own, -jnp.inf)
        p = jax.nn.softmax(jnp.concatenate([s_sel, s_own], axis=-1), axis=-1)
        p_sel = p[..., :topk * BLK].reshape(H, Q, topk, BLK).astype(vs.dtype)
        p_own = p[..., topk * BLK:].astype(v_own.dtype)
        return (jnp.einsum('hqjk,hqjkd->hqd', p_sel, vs)
                + jnp.einsum('hqk,hkd->hqd', p_own, v_own))

    out = lax.map(one_chunk, (to_chunks(q), to_chunks(top_idx), to_chunks(sel_ok), b_ids, c_ids))
    out = out.reshape(B, nqc, H, Q, D).transpose(0, 1, 3, 2, 4)
    return out.reshape(B, S, H * D)


def hierarchical_moe(h, w_rg, w_re, w_g, w_u, w_d):
    B, S, D = h.shape
    t = h.reshape(-1, D)
    f32 = jnp.float32
    lg = (t @ w_rg).astype(f32)
    p_group = jax.nn.softmax(lg, axis=-1)
    g_sel = jnp.argmax(lg, axis=-1)
    gate_group = jnp.take_along_axis(p_group, g_sel[:, None], axis=1)[:, 0]
    le = (t @ w_re).astype(f32).reshape(-1, MOE_GROUPS, MOE_EXPERTS_PER_GROUP)
    le = jnp.take_along_axis(le, g_sel[:, None, None], axis=1)[:, 0]
    top_v, top_i = lax.top_k(le, MOE_TOPK)
    w_sel = jax.nn.softmax(top_v, axis=-1) * gate_group[:, None]
    e_ids = g_sel[:, None] * MOE_EXPERTS_PER_GROUP + top_i
    comb = jnp.sum(jax.nn.one_hot(e_ids, MOE_N_EXPERTS, dtype=f32) * w_sel[..., None], axis=1)
    comb = comb.astype(t.dtype)
    y = jnp.zeros_like(t)
    for e in range(MOE_N_EXPERTS):
        he = jax.nn.silu(t @ w_g[e]) * (t @ w_u[e])
        y = y + comb[:, e:e + 1] * (he @ w_d[e])
    return y.reshape(B, S, D)


def setup_inputs(seed: int = 0) -> dict:
    key = jax.random.key(seed)
    ks = jax.random.split(key, 17)
    f32 = jnp.float32
    nrm = lambda k, shape, s: jax.random.normal(k, shape, f32) * s
    gain = lambda k, shape: 1.0 + 0.02 * jax.random.normal(k, shape, f32)
    return {
        'x': nrm(ks[0], (BATCH, SEQ, D_MODEL), 1.0),
        'attn_norm_g': gain(ks[1], (DEPTH, D_MODEL)),
        'w_in': nrm(ks[2], (DEPTH, D_MODEL, IN_COLS), D_MODEL ** -0.5),
        'gla_gk_w2': nrm(ks[3], (DEPTH, GLA_LOWRANK, GLA_KW), GLA_LOWRANK ** -0.5),
        'gla_gk_b': nrm(ks[4], (DEPTH, GLA_KW), 0.1),
        'gla_norm_g': gain(ks[5], (DEPTH, GLA_DV)),
        'moba_qnorm_g': gain(ks[6], (DEPTH, MOBA_HD)),
        'moba_knorm_g': gain(ks[7], (DEPTH, MOBA_HD)),
        'hgrn_lb_param': nrm(ks[8], (DEPTH, HGRN_KW), 1.0),
        'hgrn_norm_g': gain(ks[9], (DEPTH, HGRN_DV)),
        'w_out': nrm(ks[10], (DEPTH, MIX_WIDTH, D_MODEL), MIX_WIDTH ** -0.5),
        'ffn_norm_g': gain(ks[11], (DEPTH, D_MODEL)),
        'w_router_group': nrm(ks[12], (DEPTH, D_MODEL, MOE_GROUPS), D_MODEL ** -0.5),
        'w_router_expert': nrm(ks[13], (DEPTH, D_MODEL, MOE_N_EXPERTS), D_MODEL ** -0.5),
        'w_exp_gate': nrm(ks[14], (DEPTH, MOE_N_EXPERTS, D_MODEL, MOE_FF), D_MODEL ** -0.5),
        'w_exp_up': nrm(ks[15], (DEPTH, MOE_N_EXPERTS, D_MODEL, MOE_FF), D_MODEL ** -0.5),
        'w_exp_down': nrm(ks[16], (DEPTH, MOE_N_EXPERTS, MOE_FF, D_MODEL), MOE_FF ** -0.5),
    }


def reference(x, attn_norm_g, w_in, gla_gk_w2, gla_gk_b, gla_norm_g, moba_qnorm_g,
              moba_knorm_g, hgrn_lb_param, hgrn_norm_g, w_out, ffn_norm_g,
              w_router_group, w_router_expert, w_exp_gate, w_exp_up, w_exp_down):
    B, S, _ = x.shape
    f32 = jnp.float32
    pos = jnp.arange(S)
    offs = np.cumsum(IN_SPLITS)[:-1].tolist()
    lb_p = jax.nn.softmax(hgrn_lb_param.astype(f32), axis=0)
    lower_bounds = jnp.cumsum(lb_p, axis=0) - lb_p[0]

    def heads(t, n):
        return t.reshape(B, S, n, -1)

    for l in range(DEPTH):
        h = rms_norm(x, attn_norm_g[l])
        proj = h @ w_in[l]
        (a_q, a_k, a_v, a_g, a_lr, b_q, b_k, b_v,
         c_q, c_f, c_i, c_g) = jnp.split(proj, offs, axis=-1)

        log_alpha = jax.nn.log_sigmoid((a_lr @ gla_gk_w2[l] + gla_gk_b[l]).astype(f32)) / GLA_GATE_TAU
        o_a = gated_linear_chunked(heads(a_q, GLA_HEADS) * (GLA_DK ** -0.5), heads(a_k, GLA_HEADS),
                                   heads(a_v, GLA_HEADS), heads(log_alpha, GLA_HEADS))
        o_a = rms_norm(o_a.astype(x.dtype), gla_norm_g[l]) * jax.nn.silu(heads(a_g, GLA_HEADS))

        mq = partial_rotary(rms_norm(heads(b_q, MOBA_HEADS), moba_qnorm_g[l]), pos)
        mk = partial_rotary(rms_norm(heads(b_k, MOBA_HEADS), moba_knorm_g[l]), pos)
        o_b = moba_attention(mq, mk, heads(b_v, MOBA_HEADS))

        lb = lower_bounds[l].reshape(HGRN_HEADS, HGRN_DK)
        f_raw = heads(c_f, HGRN_HEADS).astype(f32)
        log_f = jnp.log(lb + (1.0 - lb) * jax.nn.sigmoid(f_raw))
        k_c = (1.0 - lb) * jax.nn.sigmoid(-f_raw)
        o_c = gated_linear_chunked(jax.nn.silu(heads(c_q, HGRN_HEADS)), k_c,
                                   heads(c_i, HGRN_HEADS), log_f)
        o_c = rms_norm(o_c.astype(x.dtype), hgrn_norm_g[l]) * jax.nn.silu(heads(c_g, HGRN_HEADS))

        mix = jnp.concatenate([o_a.reshape(B, S, GLA_VW), o_b, o_c.reshape(B, S, HGRN_VW)], axis=-1)
        x = x + mix @ w_out[l]

        h2 = rms_norm(x, ffn_norm_g[l])
        x = x + hierarchical_moe(h2, w_router_group[l], w_router_expert[l],
                                 w_exp_gate[l], w_exp_up[l], w_exp_down[l])
    return x
```

```cpp
#include <hip/hip_runtime.h>
#include <hip/hip_cooperative_groups.h>
#include <cstdio>
#include <cstdint>
namespace cg = cooperative_groups;

#ifndef MK_PER_PHASE
#define MK_PER_PHASE 0
#endif

#define LAS __attribute__((address_space(3)))
typedef unsigned short bf16_t;
typedef short bf16x8 __attribute__((ext_vector_type(8)));
typedef short s16x4 __attribute__((ext_vector_type(4)));
typedef float f32x2 __attribute__((ext_vector_type(2)));
typedef float f32x4 __attribute__((ext_vector_type(4)));
typedef float f32x16 __attribute__((ext_vector_type(16)));
typedef unsigned u32x2 __attribute__((ext_vector_type(2)));
typedef unsigned u32x4 __attribute__((ext_vector_type(4)));
typedef __bf16 bf16x2_t __attribute__((ext_vector_type(2)));

constexpr int NTOK = 16384, DM = 1024, SEQ = 4096, NBATCH = 4, DEPTH = 2;
constexpr int IN_COLS = 3344;
constexpr int PP = 3328;
constexpr int NW_IN = 3584;
constexpr int C_AQ = 0, C_AK = 128, C_AV = 256, C_AG = 512, C_BQ = 768, C_BK = 1280, C_BV = 1792, C_CQ = 2304, C_CF = 2560, C_CI = 2816, C_CG = 3072;
constexpr int NEXP = 16, FF = 512;
constexpr int MOE_ROWS = 36864;
constexpr float EPS = 1e-6f;
constexpr float LOG2E = 1.4426950408889634f;

constexpr size_t MiB = 1u << 20;
constexpr size_t WS_CTL = 0;
constexpr size_t WS_SMALL = 1 * MiB;
constexpr size_t SM_COS = WS_SMALL, SM_SIN = WS_SMALL + 128 * 1024;
constexpr size_t SM_LR = WS_SMALL + 256 * 1024;
constexpr size_t SM_KPART = WS_SMALL + 768 * 1024;
constexpr size_t SM_DECAY = WS_SMALL + 1280 * 1024;
constexpr size_t SM_ROUTE = WS_SMALL + 1792 * 1024;
constexpr size_t SM_SLOTW = WS_SMALL + 2304 * 1024;
constexpr size_t WS_WIN = 5 * MiB;
constexpr size_t WS_WOUT = 19 * MiB;
constexpr size_t WS_WGU = 23 * MiB;
constexpr size_t WS_WD = 87 * MiB;
constexpr size_t WS_PROJ = 119 * MiB;
constexpr size_t WS_ST = 223 * MiB;
constexpr size_t WS_AB = 239 * MiB;
constexpr size_t WS_END = 271 * MiB;
constexpr size_t WS_APERM = WS_PROJ;
constexpr size_t WS_H = WS_PROJ + 72 * MiB;
static_assert(WS_H + (size_t)MOE_ROWS * FF * 2 <= WS_AB, "moe overlay");

constexpr int LDS_BYTES = 155648;
constexpr int MISC_OFF = 147456;
constexpr int WAVE_LDS = 18432;

__device__ __forceinline__ unsigned cvtpk(float lo, float hi) { f32x2 v = {lo, hi}; bf16x2_t b = __builtin_convertvector(v, bf16x2_t); return __builtin_bit_cast(unsigned, b); }
__device__ __forceinline__ float bf2f(unsigned short u) { return __builtin_bit_cast(float, (unsigned)u << 16); }
__device__ __forceinline__ float bflo(unsigned u) { return __builtin_bit_cast(float, u << 16); }
__device__ __forceinline__ float bfhi(unsigned u) { return __builtin_bit_cast(float, u & 0xffff0000u); }
__device__ __forceinline__ float wave_sum(float v) {
#pragma unroll
    for (int o = 1; o < 64; o <<= 1) v += __shfl_xor(v, o);
    return v;
}
__device__ __forceinline__ float wave_max(float v) {
#pragma unroll
    for (int o = 1; o < 64; o <<= 1) v = fmaxf(v, __shfl_xor(v, o));
    return v;
}
__device__ __forceinline__ int crow(int r, int hi) { return (r & 3) + 8 * (r >> 2) + 4 * hi; }
__device__ __forceinline__ float sigmoidf_(float x) { return 1.0f / (1.0f + __expf(-x)); }
#define MFMA32(a, b, c) __builtin_amdgcn_mfma_f32_32x32x16_bf16((a), (b), (c), 0, 0, 0)

namespace pg8 {
#define PG8_LAS __attribute__((address_space(3)))
constexpr int BM = 256, BK = 64, HALF = 128, HTB = HALF * BK * 2, STAGE_BYTES = 8 * HTB, NXCD = 8, WGM = 8;
__host__ __device__ __forceinline__ int lds_byte(int r, int c) { const int st = (r >> 4) * 2 + (c >> 5), rr = r & 15, cc = c & 31, ob = rr * 64 + cc * 2; return st * 1024 + (ob ^ (((ob >> 9) & 1) << 5)); }
__host__ __device__ __forceinline__ void stage_rc(int b, int& R, int& C) { const int st = b / 1024, sb = b % 1024, swz = sb ^ (((sb >> 9) & 1) << 5); R = (st >> 1) * 16 + swz / 64; C = (st & 1) * 32 + (swz % 64) / 2; }
__host__ __device__ __forceinline__ int perm32(int rho) { const int n = rho >> 4, i = rho & 15; return 8 * (i >> 2) + 4 * n + (i & 3); }

struct Unit { int pm, pn, bt; };
struct Gemm { const bf16_t* A; const bf16_t* Bt; int K; };

struct StaticOrder {
    int nM, nN, nwg, G, c;
    __device__ void init(int M, int N, int G_, int c_) { nM = M / BM; nN = N / BM; nwg = nM * nN; G = G_; c = c_; }
    __device__ bool next(int i, Unit& u) const {
        const long L = (long)i * G + c; if (L >= nwg) return false;
        int wgid = (int)L; { const int q = nwg / NXCD, r = nwg % NXCD, xcd = wgid % NXCD, off = wgid / NXCD; wgid = (xcd < r ? xcd * (q + 1) : r * (q + 1) + (xcd - r) * q) + off; }
        const int nig = WGM * nN, gid = wgid / nig, fm = gid * WGM, gsz = (nM - fm) < WGM ? (nM - fm) : WGM;
        u.pm = fm + ((wgid % nig) % gsz); u.pn = (wgid % nig) / gsz; u.bt = u.pn; return true;
    }
};
struct GroupedOrder {
    const volatile PG8_LAS int* toff; int G, vcu, wbase;
    __device__ bool next(int i, Unit& u) const {
        const int U = i * G + vcu; const int total = toff[16];
        if (U >= total * 4) return false;
        const int rt = U >> 2, pn = U & 3; int e = 0;
#pragma unroll
        for (int j = 1; j < 16; ++j) e += (rt >= toff[j]) ? 1 : 0;
        u.pm = rt; u.pn = pn; u.bt = wbase + e * 4 + pn; return true;
    }
};

template <class Epi, class Sched>
__device__ __forceinline__ void gemm_phase(PG8_LAS unsigned char* lds, const Gemm g, const Sched& S, const Epi& E, const int tid) {
    const int  wid = __builtin_amdgcn_readfirstlane(tid >> 6), lane = tid & 63, wr = wid >> 2, wc = wid & 3, fr = lane & 15, fq = lane >> 4;
    const int K = g.K, nt = K / BK;
    unsigned voffA[2], voffB[2];
#pragma unroll
    for (int i = 0; i < 2; ++i) { int R, C; stage_rc(tid * 16 + i * 8192, R, C); const int Rb = Epi::PERM ? ((R & ~31) + perm32(R & 31)) : R;
        voffA[i] = (unsigned)(R * K + C) * 2u; voffB[i] = (unsigned)(Rb * K + C) * 2u; }
    const size_t kstep = (size_t)(BK * 2);
    const size_t hstep = (size_t)HALF * K * 2;
    const size_t tstep = 2 * hstep;
    const unsigned ldsw = (unsigned)wid * 1024u;
    const int aoff = lds_byte(wr * 64 + fr, fq * 8), boff = lds_byte(wc * 32 + fr, fq * 8);
#define PG8_SA(b, h) (((b) * 2 + (h)) * HTB)
#define PG8_SB(b, h) ((4 + (b) * 2 + (h)) * HTB)
#define PG8_STAGE(bufoff, gbase, voff) do { _Pragma("unroll") for (int _i = 0; _i < 2; ++_i) \
        __builtin_amdgcn_global_load_lds((const unsigned*)((const char*)(gbase) + (voff)[_i]), (PG8_LAS unsigned*)(lds + (bufoff) + ldsw + _i * 8192), 16, 0, 0); } while (0)
#define PG8_LDA(dst, b, h) do { _Pragma("unroll") for (int m = 0; m < 4; ++m) _Pragma("unroll") for (int k = 0; k < 2; ++k) dst[m][k] = *(const PG8_LAS bf16x8*)(lds + PG8_SA(b, h) + aoff + m * 2048 + k * 1024); } while (0)
#define PG8_LDB(dst, b, h) do { _Pragma("unroll") for (int n = 0; n < 2; ++n) _Pragma("unroll") for (int k = 0; k < 2; ++k) dst[n][k] = *(const PG8_LAS bf16x8*)(lds + PG8_SB(b, h) + boff + n * 2048 + k * 1024); } while (0)
#define PG8_MMA(ai, bj, At, Bt) do { __builtin_amdgcn_s_setprio(1); _Pragma("unroll") for (int m = 0; m < 4; ++m) _Pragma("unroll") for (int n = 0; n < 2; ++n) _Pragma("unroll") for (int k = 0; k < 2; ++k) \
        acc[ai][bj][m][n] = __builtin_amdgcn_mfma_f32_16x16x32_bf16(Bt[n][k], At[m][k], acc[ai][bj][m][n], 0, 0, 0); __builtin_amdgcn_s_setprio(0); } while (0)
#define PG8_WAIT_V(n) asm volatile("s_waitcnt vmcnt(" #n ")" ::: "memory")
#define PG8_WAIT_L(n) asm volatile("s_waitcnt lgkmcnt(" #n ")" ::: "memory")
#define PG8_BAR __builtin_amdgcn_s_barrier()
#define PG8_SCHED __builtin_amdgcn_sched_barrier(0)
    Unit cur, nxt; int ui = 0;
    if (!S.next(0, cur)) return;
    f32x4 acc[2][2][4][2];
#pragma unroll
    for (int a = 0; a < 2; ++a)
#pragma unroll
        for (int b = 0; b < 2; ++b)
#pragma unroll
            for (int m = 0; m < 4; ++m)
#pragma unroll
                for (int n = 0; n < 2; ++n) acc[a][b][m][n] = (f32x4){0.f, 0.f, 0.f, 0.f};
    bf16x8 At[4][2], B0[2][2], B1[2][2];
    const char* cA = (const char*)g.A + (size_t)cur.pm * tstep; const char* cB = (const char*)g.Bt + (size_t)cur.bt * tstep;
    PG8_STAGE(PG8_SB(0, 0), cB, voffB); PG8_STAGE(PG8_SB(0, 1), cB + hstep, voffB); PG8_STAGE(PG8_SA(0, 0), cA, voffA); PG8_STAGE(PG8_SA(0, 1), cA + hstep, voffA);
    if (wr == 1) PG8_BAR;
    PG8_WAIT_V(2); PG8_BAR;
    PG8_STAGE(PG8_SB(1, 0), cB + kstep, voffB); PG8_STAGE(PG8_SA(1, 0), cA + kstep, voffA); PG8_STAGE(PG8_SB(1, 1), cB + hstep + kstep, voffB);
    PG8_WAIT_V(6); PG8_BAR;
    for (;;) {
        const bool has_next = S.next(ui + 1, nxt);
        const char* nA = has_next ? (const char*)g.A + (size_t)nxt.pm * tstep : cA; const char* nB = has_next ? (const char*)g.Bt + (size_t)nxt.bt * tstep : cB;
        for (int t = 0; t < nt; t += 2) {
            const bool last = (t == nt - 2);
            const char* a1 = cA + (size_t)(t + 1) * kstep;
            const char* a2 = last ? nA : cA + (size_t)(t + 2) * kstep; const char* b2 = last ? nB : cB + (size_t)(t + 2) * kstep;
            const char* a3 = a2 + kstep; const char* b3 = b2 + kstep;
            PG8_LDB(B0, 0, 0); PG8_LDB(B1, 0, 1); PG8_SCHED; PG8_LDA(At, 0, 0); PG8_STAGE(PG8_SA(1, 1), a1 + hstep, voffA);
            PG8_WAIT_V(8); PG8_WAIT_L(0); PG8_BAR; PG8_MMA(0, 0, At, B0); PG8_MMA(0, 1, At, B1); PG8_BAR; PG8_SCHED;
            PG8_LDA(At, 0, 1); PG8_STAGE(PG8_SB(0, 0), b2, voffB); PG8_STAGE(PG8_SB(0, 1), b2 + hstep, voffB); PG8_STAGE(PG8_SA(0, 0), a2, voffA);
            PG8_WAIT_V(8); PG8_WAIT_L(0); PG8_BAR; PG8_MMA(1, 0, At, B0); PG8_MMA(1, 1, At, B1); PG8_BAR; PG8_SCHED;
            PG8_LDB(B0, 1, 0); PG8_LDB(B1, 1, 1); PG8_SCHED; PG8_LDA(At, 1, 0); PG8_STAGE(PG8_SA(0, 1), a2 + hstep, voffA);
            PG8_WAIT_V(8); PG8_WAIT_L(0); PG8_BAR; PG8_MMA(0, 0, At, B0); PG8_MMA(0, 1, At, B1); PG8_BAR; PG8_SCHED;
            PG8_LDA(At, 1, 1); PG8_STAGE(PG8_SB(1, 0), b3, voffB); PG8_STAGE(PG8_SB(1, 1), b3 + hstep, voffB); PG8_STAGE(PG8_SA(1, 0), a3, voffA);
            PG8_WAIT_V(8); PG8_WAIT_L(0); PG8_BAR; PG8_MMA(1, 0, At, B0); PG8_MMA(1, 1, At, B1); PG8_BAR; PG8_SCHED;
        }
        if (wr == 0) PG8_BAR;
        E(acc, cur, wr, wc, fr, fq);
        if (!has_next) break;
#pragma unroll
        for (int a = 0; a < 2; ++a)
#pragma unroll
            for (int b = 0; b < 2; ++b)
#pragma unroll
                for (int m = 0; m < 4; ++m)
#pragma unroll
                    for (int n = 0; n < 2; ++n) acc[a][b][m][n] = (f32x4){0.f, 0.f, 0.f, 0.f};
        cur = nxt; cA = nA; cB = nB; ++ui;
        if (wr == 1) PG8_BAR;
    }
    PG8_WAIT_V(0);
    PG8_BAR;
#undef PG8_SA
#undef PG8_SB
#undef PG8_STAGE
#undef PG8_LDA
#undef PG8_LDB
#undef PG8_MMA
#undef PG8_WAIT_V
#undef PG8_WAIT_L
#undef PG8_BAR
#undef PG8_SCHED
}
}

struct EpiProj {
    static constexpr bool PERM = true;
    bf16_t* O; bf16_t* LR;
    __device__ __forceinline__ void operator()(const f32x4 (&acc)[2][2][4][2], const pg8::Unit& u, int wr, int wc, int fr, int fq) const {
        const int row0 = u.pm * 256 + wr * 64 + fr;
        if (u.pn < 13) {
            const int col0 = u.pn * 256 + wc * 32 + 8 * fq;
#pragma unroll
            for (int ai = 0; ai < 2; ++ai)
#pragma unroll
                for (int m = 0; m < 4; ++m) { bf16_t* rowp = O + (size_t)(row0 + ai * 128 + m * 16) * PP + col0;
#pragma unroll
                    for (int bj = 0; bj < 2; ++bj) { const f32x4 v0 = acc[ai][bj][m][0], v1 = acc[ai][bj][m][1];
                        u32x4 w; w.x = cvtpk(v0[0], v0[1]); w.y = cvtpk(v0[2], v0[3]); w.z = cvtpk(v1[0], v1[1]); w.w = cvtpk(v1[2], v1[3]);
                        *(u32x4*)(rowp + bj * 128) = w; } }
        } else if (wc == 0 && fq < 2) {
#pragma unroll
            for (int ai = 0; ai < 2; ++ai)
#pragma unroll
                for (int m = 0; m < 4; ++m) { const f32x4 v0 = acc[ai][0][m][0], v1 = acc[ai][0][m][1];
                    u32x4 w; w.x = cvtpk(v0[0], v0[1]); w.y = cvtpk(v0[2], v0[3]); w.z = cvtpk(v1[0], v1[1]); w.w = cvtpk(v1[2], v1[3]);
                    *(u32x4*)(LR + (size_t)(row0 + ai * 128 + m * 16) * 16 + 8 * fq) = w; }
        }
    }
};
struct EpiResid {
    static constexpr bool PERM = false;
    const float* base; float* out;
    __device__ __forceinline__ void operator()(const f32x4 (&acc)[2][2][4][2], const pg8::Unit& u, int wr, int wc, int fr, int fq) const {
        const int row0 = u.pm * 256 + wr * 64 + fr, col0 = u.pn * 256 + wc * 32 + 4 * fq;
#pragma unroll
        for (int ai = 0; ai < 2; ++ai)
#pragma unroll
            for (int m = 0; m < 4; ++m) { const size_t off = (size_t)(row0 + ai * 128 + m * 16) * DM + col0;
#pragma unroll
                for (int bj = 0; bj < 2; ++bj)
#pragma unroll
                    for (int n = 0; n < 2; ++n) { const f32x4 bs = *(const f32x4*)(base + off + bj * 128 + n * 16); *(f32x4*)(out + off + bj * 128 + n * 16) = bs + acc[ai][bj][m][n]; } }
    }
};
struct EpiSwiglu {
    static constexpr bool PERM = true;
    bf16_t* H;
    __device__ __forceinline__ void operator()(const f32x4 (&acc)[2][2][4][2], const pg8::Unit& u, int wr, int wc, int fr, int fq) const {
        const int row0 = u.pm * 256 + wr * 64 + fr, col0 = u.pn * 128 + wc * 32 + 8 * fq;
#pragma unroll
        for (int ai = 0; ai < 2; ++ai)
#pragma unroll
            for (int m = 0; m < 4; ++m) { float o[8];
#pragma unroll
                for (int n = 0; n < 2; ++n)
#pragma unroll
                    for (int j = 0; j < 4; ++j) { const float gt = acc[ai][0][m][n][j], up = acc[ai][1][m][n][j]; o[n * 4 + j] = gt * sigmoidf_(gt) * up; }
                u32x4 w; w.x = cvtpk(o[0], o[1]); w.y = cvtpk(o[2], o[3]); w.z = cvtpk(o[4], o[5]); w.w = cvtpk(o[6], o[7]);
                *(u32x4*)(H + (size_t)(row0 + ai * 128 + m * 16) * FF + col0) = w; }
    }
};
struct EpiDown {
    static constexpr bool PERM = true;
    bf16_t* Y; const float* slotw;
    __device__ __forceinline__ void operator()(const f32x4 (&acc)[2][2][4][2], const pg8::Unit& u, int wr, int wc, int fr, int fq) const {
        const int row0 = u.pm * 256 + wr * 64 + fr, col0 = u.pn * 256 + wc * 32 + 8 * fq;
#pragma unroll
        for (int ai = 0; ai < 2; ++ai)
#pragma unroll
            for (int m = 0; m < 4; ++m) { const int row = row0 + ai * 128 + m * 16; const float sw = slotw[row]; bf16_t* rowp = Y + (size_t)row * DM + col0;
#pragma unroll
                for (int bj = 0; bj < 2; ++bj) { const f32x4 v0 = acc[ai][bj][m][0] * sw, v1 = acc[ai][bj][m][1] * sw;
                    u32x4 w; w.x = cvtpk(v0[0], v0[1]); w.y = cvtpk(v0[2], v0[3]); w.z = cvtpk(v1[0], v1[1]); w.w = cvtpk(v1[2], v1[3]);
                    *(u32x4*)(rowp + bj * 128) = w; } }
    }
};

struct Args { const float* in[17]; float* out; unsigned char* ws; int ph_lo, ph_hi; };
struct Ctx {
    LAS unsigned char* lds; const float* in_[17]; float* out_; unsigned char* ws_;
    int tid, lane, wave, G, vcu, gw, NGW, bx;
#define CTX_IN(name, idx) __device__ __forceinline__ const float* name() const { return in_[idx]; }
    CTX_IN(x, 0) CTX_IN(attn_g, 1) CTX_IN(w_in, 2) CTX_IN(gk_w2, 3) CTX_IN(gk_b, 4) CTX_IN(gla_g, 5) CTX_IN(qn_g, 6) CTX_IN(kn_g, 7) CTX_IN(lb_param, 8) CTX_IN(hgrn_g, 9)
    CTX_IN(w_out, 10) CTX_IN(ffn_g, 11) CTX_IN(w_rg, 12) CTX_IN(w_re, 13) CTX_IN(w_eg, 14) CTX_IN(w_eu, 15) CTX_IN(w_ed, 16)
#define CTX_WS(type, name, off) __device__ __forceinline__ type* name() const { return (type*)(ws_ + (off)); }
    __device__ __forceinline__ float* out() const { return out_; }
    CTX_WS(unsigned, ctl, WS_CTL) CTX_WS(float, cosT, SM_COS) CTX_WS(float, sinT, SM_SIN) CTX_WS(bf16_t, lr, SM_LR) CTX_WS(float, kpart, SM_KPART) CTX_WS(float, decay, SM_DECAY)
    CTX_WS(unsigned, route, SM_ROUTE) CTX_WS(float, slotw, SM_SLOTW) CTX_WS(bf16_t, win, WS_WIN) CTX_WS(bf16_t, wout, WS_WOUT) CTX_WS(bf16_t, wgu, WS_WGU) CTX_WS(bf16_t, wd, WS_WD)
    CTX_WS(bf16_t, proj, WS_PROJ) CTX_WS(bf16_t, st, WS_ST) CTX_WS(bf16_t, ab, WS_AB) CTX_WS(float, kvt, WS_AB) CTX_WS(bf16_t, aperm, WS_APERM) CTX_WS(bf16_t, hbuf, WS_H)
};

__device__ __forceinline__ void tr_item(const float* W, int ldw, int col0, int k0, bf16_t* WT, int K, int drow0, int nvalid, LAS float* scr, int lane) {
#pragma unroll 8
    for (int i = 0; i < 32; ++i) { const int kk = 2 * i + (lane >> 5); scr[kk * 33 + (lane & 31)] = W[(size_t)(k0 + kk) * ldw + col0 + (lane & 31)]; }
    asm volatile("s_waitcnt lgkmcnt(0)" ::: "memory");
    const int c = lane & 7;
#pragma unroll
    for (int j = 0; j < 4; ++j) { const int n = (lane >> 3) + 8 * j; const LAS float* s = scr + (8 * c) * 33 + n;
        u32x4 o; o.x = cvtpk(s[0 * 33], s[1 * 33]); o.y = cvtpk(s[2 * 33], s[3 * 33]); o.z = cvtpk(s[4 * 33], s[5 * 33]); o.w = cvtpk(s[6 * 33], s[7 * 33]);
        if (n < nvalid) *(u32x4*)(WT + (size_t)(drow0 + n) * K + k0 + 8 * c) = o; }
    asm volatile("s_waitcnt lgkmcnt(0)" ::: "memory");
}
constexpr int WC_PER_LAYER = 1664 + 16 + 512 + 16 * 768;
__device__ __forceinline__ void wconv_item(const Ctx& X, int it, LAS float* scr) {
    const int l = it / WC_PER_LAYER; int r = it % WC_PER_LAYER; const int lane = X.lane;
    if (r < 1664) { const int kb = r / 104, nb = r % 104; const int col0 = nb < 24 ? 32 * nb : 784 + 32 * (nb - 24), drow = nb < 24 ? 32 * nb : 768 + 32 * (nb - 24);
        tr_item(X.w_in() + (size_t)l * DM * IN_COLS, IN_COLS, col0, 64 * kb, X.win() + (size_t)l * NW_IN * DM, DM, drow, 32, scr, lane); return; }
    r -= 1664;
    if (r < 16) { tr_item(X.w_in() + (size_t)l * DM * IN_COLS, IN_COLS, 768, 64 * r, X.win() + (size_t)l * NW_IN * DM, DM, 3328, 16, scr, lane); return; }
    r -= 16;
    if (r < 512) { const int kb = r / 32, nb = r % 32; tr_item(X.w_out() + (size_t)l * DM * DM, DM, 32 * nb, 64 * kb, X.wout() + (size_t)l * DM * DM, DM, 32 * nb, 32, scr, lane); return; }
    r -= 512;
    const int e = r / 768, q = r % 768; const size_t le = (size_t)l * NEXP + e;
    if (q < 512) { const int up = q >= 256, qq = q & 255, kb = qq / 16, nb = qq % 16, col0 = 32 * nb;
        const float* src = (up ? X.w_eu() : X.w_eg()) + le * DM * FF;
        tr_item(src, FF, col0, 64 * kb, X.wgu() + le * DM * DM, DM, 256 * (col0 / 128) + (col0 % 128) + (up ? 128 : 0), 32, scr, lane); return; }
    { const int qq = q - 512, kb = qq / 32, nb = qq % 32;
      tr_item(X.w_ed() + le * FF * DM, DM, 32 * nb, 64 * kb, X.wd() + le * DM * FF, FF, 32 * nb, 32, scr, lane); }
}

__device__ __forceinline__ void rownorm(const float* xrow, const float* g, bf16_t* orow, int lane, f32x4 (&v)[4]) {
    const f32x4* xr = (const f32x4*)xrow + lane; float s = 0.f;
#pragma unroll
    for (int j = 0; j < 4; ++j) { v[j] = xr[64 * j]; s += (v[j].x * v[j].x + v[j].y * v[j].y) + (v[j].z * v[j].z + v[j].w * v[j].w); }
    const float rstd = rsqrtf(wave_sum(s) * (1.f / DM) + EPS);
    const f32x4* gr = (const f32x4*)g + lane; u32x2* o8 = (u32x2*)orow + lane;
#pragma unroll
    for (int j = 0; j < 4; ++j) { const f32x4 gg = gr[64 * j]; v[j] = v[j] * rstd * gg; u32x2 w; w.x = cvtpk(v[j].x, v[j].y); w.y = cvtpk(v[j].z, v[j].w); o8[64 * j] = w; }
}

__device__ __forceinline__ void phase0(const Ctx& X) {
    LAS float* scr = (LAS float*)(X.lds + X.wave * 16384);
    for (int it = X.gw; it < DEPTH * WC_PER_LAYER; it += X.NGW) wconv_item(X, it, scr);
    { const int gt = X.gw * 64 + X.lane, NT = X.NGW * 64; const int per = 240 * DM / 8;
      for (int i = gt; i < DEPTH * per; i += NT) { const int l = i / per, j = i % per; *(u32x4*)(X.win() + (size_t)l * NW_IN * DM + (size_t)3344 * DM + (size_t)j * 8) = (u32x4){0u, 0u, 0u, 0u}; } }
    { const int gt = X.gw * 64 + X.lane, NT = X.NGW * 64;
      for (int i = gt; i < SEQ * 8; i += NT) { const int pos = i >> 3, f = i & 7;
          const float inv = exp2f(-(float)f * 0.125f * 18.931568569324174f);
          const float ang = (float)pos * inv;
          const double a = (double)ang; const double kx = __builtin_rint(a * 0.15915494309189535); const float red = (float)(a - kx * 6.283185307179586);
          X.cosT()[i] = __cosf(red); X.sinT()[i] = __sinf(red); } }
    if (X.bx == 0 && X.tid < 64) X.ctl()[X.tid] = 0u;
    for (int m = X.gw; m < NTOK; m += X.NGW) { f32x4 v[4]; rownorm(X.x() + (size_t)m * DM, X.attn_g(), X.ab() + (size_t)m * DM, X.lane, v); }
}

__device__ __forceinline__ void moba_prep_item(const Ctx& X, int layer, int item) {
    const int part = item & 3, bb = item >> 2; const int lane = X.lane, w = X.wave;
    const int tok0 = (bb >> 4) * SEQ + (bb & 15) * 256 + part * 64 + w * 8;
    const int sub = lane & 7;
    float gq[8], gk[8], ks[8];
#pragma unroll
    for (int j = 0; j < 8; ++j) { gq[j] = X.qn_g()[layer * 64 + sub * 8 + j]; gk[j] = X.kn_g()[layer * 64 + sub * 8 + j]; ks[j] = 0.f; }
    for (int t = 0; t < 8; ++t) {
        const int tok = tok0 + t, pos = tok & (SEQ - 1);
        float cs[8], sn[8];
#pragma unroll
        for (int j = 0; j < 8; ++j) { cs[j] = X.cosT()[pos * 8 + j]; sn[j] = X.sinT()[pos * 8 + j]; }
#pragma unroll
        for (int which = 0; which < 2; ++which) {
            bf16_t* p = X.proj() + (size_t)tok * PP + (which ? C_BK : C_BQ) + lane * 8;
            const u32x4 raw = *(const u32x4*)p; float v[8];
            v[0] = bflo(raw.x); v[1] = bfhi(raw.x); v[2] = bflo(raw.y); v[3] = bfhi(raw.y); v[4] = bflo(raw.z); v[5] = bfhi(raw.z); v[6] = bflo(raw.w); v[7] = bfhi(raw.w);
            float ss = 0.f;
#pragma unroll
            for (int j = 0; j < 8; ++j) ss += v[j] * v[j];
            ss += __shfl_xor(ss, 1); ss += __shfl_xor(ss, 2); ss += __shfl_xor(ss, 4);
            const float rstd = rsqrtf(ss * (1.f / 64.f) + EPS);
#pragma unroll
            for (int j = 0; j < 8; ++j) v[j] = v[j] * rstd * (which ? gk[j] : gq[j]);
#pragma unroll
            for (int j = 0; j < 8; ++j) { const float other = __shfl_xor(v[j], 1);
                if (sub == 0) v[j] = v[j] * cs[j] - other * sn[j]; else if (sub == 1) v[j] = v[j] * cs[j] + other * sn[j]; }
            if (which) {
#pragma unroll
                for (int j = 0; j < 8; ++j) ks[j] += v[j];
            } else {
#pragma unroll
                for (int j = 0; j < 8; ++j) v[j] *= (0.125f * LOG2E);
            }
            u32x4 o; o.x = cvtpk(v[0], v[1]); o.y = cvtpk(v[2], v[3]); o.z = cvtpk(v[4], v[5]); o.w = cvtpk(v[6], v[7]);
            *(u32x4*)p = o;
        }
    }
    LAS float* red = (LAS float*)X.lds;
#pragma unroll
    for (int j = 0; j < 8; ++j) red[w * 512 + lane * 8 + j] = ks[j];
    __syncthreads();
    { const int c = X.tid; float s = 0.f;
#pragma unroll
      for (int ww = 0; ww < 8; ++ww) s += red[ww * 512 + c];
      X.kpart()[(size_t)item * 512 + c] = s; }
    __syncthreads();
}

template <bool GLA, bool PHC>
__device__ __forceinline__ void lin_item(const Ctx& X, int layer, int b, int c, int h, LAS unsigned char* wl) {
    const int lane = X.lane, r32 = lane & 31, hi = lane >> 5;
    const size_t row0 = (size_t)b * SEQ + (size_t)c * 64;
    const bf16_t* P = X.proj();
    const int fl = GLA ? (lane & 31) : lane;
    const int qcol = GLA ? (C_AQ + 32 * h + fl) : (C_CQ + 64 * h + fl);
    const int kcol = GLA ? (C_AK + 32 * h + fl) : (C_CF + 64 * h + fl);
    const int vcol = GLA ? (C_AV + 64 * h + lane) : (C_CI + 64 * h + lane);
    const float fv = (GLA && lane >= 32) ? 0.f : 1.f;
    float w2[16]; float bias = 0.f, lb = 0.f;
    if (GLA) {
#pragma unroll
        for (int r = 0; r < 16; ++r) w2[r] = X.gk_w2()[(size_t)layer * 16 * 128 + r * 128 + 32 * h + fl];
        bias = X.gk_b()[layer * 128 + 32 * h + fl];
    } else {
#pragma unroll
        for (int r = 0; r < 16; ++r) w2[r] = 0.f;
        if (layer > 0) lb = sigmoidf_(X.lb_param()[256 + 64 * h + fl] - X.lb_param()[64 * h + fl]);
    }
    const int h8 = GLA ? h : 4 + h;
    const size_t sbase = (((size_t)b * 64 + c) * 8 + h8) * 4096;
    float bsum = 0.f;
    f32x16 g00 = {}, g01 = {}, g10 = {}, g11 = {};
    for (int s = 0; s < 4; ++s) {
        float kt[16], qt[16];
        const size_t rb = row0 + 16 * s;
#pragma unroll
        for (int t = 0; t < 16; ++t) {
            const size_t row = rb + t;
            const float rawk = bf2f(P[row * PP + kcol]);
            float qv = 0.f; if (PHC) qv = bf2f(P[row * PP + qcol]);
            float a, kk;
            if (GLA) {
                const u32x4 l0 = *(const u32x4*)(X.lr() + row * 16), l1 = *(const u32x4*)(X.lr() + row * 16 + 8);
                float z = bias;
                z += bflo(l0.x) * w2[0] + bfhi(l0.x) * w2[1] + bflo(l0.y) * w2[2] + bfhi(l0.y) * w2[3] + bflo(l0.z) * w2[4] + bfhi(l0.z) * w2[5] + bflo(l0.w) * w2[6] + bfhi(l0.w) * w2[7];
                z += bflo(l1.x) * w2[8] + bfhi(l1.x) * w2[9] + bflo(l1.y) * w2[10] + bfhi(l1.y) * w2[11] + bflo(l1.z) * w2[12] + bfhi(l1.z) * w2[13] + bflo(l1.w) * w2[14] + bfhi(l1.w) * w2[15];
                a = (fminf(z, 0.f) - __logf(1.f + __expf(-fabsf(z)))) * (1.f / 16.f);
                kk = rawk; qv *= 0.17677669529663687f;
            } else {
                const float ef = __expf(-rawk), sg = 1.f / (1.f + ef);
                a = __logf(lb + (1.f - lb) * sg);
                kk = (1.f - lb) * (ef * sg);
                qv = qv * sigmoidf_(qv);
            }
            a *= fv; kk *= fv; qv *= fv;
            bsum += a;
            const float eb = __expf(bsum), enb = __expf(-bsum);
            kt[t] = kk * enb; qt[t] = qv * eb;
            if ((t & 3) == 3) asm volatile("" ::: "memory");
        }
        if (PHC) {
#pragma unroll
            for (int t = 0; t < 16; ++t) {
                *(LAS bf16_t*)(wl + (16 * s + t) * 144 + lane * 2) = (bf16_t)(cvtpk(qt[t], 0.f) & 0xffffu);
                *(LAS bf16_t*)(wl + 9216 + (16 * s + t) * 144 + lane * 2) = (bf16_t)(cvtpk(kt[t], 0.f) & 0xffffu);
            }
        } else {
            unsigned pk[8], pv[8];
#pragma unroll
            for (int m = 0; m < 8; ++m) { pk[m] = cvtpk(kt[2 * m], kt[2 * m + 1]);
                const unsigned v0 = P[(rb + 2 * m) * PP + vcol], v1 = P[(rb + 2 * m + 1) * PP + vcol]; pv[m] = v0 | (v1 << 16); }
            u32x4 av0, av1, bk0, bk1;
#pragma unroll
            for (int m = 0; m < 4; ++m) {
                auto rv = __builtin_amdgcn_permlane32_swap(pv[m], pv[m + 4], false, false); av0[m] = rv[0]; av1[m] = rv[1];
                auto rk = __builtin_amdgcn_permlane32_swap(pk[m], pk[m + 4], false, false); bk0[m] = rk[0]; bk1[m] = rk[1];
            }
            const bf16x8 A0 = __builtin_bit_cast(bf16x8, av0), A1 = __builtin_bit_cast(bf16x8, av1), B0 = __builtin_bit_cast(bf16x8, bk0), B1 = __builtin_bit_cast(bf16x8, bk1);
            g00 = MFMA32(A0, B0, g00); g01 = MFMA32(A0, B1, g01); g10 = MFMA32(A1, B0, g10); g11 = MFMA32(A1, B1, g11);
        }
    }
    if (!PHC) {
        const float dec = __expf(bsum);
        X.decay()[(((size_t)b * 64 + c) * 8 + h8) * 64 + lane] = dec;
        const float d0 = __shfl(dec, r32), d1 = __shfl(dec, 32 + r32);
        float* kv = X.kvt() + sbase;
#pragma unroll
        for (int r = 0; r < 16; ++r) { const int v0 = crow(r, hi);
            kv[(size_t)v0 * 64 + r32] = g00[r] * d0; kv[(size_t)v0 * 64 + 32 + r32] = g01[r] * d1;
            kv[(size_t)(32 + v0) * 64 + r32] = g10[r] * d0; kv[(size_t)(32 + v0) * 64 + 32 + r32] = g11[r] * d1; }
        return;
    }
    if (PHC) {
        unsigned pv[32];
#pragma unroll
        for (int m = 0; m < 32; ++m) { const unsigned v0 = P[(row0 + 2 * m) * PP + vcol], v1 = P[(row0 + 2 * m + 1) * PP + vcol]; pv[m] = v0 | (v1 << 16); if ((m & 7) == 7) asm volatile("" ::: "memory"); }
        bf16x8 avp[2][4];
#pragma unroll
        for (int sg = 0; sg < 4; ++sg) {
            u32x4 f0, f1;
            auto r0 = __builtin_amdgcn_permlane32_swap(pv[8 * sg + 0], pv[8 * sg + 2], false, false); f0[0] = r0[0]; f1[0] = r0[1];
            auto r1 = __builtin_amdgcn_permlane32_swap(pv[8 * sg + 1], pv[8 * sg + 3], false, false); f0[1] = r1[0]; f1[1] = r1[1];
            auto r2 = __builtin_amdgcn_permlane32_swap(pv[8 * sg + 4], pv[8 * sg + 6], false, false); f0[2] = r2[0]; f1[2] = r2[1];
            auto r3 = __builtin_amdgcn_permlane32_swap(pv[8 * sg + 5], pv[8 * sg + 7], false, false); f0[3] = r3[0]; f1[3] = r3[1];
            avp[0][sg] = __builtin_bit_cast(bf16x8, f0); avp[1][sg] = __builtin_bit_cast(bf16x8, f1);
        }
        const LAS unsigned char* QT = wl; const LAS unsigned char* KT = wl + 9216;
        const bf16_t* S0 = X.st() + sbase;
        f32x16 o[2][2];
#pragma unroll
        for (int it = 0; it < 2; ++it) {
            bf16x8 bq[4];
#pragma unroll
            for (int ks = 0; ks < 4; ++ks) bq[ks] = *(const LAS bf16x8*)(QT + (32 * it + r32) * 144 + ks * 32 + hi * 16);
#pragma unroll
            for (int vi = 0; vi < 2; ++vi) { f32x16 acc = {};
#pragma unroll
                for (int ks = 0; ks < 4; ++ks) { const bf16x8 sf = *(const bf16x8*)(S0 + (size_t)(32 * vi + r32) * 64 + 16 * ks + 8 * hi); acc = MFMA32(sf, bq[ks], acc); }
                o[vi][it] = acc; }
#pragma unroll
            for (int jt = 0; jt <= it; ++jt) {
                f32x16 sc = {};
#pragma unroll
                for (int ks = 0; ks < 4; ++ks) { const bf16x8 ak = *(const LAS bf16x8*)(KT + (32 * jt + r32) * 144 + ks * 32 + hi * 16); sc = MFMA32(ak, bq[ks], sc); }
                if (jt == it) {
#pragma unroll
                    for (int r = 0; r < 16; ++r) if (crow(r, hi) > r32) sc[r] = 0.f;
                }
#pragma unroll
                for (int sp = 0; sp < 2; ++sp) {
                    u32x4 pw; pw.x = cvtpk(sc[8 * sp + 0], sc[8 * sp + 1]); pw.y = cvtpk(sc[8 * sp + 2], sc[8 * sp + 3]); pw.z = cvtpk(sc[8 * sp + 4], sc[8 * sp + 5]); pw.w = cvtpk(sc[8 * sp + 6], sc[8 * sp + 7]);
                    const bf16x8 pb = __builtin_bit_cast(bf16x8, pw);
                    o[0][it] = MFMA32(avp[0][2 * jt + sp], pb, o[0][it]); o[1][it] = MFMA32(avp[1][2 * jt + sp], pb, o[1][it]);
                }
            }
        }
        const float* ng = (GLA ? X.gla_g() : X.hgrn_g()) + layer * 64;
        const int gcol = GLA ? (C_AG + 64 * h) : (C_CG + 64 * h);
        const int mcol = GLA ? (64 * h) : (768 + 64 * h);
#pragma unroll
        for (int it = 0; it < 2; ++it) {
            float ss = 0.f;
#pragma unroll
            for (int vi = 0; vi < 2; ++vi)
#pragma unroll
                for (int r = 0; r < 16; ++r) ss += o[vi][it][r] * o[vi][it][r];
            ss += __shfl_xor(ss, 32);
            const float rstd = rsqrtf(ss * (1.f / 64.f) + EPS);
            const size_t row = row0 + 32 * it + r32;
#pragma unroll
            for (int vi = 0; vi < 2; ++vi)
#pragma unroll
                for (int g = 0; g < 4; ++g) { const int v0 = 32 * vi + 8 * g + 4 * hi;
                    const u32x2 gr = *(const u32x2*)(P + row * PP + gcol + v0);
                    const f32x4 gn = *(const f32x4*)(ng + v0);
                    const float g0 = bflo(gr.x), g1 = bfhi(gr.x), g2 = bflo(gr.y), g3 = bfhi(gr.y);
                    const float y0 = o[vi][it][4 * g + 0] * rstd * gn.x * (g0 * sigmoidf_(g0)), y1 = o[vi][it][4 * g + 1] * rstd * gn.y * (g1 * sigmoidf_(g1));
                    const float y2 = o[vi][it][4 * g + 2] * rstd * gn.z * (g2 * sigmoidf_(g2)), y3 = o[vi][it][4 * g + 3] * rstd * gn.w * (g3 * sigmoidf_(g3));
                    u32x2 w; w.x = cvtpk(y0, y1); w.y = cvtpk(y2, y3);
                    *(u32x2*)(X.ab() + row * DM + mcol + v0) = w; asm volatile("" ::: "memory"); }
        }
    }
}

__device__ __forceinline__ void scan_phase(const Ctx& X) {
    const int NTH = X.G * 512;
    for (int e = X.bx * 512 + X.tid; e < NBATCH * 8 * 4096; e += NTH) {
        const int b = e >> 15, rem = e & 32767, h8 = rem >> 12, vk = rem & 4095, k = vk & 63;
        float S = 0.f;
        for (int c0 = 0; c0 < 64; c0 += 8) {
            float kv[8], dc[8];
#pragma unroll
            for (int j = 0; j < 8; ++j) { const size_t cb = ((size_t)b * 64 + c0 + j) * 8 + h8; kv[j] = X.kvt()[cb * 4096 + vk]; dc[j] = X.decay()[cb * 64 + k]; }
#pragma unroll
            for (int j = 0; j < 8; ++j) { const size_t cb = ((size_t)b * 64 + c0 + j) * 8 + h8; X.st()[cb * 4096 + vk] = (bf16_t)(cvtpk(S, 0.f) & 0xffffu); S = dc[j] * S + kv[j]; }
        }
    }
}

constexpr int AT_KS = 0, AT_K0 = 4096, AT_V0 = 13312, AT_K1 = 21504, AT_V1 = 30720, AT_WL = 38912;
__device__ __forceinline__ s16x4 vtr(const LAS unsigned char* p) { typedef short v4i16_t __attribute__((ext_vector_type(4))); return __builtin_bit_cast(s16x4, __builtin_amdgcn_ds_read_tr16_b64_v4i16((LAS v4i16_t*)p)); }
__device__ __forceinline__ void attn_unit(const Ctx& X, int layer, int b, int h, int qi) {
    const int tid = X.tid, lane = X.lane, wid = X.wave, r32 = lane & 31, hi = lane >> 5;
    LAS unsigned char* lds = X.lds;
    const bf16_t* P = X.proj();
    const size_t rowbase = (size_t)b * SEQ;
    const size_t qrow = rowbase + 256 * qi + 32 * wid + r32;
    float gqm = fabsf(X.qn_g()[layer * 64 + lane]), gkm = fabsf(X.kn_g()[layer * 64 + lane]);
    gqm = wave_max(gqm); gkm = wave_max(gkm);
    const float negM = -(8.3f * gqm * gkm * LOG2E);
    bf16x8 qr[4];
#pragma unroll
    for (int d0 = 0; d0 < 4; ++d0) qr[d0] = *(const bf16x8*)(P + qrow * PP + C_BQ + 64 * h + 16 * d0 + 8 * hi);
    {
        LAS float* ks = (LAS float*)(lds + AT_KS);
#pragma unroll
        for (int e = 0; e < 2; ++e) { const int idx = tid * 2 + e, n = idx >> 6, d = idx & 63; float s = 0.f;
#pragma unroll
            for (int p = 0; p < 4; ++p) s += X.kpart()[((size_t)(b * 16 + n) * 4 + p) * 512 + 64 * h + d];
            ks[idx] = s; }
    }
    const int krow = tid >> 3, kch = tid & 7;
    const int vrow = 16 * (wid & 3) + (lane >> 2), vcl = (wid >> 2) * 32 + (lane & 3) * 8;
    const bf16_t* kg = P + (rowbase + krow) * PP + C_BK + 64 * h + 8 * kch;
    const bf16_t* vg = P + (rowbase + vrow) * PP + C_BV + 64 * h + vcl;
    u32x4 kreg = *(const u32x4*)kg, vreg = *(const u32x4*)vg;
    *(LAS u32x4*)(lds + AT_K0 + krow * 144 + kch * 16) = kreg;
    *(LAS u32x4*)(lds + AT_V0 + wid * 1024 + lane * 16) = vreg;
    __syncthreads();
    unsigned sel = 0u;
    if (qi <= 3) sel = (1u << qi) - 1u;
    else {
        float qf[32];
#pragma unroll
        for (int d0 = 0; d0 < 4; ++d0) { const u32x4 w = __builtin_bit_cast(u32x4, qr[d0]);
            qf[8 * d0 + 0] = bflo(w.x); qf[8 * d0 + 1] = bfhi(w.x); qf[8 * d0 + 2] = bflo(w.y); qf[8 * d0 + 3] = bfhi(w.y);
            qf[8 * d0 + 4] = bflo(w.z); qf[8 * d0 + 5] = bfhi(w.z); qf[8 * d0 + 6] = bflo(w.w); qf[8 * d0 + 7] = bfhi(w.w); }
        float gt[15];
        const LAS float* ks = (const LAS float*)(lds + AT_KS);
#pragma unroll
        for (int n = 0; n < 15; ++n) {
            float s = 0.f;
            if (n < qi) {
#pragma unroll
                for (int d0 = 0; d0 < 4; ++d0) { const f32x4 k0 = *(const LAS f32x4*)(ks + n * 64 + 16 * d0 + 8 * hi), k1 = *(const LAS f32x4*)(ks + n * 64 + 16 * d0 + 8 * hi + 4);
                    s += qf[8 * d0 + 0] * k0.x + qf[8 * d0 + 1] * k0.y + qf[8 * d0 + 2] * k0.z + qf[8 * d0 + 3] * k0.w + qf[8 * d0 + 4] * k1.x + qf[8 * d0 + 5] * k1.y + qf[8 * d0 + 6] * k1.z + qf[8 * d0 + 7] * k1.w; }
                s += __shfl_xor(s, 32);
                asm volatile("" ::: "memory");
            }
            gt[n] = (n < qi) ? s : -INFINITY;
        }
#pragma unroll
        for (int pass = 0; pass < 3; ++pass) {
            float best = -INFINITY; int bi = -1;
#pragma unroll
            for (int n = 0; n < 15; ++n) if (gt[n] > best) { best = gt[n]; bi = n; }
            if (bi >= 0) sel |= 1u << bi;
#pragma unroll
            for (int n = 0; n < 15; ++n) if (n == bi) gt[n] = -INFINITY;
        }
    }
    f32x16 o0 = {}, o1 = {}; float lsum = 0.f;
    const int T = 4 * (qi + 1);
    const int vpo = ((lane >> 4) & 1) * 32 + (lane & 3) * 8 + (4 * hi + ((lane & 15) >> 2)) * 64;
    for (int t = 0; t < T; ++t) {
        const int cur = t & 1;
        if (t + 1 < T) { kreg = *(const u32x4*)(kg + (size_t)(t + 1) * 64 * PP); vreg = *(const u32x4*)(vg + (size_t)(t + 1) * 64 * PP); }
        const int j = t >> 2, tt = t & 3; const bool own = (j == qi);
        const bool mysel = ((sel >> j) & 1u) != 0u;
        const bool need = own ? (64 * tt <= 32 * wid + 31) : (__any((int)mysel) != 0);
        if (need) {
            const LAS unsigned char* Kb = lds + (cur ? AT_K1 : AT_K0);
            const LAS unsigned char* Vb = lds + (cur ? AT_V1 : AT_V0);
            f32x16 p0, p1;
#pragma unroll
            for (int r = 0; r < 16; ++r) { p0[r] = negM; p1[r] = negM; }
#pragma unroll
            for (int d0 = 0; d0 < 4; ++d0) {
                const bf16x8 a0 = *(const LAS bf16x8*)(Kb + r32 * 144 + d0 * 32 + hi * 16);
                const bf16x8 a1 = *(const LAS bf16x8*)(Kb + (32 + r32) * 144 + d0 * 32 + hi * 16);
                p0 = MFMA32(a0, qr[d0], p0); p1 = MFMA32(a1, qr[d0], p1);
            }
            const int qrel = 32 * wid + r32;
#pragma unroll
            for (int r = 0; r < 16; ++r) {
                const int kv = 64 * tt + crow(r, hi);
                float e0 = __builtin_amdgcn_exp2f(p0[r]), e1 = __builtin_amdgcn_exp2f(p1[r]);
                const bool k0 = own ? (kv <= qrel) : mysel, k1 = own ? (kv + 32 <= qrel) : mysel;
                e0 = k0 ? e0 : 0.f; e1 = k1 ? e1 : 0.f;
                p0[r] = e0; p1[r] = e1; lsum += e0 + e1;
            }
            bf16x8 pa[4];
#pragma unroll
            for (int s = 0; s < 2; ++s) {
                u32x4 w0; w0.x = cvtpk(p0[8 * s + 0], p0[8 * s + 1]); w0.y = cvtpk(p0[8 * s + 2], p0[8 * s + 3]); w0.z = cvtpk(p0[8 * s + 4], p0[8 * s + 5]); w0.w = cvtpk(p0[8 * s + 6], p0[8 * s + 7]);
                u32x4 w1; w1.x = cvtpk(p1[8 * s + 0], p1[8 * s + 1]); w1.y = cvtpk(p1[8 * s + 2], p1[8 * s + 3]); w1.z = cvtpk(p1[8 * s + 4], p1[8 * s + 5]); w1.w = cvtpk(p1[8 * s + 6], p1[8 * s + 7]);
                pa[s] = __builtin_bit_cast(bf16x8, w0); pa[2 + s] = __builtin_bit_cast(bf16x8, w1);
            }
#pragma unroll
            for (int ks = 0; ks < 4; ++ks) {
                const s16x4 l0 = vtr(Vb + vpo + ks * 1024), h0 = vtr(Vb + vpo + ks * 1024 + 512);
                const s16x4 l1 = vtr(Vb + vpo + 4096 + ks * 1024), h1 = vtr(Vb + vpo + 4096 + ks * 1024 + 512);
                const bf16x8 vb0 = (bf16x8){l0[0], l0[1], l0[2], l0[3], h0[0], h0[1], h0[2], h0[3]};
                const bf16x8 vb1 = (bf16x8){l1[0], l1[1], l1[2], l1[3], h1[0], h1[1], h1[2], h1[3]};
                o0 = MFMA32(pa[ks], vb0, o0); o1 = MFMA32(pa[ks], vb1, o1);
            }
        }
        if (t + 1 < T) {
            *(LAS u32x4*)(lds + (cur ? AT_K0 : AT_K1) + krow * 144 + kch * 16) = kreg;
            *(LAS u32x4*)(lds + (cur ? AT_V0 : AT_V1) + wid * 1024 + lane * 16) = vreg;
        }
        __syncthreads();
    }
    lsum += __shfl_xor(lsum, 32);
    LAS float* wlf = (LAS float*)(lds + AT_WL) + wid * 32;
    if (hi == 0) wlf[r32] = lsum;
    __syncthreads();
    bf16_t* orow = X.ab() + (rowbase + 256 * qi + 32 * wid) * DM + 256 + 64 * h;
#pragma unroll
    for (int r = 0; r < 16; ++r) { const int q = crow(r, hi); const float rl = 1.0f / wlf[q];
        orow[(size_t)q * DM + r32] = (bf16_t)(cvtpk(o0[r] * rl, 0.f) & 0xffffu);
        orow[(size_t)q * DM + 32 + r32] = (bf16_t)(cvtpk(o1[r] * rl, 0.f) & 0xffffu); }
    __syncthreads();
}

__device__ __forceinline__ void router_phase(const Ctx& X, int layer) {
    LAS float* wr = (LAS float*)X.lds;
    for (int i = X.tid; i < 20 * DM; i += 512) { const int c = i / DM, k = i % DM;
        wr[i] = (c < 4) ? X.w_rg()[(size_t)layer * DM * 4 + k * 4 + c] : X.w_re()[(size_t)layer * DM * 16 + k * 16 + (c - 4)]; }
    __syncthreads();
    const int lane = X.lane;
    for (int m = X.gw; m < NTOK; m += X.NGW) {
        f32x4 v[4]; rownorm(X.out() + (size_t)m * DM, X.ffn_g() + layer * DM, X.ab() + (size_t)m * DM, lane, v);
        float lg[20];
#pragma unroll
        for (int c = 0; c < 20; ++c) { float s = 0.f;
#pragma unroll
            for (int j = 0; j < 4; ++j) { const f32x4 w = *(const LAS f32x4*)(wr + c * DM + 4 * (64 * j + lane)); s += v[j].x * w.x + v[j].y * w.y + v[j].z * w.z + v[j].w * w.w; }
            lg[c] = wave_sum(s); asm volatile("" ::: "memory"); }
        int gs = 0; float gm = lg[0];
#pragma unroll
        for (int c = 1; c < 4; ++c) if (lg[c] > gm) { gm = lg[c]; gs = c; }
        float den = 0.f;
#pragma unroll
        for (int c = 0; c < 4; ++c) den += __expf(lg[c] - gm);
        const float pg = 1.0f / den;
        float le[4];
#pragma unroll
        for (int j = 0; j < 4; ++j) le[j] = gs == 0 ? lg[4 + j] : gs == 1 ? lg[8 + j] : gs == 2 ? lg[12 + j] : lg[16 + j];
        int i1 = 0; float v1 = le[0];
#pragma unroll
        for (int j = 1; j < 4; ++j) if (le[j] > v1) { v1 = le[j]; i1 = j; }
        int i2 = -1; float v2 = -INFINITY;
#pragma unroll
        for (int j = 0; j < 4; ++j) if (j != i1 && le[j] > v2) { v2 = le[j]; i2 = j; }
        const float ex = __expf(v2 - v1); const float w1 = pg / (1.f + ex), w2 = pg * ex / (1.f + ex);
        if (lane == 0) {
            const int e0 = 4 * gs + i1, e1 = 4 * gs + i2;
            const unsigned p0 = atomicAdd(X.ctl() + layer * 16 + e0, 1u), p1 = atomicAdd(X.ctl() + layer * 16 + e1, 1u);
            unsigned* rt = X.route() + (size_t)m * 8;
            rt[0] = (unsigned)e0; rt[1] = (unsigned)e1; rt[2] = p0; rt[3] = p1; rt[4] = __float_as_uint(w1); rt[5] = __float_as_uint(w2);
        }
    }
}

__device__ __forceinline__ int expert_off_rows(const Ctx& X, int layer, int lane) {
    const int e = lane & 15; const unsigned c = __hip_atomic_load(X.ctl() + layer * 16 + e, __ATOMIC_RELAXED, __HIP_MEMORY_SCOPE_AGENT);
    const int tiles = (int)((c + 255u) >> 8); int incl = tiles;
#pragma unroll
    for (int o = 1; o < 16; o <<= 1) { const int t = __shfl_up(incl, o, 16); if (e >= o) incl += t; }
    return (incl - tiles) * 256;
}

__device__ __forceinline__ void gather_phase(const Ctx& X, int layer) {
    const int lane = X.lane; const int off = expert_off_rows(X, layer, lane);
    for (int m = X.gw; m < NTOK; m += X.NGW) {
        unsigned* rt = X.route() + (size_t)m * 8;
        const unsigned e0 = rt[0], e1 = rt[1], p0 = rt[2], p1 = rt[3];
        const int s0 = __shfl(off, (int)e0) + (int)p0, s1 = __shfl(off, (int)e1) + (int)p1;
        const u32x4* src = (const u32x4*)(X.ab() + (size_t)m * DM);
        const u32x4 a = src[lane], bq = src[64 + lane];
        u32x4* d0 = (u32x4*)(X.aperm() + (size_t)s0 * DM); u32x4* d1 = (u32x4*)(X.aperm() + (size_t)s1 * DM);
        d0[lane] = a; d0[64 + lane] = bq; d1[lane] = a; d1[64 + lane] = bq;
        if (lane == 0) { X.slotw()[s0] = __uint_as_float(rt[4]); X.slotw()[s1] = __uint_as_float(rt[5]); rt[6] = (unsigned)s0; rt[7] = (unsigned)s1; }
    }
}
__device__ __forceinline__ void moe_table(const Ctx& X, int layer) {
    volatile LAS int* toff = (volatile LAS int*)(X.lds + MISC_OFF);
    if (X.tid < 64) { const int off = expert_off_rows(X, layer, X.lane);
        if (X.lane < 16) toff[X.lane] = off >> 8;
        if (X.lane == 15) { const unsigned c = __hip_atomic_load(X.ctl() + layer * 16 + 15, __ATOMIC_RELAXED, __HIP_MEMORY_SCOPE_AGENT); toff[16] = (off >> 8) + (int)((c + 255u) >> 8); } }
    __syncthreads();
}

__device__ __forceinline__ void combine_phase(const Ctx& X, int layer) {
    const int lane = X.lane;
    for (int m = X.gw; m < NTOK; m += X.NGW) {
        const unsigned* rt = X.route() + (size_t)m * 8; const unsigned s0 = rt[6], s1 = rt[7];
        float* xr = X.out() + (size_t)m * DM;
        const u32x2* y0 = (const u32x2*)(X.aperm() + (size_t)s0 * DM) + lane; const u32x2* y1 = (const u32x2*)(X.aperm() + (size_t)s1 * DM) + lane;
        f32x4 v[4]; float ss = 0.f;
#pragma unroll
        for (int j = 0; j < 4; ++j) { const f32x4 xv = ((const f32x4*)xr)[64 * j + lane]; const u32x2 a = y0[64 * j], bq = y1[64 * j];
            f32x4 r; r.x = xv.x + bflo(a.x) + bflo(bq.x); r.y = xv.y + bfhi(a.x) + bfhi(bq.x); r.z = xv.z + bflo(a.y) + bflo(bq.y); r.w = xv.w + bfhi(a.y) + bfhi(bq.y);
            v[j] = r; ((f32x4*)xr)[64 * j + lane] = r; ss += (r.x * r.x + r.y * r.y) + (r.z * r.z + r.w * r.w); }
        if (layer + 1 < DEPTH) {
            const float rstd = rsqrtf(wave_sum(ss) * (1.f / DM) + EPS);
            const f32x4* gr = (const f32x4*)(X.attn_g() + (layer + 1) * DM) + lane; u32x2* o8 = (u32x2*)(X.ab() + (size_t)m * DM) + lane;
#pragma unroll
            for (int j = 0; j < 4; ++j) { const f32x4 gg = gr[64 * j]; const f32x4 hh = v[j] * rstd * gg; u32x2 w; w.x = cvtpk(hh.x, hh.y); w.y = cvtpk(hh.z, hh.w); o8[64 * j] = w; }
        }
    }
}

#ifndef PHMASK
#define PHMASK 0xffff
#endif
constexpr int NPHASE = 1 + 10 * DEPTH;
__global__ void __launch_bounds__(512, 2) fwd_kernel(Args args) {
    extern __shared__ __attribute__((aligned(16))) unsigned char lds_raw[];
    cg::grid_group grid = cg::this_grid();
    const int lo = args.ph_lo, hi = args.ph_hi;
    for (int ph = lo; ph < hi; ++ph) {
        if (ph > lo) grid.sync();
        Ctx X;
        X.lds = (LAS unsigned char*)lds_raw;
        { int t = threadIdx.x; asm volatile("" : "+v"(t)); X.tid = t; X.lane = t & 63; X.wave = __builtin_amdgcn_readfirstlane(t >> 6); }
        { int bx = blockIdx.x, G = gridDim.x; asm volatile("" : "+s"(bx), "+s"(G)); X.G = G; X.vcu = (G % 8 == 0) ? (bx % 8) * (G / 8) + bx / 8 : bx; X.bx = bx; }
        X.gw = X.vcu * 8 + X.wave; X.NGW = X.G * 8;
        { unsigned char* w = args.ws; float* o = args.out; asm volatile("" : "+s"(w), "+s"(o)); X.ws_ = w; X.out_ = o; }
#pragma unroll
        for (int i = 0; i < 17; ++i) X.in_[i] = args.in[i];
        if (ph == 0) { if (PHMASK & 1) phase0(X); continue; }
        const int layer = (ph - 1) / 10, k = (ph - 1) % 10 + 1;
        if (!((PHMASK >> k) & 1)) continue;
        switch (k) {
        case 1: {
            pg8::Gemm g{X.ab(), X.win() + (size_t)layer * NW_IN * DM, DM}; pg8::StaticOrder S; S.init(NTOK, NW_IN, X.G, X.bx);
            EpiProj E{X.proj(), X.lr()};
            pg8::gemm_phase<EpiProj, pg8::StaticOrder>(X.lds, g, S, E, X.tid);
        } break;
        case 2: {
            for (int it = X.vcu; it < 256; it += X.G) moba_prep_item(X, layer, it);
            LAS unsigned char* wl = X.lds + X.wave * WAVE_LDS;
            for (int it = X.gw; it < 2048; it += X.NGW) { const int h8 = it & 7, bc = it >> 3, b = bc >> 6, c = bc & 63;
                if (h8 < 4) lin_item<true, false>(X, layer, b, c, h8, wl); else lin_item<false, false>(X, layer, b, c, h8 - 4, wl); }
        } break;
        case 3: scan_phase(X); break;
        case 4: {
            if (PHMASK & 0x800) for (int v = X.vcu; v < 256; v += X.G) { const int bh = v >> 3, s = v & 7; attn_unit(X, layer, bh >> 3, bh & 7, s); attn_unit(X, layer, bh >> 3, bh & 7, 15 - s); }
            LAS unsigned char* wl = X.lds + X.wave * WAVE_LDS;
            if (PHMASK & 0x1000) for (int it = X.gw; it < 2048; it += X.NGW) { const int h8 = it & 7, bc = it >> 3, b = bc >> 6, c = bc & 63;
                if (h8 < 4) lin_item<true, true>(X, layer, b, c, h8, wl); else lin_item<false, true>(X, layer, b, c, h8 - 4, wl); }
        } break;
        case 5: {
            pg8::Gemm g{X.ab(), X.wout() + (size_t)layer * DM * DM, DM}; pg8::StaticOrder S; S.init(NTOK, DM, X.G, X.bx);
            EpiResid E{layer == 0 ? X.x() : X.out(), X.out()};
            pg8::gemm_phase<EpiResid, pg8::StaticOrder>(X.lds, g, S, E, X.tid);
        } break;
        case 6: router_phase(X, layer); break;
        case 7: gather_phase(X, layer); break;
        case 8: {
            moe_table(X, layer);
            pg8::Gemm g{X.aperm(), X.wgu(), DM}; pg8::GroupedOrder S{(const volatile LAS int*)(X.lds + MISC_OFF), X.G, X.vcu, layer * 64};
            EpiSwiglu E{X.hbuf()};
            pg8::gemm_phase<EpiSwiglu, pg8::GroupedOrder>(X.lds, g, S, E, X.tid);
        } break;
        case 9: {
            moe_table(X, layer);
            pg8::Gemm g{X.hbuf(), X.wd(), FF}; pg8::GroupedOrder S{(const volatile LAS int*)(X.lds + MISC_OFF), X.G, X.vcu, layer * 64};
            EpiDown E{X.aperm(), X.slotw()};
            pg8::gemm_phase<EpiDown, pg8::GroupedOrder>(X.lds, g, S, E, X.tid);
        } break;
        case 10: combine_phase(X, layer); break;
        }
        __syncthreads();
    }
}

extern "C" void kernel_launch(void* const* d_in, const int* in_sizes, int n_in, void* d_out, int out_size, void* d_ws, size_t ws_size, hipStream_t stream) {
    static int grid = 0;
    if (grid == 0) {
        if (n_in != 17 || out_size != NTOK * DM || ws_size < WS_END) { fprintf(stderr, "kernel_launch: unexpected problem (n_in %d out %d ws %zu)\n", n_in, out_size, ws_size); grid = -1; return; }
        int dev = 0, cus = 0, per_cu = 0;
        hipGetDevice(&dev); hipDeviceGetAttribute(&cus, hipDeviceAttributeMultiprocessorCount, dev);
        if (hipFuncSetAttribute((const void*)fwd_kernel, hipFuncAttributeMaxDynamicSharedMemorySize, LDS_BYTES) != hipSuccess) { fprintf(stderr, "kernel_launch: hipFuncSetAttribute failed\n"); }
        if (hipOccupancyMaxActiveBlocksPerMultiprocessor(&per_cu, (const void*)fwd_kernel, 512, LDS_BYTES) != hipSuccess || per_cu < 1) { fprintf(stderr, "kernel_launch: occupancy query says %d\n", per_cu); per_cu = 1; }
        (void)hipGetLastError();
        grid = cus * per_cu;
        fprintf(stderr, "kernel_launch: grid %d (cus %d x %d), ws %zu\n", grid, cus, per_cu, ws_size);
    }
    if (grid < 0) return;
    Args a{};
    for (int i = 0; i < 17; ++i) a.in[i] = (const float*)d_in[i];
    a.out = (float*)d_out; a.ws = (unsigned char*)d_ws;
#if MK_PER_PHASE
    for (int ph = 0; ph < NPHASE; ++ph) { a.ph_lo = ph; a.ph_hi = ph + 1; hipLaunchKernelGGL(fwd_kernel, dim3(grid), dim3(512), LDS_BYTES, stream, a); }
#else
    a.ph_lo = 0; a.ph_hi = NPHASE;
    void* kargs[] = {&a};
    hipError_t e = hipLaunchCooperativeKernel((const void*)fwd_kernel, dim3(grid), dim3(512), kargs, LDS_BYTES, stream);
    if (e != hipSuccess) fprintf(stderr, "cooperative launch failed: %s (grid %d)\n", hipGetErrorString(e), grid);
#endif
}
```

```cpp
#include <hip/hip_runtime.h>
#include <hip/hip_cooperative_groups.h>
#include <cstdio>
#include <cstdint>
#include <cstddef>
namespace cg = cooperative_groups;

#ifndef MK_PER_PHASE
#define MK_PER_PHASE 0
#endif

#define LAS __attribute__((address_space(3)))
typedef unsigned short bf16_t;
typedef short bf16x8 __attribute__((ext_vector_type(8)));
typedef short s16x4 __attribute__((ext_vector_type(4)));
typedef float f32x2 __attribute__((ext_vector_type(2)));
typedef float f32x4 __attribute__((ext_vector_type(4)));
typedef float f32x16 __attribute__((ext_vector_type(16)));
typedef unsigned u32x2 __attribute__((ext_vector_type(2)));
typedef unsigned u32x4 __attribute__((ext_vector_type(4)));
typedef __bf16 bf16x2_t __attribute__((ext_vector_type(2)));

constexpr int NTOK = 16384, DM = 1024, SEQ = 4096, NBATCH = 4, DEPTH = 2;
constexpr int IN_COLS = 3344;
constexpr int PP = 3328;
constexpr int NW_IN = 3584;
constexpr int C_AQ = 0, C_AK = 128, C_AV = 256, C_AG = 512, C_BQ = 768, C_BK = 1280, C_BV = 1792, C_CQ = 2304, C_CF = 2560, C_CI = 2816, C_CG = 3072;
constexpr int NEXP = 16, FF = 512;
constexpr int MOE_ROWS = 36864;
constexpr float EPS = 1e-6f;
constexpr float LOG2E = 1.4426950408889634f;

constexpr size_t MiB = 1u << 20;
constexpr size_t WS_CTL = 0;
constexpr size_t WS_SMALL = 1 * MiB;
constexpr size_t SM_COS = WS_SMALL, SM_SIN = WS_SMALL + 128 * 1024;
constexpr size_t SM_LR = WS_SMALL + 256 * 1024;
constexpr size_t SM_KPART = WS_SMALL + 768 * 1024;
constexpr size_t SM_DECAY = WS_SMALL + 1280 * 1024;
constexpr size_t SM_ROUTE = WS_SMALL + 1792 * 1024;
constexpr size_t SM_SLOTW = WS_SMALL + 2304 * 1024;
constexpr size_t SM_AMAP = WS_SMALL + 2816 * 1024;
constexpr size_t SM_WGCNT = WS_SMALL + 2560 * 1024;
constexpr int CW_BAR = 4096;
constexpr size_t CTL_ZERO_BYTES = 65536;
constexpr size_t WS_WIN = 5 * MiB;
constexpr size_t WS_WOUT = 19 * MiB;
constexpr size_t WS_WGU = 23 * MiB;
constexpr size_t WS_X1B = 23 * MiB + 32 * MiB;
constexpr size_t WS_WD = 87 * MiB;
constexpr size_t WS_H8 = 103 * MiB;
constexpr size_t WS_PROJ = 119 * MiB;
constexpr size_t WS_ST = 223 * MiB;
constexpr size_t WS_AB = 239 * MiB;
constexpr size_t WS_END = 271 * MiB;
constexpr size_t WS_APERM = WS_PROJ;
constexpr size_t WS_H = WS_PROJ + 72 * MiB;
static_assert(WS_H + (size_t)MOE_ROWS * FF * 2 <= WS_AB, "moe overlay");

constexpr int LDS_BYTES = 159744;
constexpr int MISC_OFF = 147456;
constexpr int GROW_OFF = MISC_OFF + 1024;
constexpr int WAVE_LDS = 18432;

__device__ __forceinline__ unsigned cvtpk(float lo, float hi) { f32x2 v = {lo, hi}; bf16x2_t b = __builtin_convertvector(v, bf16x2_t); return __builtin_bit_cast(unsigned, b); }
__device__ __forceinline__ float bf2f(unsigned short u) { return __builtin_bit_cast(float, (unsigned)u << 16); }
__device__ __forceinline__ float bflo(unsigned u) { return __builtin_bit_cast(float, u << 16); }
__device__ __forceinline__ float bfhi(unsigned u) { return __builtin_bit_cast(float, u & 0xffff0000u); }
#define DPP_ADD(v, ctrl) ((v) + __builtin_bit_cast(float, __builtin_amdgcn_update_dpp(0, __builtin_bit_cast(int, (v)), (ctrl), 0xf, 0xf, true)))
__device__ __forceinline__ float wave_sum(float v) {
    v = DPP_ADD(v, 0xB1); v = DPP_ADD(v, 0x4E); v = DPP_ADD(v, 0x141); v = DPP_ADD(v, 0x140);
    const int iv = __builtin_bit_cast(int, v);
    const float r0 = __builtin_bit_cast(float, __builtin_amdgcn_readlane(iv, 0)), r1 = __builtin_bit_cast(float, __builtin_amdgcn_readlane(iv, 16));
    const float r2 = __builtin_bit_cast(float, __builtin_amdgcn_readlane(iv, 32)), r3 = __builtin_bit_cast(float, __builtin_amdgcn_readlane(iv, 48));
    return (r0 + r1) + (r2 + r3);
}
__device__ __forceinline__ float wave_max(float v) {
#pragma unroll
    for (int o = 1; o < 64; o <<= 1) v = fmaxf(v, __shfl_xor(v, o));
    return v;
}
__device__ __forceinline__ int crow(int r, int hi) { return (r & 3) + 8 * (r >> 2) + 4 * hi; }
__device__ __forceinline__ float sigmoidf_(float x) { return 1.0f / (1.0f + __expf(-x)); }
#define MFMA32(a, b, c) __builtin_amdgcn_mfma_f32_32x32x16_bf16((a), (b), (c), 0, 0, 0)

__device__ __forceinline__ void glds16(const void* sbase, unsigned voff, unsigned lds_dst) { unsigned keep;
    asm volatile("s_mov_b32 %0, m0\n\ts_mov_b32 m0, %3\n\ts_nop 0\n\tglobal_load_lds_dwordx4 %1, %2\n\ts_mov_b32 m0, %0" : "=&s"(keep) : "v"(voff), "s"(sbase), "s"(lds_dst) : "memory"); }

namespace pg8 {
#define PG8_LAS __attribute__((address_space(3)))
constexpr int BM = 256, BK = 64, HALF = 128, HTB = HALF * BK * 2, STAGE_BYTES = 8 * HTB, NXCD = 8, WGM = 8;
__host__ __device__ __forceinline__ int lds_byte(int r, int c) { const int st = (r >> 4) * 2 + (c >> 5), rr = r & 15, cc = c & 31, ob = rr * 64 + cc * 2; return st * 1024 + (ob ^ (((ob >> 9) & 1) << 5)); }
__host__ __device__ __forceinline__ void stage_rc(int b, int& R, int& C) { const int st = b / 1024, sb = b % 1024, swz = sb ^ (((sb >> 9) & 1) << 5); R = (st >> 1) * 16 + swz / 64; C = (st & 1) * 32 + (swz % 64) / 2; }
__host__ __device__ __forceinline__ int perm32(int rho) { const int n = rho >> 4, i = rho & 15; return 8 * (i >> 2) + 4 * n + (i & 3); }

struct Unit { int pm, pn, bt; };
struct Gemm { const bf16_t* A; const bf16_t* Bt; int K; };

struct StaticOrder {
    int nM, nN, nwg, G, c, compact, skew; unsigned long long tbl;
    __device__ void init(int M, int N, int G_, int c_, unsigned long long tbl_ = 0xFEDCBA9876543210ull, int compact_ = 0, int skew_ = 0) { nM = M / BM; nN = N / BM; nwg = nM * nN; G = G_; c = c_; tbl = tbl_; compact = compact_; skew = skew_; }
    __device__ bool next(int i, Unit& u) const {
        long L = (long)i * G + c;
        if (skew && i > 0) { const int hg = G >> 1; if (c < hg) return false; L = (long)G + (long)(i - 1) * hg + (c - hg); }
        if (L >= nwg) return false;
        int wgid = (int)L; { const int q = nwg / NXCD, r = nwg % NXCD, xcd = wgid % NXCD, off = wgid / NXCD; wgid = (xcd < r ? xcd * (q + 1) : r * (q + 1) + (xcd - r) * q) + off; }
        const int nig = WGM * nN, gid = wgid / nig, fm = gid * WGM, gsz = (nM - fm) < WGM ? (nM - fm) : WGM;
        u.pm = fm + ((wgid % nig) % gsz); { const int pn_ = (wgid % nig) / gsz; u.pn = (int)((tbl >> (4 * pn_)) & 15ull); u.bt = compact ? pn_ : u.pn; } return true;
    }
    __device__ __forceinline__ void a_ready(const Unit&) const {}
    __device__ __forceinline__ void done(const Unit&) const {}
};
struct GroupedOrder {
    const volatile PG8_LAS int* toff; int G, vcu, wbase;
    __device__ bool next(int i, Unit& u) const {
        const int U = i * G + vcu; const int total = toff[16];
        if (U >= total * 4) return false;
        const int rt = U >> 2, pn = U & 3; int e = 0;
#pragma unroll
        for (int j = 1; j < 16; ++j) e += (rt >= toff[j]) ? 1 : 0;
        u.pm = __builtin_amdgcn_readfirstlane(rt); u.pn = __builtin_amdgcn_readfirstlane(pn); u.bt = __builtin_amdgcn_readfirstlane(wbase + e * 4 + pn); return true;
    }
    __device__ __forceinline__ void a_ready(const Unit&) const {}
    unsigned* cnt; PG8_LAS unsigned* wgarr;
    mutable int dp0, dp1, dp2, ndp;
    __device__ __forceinline__ void done(const Unit& u) const {
        { const int n8 = toff[16] * 4, rem = n8 - (n8 / G) * G;
          if (vcu >= rem) { if (ndp == 0) dp0 = u.pm; else if (ndp == 1) dp1 = u.pm; else dp2 = u.pm; ++ndp; return; } }
        asm volatile("s_waitcnt vmcnt(0)" ::: "memory");
        unsigned old = 0u;
        if (__builtin_amdgcn_mbcnt_hi(~0u, __builtin_amdgcn_mbcnt_lo(~0u, 0u)) == 0u) old = __hip_atomic_fetch_add(wgarr, 1u, __ATOMIC_RELAXED, __HIP_MEMORY_SCOPE_WORKGROUP);
        old = (unsigned)__builtin_amdgcn_readfirstlane((int)old);
        if ((old & 7u) == 7u) {
            __builtin_amdgcn_fence(__ATOMIC_RELEASE, "agent");
            if (__builtin_amdgcn_mbcnt_hi(~0u, __builtin_amdgcn_mbcnt_lo(~0u, 0u)) == 0u) __hip_atomic_fetch_add(cnt + u.pm, 1u, __ATOMIC_RELAXED, __HIP_MEMORY_SCOPE_AGENT);
        }
    }
    __device__ __forceinline__ void finish(int wid) const {
        if (ndp > 0 && wid == 0) {
            __builtin_amdgcn_fence(__ATOMIC_RELEASE, "agent");
            if (__builtin_amdgcn_mbcnt_hi(~0u, __builtin_amdgcn_mbcnt_lo(~0u, 0u)) == 0u) {
                __hip_atomic_fetch_add(cnt + dp0, 1u, __ATOMIC_RELAXED, __HIP_MEMORY_SCOPE_AGENT);
                if (ndp > 1) __hip_atomic_fetch_add(cnt + dp1, 1u, __ATOMIC_RELAXED, __HIP_MEMORY_SCOPE_AGENT);
                if (ndp > 2) __hip_atomic_fetch_add(cnt + dp2, 1u, __ATOMIC_RELAXED, __HIP_MEMORY_SCOPE_AGENT);
            }
        }
    }
};
struct GroupedOrderDown {
    const volatile PG8_LAS int* toff; int G, vcu, wbase; unsigned* cnt;
    __device__ bool next(int i, Unit& u) const {
        const int n8 = toff[16] * 4, R = n8 / G, rem = n8 - R * G; int q;
        if (vcu < rem) { if (i > 0) return false; q = R * G + vcu; }
        else { q = (vcu - rem) + (G - rem) * i; if (q >= R * G) return false; }
        const int rt = q >> 2, pn = q & 3; int e = 0;
#pragma unroll
        for (int j = 1; j < 16; ++j) e += (rt >= toff[j]) ? 1 : 0;
        u.pm = __builtin_amdgcn_readfirstlane(rt); u.pn = __builtin_amdgcn_readfirstlane(pn); u.bt = __builtin_amdgcn_readfirstlane(wbase + e * 4 + pn); return true;
    }
    PG8_LAS unsigned* acq; int wid; mutable unsigned ncall;
    __device__ __forceinline__ void a_ready(const Unit& u) const {
        const unsigned k = ++ncall; unsigned sp = 0;
        if (wid == 0) {
            while ((unsigned)__builtin_amdgcn_readfirstlane((int)__hip_atomic_load(cnt + u.pm, __ATOMIC_RELAXED, __HIP_MEMORY_SCOPE_AGENT)) < 4u) { __builtin_amdgcn_s_sleep(4); if (++sp > (1u << 22)) break; }
            __builtin_amdgcn_fence(__ATOMIC_ACQUIRE, "agent");
            __hip_atomic_store(acq, k, __ATOMIC_RELEASE, __HIP_MEMORY_SCOPE_WORKGROUP);
        } else {
            while ((unsigned)__builtin_amdgcn_readfirstlane((int)__hip_atomic_load(acq, __ATOMIC_ACQUIRE, __HIP_MEMORY_SCOPE_WORKGROUP)) < k) { __builtin_amdgcn_s_sleep(2); if (++sp > (1u << 24)) break; }
        }
        asm volatile("" ::: "memory");
    }
    __device__ __forceinline__ void done(const Unit&) const {}
};

template <class Epi, class Sched, bool GATHER = false, bool FP8 = false>
__device__ __forceinline__ void gemm_phase(PG8_LAS unsigned char* lds, const Gemm g, const Sched& S, const Epi& E, const int tid, const unsigned* amap = nullptr, unsigned amap_max = 0u) {
    const int  wid = __builtin_amdgcn_readfirstlane(tid >> 6), lane = tid & 63, wr = wid >> 2, wc = wid & 3, fr = lane & 15, fq = lane >> 4;
    int Kq_ = g.K; asm volatile("" : "+s"(Kq_));
    const int K = Kq_, nt = K / BK;
    unsigned voffA[2], voffB[2]; int gR[2]; unsigned gC[2];
#pragma unroll
    for (int i = 0; i < 2; ++i) { int R, C; stage_rc(tid * 16 + i * 8192, R, C); const int Rb = Epi::PERM ? ((R & ~31) + perm32(R & 31)) : R;
        voffA[i] = (unsigned)(R * K + C) * 2u; voffB[i] = (unsigned)(Rb * K + C) * 2u; gR[i] = R; gC[i] = (unsigned)C * 2u; }
    unsigned arC[2][2];
    PG8_LAS unsigned* arNp = (PG8_LAS unsigned*)(lds + 147456 + 1024 + tid * 16);
#define PG8_GROWS(dst, pm_) do { _Pragma("unroll") for (int h_ = 0; h_ < 2; ++h_) _Pragma("unroll") for (int i_ = 0; i_ < 2; ++i_) { \
        unsigned tk_ = amap[(size_t)(pm_) * 256 + h_ * 128 + gR[0] + 64 * i_]; tk_ = tk_ < amap_max ? tk_ : amap_max; dst[h_][i_] = tk_ * (unsigned)(K * 2) + gC[0]; } } while (0)
    const size_t kstep = (size_t)(BK * 2);
    const size_t hstep = (size_t)HALF * K * 2;
    const size_t tstep = 2 * hstep;
    const unsigned ldsw = (unsigned)wid * 1024u; const unsigned lds0_ = (unsigned)(uintptr_t)lds;
    const int aoff = lds_byte(wr * 64 + fr, fq * 8), boff = lds_byte(wc * 32 + fr, fq * 8);
#define PG8_SA(b, h) (((b) * 2 + (h)) * HTB)
#define PG8_SB(b, h) ((4 + (b) * 2 + (h)) * HTB)
#define PG8_STAGE(bufoff, gbase, voff) do { const unsigned long long gb_ = (unsigned long long)(uintptr_t)(gbase); \
        const void* sb_ = (const void*)(uintptr_t)(((unsigned long long)(unsigned)__builtin_amdgcn_readfirstlane((int)(gb_ >> 32)) << 32) | (unsigned long long)(unsigned)__builtin_amdgcn_readfirstlane((int)gb_)); \
        _Pragma("unroll") for (int _i = 0; _i < 2; ++_i) \
        glds16(sb_, (voff)[_i], (unsigned)__builtin_amdgcn_readfirstlane((int)(lds0_ + (unsigned)(bufoff) + ldsw + (unsigned)(_i * 8192)))); } while (0)
#define PG8_STAGEA(bufoff, gbase, h, isn) do { if (GATHER) { unsigned vo_[2] = {arC[h][0], arC[h][1]}; if (isn) { vo_[0] = arNp[2 * (h)]; vo_[1] = arNp[2 * (h) + 1]; } PG8_STAGE(bufoff, gbase, vo_); } \
        else { PG8_STAGE(bufoff, (gbase) + (h) * hstep, voffA); } } while (0)
    typedef int pg8_v4i __attribute__((ext_vector_type(4))); typedef int pg8_v8i __attribute__((ext_vector_type(8)));
#define PG8_LDA(dst, b, h) do { _Pragma("unroll") for (int m = 0; m < 4; ++m) { if (FP8) { const pg8_v4i l_ = *(const PG8_LAS pg8_v4i*)(lds + PG8_SA(b, h) + aoff + m * 2048), h_ = *(const PG8_LAS pg8_v4i*)(lds + PG8_SA(b, h) + aoff + m * 2048 + 1024); \
            dst##8[m] = __builtin_shufflevector(l_, h_, 0, 1, 2, 3, 4, 5, 6, 7); } \
        else { _Pragma("unroll") for (int k = 0; k < 2; ++k) dst[m][k] = *(const PG8_LAS bf16x8*)(lds + PG8_SA(b, h) + aoff + m * 2048 + k * 1024); } } } while (0)
#define PG8_LDB(dst, b, h) do { _Pragma("unroll") for (int n = 0; n < 2; ++n) { if (FP8) { const pg8_v4i l_ = *(const PG8_LAS pg8_v4i*)(lds + PG8_SB(b, h) + boff + n * 2048), h_ = *(const PG8_LAS pg8_v4i*)(lds + PG8_SB(b, h) + boff + n * 2048 + 1024); \
            dst##8[n] = __builtin_shufflevector(l_, h_, 0, 1, 2, 3, 4, 5, 6, 7); } \
        else { _Pragma("unroll") for (int k = 0; k < 2; ++k) dst[n][k] = *(const PG8_LAS bf16x8*)(lds + PG8_SB(b, h) + boff + n * 2048 + k * 1024); } } } while (0)
#define PG8_MMA(ai, bj, At, Bt) do { __builtin_amdgcn_s_setprio(1); _Pragma("unroll") for (int m = 0; m < 4; ++m) _Pragma("unroll") for (int n = 0; n < 2; ++n) { \
        if (FP8) { acc[ai][bj][m][n] = __builtin_amdgcn_mfma_scale_f32_16x16x128_f8f6f4(Bt##8[n], At##8[m], acc[ai][bj][m][n], 0, 0, 0, 0x7f7f7f7f, 0, 0x7f7f7f7f); } \
        else { _Pragma("unroll") for (int k = 0; k < 2; ++k) acc[ai][bj][m][n] = __builtin_amdgcn_mfma_f32_16x16x32_bf16(Bt[n][k], At[m][k], acc[ai][bj][m][n], 0, 0, 0); } } \
        if (FP8) asm volatile("" : "+v"(acc[ai][bj][0][0]), "+v"(acc[ai][bj][0][1]), "+v"(acc[ai][bj][1][0]), "+v"(acc[ai][bj][1][1]), "+v"(acc[ai][bj][2][0]), "+v"(acc[ai][bj][2][1]), "+v"(acc[ai][bj][3][0]), "+v"(acc[ai][bj][3][1]));     \
        __builtin_amdgcn_s_setprio(0); } while (0)
#define PG8_WAIT_V(n) asm volatile("s_waitcnt vmcnt(" #n ")" ::: "memory")
#define PG8_WAIT_L(n) asm volatile("s_waitcnt lgkmcnt(" #n ")" ::: "memory")
#define PG8_BAR __builtin_amdgcn_s_barrier()
#define PG8_SCHED __builtin_amdgcn_sched_barrier(0)
    Unit cur, nxt; int ui = 0;
    if (!S.next(0, cur)) return;
    f32x4 acc[2][2][4][2];
#pragma unroll
    for (int a = 0; a < 2; ++a)
#pragma unroll
        for (int b = 0; b < 2; ++b)
#pragma unroll
            for (int m = 0; m < 4; ++m)
#pragma unroll
                for (int n = 0; n < 2; ++n) acc[a][b][m][n] = (f32x4){0.f, 0.f, 0.f, 0.f};
    bf16x8 At[4][2], B0[2][2], B1[2][2]; pg8_v8i At8[4], B08[2], B18[2];
    const char* cA = (const char*)g.A + (GATHER ? (size_t)0 : (size_t)cur.pm * tstep); const char* cB = (const char*)g.Bt + (size_t)cur.bt * tstep;
    S.a_ready(cur);
    if (GATHER) { PG8_GROWS(arC, cur.pm); }
    PG8_STAGE(PG8_SB(0, 0), cB, voffB); PG8_STAGE(PG8_SB(0, 1), cB + hstep, voffB); PG8_STAGEA(PG8_SA(0, 0), cA, 0, false); PG8_STAGEA(PG8_SA(0, 1), cA, 1, false);
    if (wr == 1) PG8_BAR;
    PG8_WAIT_V(2); PG8_BAR;
    PG8_STAGE(PG8_SB(1, 0), cB + kstep, voffB); PG8_STAGEA(PG8_SA(1, 0), cA + kstep, 0, false); PG8_STAGE(PG8_SB(1, 1), cB + hstep + kstep, voffB);
    PG8_WAIT_V(6); PG8_BAR;
    for (;;) {
        const bool has_next = S.next(ui + 1, nxt);
        const char* nA = (has_next && !GATHER) ? (const char*)g.A + (size_t)nxt.pm * tstep : cA; const char* nB = has_next ? (const char*)g.Bt + (size_t)nxt.bt * tstep : cB;
        if (GATHER && has_next) { unsigned tn_[2][2]; PG8_GROWS(tn_, nxt.pm); arNp[0] = tn_[0][0]; arNp[1] = tn_[0][1]; arNp[2] = tn_[1][0]; arNp[3] = tn_[1][1]; }
#pragma unroll 1
        for (int t = 0; t < nt; t += 2) {
            const bool last = (t == nt - 2);
            const char* a1 = cA + (size_t)(t + 1) * kstep;
            const char* a2 = last ? nA : cA + (size_t)(t + 2) * kstep; const char* b2 = last ? nB : cB + (size_t)(t + 2) * kstep;
            const char* a3 = a2 + kstep; const char* b3 = b2 + kstep;
            const bool isn = last && has_next;
            if (isn) S.a_ready(nxt);
            PG8_LDB(B0, 0, 0); PG8_LDB(B1, 0, 1); PG8_SCHED; PG8_LDA(At, 0, 0); PG8_STAGEA(PG8_SA(1, 1), a1, 1, false);
            PG8_WAIT_V(8); PG8_WAIT_L(0); PG8_BAR; PG8_MMA(0, 0, At, B0); PG8_MMA(0, 1, At, B1); PG8_BAR; PG8_SCHED;
            PG8_LDA(At, 0, 1); PG8_STAGE(PG8_SB(0, 0), b2, voffB); PG8_STAGE(PG8_SB(0, 1), b2 + hstep, voffB); PG8_STAGEA(PG8_SA(0, 0), a2, 0, isn);
            PG8_WAIT_V(8); PG8_WAIT_L(0); PG8_BAR; PG8_MMA(1, 0, At, B0); PG8_MMA(1, 1, At, B1); PG8_BAR; PG8_SCHED;
            PG8_LDB(B0, 1, 0); PG8_LDB(B1, 1, 1); PG8_SCHED; PG8_LDA(At, 1, 0); PG8_STAGEA(PG8_SA(0, 1), a2, 1, isn);
            PG8_WAIT_V(8); PG8_WAIT_L(0); PG8_BAR; PG8_MMA(0, 0, At, B0); PG8_MMA(0, 1, At, B1); PG8_BAR; PG8_SCHED;
            PG8_LDA(At, 1, 1); PG8_STAGE(PG8_SB(1, 0), b3, voffB); PG8_STAGE(PG8_SB(1, 1), b3 + hstep, voffB); PG8_STAGEA(PG8_SA(1, 0), a3, 0, isn);
            PG8_WAIT_V(8); PG8_WAIT_L(0); PG8_BAR; PG8_MMA(1, 0, At, B0); PG8_MMA(1, 1, At, B1); PG8_BAR; PG8_SCHED;
        }
        if (wr == 0) PG8_BAR;
        { unsigned z_ = 0u; asm volatile("" : "+s"(z_)); const int ln2 = (int)__builtin_amdgcn_mbcnt_hi(~0u, __builtin_amdgcn_mbcnt_lo(~0u, z_));
          E(acc, cur, wr, wc, ln2 & 15, ln2 >> 4); }
        S.done(cur);
        if (!has_next) break;
#pragma unroll
        for (int a = 0; a < 2; ++a)
#pragma unroll
            for (int b = 0; b < 2; ++b)
#pragma unroll
                for (int m = 0; m < 4; ++m)
#pragma unroll
                    for (int n = 0; n < 2; ++n) acc[a][b][m][n] = (f32x4){0.f, 0.f, 0.f, 0.f};
        cur = nxt; cA = nA; cB = nB; ++ui;
        if (GATHER) { arC[0][0] = arNp[0]; arC[0][1] = arNp[1]; arC[1][0] = arNp[2]; arC[1][1] = arNp[3]; }
        if (wr == 1) PG8_BAR;
    }
    PG8_WAIT_V(0);
    PG8_BAR;
#undef PG8_SA
#undef PG8_SB
#undef PG8_STAGE
#undef PG8_STAGEA
#undef PG8_GROWS
#undef PG8_LDA
#undef PG8_LDB
#undef PG8_MMA
#undef PG8_WAIT_V
#undef PG8_WAIT_L
#undef PG8_BAR
#undef PG8_SCHED
}
}

template <bool F8> struct EpiProj {
    static constexpr bool PERM = true;
    bf16_t* O; bf16_t* LR; const float* gq; const float* gk; const float* cosT; const float* sinT; float* kpart;
    __device__ __forceinline__ void operator()(const f32x4 (&acc)[2][2][4][2], const pg8::Unit& u, int wr, int wc, int fr, int fq) const {
        const int row0 = u.pm * 256 + wr * 64 + fr;
        constexpr float SC = F8 ? 0.03125f : 1.0f;
        if (F8 && u.pn >= 3 && u.pn <= 6) {
            const bool isk = u.pn >= 5; const int hh = 4 * ((u.pn - 3) & 1) + wc;
            const float* g = isk ? gk : gq;
            float gg[2][8];
#pragma unroll
            for (int bj = 0; bj < 2; ++bj)
#pragma unroll
                for (int e = 0; e < 8; ++e) gg[bj][e] = g[32 * bj + 8 * fq + e];
            float ks[2][8];
#pragma unroll
            for (int bj = 0; bj < 2; ++bj)
#pragma unroll
                for (int e = 0; e < 8; ++e) ks[bj][e] = 0.f;
            bf16_t* obase = O + (isk ? C_BK : C_BQ) + 64 * hh + 8 * fq;
#pragma unroll
            for (int ai = 0; ai < 2; ++ai)
#pragma unroll
                for (int m = 0; m < 4; ++m) {
                    const int row = row0 + ai * 128 + m * 16; const int pos = row & (SEQ - 1);
                    float v[2][8]; float ss = 0.f;
#pragma unroll
                    for (int bj = 0; bj < 2; ++bj)
#pragma unroll
                        for (int n = 0; n < 2; ++n)
#pragma unroll
                            for (int j = 0; j < 4; ++j) { const float x = acc[ai][bj][m][n][j] * SC; v[bj][4 * n + j] = x; ss += x * x; }
                    ss += __shfl_xor(ss, 16); ss += __shfl_xor(ss, 32);
                    const float rstd = rsqrtf(ss * (1.f / 64.f) + EPS);
#pragma unroll
                    for (int bj = 0; bj < 2; ++bj)
#pragma unroll
                        for (int e = 0; e < 8; ++e) v[bj][e] = v[bj][e] * rstd * gg[bj][e];
                    { const f32x4 c0 = *(const f32x4*)(cosT + pos * 8), c1 = *(const f32x4*)(cosT + pos * 8 + 4), s0 = *(const f32x4*)(sinT + pos * 8), s1 = *(const f32x4*)(sinT + pos * 8 + 4);
                      const float cs[8] = {c0.x, c0.y, c0.z, c0.w, c1.x, c1.y, c1.z, c1.w}, sn[8] = {s0.x, s0.y, s0.z, s0.w, s1.x, s1.y, s1.z, s1.w};
#pragma unroll
                      for (int e = 0; e < 8; ++e) { const float other = __shfl_xor(v[0][e], 16);
                          if (fq == 0) v[0][e] = v[0][e] * cs[e] - other * sn[e]; else if (fq == 1) v[0][e] = v[0][e] * cs[e] + other * sn[e]; } }
                    if (isk) {
#pragma unroll
                        for (int bj = 0; bj < 2; ++bj)
#pragma unroll
                            for (int e = 0; e < 8; ++e) ks[bj][e] += v[bj][e];
                    } else {
#pragma unroll
                        for (int bj = 0; bj < 2; ++bj)
#pragma unroll
                            for (int e = 0; e < 8; ++e) v[bj][e] *= (0.125f * LOG2E);
                    }
#pragma unroll
                    for (int bj = 0; bj < 2; ++bj) { u32x4 w; w.x = cvtpk(v[bj][0], v[bj][1]); w.y = cvtpk(v[bj][2], v[bj][3]); w.z = cvtpk(v[bj][4], v[bj][5]); w.w = cvtpk(v[bj][6], v[bj][7]);
                        *(u32x4*)(obase + (size_t)row * PP + 32 * bj) = w; }
                }
            if (isk) {
#pragma unroll
                for (int bj = 0; bj < 2; ++bj)
#pragma unroll
                    for (int e = 0; e < 8; ++e) { float s = ks[bj][e]; s += __shfl_xor(s, 1); s += __shfl_xor(s, 2); s += __shfl_xor(s, 4); s += __shfl_xor(s, 8); ks[bj][e] = s; }
                if (fr == 0) { float* kp = kpart + ((size_t)u.pm * 2 + wr) * 512 + 64 * hh + 8 * fq;
#pragma unroll
                    for (int bj = 0; bj < 2; ++bj) { *(f32x4*)(kp + 32 * bj) = (f32x4){ks[bj][0], ks[bj][1], ks[bj][2], ks[bj][3]}; *(f32x4*)(kp + 32 * bj + 4) = (f32x4){ks[bj][4], ks[bj][5], ks[bj][6], ks[bj][7]}; } }
            }
        } else if (u.pn < 13) {
            const int col0 = u.pn * 256 + wc * 32 + 8 * fq;
#pragma unroll
            for (int ai = 0; ai < 2; ++ai)
#pragma unroll
                for (int m = 0; m < 4; ++m) { bf16_t* rowp = O + (size_t)(row0 + ai * 128 + m * 16) * PP + col0;
#pragma unroll
                    for (int bj = 0; bj < 2; ++bj) { const f32x4 v0 = acc[ai][bj][m][0] * SC, v1 = acc[ai][bj][m][1] * SC;
                        u32x4 w; w.x = cvtpk(v0[0], v0[1]); w.y = cvtpk(v0[2], v0[3]); w.z = cvtpk(v1[0], v1[1]); w.w = cvtpk(v1[2], v1[3]);
                        *(u32x4*)(rowp + bj * 128) = w; } }
        } else if (F8 && wc == 0 && fq < 2) {
#pragma unroll
            for (int ai = 0; ai < 2; ++ai)
#pragma unroll
                for (int m = 0; m < 4; ++m) { const f32x4 v0 = acc[ai][0][m][0] * SC, v1 = acc[ai][0][m][1] * SC;
                    u32x4 w; w.x = cvtpk(v0[0], v0[1]); w.y = cvtpk(v0[2], v0[3]); w.z = cvtpk(v1[0], v1[1]); w.w = cvtpk(v1[2], v1[3]);
                    *(u32x4*)(LR + (size_t)(row0 + ai * 128 + m * 16) * 16 + 8 * fq) = w; }
        }
    }
};
struct EpiResid {
    static constexpr bool PERM = false;
    const float* base; bf16_t* out; const bf16_t* base16;
    __device__ __forceinline__ void operator()(const f32x4 (&acc)[2][2][4][2], const pg8::Unit& u, int wr, int wc, int fr, int fq) const {
        const int row0 = u.pm * 256 + wr * 64 + fr, col0 = u.pn * 256 + wc * 32 + 4 * fq;
#pragma unroll
        for (int ai = 0; ai < 2; ++ai)
#pragma unroll
            for (int m = 0; m < 4; ++m) { const size_t off = (size_t)(row0 + ai * 128 + m * 16) * DM + col0;
#pragma unroll
                for (int bj = 0; bj < 2; ++bj)
#pragma unroll
                    for (int n = 0; n < 2; ++n) { f32x4 bs;
                        if (base16) { const u32x2 bw = *(const u32x2*)(base16 + off + bj * 128 + n * 16); bs = (f32x4){bflo(bw.x), bfhi(bw.x), bflo(bw.y), bfhi(bw.y)}; }
                        else bs = *(const f32x4*)(base + off + bj * 128 + n * 16);
                        const f32x4 r = bs + acc[ai][bj][m][n];
                        u32x2 w; w.x = cvtpk(r.x, r.y); w.y = cvtpk(r.z, r.w); *(u32x2*)(out + off + bj * 128 + n * 16) = w; } }
    }
};
struct EpiSwiglu {
    static constexpr bool PERM = true;
    bf16_t* H;
    __device__ __forceinline__ void operator()(const f32x4 (&acc)[2][2][4][2], const pg8::Unit& u, int wr, int wc, int fr, int fq) const {
        const int row0 = u.pm * 256 + wr * 64 + fr, col0 = u.pn * 128 + wc * 32 + 8 * fq;
#pragma unroll
        for (int ai = 0; ai < 2; ++ai)
#pragma unroll
            for (int m = 0; m < 4; ++m) { float o[8];
#pragma unroll
                for (int n = 0; n < 2; ++n)
#pragma unroll
                    for (int j = 0; j < 4; ++j) { const float gt = acc[ai][0][m][n][j] * 0.03125f, up = acc[ai][1][m][n][j] * 0.03125f; o[n * 4 + j] = gt * sigmoidf_(gt) * up; }
                int p0 = 0, p1 = 0;
                p0 = __builtin_amdgcn_cvt_pk_fp8_f32(o[0], o[1], p0, false); p0 = __builtin_amdgcn_cvt_pk_fp8_f32(o[2], o[3], p0, true);
                p1 = __builtin_amdgcn_cvt_pk_fp8_f32(o[4], o[5], p1, false); p1 = __builtin_amdgcn_cvt_pk_fp8_f32(o[6], o[7], p1, true);
                *(u32x2*)((unsigned char*)H + (size_t)(row0 + ai * 128 + m * 16) * FF + col0) = (u32x2){(unsigned)p0, (unsigned)p1}; }
    }
};
struct EpiDown {
    static constexpr bool PERM = true;
    bf16_t* Y; const float* slotw;
    __device__ __forceinline__ void operator()(const f32x4 (&acc)[2][2][4][2], const pg8::Unit& u, int wr, int wc, int fr, int fq) const {
        const int row0 = u.pm * 256 + wr * 64 + fr, col0 = u.pn * 256 + wc * 32 + 8 * fq;
#pragma unroll
        for (int ai = 0; ai < 2; ++ai)
#pragma unroll
            for (int m = 0; m < 4; ++m) { const int row = row0 + ai * 128 + m * 16; const float sw = slotw[row] * 0.03125f; bf16_t* rowp = Y + (size_t)row * DM + col0;
#pragma unroll
                for (int bj = 0; bj < 2; ++bj) { const f32x4 v0 = acc[ai][bj][m][0] * sw, v1 = acc[ai][bj][m][1] * sw;
                    u32x4 w; w.x = cvtpk(v0[0], v0[1]); w.y = cvtpk(v0[2], v0[3]); w.z = cvtpk(v1[0], v1[1]); w.w = cvtpk(v1[2], v1[3]);
                    *(u32x4*)(rowp + bj * 128) = w; } }
    }
};

struct Args { const float* in[17]; float* out; unsigned char* ws; int ph_lo, ph_hi; };
static_assert(offsetof(Args, out) == 136 && offsetof(Args, ws) == 144 && sizeof(Args) == 160, "kernarg layout");
struct Ctx {
    LAS unsigned char* lds; const __attribute__((address_space(4))) unsigned char* ka;
    int wave, G, vcu, gw, NGW, bx;
    __device__ __forceinline__ int lane() const { unsigned z_ = 0u; asm volatile("" : "+s"(z_)); return (int)__builtin_amdgcn_mbcnt_hi(~0u, __builtin_amdgcn_mbcnt_lo(~0u, z_)); }
    __device__ __forceinline__ int tid() const { return wave * 64 + lane(); }
#define CTX_IN(name, idx) __device__ __forceinline__ const float* name() const { return *(const float* const __attribute__((address_space(4)))*)(ka + 8 * (idx)); }
    CTX_IN(x, 0) CTX_IN(attn_g, 1) CTX_IN(w_in, 2) CTX_IN(gk_w2, 3) CTX_IN(gk_b, 4) CTX_IN(gla_g, 5) CTX_IN(qn_g, 6) CTX_IN(kn_g, 7) CTX_IN(lb_param, 8) CTX_IN(hgrn_g, 9)
    CTX_IN(w_out, 10) CTX_IN(ffn_g, 11) CTX_IN(w_rg, 12) CTX_IN(w_re, 13) CTX_IN(w_eg, 14) CTX_IN(w_eu, 15) CTX_IN(w_ed, 16)
#define CTX_WS(type, name, off) __device__ __forceinline__ type* name() const { return (type*)(*(unsigned char* const __attribute__((address_space(4)))*)(ka + 144) + (off)); }
    __device__ __forceinline__ float* out() const { return *(float* const __attribute__((address_space(4)))*)(ka + 136); }
    CTX_WS(unsigned, ctl, WS_CTL) CTX_WS(float, cosT, SM_COS) CTX_WS(float, sinT, SM_SIN) CTX_WS(bf16_t, lr, SM_LR) CTX_WS(float, kpart, SM_KPART) CTX_WS(float, decay, SM_DECAY)
    CTX_WS(unsigned, route, SM_ROUTE) CTX_WS(float, slotw, SM_SLOTW) CTX_WS(unsigned, wgcnt, SM_WGCNT) CTX_WS(bf16_t, x1b, WS_X1B) CTX_WS(unsigned, amap, SM_AMAP) CTX_WS(bf16_t, win, WS_WIN) CTX_WS(bf16_t, wout, WS_WOUT) CTX_WS(bf16_t, wgu, WS_WGU) CTX_WS(bf16_t, wd, WS_WD) CTX_WS(unsigned char, h8, WS_H8)
    CTX_WS(bf16_t, proj, WS_PROJ) CTX_WS(bf16_t, st, WS_ST) CTX_WS(bf16_t, ab, WS_AB) CTX_WS(float, kvt, WS_AB) CTX_WS(bf16_t, aperm, WS_APERM) CTX_WS(bf16_t, hbuf, WS_H)
};

struct TrDesc { const float* W; bf16_t* WT; int ldw, col0, k0, K, drow0, nvalid, fp8; };
__device__ __forceinline__ void tr_load(const TrDesc& d, float (&tmp)[32], int lane) {
#pragma unroll
    for (int i = 0; i < 32; ++i) { const int kk = 2 * i + (lane >> 5); tmp[i] = d.W[(size_t)(d.k0 + kk) * d.ldw + d.col0 + (lane & 31)]; }
}
__device__ __forceinline__ void tr_finish(const TrDesc& d, const float (&tmp)[32], LAS float* scr, int lane) {
#pragma unroll
    for (int i = 0; i < 32; ++i) { const int kk = 2 * i + (lane >> 5); scr[kk * 33 + (lane & 31)] = tmp[i]; }
    asm volatile("s_waitcnt lgkmcnt(0)" ::: "memory");
    const int c = lane & 7;
    if (d.fp8) {
#pragma unroll
        for (int j = 0; j < 4; ++j) { const int n = (lane >> 3) + 8 * j; const LAS float* s = scr + (8 * c) * 33 + n;
            int p0 = 0, p1 = 0;
            p0 = __builtin_amdgcn_cvt_pk_fp8_f32(s[0 * 33] * 32.f, s[1 * 33] * 32.f, p0, false); p0 = __builtin_amdgcn_cvt_pk_fp8_f32(s[2 * 33] * 32.f, s[3 * 33] * 32.f, p0, true);
            p1 = __builtin_amdgcn_cvt_pk_fp8_f32(s[4 * 33] * 32.f, s[5 * 33] * 32.f, p1, false); p1 = __builtin_amdgcn_cvt_pk_fp8_f32(s[6 * 33] * 32.f, s[7 * 33] * 32.f, p1, true);
            if (n < d.nvalid) *(u32x2*)((unsigned char*)d.WT + (size_t)(d.drow0 + n) * d.K + d.k0 + 8 * c) = (u32x2){(unsigned)p0, (unsigned)p1}; }
    } else {
#pragma unroll
    for (int j = 0; j < 4; ++j) { const int n = (lane >> 3) + 8 * j; const LAS float* s = scr + (8 * c) * 33 + n;
        u32x4 o; o.x = cvtpk(s[0 * 33], s[1 * 33]); o.y = cvtpk(s[2 * 33], s[3 * 33]); o.z = cvtpk(s[4 * 33], s[5 * 33]); o.w = cvtpk(s[6 * 33], s[7 * 33]);
        if (n < d.nvalid) *(u32x4*)(d.WT + (size_t)(d.drow0 + n) * d.K + d.k0 + 8 * c) = o; }
    }
    asm volatile("s_waitcnt lgkmcnt(0)" ::: "memory");
}
constexpr int WC_PER_LAYER = 1664 + 16 + 512 + 16 * 768;
__device__ __forceinline__ TrDesc wconv_decode(const Ctx& X, int it) {
    const int l = it / WC_PER_LAYER; int r = it % WC_PER_LAYER;
    if (r < 1664) { const int kb = r / 104, nb = r % 104; const int col0 = nb < 24 ? 32 * nb : 784 + 32 * (nb - 24); int drow = nb < 24 ? 32 * nb : 768 + 32 * (nb - 24);
        if (drow >= C_BQ && drow < C_BV) {
            const int rel = drow - C_BQ, sec = rel >> 9, hh = (rel & 511) >> 6, dh = (rel & 63) >> 5;
            drow = C_BQ + sec * 512 + 256 * (hh >> 2) + 128 * dh + 32 * (hh & 3); }
        if (drow >= C_BQ && drow < C_CQ) return TrDesc{X.w_in() + (size_t)l * DM * IN_COLS, (bf16_t*)((unsigned char*)(X.win() + (size_t)l * NW_IN * DM) + (size_t)C_BQ * DM * 2), IN_COLS, col0, 64 * kb, DM, drow - C_BQ, 32, 1};
        if (drow >= C_AG && drow < C_BQ) return TrDesc{X.w_in() + (size_t)l * DM * IN_COLS, (bf16_t*)((unsigned char*)(X.win() + (size_t)l * NW_IN * DM) + (size_t)C_BQ * DM * 2), IN_COLS, col0, 64 * kb, DM, 1792 + drow - C_AG, 32, 1};
        return TrDesc{X.w_in() + (size_t)l * DM * IN_COLS, X.win() + (size_t)l * NW_IN * DM, IN_COLS, col0, 64 * kb, DM, drow, 32, 0}; }
    r -= 1664;
    if (r < 16) return TrDesc{X.w_in() + (size_t)l * DM * IN_COLS, (bf16_t*)((unsigned char*)(X.win() + (size_t)l * NW_IN * DM) + (size_t)C_BQ * DM * 2), IN_COLS, 768, 64 * r, DM, 1536, 16, 1};
    r -= 16;
    if (r < 512) { const int kb = r / 32, nb = r % 32; return TrDesc{X.w_out() + (size_t)l * DM * DM, X.wout() + (size_t)l * DM * DM, DM, 32 * nb, 64 * kb, DM, 32 * nb, 32, 0}; }
    r -= 512;
    const int e = r / 768, q = r % 768; const size_t le = (size_t)l * NEXP + e;
    if (q < 512) { const int up = q >= 256, qq = q & 255, kb = qq / 16, nb = qq % 16, col0 = 32 * nb;
        return TrDesc{(up ? X.w_eu() : X.w_eg()) + le * DM * FF, (bf16_t*)((unsigned char*)X.wgu() + le * DM * DM), FF, col0, 64 * kb, DM, 256 * (col0 / 128) + (col0 % 128) + (up ? 128 : 0), 32, 1}; }
    const int qq = q - 512, kb = qq / 32, nb = qq % 32;
    return TrDesc{X.w_ed() + le * FF * DM, (bf16_t*)((unsigned char*)X.wd() + le * DM * FF), DM, 32 * nb, 64 * kb, FF, 32 * nb, 32, 1};
}

__device__ __forceinline__ void row_load(const float* xrow, int lane, f32x4 (&v)[4]) {
    const f32x4* xr = (const f32x4*)xrow + lane;
#pragma unroll
    for (int j = 0; j < 4; ++j) v[j] = xr[64 * j];
}
__device__ __forceinline__ void row_load_bf16(const bf16_t* xrow, int lane, f32x4 (&v)[4]) {
    const u32x2* xr = (const u32x2*)xrow + lane;
#pragma unroll
    for (int j = 0; j < 4; ++j) { const u32x2 w = xr[64 * j]; v[j] = (f32x4){bflo(w.x), bfhi(w.x), bflo(w.y), bfhi(w.y)}; }
}
__device__ __forceinline__ void row_norm_store(f32x4 (&v)[4], const float* g, bf16_t* orow, unsigned char* orow8, int lane) {
    float s = 0.f;
#pragma unroll
    for (int j = 0; j < 4; ++j) s += (v[j].x * v[j].x + v[j].y * v[j].y) + (v[j].z * v[j].z + v[j].w * v[j].w);
    const float rstd = rsqrtf(wave_sum(s) * (1.f / DM) + EPS);
    const f32x4* gr = (const f32x4*)g + lane; u32x2* o8 = (u32x2*)orow + lane;
#pragma unroll
    for (int j = 0; j < 4; ++j) { const f32x4 gg = gr[64 * j]; v[j] = v[j] * rstd * gg; u32x2 w; w.x = cvtpk(v[j].x, v[j].y); w.y = cvtpk(v[j].z, v[j].w); o8[64 * j] = w;
        int p = 0; p = __builtin_amdgcn_cvt_pk_fp8_f32(v[j].x, v[j].y, p, false); p = __builtin_amdgcn_cvt_pk_fp8_f32(v[j].z, v[j].w, p, true); ((unsigned*)orow8)[64 * j + lane] = (unsigned)p; }
}

__device__ __forceinline__ void phase0(const Ctx& X) {
    LAS float* scr = (LAS float*)(X.lds + X.wave * 16384);
    {
        constexpr int NIT = DEPTH * WC_PER_LAYER; int it = X.gw; float cur[32], nxt[32]; TrDesc d, dn;
        if (it < NIT) { d = wconv_decode(X, it); tr_load(d, cur, X.lane()); }
        while (it < NIT) { const int nit = it + X.NGW; dn = d;
            if (nit < NIT) { dn = wconv_decode(X, nit); tr_load(dn, nxt, X.lane()); }
            __builtin_amdgcn_sched_barrier(0);
            tr_finish(d, cur, scr, X.lane());
#pragma unroll
            for (int i = 0; i < 32; ++i) cur[i] = nxt[i];
            d = dn; it = nit; }
    }
    { const int gt = X.gw * 64 + X.lane(), NT = X.NGW * 64;
      for (int i = gt; i < SEQ * 8; i += NT) { const int pos = i >> 3, f = i & 7;
          const float inv = exp2f(-(float)f * 0.125f * 18.931568569324174f);
          const float ang = (float)pos * inv;
          const double a = (double)ang; const double kx = __builtin_rint(a * 0.15915494309189535); const float red = (float)(a - kx * 6.283185307179586);
          X.cosT()[i] = __cosf(red); X.sinT()[i] = __sinf(red); } }
}
__device__ __forceinline__ void phase0b(const Ctx& X) {
    if (X.bx == 0) { for (int i = X.tid(); i < CW_BAR + 3456; i += 512) __hip_atomic_store(X.ctl() + i, 0u, __ATOMIC_RELAXED, __HIP_MEMORY_SCOPE_AGENT); }
    {
        int m = X.gw; f32x4 cur[4], nxt[4];
        if (m < NTOK) row_load(X.x() + (size_t)m * DM, X.lane(), cur);
        for (; m < NTOK; m += X.NGW) { const int mn = m + X.NGW;
            if (mn < NTOK) row_load(X.x() + (size_t)mn * DM, X.lane(), nxt);
            row_norm_store(cur, X.attn_g(), X.ab() + (size_t)m * DM, X.h8() + (size_t)m * DM, X.lane());
#pragma unroll
            for (int j = 0; j < 4; ++j) cur[j] = nxt[j]; }
    }
}

__device__ __forceinline__ void moba_prep_item(const Ctx& X, int layer, int item) {
    const int part = item & 3, bb = item >> 2; const int lane = X.lane(), w = X.wave;
    const int tok0 = (bb >> 4) * SEQ + (bb & 15) * 256 + part * 64 + w * 8;
    const int sub = lane & 7;
    float gq[8], gk[8], ks[8];
#pragma unroll
    for (int j = 0; j < 8; ++j) { gq[j] = X.qn_g()[layer * 64 + sub * 8 + j]; gk[j] = X.kn_g()[layer * 64 + sub * 8 + j]; ks[j] = 0.f; }
    for (int t = 0; t < 8; ++t) {
        const int tok = tok0 + t, pos = tok & (SEQ - 1);
        float cs[8], sn[8];
#pragma unroll
        for (int j = 0; j < 8; ++j) { cs[j] = X.cosT()[pos * 8 + j]; sn[j] = X.sinT()[pos * 8 + j]; }
#pragma unroll
        for (int which = 0; which < 2; ++which) {
            bf16_t* p = X.proj() + (size_t)tok * PP + (which ? C_BK : C_BQ) + lane * 8;
            const u32x4 raw = *(const u32x4*)p; float v[8];
            v[0] = bflo(raw.x); v[1] = bfhi(raw.x); v[2] = bflo(raw.y); v[3] = bfhi(raw.y); v[4] = bflo(raw.z); v[5] = bfhi(raw.z); v[6] = bflo(raw.w); v[7] = bfhi(raw.w);
            float ss = 0.f;
#pragma unroll
            for (int j = 0; j < 8; ++j) ss += v[j] * v[j];
            ss += __shfl_xor(ss, 1); ss += __shfl_xor(ss, 2); ss += __shfl_xor(ss, 4);
            const float rstd = rsqrtf(ss * (1.f / 64.f) + EPS);
#pragma unroll
            for (int j = 0; j < 8; ++j) v[j] = v[j] * rstd * (which ? gk[j] : gq[j]);
#pragma unroll
            for (int j = 0; j < 8; ++j) { const float other = __shfl_xor(v[j], 1);
                if (sub == 0) v[j] = v[j] * cs[j] - other * sn[j]; else if (sub == 1) v[j] = v[j] * cs[j] + other * sn[j]; }
            if (which) {
#pragma unroll
                for (int j = 0; j < 8; ++j) ks[j] += v[j];
            } else {
#pragma unroll
                for (int j = 0; j < 8; ++j) v[j] *= (0.125f * LOG2E);
            }
            u32x4 o; o.x = cvtpk(v[0], v[1]); o.y = cvtpk(v[2], v[3]); o.z = cvtpk(v[4], v[5]); o.w = cvtpk(v[6], v[7]);
            *(u32x4*)p = o;
        }
    }
    LAS float* red = (LAS float*)X.lds;
#pragma unroll
    for (int j = 0; j < 8; ++j) red[w * 512 + lane * 8 + j] = ks[j];
    __syncthreads();
    { const int c = X.tid(); float s = 0.f;
#pragma unroll
      for (int ww = 0; ww < 8; ++ww) s += red[ww * 512 + c];
      X.kpart()[(size_t)item * 512 + c] = s; }
    __syncthreads();
}

template <int W> __device__ __forceinline__ void tile_load(const bf16_t* src, u32x4 (&r)[W / 8], int lane) {
    constexpr int LPR = W / 8, RPI = 64 / LPR;
#pragma unroll
    for (int i = 0; i < W / 8; ++i) r[i] = *(const u32x4*)(src + (size_t)(RPI * i + lane / LPR) * PP + (lane % LPR) * 8);
}
template <int W> __device__ __forceinline__ void tile_store(LAS unsigned char* reg, const u32x4 (&r)[W / 8], int lane) {
    constexpr int LPR = W / 8, RPI = 64 / LPR;
#pragma unroll
    for (int i = 0; i < W / 8; ++i) *(LAS u32x4*)(reg + (RPI * i + lane / LPR) * 144 + (lane % LPR) * 16) = r[i];
}
template <bool GLA, bool PHC>
__device__ __forceinline__ void lin_item(const Ctx& X, int layer, int b, int c, int h, LAS unsigned char* wl) {
    const int lane = X.lane(), r32 = lane & 31, hi = lane >> 5;
    const size_t row0 = (size_t)b * SEQ + (size_t)c * 64;
    const bf16_t* P = X.proj();
    constexpr int WK = GLA ? 32 : 64;
    const int fl = GLA ? (lane & 31) : lane;
    const int qcol0 = GLA ? (C_AQ + 32 * h) : (C_CQ + 64 * h);
    const int kcol0 = GLA ? (C_AK + 32 * h) : (C_CF + 64 * h);
    const int vcol0 = GLA ? (C_AV + 64 * h) : (C_CI + 64 * h);
    const float fv = (GLA && lane >= 32) ? 0.f : 1.f;
    LAS unsigned char* R0 = wl; LAS unsigned char* R1 = wl + 9216;
    u32x4 tv[8], tk[WK / 8], tq[WK / 8]; u32x4 lr0 = {}, lr1 = {};
    tile_load<64>(P + row0 * PP + vcol0, tv, lane);
    tile_load<WK>(P + row0 * PP + kcol0, tk, lane);
    if (PHC) tile_load<WK>(P + row0 * PP + qcol0, tq, lane);
    if (GLA) { lr0 = *(const u32x4*)(X.lr() + (row0 + lane) * 16); lr1 = *(const u32x4*)(X.lr() + (row0 + lane) * 16 + 8); }
    float w2[16]; float bias = 0.f, lb = 0.f;
    if (GLA) {
#pragma unroll
        for (int r = 0; r < 16; ++r) w2[r] = X.gk_w2()[(size_t)layer * 16 * 128 + r * 128 + 32 * h + fl];
        bias = X.gk_b()[layer * 128 + 32 * h + fl];
    } else {
#pragma unroll
        for (int r = 0; r < 16; ++r) w2[r] = 0.f;
        if (layer > 0) lb = sigmoidf_(X.lb_param()[256 + 64 * h + fl] - X.lb_param()[64 * h + fl]);
    }
    const int h8 = GLA ? h : 4 + h;
    const size_t sbase = (((size_t)b * 64 + c) * 8 + h8) * 4096;
    unsigned pvall[32];
    bf16x8 s0f[2][4];
    if (PHC) {
#pragma unroll
        for (int vi = 0; vi < 2; ++vi)
#pragma unroll
            for (int ks = 0; ks < 4; ++ks) s0f[vi][ks] = *(const bf16x8*)(X.st() + sbase + (size_t)(32 * vi + r32) * 64 + 16 * ks + 8 * hi);
        tile_store<64>(R0, tv, lane);
#pragma unroll
        for (int m = 0; m < 32; ++m) { const unsigned v0 = *(const LAS bf16_t*)(R0 + (2 * m) * 144 + lane * 2), v1 = *(const LAS bf16_t*)(R0 + (2 * m + 1) * 144 + lane * 2); pvall[m] = v0 | (v1 << 16); }
        asm volatile("s_waitcnt lgkmcnt(0)" ::: "memory");
        tile_store<WK>(R0, tq, lane); tile_store<WK>(R1, tk, lane);
    } else {
        tile_store<64>(R0, tv, lane); tile_store<WK>(R1, tk, lane);
    }
    float bsum = 0.f, eprod = 1.f;
    f32x16 g00 = {}, g01 = {}, g10 = {}, g11 = {};
    for (int s = 0; s < 4; ++s) {
        float kt[16], qt[16];
#pragma unroll
        for (int t = 0; t < 16; ++t) {
            const int tt = 16 * s + t;
            const float rawk = bf2f(*(const LAS bf16_t*)(R1 + tt * 144 + fl * 2));
            float qv = 0.f; if (PHC) qv = bf2f(*(const LAS bf16_t*)(R0 + tt * 144 + fl * 2));
            float a, kk;
            if (GLA) {
                float z = bias;
                { const unsigned u0 = (unsigned)__builtin_amdgcn_readlane((int)lr0.x, tt), u1 = (unsigned)__builtin_amdgcn_readlane((int)lr0.y, tt), u2 = (unsigned)__builtin_amdgcn_readlane((int)lr0.z, tt), u3 = (unsigned)__builtin_amdgcn_readlane((int)lr0.w, tt);
                  z += bflo(u0) * w2[0] + bfhi(u0) * w2[1] + bflo(u1) * w2[2] + bfhi(u1) * w2[3] + bflo(u2) * w2[4] + bfhi(u2) * w2[5] + bflo(u3) * w2[6] + bfhi(u3) * w2[7]; }
                { const unsigned u0 = (unsigned)__builtin_amdgcn_readlane((int)lr1.x, tt), u1 = (unsigned)__builtin_amdgcn_readlane((int)lr1.y, tt), u2 = (unsigned)__builtin_amdgcn_readlane((int)lr1.z, tt), u3 = (unsigned)__builtin_amdgcn_readlane((int)lr1.w, tt);
                  z += bflo(u0) * w2[8] + bfhi(u0) * w2[9] + bflo(u1) * w2[10] + bfhi(u1) * w2[11] + bflo(u2) * w2[12] + bfhi(u2) * w2[13] + bflo(u3) * w2[14] + bfhi(u3) * w2[15]; }
                a = (fminf(z, 0.f) - __logf(1.f + __expf(-fabsf(z)))) * (1.f / 16.f);
                kk = rawk; qv *= 0.17677669529663687f;
            } else {
                const float ef = __expf(-rawk), sg = 1.f / (1.f + ef);
                a = lb + (1.f - lb) * sg;
                kk = (1.f - lb) * (ef * sg);
                qv = qv * sigmoidf_(qv);
            }
            float eb, enb;
            if (GLA) { a *= fv; kk *= fv; qv *= fv; bsum += a; eb = __expf(bsum); enb = __expf(-bsum); }
            else { eprod *= a; eb = eprod; enb = __builtin_amdgcn_rcpf(eprod); }
            kt[t] = kk * enb; qt[t] = qv * eb;
        }
        if (PHC) {
#pragma unroll
            for (int t = 0; t < 16; ++t) {
                *(LAS bf16_t*)(R0 + (16 * s + t) * 144 + lane * 2) = (bf16_t)(cvtpk(qt[t], 0.f) & 0xffffu);
                *(LAS bf16_t*)(R1 + (16 * s + t) * 144 + lane * 2) = (bf16_t)(cvtpk(kt[t], 0.f) & 0xffffu);
            }
        } else {
            unsigned pk[8], pv[8];
#pragma unroll
            for (int m = 0; m < 8; ++m) { pk[m] = cvtpk(kt[2 * m], kt[2 * m + 1]);
                const unsigned v0 = *(const LAS bf16_t*)(R0 + (16 * s + 2 * m) * 144 + lane * 2), v1 = *(const LAS bf16_t*)(R0 + (16 * s + 2 * m + 1) * 144 + lane * 2); pv[m] = v0 | (v1 << 16); }
            u32x4 av0, av1, bk0, bk1;
#pragma unroll
            for (int m = 0; m < 4; ++m) {
                auto rv = __builtin_amdgcn_permlane32_swap(pv[m], pv[m + 4], false, false); av0[m] = rv[0]; av1[m] = rv[1];
                auto rk = __builtin_amdgcn_permlane32_swap(pk[m], pk[m + 4], false, false); bk0[m] = rk[0]; bk1[m] = rk[1];
            }
            const bf16x8 A0 = __builtin_bit_cast(bf16x8, av0), A1 = __builtin_bit_cast(bf16x8, av1), B0 = __builtin_bit_cast(bf16x8, bk0), B1 = __builtin_bit_cast(bf16x8, bk1);
            g00 = MFMA32(A0, B0, g00); g01 = MFMA32(A0, B1, g01); g10 = MFMA32(A1, B0, g10); g11 = MFMA32(A1, B1, g11);
        }
    }
    if (!PHC) {
        const float dec = GLA ? __expf(bsum) : eprod;
        X.decay()[(((size_t)b * 64 + c) * 8 + h8) * 64 + lane] = dec;
        const float d0 = __shfl(dec, r32), d1 = __shfl(dec, 32 + r32);
        float* kv = X.kvt() + sbase;
#pragma unroll
        for (int r = 0; r < 16; ++r) { const int v0 = crow(r, hi);
            kv[(size_t)v0 * 64 + r32] = g00[r] * d0; kv[(size_t)v0 * 64 + 32 + r32] = g01[r] * d1;
            kv[(size_t)(32 + v0) * 64 + r32] = g10[r] * d0; kv[(size_t)(32 + v0) * 64 + 32 + r32] = g11[r] * d1; }
        return;
    }
    if (PHC) {
        bf16x8 avp[2][4];
#pragma unroll
        for (int sg = 0; sg < 4; ++sg) {
            u32x4 f0, f1;
            auto r0 = __builtin_amdgcn_permlane32_swap(pvall[8 * sg + 0], pvall[8 * sg + 2], false, false); f0[0] = r0[0]; f1[0] = r0[1];
            auto r1 = __builtin_amdgcn_permlane32_swap(pvall[8 * sg + 1], pvall[8 * sg + 3], false, false); f0[1] = r1[0]; f1[1] = r1[1];
            auto r2 = __builtin_amdgcn_permlane32_swap(pvall[8 * sg + 4], pvall[8 * sg + 6], false, false); f0[2] = r2[0]; f1[2] = r2[1];
            auto r3 = __builtin_amdgcn_permlane32_swap(pvall[8 * sg + 5], pvall[8 * sg + 7], false, false); f0[3] = r3[0]; f1[3] = r3[1];
            avp[0][sg] = __builtin_bit_cast(bf16x8, f0); avp[1][sg] = __builtin_bit_cast(bf16x8, f1);
        }
        const LAS unsigned char* QT = wl; const LAS unsigned char* KT = wl + 9216;
        f32x16 o[2][2];
#pragma unroll
        for (int it = 0; it < 2; ++it) {
            bf16x8 bq[4];
#pragma unroll
            for (int ks = 0; ks < 4; ++ks) bq[ks] = *(const LAS bf16x8*)(QT + (32 * it + r32) * 144 + ks * 32 + hi * 16);
#pragma unroll
            for (int vi = 0; vi < 2; ++vi) { f32x16 acc = {};
#pragma unroll
                for (int ks = 0; ks < 4; ++ks) acc = MFMA32(s0f[vi][ks], bq[ks], acc);
                o[vi][it] = acc; }
#pragma unroll
            for (int jt = 0; jt <= it; ++jt) {
                f32x16 sc = {};
#pragma unroll
                for (int ks = 0; ks < 4; ++ks) { const bf16x8 ak = *(const LAS bf16x8*)(KT + (32 * jt + r32) * 144 + ks * 32 + hi * 16); sc = MFMA32(ak, bq[ks], sc); }
                if (jt == it) {
#pragma unroll
                    for (int r = 0; r < 16; ++r) if (crow(r, hi) > r32) sc[r] = 0.f;
                }
#pragma unroll
                for (int sp = 0; sp < 2; ++sp) {
                    u32x4 pw; pw.x = cvtpk(sc[8 * sp + 0], sc[8 * sp + 1]); pw.y = cvtpk(sc[8 * sp + 2], sc[8 * sp + 3]); pw.z = cvtpk(sc[8 * sp + 4], sc[8 * sp + 5]); pw.w = cvtpk(sc[8 * sp + 6], sc[8 * sp + 7]);
                    const bf16x8 pb = __builtin_bit_cast(bf16x8, pw);
                    o[0][it] = MFMA32(avp[0][2 * jt + sp], pb, o[0][it]); o[1][it] = MFMA32(avp[1][2 * jt + sp], pb, o[1][it]);
                }
            }
        }
        const float* ng = (GLA ? X.gla_g() : X.hgrn_g()) + layer * 64;
        const int gcol = GLA ? (C_AG + 64 * h) : (C_CG + 64 * h);
        const int mcol = GLA ? (64 * h) : (768 + 64 * h);
#pragma unroll
        for (int it = 0; it < 2; ++it) {
            float ss = 0.f;
#pragma unroll
            for (int vi = 0; vi < 2; ++vi)
#pragma unroll
                for (int r = 0; r < 16; ++r) ss += o[vi][it][r] * o[vi][it][r];
            ss += __shfl_xor(ss, 32);
            const float rstd = rsqrtf(ss * (1.f / 64.f) + EPS);
            const size_t row = row0 + 32 * it + r32;
#pragma unroll
            for (int vi = 0; vi < 2; ++vi)
#pragma unroll
                for (int g = 0; g < 4; ++g) { const int v0 = 32 * vi + 8 * g + 4 * hi;
                    const u32x2 gr = *(const u32x2*)(P + row * PP + gcol + v0);
                    const f32x4 gn = *(const f32x4*)(ng + v0);
                    const float g0 = bflo(gr.x), g1 = bfhi(gr.x), g2 = bflo(gr.y), g3 = bfhi(gr.y);
                    const float y0 = o[vi][it][4 * g + 0] * rstd * gn.x * (g0 * sigmoidf_(g0)), y1 = o[vi][it][4 * g + 1] * rstd * gn.y * (g1 * sigmoidf_(g1));
                    const float y2 = o[vi][it][4 * g + 2] * rstd * gn.z * (g2 * sigmoidf_(g2)), y3 = o[vi][it][4 * g + 3] * rstd * gn.w * (g3 * sigmoidf_(g3));
                    u32x2 w; w.x = cvtpk(y0, y1); w.y = cvtpk(y2, y3);
                    *(u32x2*)(X.ab() + row * DM + mcol + v0) = w; asm volatile("" ::: "memory"); }
        }
    }
}

__device__ __forceinline__ void scan_phase(const Ctx& X, int layer) {
    const int NTH = X.G * 512;
    for (int e = X.bx * 512 + X.tid(); e < NBATCH * 8 * 4096; e += NTH) {
        const int b = e >> 15, rem = e & 32767, h8 = rem >> 12, vk = rem & 4095, k = vk & 63;
        float S = 0.f;
        {
            float kv[64], dc[64];
            const float* kvp = X.kvt() + ((size_t)b * 64 * 8 + h8) * 4096 + vk; const float* dcp = X.decay() + ((size_t)b * 64 * 8 + h8) * 64 + k;
#pragma unroll
            for (int j = 0; j < 64; ++j) { kv[j] = kvp[(size_t)j * 8 * 4096]; dc[j] = dcp[(size_t)j * 8 * 64]; }
            __builtin_amdgcn_sched_barrier(0);
            bf16_t* stp = X.st() + ((size_t)b * 64 * 8 + h8) * 4096 + vk;
#pragma unroll
            for (int j = 0; j < 64; ++j) { stp[(size_t)j * 8 * 4096] = (bf16_t)(cvtpk(S, 0.f) & 0xffffu); S = dc[j] * S + kv[j]; }
        }
    }
    asm volatile("s_waitcnt vmcnt(0)" ::: "memory");
    __syncthreads();
    if (X.tid() == 0) { __builtin_amdgcn_fence(__ATOMIC_RELEASE, "agent"); __hip_atomic_fetch_add(X.ctl() + 64 + layer, 1u, __ATOMIC_RELAXED, __HIP_MEMORY_SCOPE_AGENT); }
}
__device__ __forceinline__ void scan_wait(const Ctx& X, int layer) {
    if (X.tid() == 0) { unsigned sp = 0;
        while (__hip_atomic_load(X.ctl() + 64 + layer, __ATOMIC_RELAXED, __HIP_MEMORY_SCOPE_AGENT) < (unsigned)X.G) { __builtin_amdgcn_s_sleep(2); if (++sp > (1u << 24)) break; }
        __builtin_amdgcn_fence(__ATOMIC_ACQUIRE, "agent"); }
    __syncthreads();
    __builtin_amdgcn_fence(__ATOMIC_ACQUIRE, "workgroup");
}

constexpr int AT_KS = 0, AT_WL = 4096, AT_RING = 8192, AT_SLOT = 16384, AT_NSLOT = 8;
static_assert(AT_RING + AT_NSLOT * AT_SLOT <= MISC_OFF, "attention ring");
__device__ __forceinline__ s16x4 vtr(const LAS unsigned char* p) { typedef short v4i16_t __attribute__((ext_vector_type(4))); return __builtin_bit_cast(s16x4, __builtin_amdgcn_ds_read_tr16_b64_v4i16((LAS v4i16_t*)p)); }
#define AT_WAITBAR(N) asm volatile("s_waitcnt vmcnt(" #N ") lgkmcnt(0)\n\ts_barrier" ::: "memory")
__device__ __forceinline__ void at_kload(bf16x8 (&kf)[8], const LAS unsigned char* Kb, int r32, int hi) {
#pragma unroll
    for (int d0 = 0; d0 < 4; ++d0) { kf[2 * d0] = *(const LAS bf16x8*)(Kb + (2 * d0 + hi) * 1024 + r32 * 16); kf[2 * d0 + 1] = *(const LAS bf16x8*)(Kb + (2 * d0 + hi) * 1024 + (32 + r32) * 16); }
}
template <bool OWN, bool HN1, int TT>
__device__ __forceinline__ void attn_tile(f32x16& pc0, f32x16& pc1, f32x16& pn0, f32x16& pn1, f32x16& o0, f32x16& o1, f32x16& o2, const f32x16& bvec, bf16x8 (&kf)[8], const bf16x8 (&qr)[4],
                                          const LAS unsigned char* Vb, const LAS unsigned char* Kn1, int vpo, int r32, int hi, int qh) {
    if (HN1) at_kload(kf, Kn1, r32, hi);
    s16x4 vl[4], vh[4];
#pragma unroll
    for (int i = 0; i < 4; ++i) { vl[i] = vtr(Vb + vpo + i * 1024); vh[i] = vtr(Vb + vpo + i * 1024 + 512); }
    __builtin_amdgcn_sched_barrier(0);
#pragma unroll
    for (int d0 = 0; d0 < 4; ++d0) {
#pragma unroll
        for (int r = 4 * d0; r < 4 * d0 + 4; ++r) pc0[r] = __builtin_amdgcn_exp2f(pc0[r]);
        if (HN1) pn0 = MFMA32(kf[2 * d0], qr[d0], d0 == 0 ? bvec : pn0);
#pragma unroll
        for (int r = 4 * d0; r < 4 * d0 + 4; ++r) pc1[r] = __builtin_amdgcn_exp2f(pc1[r]);
        if (HN1) pn1 = MFMA32(kf[2 * d0 + 1], qr[d0], d0 == 0 ? bvec : pn1);
    }
    if (OWN) {
#pragma unroll
        for (int r = 0; r < 16; ++r) { const int kc = 64 * TT + (r & 3) + 8 * (r >> 2);
            pc0[r] = (kc > qh) ? 0.f : pc0[r]; pc1[r] = (kc + 32 > qh) ? 0.f : pc1[r]; }
    }
    s16x4 wl_[4], wh_[4];
#pragma unroll
    for (int i = 0; i < 4; ++i) { wl_[i] = vtr(Vb + vpo + 4096 + i * 1024); wh_[i] = vtr(Vb + vpo + 4096 + i * 1024 + 512); }
    __builtin_amdgcn_sched_barrier(0);
    bf16x8 pa[4];
#pragma unroll
    for (int s = 0; s < 2; ++s) {
        u32x4 w0; w0.x = cvtpk(pc0[8 * s + 0], pc0[8 * s + 1]); w0.y = cvtpk(pc0[8 * s + 2], pc0[8 * s + 3]); w0.z = cvtpk(pc0[8 * s + 4], pc0[8 * s + 5]); w0.w = cvtpk(pc0[8 * s + 6], pc0[8 * s + 7]);
        u32x4 w1; w1.x = cvtpk(pc1[8 * s + 0], pc1[8 * s + 1]); w1.y = cvtpk(pc1[8 * s + 2], pc1[8 * s + 3]); w1.z = cvtpk(pc1[8 * s + 4], pc1[8 * s + 5]); w1.w = cvtpk(pc1[8 * s + 6], pc1[8 * s + 7]);
        pa[s] = __builtin_bit_cast(bf16x8, w0); pa[2 + s] = __builtin_bit_cast(bf16x8, w1);
    }
    const bf16x8 ones = (bf16x8){0x3f80, 0x3f80, 0x3f80, 0x3f80, 0x3f80, 0x3f80, 0x3f80, 0x3f80};
#pragma unroll
    for (int ks = 0; ks < 4; ++ks) { const bf16x8 vb0 = (bf16x8){vl[ks][0], vl[ks][1], vl[ks][2], vl[ks][3], vh[ks][0], vh[ks][1], vh[ks][2], vh[ks][3]}; o0 = MFMA32(vb0, pa[ks], o0); o2 = MFMA32(ones, pa[ks], o2); }
#pragma unroll
    for (int ks = 0; ks < 4; ++ks) { const bf16x8 vb1 = (bf16x8){wl_[ks][0], wl_[ks][1], wl_[ks][2], wl_[ks][3], wh_[ks][0], wh_[ks][1], wh_[ks][2], wh_[ks][3]}; o1 = MFMA32(vb1, pa[ks], o1); }
}
__device__ __forceinline__ void attn_unit(const Ctx& X, const float negM, int b, int h, int qi) {
    int lane_ = X.lane(), wid_ = X.wave; asm volatile("" : "+v"(lane_), "+s"(wid_));
    const int lane = lane_, wid = wid_, tid = wid * 64 + lane, r32 = lane & 31, hi = lane >> 5;
    LAS unsigned char* lds = X.lds;
    const bf16_t* P = X.proj();
    const size_t rowbase = (size_t)b * SEQ;
    const size_t qrow = rowbase + 256 * qi + 32 * wid + r32;
    bf16x8 qr[4];
#pragma unroll
    for (int d0 = 0; d0 < 4; ++d0) qr[d0] = *(const bf16x8*)(P + qrow * PP + C_BQ + 64 * h + 16 * d0 + 8 * hi);
    {
        LAS float* ks = (LAS float*)(lds + AT_KS);
#pragma unroll
        for (int e = 0; e < 2; ++e) { const int idx = tid * 2 + e, n = idx >> 6, d = idx & 63; float s = 0.f;
#pragma unroll
            for (int p = 0; p < 2; ++p) s += X.kpart()[((size_t)(b * 16 + n) * 2 + p) * 512 + 64 * h + d];
            ks[idx] = s; }
    }
    __syncthreads();
    const unsigned kgo = (unsigned)(((rowbase + lane) * PP + C_BK + 64 * h + 8 * wid) * 2);
    const unsigned vgo = (unsigned)(((rowbase + 16 * (wid & 3) + (lane >> 2)) * PP + C_BV + 64 * h + (wid >> 2) * 32 + (lane & 3) * 8) * 2);
    const unsigned lds0 = (unsigned)(uintptr_t)lds;
#define AT_ISSUE(t) do { const unsigned sl_ = (unsigned)__builtin_amdgcn_readfirstlane((int)(lds0 + AT_RING + ((t) & (AT_NSLOT - 1)) * AT_SLOT + wid * 1024)); \
        glds16(P, kgo + (unsigned)(t) * (64u * PP * 2u), sl_); glds16(P, vgo + (unsigned)(t) * (64u * PP * 2u), sl_ + 8192u); } while (0)
#define AT_SLOTP(t) (lds + AT_RING + ((t) & (AT_NSLOT - 1)) * AT_SLOT)
    const int T = 4 * (qi + 1);
    AT_ISSUE(0); AT_ISSUE(1); AT_ISSUE(2); AT_ISSUE(3);
    unsigned sel = 0u;
    if (qi <= 3) sel = (1u << qi) - 1u;
    else {
        float qf[32];
#pragma unroll
        for (int d0 = 0; d0 < 4; ++d0) { const u32x4 w = __builtin_bit_cast(u32x4, qr[d0]);
            qf[8 * d0 + 0] = bflo(w.x); qf[8 * d0 + 1] = bfhi(w.x); qf[8 * d0 + 2] = bflo(w.y); qf[8 * d0 + 3] = bfhi(w.y);
            qf[8 * d0 + 4] = bflo(w.z); qf[8 * d0 + 5] = bfhi(w.z); qf[8 * d0 + 6] = bflo(w.w); qf[8 * d0 + 7] = bfhi(w.w); }
        float gt[15];
        const LAS float* ks = (const LAS float*)(lds + AT_KS);
#pragma unroll
        for (int n = 0; n < 15; ++n) {
            float s = 0.f;
            if (n < qi) {
#pragma unroll
                for (int d0 = 0; d0 < 4; ++d0) { const f32x4 k0 = *(const LAS f32x4*)(ks + n * 64 + 16 * d0 + 8 * hi), k1 = *(const LAS f32x4*)(ks + n * 64 + 16 * d0 + 8 * hi + 4);
                    s += qf[8 * d0 + 0] * k0.x + qf[8 * d0 + 1] * k0.y + qf[8 * d0 + 2] * k0.z + qf[8 * d0 + 3] * k0.w + qf[8 * d0 + 4] * k1.x + qf[8 * d0 + 5] * k1.y + qf[8 * d0 + 6] * k1.z + qf[8 * d0 + 7] * k1.w; }
                s += __shfl_xor(s, 32);
                asm volatile("" ::: "memory");
            }
            gt[n] = (n < qi) ? s : -INFINITY;
        }
#pragma unroll
        for (int pass = 0; pass < 3; ++pass) {
            float best = -INFINITY; int bi = -1;
#pragma unroll
            for (int n = 0; n < 15; ++n) if (gt[n] > best) { best = gt[n]; bi = n; }
            if (bi >= 0) sel |= 1u << bi;
#pragma unroll
            for (int n = 0; n < 15; ++n) if (n == bi) gt[n] = -INFINITY;
        }
    }
    const float NEGBIG = -1.0e30f;
#define AT_BIAS(t) (((t) >= T - 4) ? negM : ((((sel >> ((t) >> 2)) & 1u) != 0u) ? negM : NEGBIG))
    f32x16 o0 = {}, o1 = {}, o2 = {}, pA0, pA1, pB0, pB1, bvec; bf16x8 kf[8];
    const int vpo = ((lane >> 4) & 1) * 32 + (lane & 3) * 8 + (4 * hi + ((lane & 15) >> 2)) * 64;
    const int qh = 32 * wid + r32 - 4 * hi;
    AT_WAITBAR(6);
    at_kload(kf, AT_SLOTP(0), r32, hi);
    { const float b0 = AT_BIAS(0);
#pragma unroll
      for (int r = 0; r < 16; ++r) bvec[r] = b0;
#pragma unroll
      for (int d0 = 0; d0 < 4; ++d0) { pA0 = MFMA32(kf[2 * d0], qr[d0], d0 == 0 ? bvec : pA0); pA1 = MFMA32(kf[2 * d0 + 1], qr[d0], d0 == 0 ? bvec : pA1); } }
#define AT_STEP(OWN, HN1, HN2, TT, PC0, PC1, PN0, PN1, t) do { \
        if ((t) + 3 < T) AT_WAITBAR(4); else if ((t) + 2 < T) AT_WAITBAR(2); else AT_WAITBAR(0); \
        if ((t) + 4 < T) AT_ISSUE((t) + 4); \
        if ((((t) + 1) & 3) == 0) { const float bn_ = AT_BIAS((t) + 1); _Pragma("unroll") for (int r_ = 0; r_ < 16; ++r_) bvec[r_] = bn_; }        \
        attn_tile<OWN, HN1, TT>(PC0, PC1, PN0, PN1, o0, o1, o2, bvec, kf, qr, AT_SLOTP(t) + 8192, AT_SLOTP((t) + 1), vpo, r32, hi, qh); } while (0)
    int t = 0;
    for (; t < T - 4; t += 2) {
        AT_STEP(false, true, true, 0, pA0, pA1, pB0, pB1, t);
        AT_STEP(false, true, true, 0, pB0, pB1, pA0, pA1, t + 1);
    }
    AT_STEP(true, true, true, 0, pA0, pA1, pB0, pB1, t);
    AT_STEP(true, true, true, 1, pB0, pB1, pA0, pA1, t + 1);
    AT_STEP(true, true, false, 2, pA0, pA1, pB0, pB1, t + 2);
    AT_STEP(true, false, false, 3, pB0, pB1, pA0, pA1, t + 3);
    bf16_t* orow = X.ab() + (rowbase + 256 * qi + 32 * wid + r32) * DM + 256 + 64 * h + 4 * hi;
    { const float rl = 1.0f / o2[0];
#pragma unroll
      for (int g = 0; g < 4; ++g) {
          u32x2 w0, w1; w0.x = cvtpk(o0[4 * g] * rl, o0[4 * g + 1] * rl); w0.y = cvtpk(o0[4 * g + 2] * rl, o0[4 * g + 3] * rl); w1.x = cvtpk(o1[4 * g] * rl, o1[4 * g + 1] * rl); w1.y = cvtpk(o1[4 * g + 2] * rl, o1[4 * g + 3] * rl);
          *(u32x2*)(orow + 8 * g) = w0; *(u32x2*)(orow + 32 + 8 * g) = w1; } }
    __syncthreads();
#undef AT_ISSUE
#undef AT_SLOTP
#undef AT_BIAS
#undef AT_STEP
}

__device__ __forceinline__ void router_phase(const Ctx& X, int layer) {
    LAS float* wr = (LAS float*)X.lds;
    {
        f32x4 rg[2], re[2][4];
#pragma unroll
        for (int q = 0; q < 2; ++q) { const int k = X.tid() + 512 * q; rg[q] = *(const f32x4*)(X.w_rg() + (size_t)layer * DM * 4 + k * 4);
#pragma unroll
            for (int j = 0; j < 4; ++j) re[q][j] = *(const f32x4*)(X.w_re() + (size_t)layer * DM * 16 + k * 16 + 4 * j); }
#pragma unroll
        for (int q = 0; q < 2; ++q) { const int k = X.tid() + 512 * q;
#pragma unroll
            for (int c = 0; c < 4; ++c) wr[c * DM + k] = rg[q][c];
#pragma unroll
            for (int j = 0; j < 4; ++j)
#pragma unroll
                for (int c = 0; c < 4; ++c) wr[(4 + 4 * j + c) * DM + k] = re[q][j][c]; }
    }
    LAS unsigned* lcnt = (LAS unsigned*)(X.lds + MISC_OFF + 256);
    if (X.tid() < 16) lcnt[X.tid()] = 0u;
    __syncthreads();
    const int lane = X.lane();
    f32x4 v[4], vnx[4];
    if (X.gw < NTOK) row_load_bf16(X.x1b() + (size_t)X.gw * DM, lane, v);
    for (int m = X.gw; m < NTOK; m += X.NGW) {
        { const int mn = m + X.NGW; if (mn < NTOK) row_load_bf16(X.x1b() + (size_t)mn * DM, lane, vnx); }
        {
            float s = 0.f;
#pragma unroll
            for (int j = 0; j < 4; ++j) s += (v[j].x * v[j].x + v[j].y * v[j].y) + (v[j].z * v[j].z + v[j].w * v[j].w);
            const float rstd = rsqrtf(wave_sum(s) * (1.f / DM) + EPS);
            const f32x4* gr = (const f32x4*)(X.ffn_g() + layer * DM) + lane; unsigned* o4 = (unsigned*)((unsigned char*)X.ab() + (size_t)m * DM) + lane;
#pragma unroll
            for (int j = 0; j < 4; ++j) { const f32x4 gg = gr[64 * j]; v[j] = v[j] * rstd * gg; int p = 0; p = __builtin_amdgcn_cvt_pk_fp8_f32(v[j].x, v[j].y, p, false); p = __builtin_amdgcn_cvt_pk_fp8_f32(v[j].z, v[j].w, p, true); o4[64 * j] = (unsigned)p; }
        }
        float lg[4];
#pragma unroll
        for (int c = 0; c < 4; ++c) { float s = 0.f;
#pragma unroll
            for (int j = 0; j < 4; ++j) { const f32x4 w = *(const LAS f32x4*)(wr + c * DM + 4 * (64 * j + lane)); s += v[j].x * w.x + v[j].y * w.y + v[j].z * w.z + v[j].w * w.w; }
            lg[c] = wave_sum(s); }
        asm volatile("" ::: "memory");
        int gs = 0; float gm = lg[0];
#pragma unroll
        for (int c = 1; c < 4; ++c) if (lg[c] > gm) { gm = lg[c]; gs = c; }
        float den = 0.f;
#pragma unroll
        for (int c = 0; c < 4; ++c) den += __expf(lg[c] - gm);
        const float pg = 1.0f / den;
        float le[4];
        { const LAS float* wre = wr + (4 + 4 * gs) * DM;
#pragma unroll
          for (int j = 0; j < 4; ++j) { float s = 0.f;
#pragma unroll
              for (int q = 0; q < 4; ++q) { const f32x4 w = *(const LAS f32x4*)(wre + j * DM + 4 * (64 * q + lane)); s += v[q].x * w.x + v[q].y * w.y + v[q].z * w.z + v[q].w * w.w; }
              le[j] = wave_sum(s); } }
        int i1 = 0; float v1 = le[0];
#pragma unroll
        for (int j = 1; j < 4; ++j) if (le[j] > v1) { v1 = le[j]; i1 = j; }
        int i2 = -1; float v2 = -INFINITY;
#pragma unroll
        for (int j = 0; j < 4; ++j) if (j != i1 && le[j] > v2) { v2 = le[j]; i2 = j; }
        const float ex = __expf(v2 - v1); const float w1 = pg / (1.f + ex), w2 = pg * ex / (1.f + ex);
        if (lane == 0) {
            const int e0 = 4 * gs + i1, e1 = 4 * gs + i2;
            const unsigned p0 = __hip_atomic_fetch_add(lcnt + e0, 1u, __ATOMIC_RELAXED, __HIP_MEMORY_SCOPE_WORKGROUP), p1 = __hip_atomic_fetch_add(lcnt + e1, 1u, __ATOMIC_RELAXED, __HIP_MEMORY_SCOPE_WORKGROUP);
            unsigned* rt = X.route() + (size_t)m * 8;
            rt[0] = (unsigned)e0; rt[1] = (unsigned)e1; rt[2] = p0; rt[3] = p1; rt[4] = __float_as_uint(w1); rt[5] = __float_as_uint(w2);
        }
#pragma unroll
        for (int j = 0; j < 4; ++j) v[j] = vnx[j];
    }
    __syncthreads();
    if (X.tid() < 16) X.wgcnt()[X.vcu * 16 + X.tid()] = lcnt[X.tid()];
}

__device__ __forceinline__ int expert_off_rows(const Ctx& X, int layer, int lane) {
    const int e = lane & 15; const unsigned c = __hip_atomic_load(X.ctl() + layer * 16 + e, __ATOMIC_RELAXED, __HIP_MEMORY_SCOPE_AGENT);
    const int tiles = (int)((c + 255u) >> 8); int incl = tiles;
#pragma unroll
    for (int o = 1; o < 16; o <<= 1) { const int t = __shfl_up(incl, o, 16); if (e >= o) incl += t; }
    return (incl - tiles) * 256;
}

__device__ __forceinline__ void gather_phase(const Ctx& X, int layer) {
    const int lane = X.lane();
    LAS unsigned* red = (LAS unsigned*)X.lds;
    { const int e = X.tid() & 15, part = X.tid() >> 4; unsigned all = 0u, lt = 0u;
      for (int w0 = part; w0 < X.G; w0 += 256) {
          unsigned c[8];
#pragma unroll
          for (int j = 0; j < 8; ++j) { const int w = w0 + 32 * j; c[j] = (w < X.G) ? X.wgcnt()[w * 16 + e] : 0u; }
#pragma unroll
          for (int j = 0; j < 8; ++j) { const int w = w0 + 32 * j; all += c[j]; lt += (w < X.vcu) ? c[j] : 0u; } }
      red[part * 16 + e] = all; red[512 + part * 16 + e] = lt; }
    __syncthreads();
    LAS unsigned* tab = (LAS unsigned*)(X.lds + MISC_OFF + 512);
    if (X.tid() < 32) { const int e = X.tid() & 15, which = X.tid() >> 4; unsigned s = 0u;
        for (int p = 0; p < 32; ++p) s += red[which * 512 + p * 16 + e];
        tab[X.tid()] = s; if (which == 0 && X.bx == 0) X.ctl()[layer * 16 + e] = s; }
    __syncthreads();
    int off;
    { const int e = lane & 15; const unsigned c = tab[e]; const int tiles = (int)((c + 255u) >> 8); int incl = tiles;
#pragma unroll
      for (int o = 1; o < 16; o <<= 1) { const int t = __shfl_up(incl, o, 16); if (e >= o) incl += t; }
      off = (incl - tiles) * 256 + (int)tab[16 + e]; }
    for (int m0 = X.gw; m0 < NTOK; m0 += 64 * X.NGW) {
        const int m = m0 + lane * X.NGW; const bool ok = m < NTOK;
        unsigned* rt = X.route() + (size_t)(ok ? m : 0) * 8;
        const u32x4 r0 = *(const u32x4*)rt; const u32x2 r1 = *(const u32x2*)(rt + 4);
        const int s0 = __shfl(off, (int)(r0.x & 15u)) + (int)r0.z, s1 = __shfl(off, (int)(r0.y & 15u)) + (int)r0.w;
        if (ok) { X.amap()[s0] = (unsigned)m; X.amap()[s1] = (unsigned)m; X.slotw()[s0] = __uint_as_float(r1.x); X.slotw()[s1] = __uint_as_float(r1.y); *(u32x2*)(rt + 6) = (u32x2){(unsigned)s0, (unsigned)s1}; }
    }
}
__device__ __forceinline__ void moe_table(const Ctx& X, int layer) {
    volatile LAS int* toff = (volatile LAS int*)(X.lds + MISC_OFF);
    if (X.tid() < 64) { const int off = expert_off_rows(X, layer, X.lane());
        if (X.lane() < 16) toff[X.lane()] = off >> 8;
        if (X.lane() == 15) { const unsigned c = __hip_atomic_load(X.ctl() + layer * 16 + 15, __ATOMIC_RELAXED, __HIP_MEMORY_SCOPE_AGENT); toff[16] = (off >> 8) + (int)((c + 255u) >> 8); } }
    __syncthreads();
}

__device__ __forceinline__ void combine_phase(const Ctx& X, int layer) {
    const int lane = X.lane();
    int m = X.gw; unsigned sB0 = 0, sB1 = 0, sC0 = 0, sC1 = 0;
    u32x2 xc[4], xn[4]; u32x2 ya[4], yb[4], yan[4], ybn[4];
#define CB_LOAD(XV, YA, YB, mm, s0, s1) do { const u32x2* xr_ = (const u32x2*)(X.x1b() + (size_t)(mm) * DM) + lane; const u32x2* y0_ = (const u32x2*)(X.aperm() + (size_t)(s0) * DM) + lane; const u32x2* y1_ = (const u32x2*)(X.aperm() + (size_t)(s1) * DM) + lane; \
        _Pragma("unroll") for (int j = 0; j < 4; ++j) { XV[j] = xr_[64 * j]; YA[j] = y0_[64 * j]; YB[j] = y1_[64 * j]; } } while (0)
    if (m < NTOK) { const unsigned* rt = X.route() + (size_t)m * 8; const unsigned s0 = rt[6], s1 = rt[7]; CB_LOAD(xc, ya, yb, m, s0, s1); }
    if (m + X.NGW < NTOK) { const unsigned* rt = X.route() + (size_t)(m + X.NGW) * 8; sB0 = rt[6]; sB1 = rt[7]; }
    for (; m < NTOK; m += X.NGW) {
        const int mn = m + X.NGW, mnn = m + 2 * X.NGW;
        if (mn < NTOK) CB_LOAD(xn, yan, ybn, mn, sB0, sB1);
        if (mnn < NTOK) { const unsigned* rt = X.route() + (size_t)mnn * 8; sC0 = rt[6]; sC1 = rt[7]; }
        float* xr = X.out() + (size_t)m * DM;
        f32x4 v[4]; float ss = 0.f;
#pragma unroll
        for (int j = 0; j < 4; ++j) { const f32x4 xv = (f32x4){bflo(xc[j].x), bfhi(xc[j].x), bflo(xc[j].y), bfhi(xc[j].y)}; const u32x2 a = ya[j], bq = yb[j];
            f32x4 r; r.x = xv.x + bflo(a.x) + bflo(bq.x); r.y = xv.y + bfhi(a.x) + bfhi(bq.x); r.z = xv.z + bflo(a.y) + bflo(bq.y); r.w = xv.w + bfhi(a.y) + bfhi(bq.y);
            v[j] = r; ss += (r.x * r.x + r.y * r.y) + (r.z * r.z + r.w * r.w);
            if (layer + 1 < DEPTH) { u32x2 w; w.x = cvtpk(r.x, r.y); w.y = cvtpk(r.z, r.w); ((u32x2*)(X.x1b() + (size_t)m * DM))[64 * j + lane] = w; }
            else ((f32x4*)xr)[64 * j + lane] = r; }
        if (layer + 1 < DEPTH) {
            const float rstd = rsqrtf(wave_sum(ss) * (1.f / DM) + EPS);
            const f32x4* gr = (const f32x4*)(X.attn_g() + (layer + 1) * DM) + lane; u32x2* o8 = (u32x2*)(X.ab() + (size_t)m * DM) + lane;
#pragma unroll
            for (int j = 0; j < 4; ++j) { const f32x4 gg = gr[64 * j]; const f32x4 hh = v[j] * rstd * gg; u32x2 w; w.x = cvtpk(hh.x, hh.y); w.y = cvtpk(hh.z, hh.w); o8[64 * j] = w;
                int p = 0; p = __builtin_amdgcn_cvt_pk_fp8_f32(hh.x, hh.y, p, false); p = __builtin_amdgcn_cvt_pk_fp8_f32(hh.z, hh.w, p, true); ((unsigned*)(X.h8() + (size_t)m * DM))[64 * j + lane] = (unsigned)p; }
        }
#pragma unroll
        for (int j = 0; j < 4; ++j) { xc[j] = xn[j]; ya[j] = yan[j]; yb[j] = ybn[j]; }
        sB0 = sC0; sB1 = sC1;
    }
#undef CB_LOAD
}

#define XB_TMO      128
#define XB_XCNT(j)  (256  + 64 * (j))
#define XB_XSUB(j)  (1280 + 64 * (j))
#define XB_XGEN(j)  (2304 + 64 * (j))
#define XB_TOP      3328
#define XB_TOPGEN   3392
#define XB_SPIN_CAP (1u << 22)
__device__ __forceinline__ unsigned xb_ld(unsigned* p)              { return __hip_atomic_load(p, __ATOMIC_RELAXED, __HIP_MEMORY_SCOPE_AGENT); }
__device__ __forceinline__ unsigned xb_add(unsigned* p, unsigned v) { return __hip_atomic_fetch_add(p, v, __ATOMIC_RELAXED, __HIP_MEMORY_SCOPE_AGENT); }
__device__ __forceinline__ unsigned xb_xcc_id() { return (unsigned)__builtin_amdgcn_s_getreg((3 << 11) | 20) & 0xFu; }
#define XB_SPIN(cond, bar) do { unsigned _sp = 0; while (cond) { __builtin_amdgcn_s_sleep(1); \
    if ((++_sp & 255u) == 0u) { if (xb_ld(&(bar)[XB_TMO])) break; if (_sp > XB_SPIN_CAP) { atomicAdd(&(bar)[XB_TMO], 1u); break; } } } } while (0)
struct XcdBarrier { unsigned* bar; unsigned x; volatile LAS unsigned* st; };
__device__ __forceinline__ XcdBarrier xcd_barrier_post(unsigned* bar, volatile LAS unsigned* st) {
    XcdBarrier b; b.bar = bar; b.x = xb_xcc_id(); b.st = st;
    if (threadIdx.x == 0) (void)xb_add(&bar[XB_XCNT(b.x)], 1u);
    return b;
}
__device__ __forceinline__ void xcd_barrier_complete(unsigned* bar, unsigned x, unsigned& nloc, unsigned& nx) {
    const unsigned G = gridDim.x * gridDim.y * gridDim.z;
    unsigned sum, cnt, mine, sp = 0u;
    for (;;) {
        sum = 0u; cnt = 0u; mine = 0u;
#pragma unroll 1
        for (unsigned j = 0; j < 16; ++j) { const unsigned c = xb_ld(&bar[XB_XCNT(j)]); sum += c; cnt += (c > 0u) ? 1u : 0u; mine = (j == x) ? c : mine; }
        if (sum == G) break;
        __builtin_amdgcn_s_sleep(1);
        if ((++sp & 255u) == 0u) { if (xb_ld(&bar[XB_TMO])) break; if (sp > XB_SPIN_CAP) { atomicAdd(&bar[XB_TMO], 1u); break; } }
    }
    nloc = mine > 0u ? mine : 1u; nx = cnt > 0u ? cnt : 1u;
}
__device__ __forceinline__ void xcd_barrier(const XcdBarrier& b) {
    asm volatile("s_waitcnt vmcnt(0)" ::: "memory");
    __syncthreads();
    if (threadIdx.x == 0) {
        unsigned* bar = b.bar; unsigned bx_ = b.x;
        asm volatile("" : "+s"(bar), "+s"(bx_));
        __builtin_amdgcn_s_waitcnt(0);
        unsigned nloc = b.st[0], nx = b.st[1];
        if (nloc == 0u) { xcd_barrier_complete(bar, bx_, nloc, nx); b.st[0] = nloc; b.st[1] = nx; }
        const unsigned old = xb_add(&bar[XB_XSUB(bx_)], 1u);
        const unsigned gen = old / nloc;
        if (old + 1u == (gen + 1u) * nloc) {
            __builtin_amdgcn_fence(__ATOMIC_RELEASE, "agent");
            asm volatile("s_waitcnt vmcnt(0)" ::: "memory");
            const unsigned og = xb_add(&bar[XB_TOP], 1u);
            const unsigned tg = og / nx;
            if (og + 1u == (tg + 1u) * nx) xb_add(&bar[XB_TOPGEN], 1u);
            else XB_SPIN(xb_ld(&bar[XB_TOPGEN]) == tg, bar);
            __builtin_amdgcn_fence(__ATOMIC_ACQUIRE, "agent");
            xb_add(&bar[XB_XGEN(bx_)], 1u);
            asm volatile("s_waitcnt vmcnt(0)" ::: "memory");
        } else {
            XB_SPIN(xb_ld(&bar[XB_XGEN(bx_)]) == gen, bar);
            __builtin_amdgcn_fence(__ATOMIC_ACQUIRE, "agent");
            asm volatile("s_waitcnt vmcnt(0)" ::: "memory");
        }
    }
    __syncthreads();
}

#ifndef PHMASK
#define PHMASK 0xffff
#endif
#ifndef PROBE_A
#define PROBE_A -1
#define PROBE_B -1
#endif
#ifndef PROBE_BLK
#define PROBE_BLK 0
#endif
constexpr int NPHASE = 1 + 8 * DEPTH;
__global__ void __launch_bounds__(512, 2) fwd_kernel(Args args) {
    extern __shared__ __attribute__((aligned(16))) unsigned char lds_raw[];
    cg::grid_group grid = cg::this_grid();
    const int wave_s = __builtin_amdgcn_readfirstlane((int)(threadIdx.x >> 6));
    const int lo = args.ph_lo, hi = args.ph_hi;
    { volatile LAS unsigned* m = (volatile LAS unsigned*)((LAS unsigned char*)lds_raw + MISC_OFF); if (threadIdx.x < 64) m[threadIdx.x] = 0u; }
    __syncthreads();
    XcdBarrier xbar; xbar.bar = (unsigned*)(args.ws + WS_CTL) + CW_BAR; xbar.x = 0u; xbar.st = (volatile LAS unsigned*)((LAS unsigned char*)lds_raw + MISC_OFF + 128);
#if PROBE_A >= 0
    unsigned prA = 0, prT = 0, prE = 0; const unsigned prS = (unsigned)__builtin_amdgcn_s_memrealtime();
#define PROBE_ACC(type, d) do { if ((type) == PROBE_A) prA += (d); } while (0)
#endif
#if PROBE_A >= 0
#define PROBE_SUB(type) do { __syncthreads(); const unsigned t_ = (unsigned)__builtin_amdgcn_s_memrealtime(); PROBE_ACC(type, t_ - prSub); prSub = t_; } while (0)
    unsigned prSub = 0;
#else
#define PROBE_SUB(type) do {} while (0)
#endif
    for (int ph = lo; ph < hi; ++ph) {
        if (ph > lo) { if (ph == lo + 1) { grid.sync(); xbar = xcd_barrier_post((unsigned*)(args.ws + WS_CTL) + CW_BAR, (volatile LAS unsigned*)((LAS unsigned char*)lds_raw + MISC_OFF + 128)); } else xcd_barrier(xbar); }
#if PROBE_A >= 0
        prT = (unsigned)__builtin_amdgcn_s_memrealtime(); prSub = prT; if (ph > lo) PROBE_ACC(11, prT - prE);
#endif
        Ctx X;
#define CTX_REFRESH() do { \
        { unsigned l0 = 0u; asm volatile("" : "+s"(l0)); X.lds = (LAS unsigned char*)lds_raw + l0; } \
        { unsigned z0 = 0u; asm volatile("" : "+s"(z0)); \
          int ws = wave_s; asm volatile("" : "+s"(ws)); (void)z0; \
          X.wave = ws; } \
        { int bx = blockIdx.x, G = gridDim.x; asm volatile("" : "+s"(bx), "+s"(G)); X.G = G; X.vcu = (G % 8 == 0) ? (bx % 8) * (G / 8) + bx / 8 : bx; X.bx = bx; } \
        X.gw = X.vcu * 8 + X.wave; X.NGW = X.G * 8; \
        { const __attribute__((address_space(4))) unsigned char* ka = (const __attribute__((address_space(4))) unsigned char*)__builtin_amdgcn_kernarg_segment_ptr(); asm volatile("" : "+s"(ka)); X.ka = ka; } } while (0)
        CTX_REFRESH();
        const int layer = (ph - 1) / 8; int k = ph == 0 ? 0 : (ph - 1) % 8 + 1; if (k >= 3) ++k; if (k >= 9) ++k;
        if (ph == 0) { phase0(X); PROBE_SUB(15); CTX_REFRESH(); phase0b(X); PROBE_SUB(16); }
        else switch (k) {
        case 1: {
            {
                pg8::Gemm g{X.ab(), X.win() + (size_t)layer * NW_IN * DM, DM}; pg8::StaticOrder S; S.init(NTOK, 1536, X.G, X.bx, 0xCBA910ull, 0, 0);
                EpiProj<false> E{X.proj(), X.lr(), X.qn_g() + layer * 64, X.kn_g() + layer * 64, X.cosT(), X.sinT(), X.kpart()};
                pg8::gemm_phase<EpiProj<false>, pg8::StaticOrder>(X.lds, g, S, E, X.tid()); }
            PROBE_SUB(19);
            CTX_REFRESH();
            {
                pg8::Gemm g{(const bf16_t*)X.h8(), (const bf16_t*)((const unsigned char*)(X.win() + (size_t)layer * NW_IN * DM) + (size_t)C_BQ * DM * 2), DM / 2}; pg8::StaticOrder S; S.init(NTOK, 2048, X.G, X.bx, 0x2D876543ull, 1, 1);
                EpiProj<true> E{X.proj(), X.lr(), X.qn_g() + layer * 64, X.kn_g() + layer * 64, X.cosT(), X.sinT(), X.kpart()};
                pg8::gemm_phase<EpiProj<true>, pg8::StaticOrder, false, true>(X.lds, g, S, E, X.tid()); }
        } break;
        case 2: {
            PROBE_SUB(17);
            LAS unsigned char* wl = X.lds + X.wave * WAVE_LDS;
            for (int it = X.gw; it < 2048; it += X.NGW) { const int h8 = it & 7, bc = it >> 3, b = bc >> 6, c = bc & 63;
                if (h8 < 4) lin_item<true, false>(X, layer, b, c, h8, wl); else lin_item<false, false>(X, layer, b, c, h8 - 4, wl); }
            PROBE_SUB(18);
        } break;
        case 4: {
            scan_phase(X, layer);
            PROBE_SUB(3);
            CTX_REFRESH();
            float negM; { float gqm = fabsf(X.qn_g()[layer * 64 + X.lane()]), gkm = fabsf(X.kn_g()[layer * 64 + X.lane()]); gqm = wave_max(gqm); gkm = wave_max(gkm); negM = __builtin_bit_cast(float, __builtin_amdgcn_readfirstlane(__builtin_bit_cast(int, -(8.3f * gqm * gkm * LOG2E)))); }
            if (PHMASK & 0x800) for (int v = X.vcu; v < 256; v += X.G) { const int bh = v >> 3, s = v & 7; attn_unit(X, negM, bh >> 3, bh & 7, s); attn_unit(X, negM, bh >> 3, bh & 7, 15 - s); }
            PROBE_SUB(13);
            CTX_REFRESH();
            scan_wait(X, layer);
            LAS unsigned char* wl = X.lds + X.wave * WAVE_LDS;
            if (PHMASK & 0x1000) for (int it = X.gw; it < 2048; it += X.NGW) { const int h8 = it & 7, bc = it >> 3, b = bc >> 6, c = bc & 63;
                if (h8 < 4) lin_item<true, true>(X, layer, b, c, h8, wl); else lin_item<false, true>(X, layer, b, c, h8 - 4, wl); }
            PROBE_SUB(14);
        } break;
        case 5: {
            pg8::Gemm g{X.ab(), X.wout() + (size_t)layer * DM * DM, DM}; pg8::StaticOrder S; S.init(NTOK, DM, X.G, X.bx);
            EpiResid E{X.x(), X.x1b(), layer == 0 ? (const bf16_t*)nullptr : (const bf16_t*)X.x1b()};
            pg8::gemm_phase<EpiResid, pg8::StaticOrder>(X.lds, g, S, E, X.tid());
        } break;
        case 6: router_phase(X, layer); break;
        case 7: gather_phase(X, layer); break;
        case 8: {
            moe_table(X, layer);
            unsigned* tcnt;
            { const unsigned long long p_ = (unsigned long long)(uintptr_t)(X.ctl() + 256 + layer * 256);
              tcnt = (unsigned*)(uintptr_t)(((unsigned long long)(unsigned)__builtin_amdgcn_readfirstlane((int)(p_ >> 32)) << 32) | (unsigned long long)(unsigned)__builtin_amdgcn_readfirstlane((int)p_)); }
            { pg8::Gemm g{X.ab(), X.wgu(), DM / 2}; pg8::GroupedOrder S{(const volatile LAS int*)(X.lds + MISC_OFF), X.G, X.vcu, layer * 64, tcnt, (LAS unsigned*)(X.lds + MISC_OFF + 192), 0, 0, 0, 0};
              EpiSwiglu E{X.hbuf()};
              pg8::gemm_phase<EpiSwiglu, pg8::GroupedOrder, true, true>(X.lds, g, S, E, X.tid(), X.amap(), (unsigned)(NTOK - 1)); S.finish(X.wave); }
            PROBE_SUB(8);
            CTX_REFRESH();
            { pg8::Gemm g{X.hbuf(), X.wd(), FF / 2}; pg8::GroupedOrderDown S{(const volatile LAS int*)(X.lds + MISC_OFF), X.G, X.vcu, layer * 64, tcnt, (LAS unsigned*)(X.lds + MISC_OFF + 200 + 4 * layer), X.wave, 0u};
              EpiDown E{X.aperm(), X.slotw()};
              pg8::gemm_phase<EpiDown, pg8::GroupedOrderDown, false, true>(X.lds, g, S, E, X.tid()); }
            PROBE_SUB(9);
        } break;
        case 10: combine_phase(X, layer); break;
        }
        __syncthreads();
#if PROBE_A >= 0
        prE = (unsigned)__builtin_amdgcn_s_memrealtime(); PROBE_ACC(k, prE - prT);
#endif
    }
#if PROBE_A >= 0
    PROBE_ACC(12, prE - prS);
    if (wave_s == 0 && __builtin_amdgcn_mbcnt_hi(~0u, __builtin_amdgcn_mbcnt_lo(~0u, 0u)) == 0u) {
        unsigned* ctl = (unsigned*)(args.ws + WS_CTL);
        if (blockIdx.x == PROBE_BLK) { const unsigned qa = (prA + 400u) / 800u > 127u ? 127u : (prA + 400u) / 800u;
            __hip_atomic_store(ctl + 200, qa, __ATOMIC_RELAXED, __HIP_MEMORY_SCOPE_AGENT); }
        __builtin_amdgcn_fence(__ATOMIC_RELEASE, "agent");
        const unsigned done = __hip_atomic_fetch_add(ctl + 201, 1u, __ATOMIC_ACQ_REL, __HIP_MEMORY_SCOPE_AGENT);
        if (done == gridDim.x - 1) { const unsigned long long extra = (unsigned long long)__hip_atomic_load(ctl + 200, __ATOMIC_RELAXED, __HIP_MEMORY_SCOPE_AGENT) * 400ull; const unsigned long long t0 = __builtin_amdgcn_s_memrealtime();
            while (__builtin_amdgcn_s_memrealtime() - t0 < extra) __builtin_amdgcn_s_sleep(32); }
    }
#endif
}

extern "C" void kernel_launch(void* const* d_in, const int* in_sizes, int n_in, void* d_out, int out_size, void* d_ws, size_t ws_size, hipStream_t stream) {
    static int grid = 0;
    if (grid == 0) {
        if (n_in != 17 || out_size != NTOK * DM || ws_size < WS_END) { fprintf(stderr, "kernel_launch: unexpected problem (n_in %d out %d ws %zu)\n", n_in, out_size, ws_size); grid = -1; return; }
        int dev = 0, cus = 0, per_cu = 0;
        hipGetDevice(&dev); hipDeviceGetAttribute(&cus, hipDeviceAttributeMultiprocessorCount, dev);
        if (hipFuncSetAttribute((const void*)fwd_kernel, hipFuncAttributeMaxDynamicSharedMemorySize, LDS_BYTES) != hipSuccess) { fprintf(stderr, "kernel_launch: hipFuncSetAttribute failed\n"); }
        if (hipOccupancyMaxActiveBlocksPerMultiprocessor(&per_cu, (const void*)fwd_kernel, 512, LDS_BYTES) != hipSuccess || per_cu < 1) { fprintf(stderr, "kernel_launch: occupancy query says %d\n", per_cu); per_cu = 1; }
        (void)hipGetLastError();
        grid = cus * per_cu;
        fprintf(stderr, "kernel_launch: grid %d (cus %d x %d), ws %zu\n", grid, cus, per_cu, ws_size);
    }
    if (grid < 0) return;
    Args a{};
    for (int i = 0; i < 17; ++i) a.in[i] = (const float*)d_in[i];
    a.out = (float*)d_out; a.ws = (unsigned char*)d_ws;
#if MK_PER_PHASE
    for (int ph = 0; ph < NPHASE; ++ph) { a.ph_lo = ph; a.ph_hi = ph + 1; hipLaunchKernelGGL(fwd_kernel, dim3(grid), dim3(512), LDS_BYTES, stream, a); }
#else
    a.ph_lo = 0; a.ph_hi = NPHASE;
    void* kargs[] = {&a};
    hipError_t e = hipLaunchCooperativeKernel((const void*)fwd_kernel, dim3(grid), dim3(512), kargs, LDS_BYTES, stream);
    if (e != hipSuccess) fprintf(stderr, "cooperative launch failed: %s (grid %d)\n", hipGetErrorString(e), grid);
#endif
}
```

```cpp
#include <hip/hip_runtime.h>
#include <hip/hip_cooperative_groups.h>
#include <cstdio>
#include <cstdint>
#include <cstddef>
namespace cg = cooperative_groups;

#ifndef MK_PER_PHASE
#define MK_PER_PHASE 0
#endif

#define LAS __attribute__((address_space(3)))
typedef unsigned short bf16_t;
typedef short bf16x8 __attribute__((ext_vector_type(8)));
typedef short s16x4 __attribute__((ext_vector_type(4)));
typedef float f32x2 __attribute__((ext_vector_type(2)));
typedef float f32x4 __attribute__((ext_vector_type(4)));
typedef float f32x16 __attribute__((ext_vector_type(16)));
typedef unsigned u32x2 __attribute__((ext_vector_type(2)));
typedef unsigned u32x4 __attribute__((ext_vector_type(4)));
typedef __bf16 bf16x2_t __attribute__((ext_vector_type(2)));

constexpr int NTOK = 16384, DM = 1024, SEQ = 4096, NBATCH = 4, DEPTH = 2;
constexpr int IN_COLS = 3344;
constexpr int PP = 3328;
constexpr int NW_IN = 3584;
constexpr int C_AQ = 0, C_AK = 128, C_AV = 256, C_AG = 512, C_BQ = 768, C_BK = 1280, C_BV = 1792, C_CQ = 2304, C_CF = 2560, C_CI = 2816, C_CG = 3072;
constexpr int NEXP = 16, FF = 512;
constexpr int MOE_ROWS = 36864;
constexpr float EPS = 1e-6f;
constexpr float LOG2E = 1.4426950408889634f;

constexpr size_t MiB = 1u << 20;
constexpr size_t WS_CTL = 0;
constexpr size_t WS_SMALL = 1 * MiB;
constexpr size_t SM_COS = WS_SMALL, SM_SIN = WS_SMALL + 128 * 1024;
constexpr size_t SM_LR = WS_SMALL + 256 * 1024;
constexpr size_t SM_KPART = WS_SMALL + 768 * 1024;
constexpr size_t SM_DECAY = WS_SMALL + 1280 * 1024;
constexpr size_t SM_ROUTE = WS_SMALL + 1792 * 1024;
constexpr size_t SM_SLOTW = WS_SMALL + 2304 * 1024;
constexpr size_t SM_AMAP = WS_SMALL + 2816 * 1024;
constexpr size_t SM_WGCNT = WS_SMALL + 2560 * 1024;
constexpr int CW_BAR = 4096;
constexpr size_t CTL_ZERO_BYTES = 65536;
constexpr size_t WS_WIN = 5 * MiB;
constexpr size_t WS_WOUT = 19 * MiB;
constexpr size_t WS_WGU = 23 * MiB;
constexpr size_t WS_X1B = 23 * MiB + 32 * MiB;
constexpr size_t WS_WD = 87 * MiB;
constexpr size_t WS_H8 = 103 * MiB;
constexpr size_t WS_PROJ = 119 * MiB;
constexpr size_t WS_ST = 223 * MiB;
constexpr size_t WS_AB = 239 * MiB;
constexpr size_t WS_END = 271 * MiB;
constexpr size_t WS_APERM = WS_PROJ;
constexpr size_t WS_H = WS_PROJ + 72 * MiB;
static_assert(WS_H + (size_t)MOE_ROWS * FF * 2 <= WS_AB, "moe overlay");

constexpr int LDS_BYTES = 159744;
constexpr int MISC_OFF = 147456;
constexpr int GROW_OFF = MISC_OFF + 1024;
constexpr int WAVE_LDS = 18432;

__device__ __forceinline__ unsigned cvtpk(float lo, float hi) { f32x2 v = {lo, hi}; bf16x2_t b = __builtin_convertvector(v, bf16x2_t); return __builtin_bit_cast(unsigned, b); }
__device__ __forceinline__ float bf2f(unsigned short u) { return __builtin_bit_cast(float, (unsigned)u << 16); }
__device__ __forceinline__ float bflo(unsigned u) { return __builtin_bit_cast(float, u << 16); }
__device__ __forceinline__ float bfhi(unsigned u) { return __builtin_bit_cast(float, u & 0xffff0000u); }
#define DPP_ADD(v, ctrl) ((v) + __builtin_bit_cast(float, __builtin_amdgcn_update_dpp(0, __builtin_bit_cast(int, (v)), (ctrl), 0xf, 0xf, true)))
__device__ __forceinline__ float wave_sum(float v) {
    v = DPP_ADD(v, 0xB1); v = DPP_ADD(v, 0x4E); v = DPP_ADD(v, 0x141); v = DPP_ADD(v, 0x140);
    const int iv = __builtin_bit_cast(int, v);
    const float r0 = __builtin_bit_cast(float, __builtin_amdgcn_readlane(iv, 0)), r1 = __builtin_bit_cast(float, __builtin_amdgcn_readlane(iv, 16));
    const float r2 = __builtin_bit_cast(float, __builtin_amdgcn_readlane(iv, 32)), r3 = __builtin_bit_cast(float, __builtin_amdgcn_readlane(iv, 48));
    return (r0 + r1) + (r2 + r3);
}
__device__ __forceinline__ float wave_max(float v) {
#pragma unroll
    for (int o = 1; o < 64; o <<= 1) v = fmaxf(v, __shfl_xor(v, o));
    return v;
}
__device__ __forceinline__ int crow(int r, int hi) { return (r & 3) + 8 * (r >> 2) + 4 * hi; }
__device__ __forceinline__ float sigmoidf_(float x) { return 1.0f / (1.0f + __expf(-x)); }
#define MFMA32(a, b, c) __builtin_amdgcn_mfma_f32_32x32x16_bf16((a), (b), (c), 0, 0, 0)

__device__ __forceinline__ void glds16(const void* sbase, unsigned voff, unsigned lds_dst) { unsigned keep;
    asm volatile("s_mov_b32 %0, m0\n\ts_mov_b32 m0, %3\n\ts_nop 0\n\tglobal_load_lds_dwordx4 %1, %2\n\ts_mov_b32 m0, %0" : "=&s"(keep) : "v"(voff), "s"(sbase), "s"(lds_dst) : "memory"); }

namespace pg8 {
#define PG8_LAS __attribute__((address_space(3)))
constexpr int BM = 256, BK = 64, HALF = 128, HTB = HALF * BK * 2, STAGE_BYTES = 8 * HTB, NXCD = 8, WGM = 8;
__host__ __device__ __forceinline__ int lds_byte(int r, int c) { const int st = (r >> 4) * 2 + (c >> 5), rr = r & 15, cc = c & 31, ob = rr * 64 + cc * 2; return st * 1024 + (ob ^ (((ob >> 9) & 1) << 5)); }
__host__ __device__ __forceinline__ void stage_rc(int b, int& R, int& C) { const int st = b / 1024, sb = b % 1024, swz = sb ^ (((sb >> 9) & 1) << 5); R = (st >> 1) * 16 + swz / 64; C = (st & 1) * 32 + (swz % 64) / 2; }
__host__ __device__ __forceinline__ int perm32(int rho) { const int n = rho >> 4, i = rho & 15; return 8 * (i >> 2) + 4 * n + (i & 3); }

struct Unit { int pm, pn, bt; };
struct Gemm { const bf16_t* A; const bf16_t* Bt; int K; };

struct StaticOrder {
    int nM, nN, nwg, G, c, compact, skew; unsigned long long tbl;
    __device__ void init(int M, int N, int G_, int c_, unsigned long long tbl_ = 0xFEDCBA9876543210ull, int compact_ = 0, int skew_ = 0) { nM = M / BM; nN = N / BM; nwg = nM * nN; G = G_; c = c_; tbl = tbl_; compact = compact_; skew = skew_; }
    __device__ bool next(int i, Unit& u) const {
        long L = (long)i * G + c;
        if (skew && i > 0) { const int hg = G >> 1; if (c < hg) return false; L = (long)G + (long)(i - 1) * hg + (c - hg); }
        if (L >= nwg) return false;
        int wgid = (int)L; { const int q = nwg / NXCD, r = nwg % NXCD, xcd = wgid % NXCD, off = wgid / NXCD; wgid = (xcd < r ? xcd * (q + 1) : r * (q + 1) + (xcd - r) * q) + off; }
        const int nig = WGM * nN, gid = wgid / nig, fm = gid * WGM, gsz = (nM - fm) < WGM ? (nM - fm) : WGM;
        u.pm = fm + ((wgid % nig) % gsz); { const int pn_ = (wgid % nig) / gsz; u.pn = (int)((tbl >> (4 * pn_)) & 15ull); u.bt = compact ? pn_ : u.pn; } return true;
    }
    __device__ __forceinline__ void a_ready(const Unit&) const {}
    __device__ __forceinline__ void done(const Unit&) const {}
};
struct GroupedOrder {
    const volatile PG8_LAS int* toff; int G, vcu, wbase;
    __device__ bool next(int i, Unit& u) const {
        const int U = i * G + vcu; const int total = toff[16];
        if (U >= total * 4) return false;
        const int rt = U >> 2, pn = U & 3; int e = 0;
#pragma unroll
        for (int j = 1; j < 16; ++j) e += (rt >= toff[j]) ? 1 : 0;
        u.pm = __builtin_amdgcn_readfirstlane(rt); u.pn = __builtin_amdgcn_readfirstlane(pn); u.bt = __builtin_amdgcn_readfirstlane(wbase + e * 4 + pn); return true;
    }
    __device__ __forceinline__ void a_ready(const Unit&) const {}
    unsigned* cnt; PG8_LAS unsigned* wgarr;
    mutable int dp0, dp1, dp2, ndp;
    __device__ __forceinline__ void done(const Unit& u) const {
        { const int n8 = toff[16] * 4, rem = n8 - (n8 / G) * G;
          if (vcu >= rem) { if (ndp == 0) dp0 = u.pm; else if (ndp == 1) dp1 = u.pm; else dp2 = u.pm; ++ndp; return; } }
        asm volatile("s_waitcnt vmcnt(0)" ::: "memory");
        unsigned old = 0u;
        if (__builtin_amdgcn_mbcnt_hi(~0u, __builtin_amdgcn_mbcnt_lo(~0u, 0u)) == 0u) old = __hip_atomic_fetch_add(wgarr, 1u, __ATOMIC_RELAXED, __HIP_MEMORY_SCOPE_WORKGROUP);
        old = (unsigned)__builtin_amdgcn_readfirstlane((int)old);
        if ((old & 7u) == 7u) {
            __builtin_amdgcn_fence(__ATOMIC_RELEASE, "agent");
            if (__builtin_amdgcn_mbcnt_hi(~0u, __builtin_amdgcn_mbcnt_lo(~0u, 0u)) == 0u) __hip_atomic_fetch_add(cnt + u.pm, 1u, __ATOMIC_RELAXED, __HIP_MEMORY_SCOPE_AGENT);
        }
    }
    __device__ __forceinline__ void finish(int wid) const {
        if (ndp > 0 && wid == 0) {
            __builtin_amdgcn_fence(__ATOMIC_RELEASE, "agent");
            if (__builtin_amdgcn_mbcnt_hi(~0u, __builtin_amdgcn_mbcnt_lo(~0u, 0u)) == 0u) {
                __hip_atomic_fetch_add(cnt + dp0, 1u, __ATOMIC_RELAXED, __HIP_MEMORY_SCOPE_AGENT);
                if (ndp > 1) __hip_atomic_fetch_add(cnt + dp1, 1u, __ATOMIC_RELAXED, __HIP_MEMORY_SCOPE_AGENT);
                if (ndp > 2) __hip_atomic_fetch_add(cnt + dp2, 1u, __ATOMIC_RELAXED, __HIP_MEMORY_SCOPE_AGENT);
            }
        }
    }
};
struct GroupedOrderDown {
    const volatile PG8_LAS int* toff; int G, vcu, wbase; unsigned* cnt;
    __device__ bool next(int i, Unit& u) const {
        const int n8 = toff[16] * 4, R = n8 / G, rem = n8 - R * G; int q;
        if (vcu < rem) { if (i > 0) return false; q = R * G + vcu; }
        else { q = (vcu - rem) + (G - rem) * i; if (q >= R * G) return false; }
        const int rt = q >> 2, pn = q & 3; int e = 0;
#pragma unroll
        for (int j = 1; j < 16; ++j) e += (rt >= toff[j]) ? 1 : 0;
        u.pm = __builtin_amdgcn_readfirstlane(rt); u.pn = __builtin_amdgcn_readfirstlane(pn); u.bt = __builtin_amdgcn_readfirstlane(wbase + e * 4 + pn); return true;
    }
    PG8_LAS unsigned* acq; int wid; mutable unsigned ncall;
    __device__ __forceinline__ void a_ready(const Unit& u) const {
        const unsigned k = ++ncall; unsigned sp = 0;
        if (wid == 0) {
            while ((unsigned)__builtin_amdgcn_readfirstlane((int)__hip_atomic_load(cnt + u.pm, __ATOMIC_RELAXED, __HIP_MEMORY_SCOPE_AGENT)) < 4u) { __builtin_amdgcn_s_sleep(4); if (++sp > (1u << 22)) break; }
            __builtin_amdgcn_fence(__ATOMIC_ACQUIRE, "agent");
            __hip_atomic_store(acq, k, __ATOMIC_RELEASE, __HIP_MEMORY_SCOPE_WORKGROUP);
        } else {
            while ((unsigned)__builtin_amdgcn_readfirstlane((int)__hip_atomic_load(acq, __ATOMIC_ACQUIRE, __HIP_MEMORY_SCOPE_WORKGROUP)) < k) { __builtin_amdgcn_s_sleep(2); if (++sp > (1u << 24)) break; }
        }
        asm volatile("" ::: "memory");
    }
    __device__ __forceinline__ void done(const Unit&) const {}
};

template <class Epi, class Sched, bool GATHER = false, bool FP8 = false>
__device__ __forceinline__ void gemm_phase(PG8_LAS unsigned char* lds, const Gemm g, const Sched& S, const Epi& E, const int tid, const unsigned* amap = nullptr, unsigned amap_max = 0u) {
    const int  wid = __builtin_amdgcn_readfirstlane(tid >> 6), lane = tid & 63, wr = wid >> 2, wc = wid & 3, fr = lane & 15, fq = lane >> 4;
    int Kq_ = g.K; asm volatile("" : "+s"(Kq_));
    const int K = Kq_, nt = K / BK;
    unsigned voffA[2], voffB[2]; int gR[2]; unsigned gC[2];
#pragma unroll
    for (int i = 0; i < 2; ++i) { int R, C; stage_rc(tid * 16 + i * 8192, R, C); const int Rb = Epi::PERM ? ((R & ~31) + perm32(R & 31)) : R;
        voffA[i] = (unsigned)(R * K + C) * 2u; voffB[i] = (unsigned)(Rb * K + C) * 2u; gR[i] = R; gC[i] = (unsigned)C * 2u; }
    unsigned arC[2][2];
    PG8_LAS unsigned* arNp = (PG8_LAS unsigned*)(lds + 147456 + 1024 + tid * 16);
#define PG8_GROWS(dst, pm_) do { _Pragma("unroll") for (int h_ = 0; h_ < 2; ++h_) _Pragma("unroll") for (int i_ = 0; i_ < 2; ++i_) { \
        unsigned tk_ = amap[(size_t)(pm_) * 256 + h_ * 128 + gR[0] + 64 * i_]; tk_ = tk_ < amap_max ? tk_ : amap_max; dst[h_][i_] = tk_ * (unsigned)(K * 2) + gC[0]; } } while (0)
    const size_t kstep = (size_t)(BK * 2);
    const size_t hstep = (size_t)HALF * K * 2;
    const size_t tstep = 2 * hstep;
    const unsigned ldsw = (unsigned)wid * 1024u; const unsigned lds0_ = (unsigned)(uintptr_t)lds;
    const int aoff = lds_byte(wr * 64 + fr, fq * 8), boff = lds_byte(wc * 32 + fr, fq * 8);
#define PG8_SA(b, h) (((b) * 2 + (h)) * HTB)
#define PG8_SB(b, h) ((4 + (b) * 2 + (h)) * HTB)
#define PG8_STAGE(bufoff, gbase, voff) do { const unsigned long long gb_ = (unsigned long long)(uintptr_t)(gbase); \
        const void* sb_ = (const void*)(uintptr_t)(((unsigned long long)(unsigned)__builtin_amdgcn_readfirstlane((int)(gb_ >> 32)) << 32) | (unsigned long long)(unsigned)__builtin_amdgcn_readfirstlane((int)gb_)); \
        _Pragma("unroll") for (int _i = 0; _i < 2; ++_i) \
        glds16(sb_, (voff)[_i], (unsigned)__builtin_amdgcn_readfirstlane((int)(lds0_ + (unsigned)(bufoff) + ldsw + (unsigned)(_i * 8192)))); } while (0)
#define PG8_STAGEA(bufoff, gbase, h, isn) do { if (GATHER) { unsigned vo_[2] = {arC[h][0], arC[h][1]}; if (isn) { vo_[0] = arNp[2 * (h)]; vo_[1] = arNp[2 * (h) + 1]; } PG8_STAGE(bufoff, gbase, vo_); } \
        else { PG8_STAGE(bufoff, (gbase) + (h) * hstep, voffA); } } while (0)
    typedef int pg8_v4i __attribute__((ext_vector_type(4))); typedef int pg8_v8i __attribute__((ext_vector_type(8)));
#define PG8_LDA(dst, b, h) do { _Pragma("unroll") for (int m = 0; m < 4; ++m) { if (FP8) { const pg8_v4i l_ = *(const PG8_LAS pg8_v4i*)(lds + PG8_SA(b, h) + aoff + m * 2048), h_ = *(const PG8_LAS pg8_v4i*)(lds + PG8_SA(b, h) + aoff + m * 2048 + 1024); \
            dst##8[m] = __builtin_shufflevector(l_, h_, 0, 1, 2, 3, 4, 5, 6, 7); } \
        else { _Pragma("unroll") for (int k = 0; k < 2; ++k) dst[m][k] = *(const PG8_LAS bf16x8*)(lds + PG8_SA(b, h) + aoff + m * 2048 + k * 1024); } } } while (0)
#define PG8_LDB(dst, b, h) do { _Pragma("unroll") for (int n = 0; n < 2; ++n) { if (FP8) { const pg8_v4i l_ = *(const PG8_LAS pg8_v4i*)(lds + PG8_SB(b, h) + boff + n * 2048), h_ = *(const PG8_LAS pg8_v4i*)(lds + PG8_SB(b, h) + boff + n * 2048 + 1024); \
            dst##8[n] = __builtin_shufflevector(l_, h_, 0, 1, 2, 3, 4, 5, 6, 7); } \
        else { _Pragma("unroll") for (int k = 0; k < 2; ++k) dst[n][k] = *(const PG8_LAS bf16x8*)(lds + PG8_SB(b, h) + boff + n * 2048 + k * 1024); } } } while (0)
#define PG8_MMA(ai, bj, At, Bt) do { __builtin_amdgcn_s_setprio(1); _Pragma("unroll") for (int m = 0; m < 4; ++m) _Pragma("unroll") for (int n = 0; n < 2; ++n) { \
        if (FP8) { acc[ai][bj][m][n] = __builtin_amdgcn_mfma_scale_f32_16x16x128_f8f6f4(Bt##8[n], At##8[m], acc[ai][bj][m][n], 0, 0, 0, 0x7f7f7f7f, 0, 0x7f7f7f7f); } \
        else { _Pragma("unroll") for (int k = 0; k < 2; ++k) acc[ai][bj][m][n] = __builtin_amdgcn_mfma_f32_16x16x32_bf16(Bt[n][k], At[m][k], acc[ai][bj][m][n], 0, 0, 0); } } \
        if (FP8) asm volatile("" : "+v"(acc[ai][bj][0][0]), "+v"(acc[ai][bj][0][1]), "+v"(acc[ai][bj][1][0]), "+v"(acc[ai][bj][1][1]), "+v"(acc[ai][bj][2][0]), "+v"(acc[ai][bj][2][1]), "+v"(acc[ai][bj][3][0]), "+v"(acc[ai][bj][3][1]));     \
        __builtin_amdgcn_s_setprio(0); } while (0)
#define PG8_WAIT_V(n) asm volatile("s_waitcnt vmcnt(" #n ")" ::: "memory")
#define PG8_WAIT_L(n) asm volatile("s_waitcnt lgkmcnt(" #n ")" ::: "memory")
#define PG8_BAR __builtin_amdgcn_s_barrier()
#define PG8_SCHED __builtin_amdgcn_sched_barrier(0)
    Unit cur, nxt; int ui = 0;
    if (!S.next(0, cur)) return;
    f32x4 acc[2][2][4][2];
#pragma unroll
    for (int a = 0; a < 2; ++a)
#pragma unroll
        for (int b = 0; b < 2; ++b)
#pragma unroll
            for (int m = 0; m < 4; ++m)
#pragma unroll
                for (int n = 0; n < 2; ++n) acc[a][b][m][n] = (f32x4){0.f, 0.f, 0.f, 0.f};
    bf16x8 At[4][2], B0[2][2], B1[2][2]; pg8_v8i At8[4], B08[2], B18[2];
    const char* cA = (const char*)g.A + (GATHER ? (size_t)0 : (size_t)cur.pm * tstep); const char* cB = (const char*)g.Bt + (size_t)cur.bt * tstep;
    S.a_ready(cur);
    if (GATHER) { PG8_GROWS(arC, cur.pm); }
    PG8_STAGE(PG8_SB(0, 0), cB, voffB); PG8_STAGE(PG8_SB(0, 1), cB + hstep, voffB); PG8_STAGEA(PG8_SA(0, 0), cA, 0, false); PG8_STAGEA(PG8_SA(0, 1), cA, 1, false);
    if (wr == 1) PG8_BAR;
    PG8_WAIT_V(2); PG8_BAR;
    PG8_STAGE(PG8_SB(1, 0), cB + kstep, voffB); PG8_STAGEA(PG8_SA(1, 0), cA + kstep, 0, false); PG8_STAGE(PG8_SB(1, 1), cB + hstep + kstep, voffB);
    PG8_WAIT_V(6); PG8_BAR;
    for (;;) {
        const bool has_next = S.next(ui + 1, nxt);
        const char* nA = (has_next && !GATHER) ? (const char*)g.A + (size_t)nxt.pm * tstep : cA; const char* nB = has_next ? (const char*)g.Bt + (size_t)nxt.bt * tstep : cB;
        if (GATHER && has_next) { unsigned tn_[2][2]; PG8_GROWS(tn_, nxt.pm); arNp[0] = tn_[0][0]; arNp[1] = tn_[0][1]; arNp[2] = tn_[1][0]; arNp[3] = tn_[1][1]; }
#pragma unroll 1
        for (int t = 0; t < nt; t += 2) {
            const bool last = (t == nt - 2);
            const char* a1 = cA + (size_t)(t + 1) * kstep;
            const char* a2 = last ? nA : cA + (size_t)(t + 2) * kstep; const char* b2 = last ? nB : cB + (size_t)(t + 2) * kstep;
            const char* a3 = a2 + kstep; const char* b3 = b2 + kstep;
            const bool isn = last && has_next;
            if (isn) S.a_ready(nxt);
            PG8_LDB(B0, 0, 0); PG8_LDB(B1, 0, 1); PG8_SCHED; PG8_LDA(At, 0, 0); PG8_STAGEA(PG8_SA(1, 1), a1, 1, false);
            PG8_WAIT_V(8); PG8_WAIT_L(0); PG8_BAR; PG8_MMA(0, 0, At, B0); PG8_MMA(0, 1, At, B1); PG8_BAR; PG8_SCHED;
            PG8_LDA(At, 0, 1); PG8_STAGE(PG8_SB(0, 0), b2, voffB); PG8_STAGE(PG8_SB(0, 1), b2 + hstep, voffB); PG8_STAGEA(PG8_SA(0, 0), a2, 0, isn);
            PG8_WAIT_V(8); PG8_WAIT_L(0); PG8_BAR; PG8_MMA(1, 0, At, B0); PG8_MMA(1, 1, At, B1); PG8_BAR; PG8_SCHED;
            PG8_LDB(B0, 1, 0); PG8_LDB(B1, 1, 1); PG8_SCHED; PG8_LDA(At, 1, 0); PG8_STAGEA(PG8_SA(0, 1), a2, 1, isn);
            PG8_WAIT_V(8); PG8_WAIT_L(0); PG8_BAR; PG8_MMA(0, 0, At, B0); PG8_MMA(0, 1, At, B1); PG8_BAR; PG8_SCHED;
            PG8_LDA(At, 1, 1); PG8_STAGE(PG8_SB(1, 0), b3, voffB); PG8_STAGE(PG8_SB(1, 1), b3 + hstep, voffB); PG8_STAGEA(PG8_SA(1, 0), a3, 0, isn);
            PG8_WAIT_V(8); PG8_WAIT_L(0); PG8_BAR; PG8_MMA(1, 0, At, B0); PG8_MMA(1, 1, At, B1); PG8_BAR; PG8_SCHED;
        }
        if (wr == 0) PG8_BAR;
        { unsigned z_ = 0u; asm volatile("" : "+s"(z_)); const int ln2 = (int)__builtin_amdgcn_mbcnt_hi(~0u, __builtin_amdgcn_mbcnt_lo(~0u, z_));
          E(acc, cur, wr, wc, ln2 & 15, ln2 >> 4); }
        S.done(cur);
        if (!has_next) break;
#pragma unroll
        for (int a = 0; a < 2; ++a)
#pragma unroll
            for (int b = 0; b < 2; ++b)
#pragma unroll
                for (int m = 0; m < 4; ++m)
#pragma unroll
                    for (int n = 0; n < 2; ++n) acc[a][b][m][n] = (f32x4){0.f, 0.f, 0.f, 0.f};
        cur = nxt; cA = nA; cB = nB; ++ui;
        if (GATHER) { arC[0][0] = arNp[0]; arC[0][1] = arNp[1]; arC[1][0] = arNp[2]; arC[1][1] = arNp[3]; }
        if (wr == 1) PG8_BAR;
    }
    PG8_WAIT_V(0);
    PG8_BAR;
#undef PG8_SA
#undef PG8_SB
#undef PG8_STAGE
#undef PG8_STAGEA
#undef PG8_GROWS
#undef PG8_LDA
#undef PG8_LDB
#undef PG8_MMA
#undef PG8_WAIT_V
#undef PG8_WAIT_L
#undef PG8_BAR
#undef PG8_SCHED
}
}

template <bool F8> struct EpiProj {
    static constexpr bool PERM = true;
    bf16_t* O; bf16_t* LR; const float* gq; const float* gk; const float* cosT; const float* sinT; float* kpart;
    __device__ __forceinline__ void operator()(const f32x4 (&acc)[2][2][4][2], const pg8::Unit& u, int wr, int wc, int fr, int fq) const {
        const int row0 = u.pm * 256 + wr * 64 + fr;
        constexpr float SC = F8 ? 0.03125f : 1.0f;
        if (F8 && u.pn >= 3 && u.pn <= 6) {
            const bool isk = u.pn >= 5; const int hh = 4 * ((u.pn - 3) & 1) + wc;
            const float* g = isk ? gk : gq;
            float gg[2][8];
#pragma unroll
            for (int bj = 0; bj < 2; ++bj)
#pragma unroll
                for (int e = 0; e < 8; ++e) gg[bj][e] = g[32 * bj + 8 * fq + e];
            float ks[2][8];
#pragma unroll
            for (int bj = 0; bj < 2; ++bj)
#pragma unroll
                for (int e = 0; e < 8; ++e) ks[bj][e] = 0.f;
            bf16_t* obase = O + (isk ? C_BK : C_BQ) + 64 * hh + 8 * fq;
#pragma unroll
            for (int ai = 0; ai < 2; ++ai)
#pragma unroll
                for (int m = 0; m < 4; ++m) {
                    const int row = row0 + ai * 128 + m * 16; const int pos = row & (SEQ - 1);
                    float v[2][8]; float ss = 0.f;
#pragma unroll
                    for (int bj = 0; bj < 2; ++bj)
#pragma unroll
                        for (int n = 0; n < 2; ++n)
#pragma unroll
                            for (int j = 0; j < 4; ++j) { const float x = acc[ai][bj][m][n][j] * SC; v[bj][4 * n + j] = x; ss += x * x; }
                    ss += __shfl_xor(ss, 16); ss += __shfl_xor(ss, 32);
                    const float rstd = rsqrtf(ss * (1.f / 64.f) + EPS);
#pragma unroll
                    for (int bj = 0; bj < 2; ++bj)
#pragma unroll
                        for (int e = 0; e < 8; ++e) v[bj][e] = v[bj][e] * rstd * gg[bj][e];
                    { const f32x4 c0 = *(const f32x4*)(cosT + pos * 8), c1 = *(const f32x4*)(cosT + pos * 8 + 4), s0 = *(const f32x4*)(sinT + pos * 8), s1 = *(const f32x4*)(sinT + pos * 8 + 4);
                      const float cs[8] = {c0.x, c0.y, c0.z, c0.w, c1.x, c1.y, c1.z, c1.w}, sn[8] = {s0.x, s0.y, s0.z, s0.w, s1.x, s1.y, s1.z, s1.w};
#pragma unroll
                      for (int e = 0; e < 8; ++e) { const float other = __shfl_xor(v[0][e], 16);
                          if (fq == 0) v[0][e] = v[0][e] * cs[e] - other * sn[e]; else if (fq == 1) v[0][e] = v[0][e] * cs[e] + other * sn[e]; } }
                    if (isk) {
#pragma unroll
                        for (int bj = 0; bj < 2; ++bj)
#pragma unroll
                            for (int e = 0; e < 8; ++e) ks[bj][e] += v[bj][e];
                    } else {
#pragma unroll
                        for (int bj = 0; bj < 2; ++bj)
#pragma unroll
                            for (int e = 0; e < 8; ++e) v[bj][e] *= (0.125f * LOG2E);
                    }
#pragma unroll
                    for (int bj = 0; bj < 2; ++bj) { u32x4 w; w.x = cvtpk(v[bj][0], v[bj][1]); w.y = cvtpk(v[bj][2], v[bj][3]); w.z = cvtpk(v[bj][4], v[bj][5]); w.w = cvtpk(v[bj][6], v[bj][7]);
                        *(u32x4*)(obase + (size_t)row * PP + 32 * bj) = w; }
                }
            if (isk) {
#pragma unroll
                for (int bj = 0; bj < 2; ++bj)
#pragma unroll
                    for (int e = 0; e < 8; ++e) { float s = ks[bj][e]; s += __shfl_xor(s, 1); s += __shfl_xor(s, 2); s += __shfl_xor(s, 4); s += __shfl_xor(s, 8); ks[bj][e] = s; }
                if (fr == 0) { float* kp = kpart + ((size_t)u.pm * 2 + wr) * 512 + 64 * hh + 8 * fq;
#pragma unroll
                    for (int bj = 0; bj < 2; ++bj) { *(f32x4*)(kp + 32 * bj) = (f32x4){ks[bj][0], ks[bj][1], ks[bj][2], ks[bj][3]}; *(f32x4*)(kp + 32 * bj + 4) = (f32x4){ks[bj][4], ks[bj][5], ks[bj][6], ks[bj][7]}; } }
            }
        } else if (u.pn < 13) {
            const int col0 = u.pn * 256 + wc * 32 + 8 * fq;
#pragma unroll
            for (int ai = 0; ai < 2; ++ai)
#pragma unroll
                for (int m = 0; m < 4; ++m) { bf16_t* rowp = O + (size_t)(row0 + ai * 128 + m * 16) * PP + col0;
#pragma unroll
                    for (int bj = 0; bj < 2; ++bj) { const f32x4 v0 = acc[ai][bj][m][0] * SC, v1 = acc[ai][bj][m][1] * SC;
                        u32x4 w; w.x = cvtpk(v0[0], v0[1]); w.y = cvtpk(v0[2], v0[3]); w.z = cvtpk(v1[0], v1[1]); w.w = cvtpk(v1[2], v1[3]);
                        *(u32x4*)(rowp + bj * 128) = w; } }
        } else if (F8 && wc == 0 && fq < 2) {
#pragma unroll
            for (int ai = 0; ai < 2; ++ai)
#pragma unroll
                for (int m = 0; m < 4; ++m) { const f32x4 v0 = acc[ai][0][m][0] * SC, v1 = acc[ai][0][m][1] * SC;
                    u32x4 w; w.x = cvtpk(v0[0], v0[1]); w.y = cvtpk(v0[2], v0[3]); w.z = cvtpk(v1[0], v1[1]); w.w = cvtpk(v1[2], v1[3]);
                    *(u32x4*)(LR + (size_t)(row0 + ai * 128 + m * 16) * 16 + 8 * fq) = w; }
        }
    }
};
struct EpiResid {
    static constexpr bool PERM = false;
    const float* base; bf16_t* out; const bf16_t* base16;
    __device__ __forceinline__ void operator()(const f32x4 (&acc)[2][2][4][2], const pg8::Unit& u, int wr, int wc, int fr, int fq) const {
        const int row0 = u.pm * 256 + wr * 64 + fr, col0 = u.pn * 256 + wc * 32 + 4 * fq;
#pragma unroll
        for (int ai = 0; ai < 2; ++ai)
#pragma unroll
            for (int m = 0; m < 4; ++m) { const size_t off = (size_t)(row0 + ai * 128 + m * 16) * DM + col0;
#pragma unroll
                for (int bj = 0; bj < 2; ++bj)
#pragma unroll
                    for (int n = 0; n < 2; ++n) { f32x4 bs;
                        if (base16) { const u32x2 bw = *(const u32x2*)(base16 + off + bj * 128 + n * 16); bs = (f32x4){bflo(bw.x), bfhi(bw.x), bflo(bw.y), bfhi(bw.y)}; }
                        else bs = *(const f32x4*)(base + off + bj * 128 + n * 16);
                        const f32x4 r = bs + acc[ai][bj][m][n];
                        u32x2 w; w.x = cvtpk(r.x, r.y); w.y = cvtpk(r.z, r.w); *(u32x2*)(out + off + bj * 128 + n * 16) = w; } }
    }
};
struct EpiSwiglu {
    static constexpr bool PERM = true;
    bf16_t* H;
    __device__ __forceinline__ void operator()(const f32x4 (&acc)[2][2][4][2], const pg8::Unit& u, int wr, int wc, int fr, int fq) const {
        const int row0 = u.pm * 256 + wr * 64 + fr, col0 = u.pn * 128 + wc * 32 + 8 * fq;
#pragma unroll
        for (int ai = 0; ai < 2; ++ai)
#pragma unroll
            for (int m = 0; m < 4; ++m) { float o[8];
#pragma unroll
                for (int n = 0; n < 2; ++n)
#pragma unroll
                    for (int j = 0; j < 4; ++j) { const float gt = acc[ai][0][m][n][j] * 0.03125f, up = acc[ai][1][m][n][j] * 0.03125f; o[n * 4 + j] = gt * sigmoidf_(gt) * up; }
                int p0 = 0, p1 = 0;
                p0 = __builtin_amdgcn_cvt_pk_fp8_f32(o[0], o[1], p0, false); p0 = __builtin_amdgcn_cvt_pk_fp8_f32(o[2], o[3], p0, true);
                p1 = __builtin_amdgcn_cvt_pk_fp8_f32(o[4], o[5], p1, false); p1 = __builtin_amdgcn_cvt_pk_fp8_f32(o[6], o[7], p1, true);
                *(u32x2*)((unsigned char*)H + (size_t)(row0 + ai * 128 + m * 16) * FF + col0) = (u32x2){(unsigned)p0, (unsigned)p1}; }
    }
};
struct EpiDown {
    static constexpr bool PERM = true;
    bf16_t* Y; const float* slotw;
    __device__ __forceinline__ void operator()(const f32x4 (&acc)[2][2][4][2], const pg8::Unit& u, int wr, int wc, int fr, int fq) const {
        const int row0 = u.pm * 256 + wr * 64 + fr, col0 = u.pn * 256 + wc * 32 + 8 * fq;
#pragma unroll
        for (int ai = 0; ai < 2; ++ai)
#pragma unroll
            for (int m = 0; m < 4; ++m) { const int row = row0 + ai * 128 + m * 16; const float sw = slotw[row] * 0.03125f; bf16_t* rowp = Y + (size_t)row * DM + col0;
#pragma unroll
                for (int bj = 0; bj < 2; ++bj) { const f32x4 v0 = acc[ai][bj][m][0] * sw, v1 = acc[ai][bj][m][1] * sw;
                    u32x4 w; w.x = cvtpk(v0[0], v0[1]); w.y = cvtpk(v0[2], v0[3]); w.z = cvtpk(v1[0], v1[1]); w.w = cvtpk(v1[2], v1[3]);
                    *(u32x4*)(rowp + bj * 128) = w; } }
    }
};

struct Args { const float* in[17]; float* out; unsigned char* ws; int ph_lo, ph_hi; };
static_assert(offsetof(Args, out) == 136 && offsetof(Args, ws) == 144 && sizeof(Args) == 160, "kernarg layout");
struct Ctx {
    LAS unsigned char* lds; const __attribute__((address_space(4))) unsigned char* ka;
    int wave, G, vcu, gw, NGW, bx;
    __device__ __forceinline__ int lane() const { unsigned z_ = 0u; asm volatile("" : "+s"(z_)); return (int)__builtin_amdgcn_mbcnt_hi(~0u, __builtin_amdgcn_mbcnt_lo(~0u, z_)); }
    __device__ __forceinline__ int tid() const { return wave * 64 + lane(); }
#define CTX_IN(name, idx) __device__ __forceinline__ const float* name() const { return *(const float* const __attribute__((address_space(4)))*)(ka + 8 * (idx)); }
    CTX_IN(x, 0) CTX_IN(attn_g, 1) CTX_IN(w_in, 2) CTX_IN(gk_w2, 3) CTX_IN(gk_b, 4) CTX_IN(gla_g, 5) CTX_IN(qn_g, 6) CTX_IN(kn_g, 7) CTX_IN(lb_param, 8) CTX_IN(hgrn_g, 9)
    CTX_IN(w_out, 10) CTX_IN(ffn_g, 11) CTX_IN(w_rg, 12) CTX_IN(w_re, 13) CTX_IN(w_eg, 14) CTX_IN(w_eu, 15) CTX_IN(w_ed, 16)
#define CTX_WS(type, name, off) __device__ __forceinline__ type* name() const { return (type*)(*(unsigned char* const __attribute__((address_space(4)))*)(ka + 144) + (off)); }
    __device__ __forceinline__ float* out() const { return *(float* const __attribute__((address_space(4)))*)(ka + 136); }
    CTX_WS(unsigned, ctl, WS_CTL) CTX_WS(float, cosT, SM_COS) CTX_WS(float, sinT, SM_SIN) CTX_WS(bf16_t, lr, SM_LR) CTX_WS(float, kpart, SM_KPART) CTX_WS(float, decay, SM_DECAY)
    CTX_WS(unsigned, route, SM_ROUTE) CTX_WS(float, slotw, SM_SLOTW) CTX_WS(unsigned, wgcnt, SM_WGCNT) CTX_WS(bf16_t, x1b, WS_X1B) CTX_WS(unsigned, amap, SM_AMAP) CTX_WS(bf16_t, win, WS_WIN) CTX_WS(bf16_t, wout, WS_WOUT) CTX_WS(bf16_t, wgu, WS_WGU) CTX_WS(bf16_t, wd, WS_WD) CTX_WS(unsigned char, h8, WS_H8)
    CTX_WS(bf16_t, proj, WS_PROJ) CTX_WS(bf16_t, st, WS_ST) CTX_WS(bf16_t, ab, WS_AB) CTX_WS(float, kvt, WS_AB) CTX_WS(bf16_t, aperm, WS_APERM) CTX_WS(bf16_t, hbuf, WS_H)
};

struct TrDesc { const float* W; bf16_t* WT; int ldw, col0, k0, K, drow0, nvalid, fp8; };
__device__ __forceinline__ void tr_load(const TrDesc& d, float (&tmp)[32], int lane) {
#pragma unroll
    for (int i = 0; i < 8; ++i) { const int kk = 8 * i + (lane >> 3);
        const f32x4 t = *(const f32x4*)(d.W + (size_t)(d.k0 + kk) * d.ldw + d.col0 + 4 * (lane & 7)); tmp[4 * i] = t.x; tmp[4 * i + 1] = t.y; tmp[4 * i + 2] = t.z; tmp[4 * i + 3] = t.w; }
}
__device__ __forceinline__ void tr_finish(const TrDesc& d, const float (&tmp)[32], LAS float* scr, int lane) {
#pragma unroll
    for (int i = 0; i < 8; ++i) { const int kk = 8 * i + (lane >> 3);
#pragma unroll
        for (int j = 0; j < 4; ++j) scr[kk * 33 + 4 * (lane & 7) + j] = tmp[4 * i + j]; }
    asm volatile("s_waitcnt lgkmcnt(0)" ::: "memory");
    const int c = lane & 7;
    if (d.fp8) {
#pragma unroll
        for (int j = 0; j < 4; ++j) { const int n = (lane >> 3) + 8 * j; const LAS float* s = scr + (8 * c) * 33 + n;
            int p0 = 0, p1 = 0;
            p0 = __builtin_amdgcn_cvt_pk_fp8_f32(s[0 * 33] * 32.f, s[1 * 33] * 32.f, p0, false); p0 = __builtin_amdgcn_cvt_pk_fp8_f32(s[2 * 33] * 32.f, s[3 * 33] * 32.f, p0, true);
            p1 = __builtin_amdgcn_cvt_pk_fp8_f32(s[4 * 33] * 32.f, s[5 * 33] * 32.f, p1, false); p1 = __builtin_amdgcn_cvt_pk_fp8_f32(s[6 * 33] * 32.f, s[7 * 33] * 32.f, p1, true);
            if (n < d.nvalid) *(u32x2*)((unsigned char*)d.WT + (size_t)(d.drow0 + n) * d.K + d.k0 + 8 * c) = (u32x2){(unsigned)p0, (unsigned)p1}; }
    } else {
#pragma unroll
    for (int j = 0; j < 4; ++j) { const int n = (lane >> 3) + 8 * j; const LAS float* s = scr + (8 * c) * 33 + n;
        u32x4 o; o.x = cvtpk(s[0 * 33], s[1 * 33]); o.y = cvtpk(s[2 * 33], s[3 * 33]); o.z = cvtpk(s[4 * 33], s[5 * 33]); o.w = cvtpk(s[6 * 33], s[7 * 33]);
        if (n < d.nvalid) *(u32x4*)(d.WT + (size_t)(d.drow0 + n) * d.K + d.k0 + 8 * c) = o; }
    }
    asm volatile("s_waitcnt lgkmcnt(0)" ::: "memory");
}
constexpr int WC_PER_LAYER = 1664 + 16 + 512 + 16 * 768;
__device__ __forceinline__ TrDesc wconv_decode(const Ctx& X, int it) {
    const int l = it / WC_PER_LAYER; int r = it % WC_PER_LAYER;
    if (r < 1664) { const int kb = r / 104, nb = r % 104; const int col0 = nb < 24 ? 32 * nb : 784 + 32 * (nb - 24); int drow = nb < 24 ? 32 * nb : 768 + 32 * (nb - 24);
        if (drow >= C_BQ && drow < C_BV) {
            const int rel = drow - C_BQ, sec = rel >> 9, hh = (rel & 511) >> 6, dh = (rel & 63) >> 5;
            drow = C_BQ + sec * 512 + 256 * (hh >> 2) + 128 * dh + 32 * (hh & 3); }
        if (drow >= C_BQ && drow < C_CQ) return TrDesc{X.w_in() + (size_t)l * DM * IN_COLS, (bf16_t*)((unsigned char*)(X.win() + (size_t)l * NW_IN * DM) + (size_t)C_BQ * DM * 2), IN_COLS, col0, 64 * kb, DM, drow - C_BQ, 32, 1};
        if (drow >= C_AG && drow < C_BQ) return TrDesc{X.w_in() + (size_t)l * DM * IN_COLS, (bf16_t*)((unsigned char*)(X.win() + (size_t)l * NW_IN * DM) + (size_t)C_BQ * DM * 2), IN_COLS, col0, 64 * kb, DM, 1792 + drow - C_AG, 32, 1};
        return TrDesc{X.w_in() + (size_t)l * DM * IN_COLS, X.win() + (size_t)l * NW_IN * DM, IN_COLS, col0, 64 * kb, DM, drow, 32, 0}; }
    r -= 1664;
    if (r < 16) return TrDesc{X.w_in() + (size_t)l * DM * IN_COLS, (bf16_t*)((unsigned char*)(X.win() + (size_t)l * NW_IN * DM) + (size_t)C_BQ * DM * 2), IN_COLS, 768, 64 * r, DM, 1536, 16, 1};
    r -= 16;
    if (r < 512) { const int kb = r / 32, nb = r % 32; return TrDesc{X.w_out() + (size_t)l * DM * DM, X.wout() + (size_t)l * DM * DM, DM, 32 * nb, 64 * kb, DM, 32 * nb, 32, 0}; }
    r -= 512;
    const int e = r / 768, q = r % 768; const size_t le = (size_t)l * NEXP + e;
    if (q < 512) { const int up = q >= 256, qq = q & 255, kb = qq / 16, nb = qq % 16, col0 = 32 * nb;
        return TrDesc{(up ? X.w_eu() : X.w_eg()) + le * DM * FF, (bf16_t*)((unsigned char*)X.wgu() + le * DM * DM), FF, col0, 64 * kb, DM, 256 * (col0 / 128) + (col0 % 128) + (up ? 128 : 0), 32, 1}; }
    const int qq = q - 512, kb = qq / 32, nb = qq % 32;
    return TrDesc{X.w_ed() + le * FF * DM, (bf16_t*)((unsigned char*)X.wd() + le * DM * FF), DM, 32 * nb, 64 * kb, FF, 32 * nb, 32, 1};
}

__device__ __forceinline__ void row_load(const float* xrow, int lane, f32x4 (&v)[4]) {
    const f32x4* xr = (const f32x4*)xrow + lane;
#pragma unroll
    for (int j = 0; j < 4; ++j) v[j] = xr[64 * j];
}
__device__ __forceinline__ void row_load_bf16(const bf16_t* xrow, int lane, f32x4 (&v)[4]) {
    const u32x2* xr = (const u32x2*)xrow + lane;
#pragma unroll
    for (int j = 0; j < 4; ++j) { const u32x2 w = xr[64 * j]; v[j] = (f32x4){bflo(w.x), bfhi(w.x), bflo(w.y), bfhi(w.y)}; }
}
__device__ __forceinline__ void row_norm_store(f32x4 (&v)[4], const float* g, bf16_t* orow, unsigned char* orow8, int lane) {
    float s = 0.f;
#pragma unroll
    for (int j = 0; j < 4; ++j) s += (v[j].x * v[j].x + v[j].y * v[j].y) + (v[j].z * v[j].z + v[j].w * v[j].w);
    const float rstd = rsqrtf(wave_sum(s) * (1.f / DM) + EPS);
    const f32x4* gr = (const f32x4*)g + lane; u32x2* o8 = (u32x2*)orow + lane;
#pragma unroll
    for (int j = 0; j < 4; ++j) { const f32x4 gg = gr[64 * j]; v[j] = v[j] * rstd * gg; u32x2 w; w.x = cvtpk(v[j].x, v[j].y); w.y = cvtpk(v[j].z, v[j].w); o8[64 * j] = w;
        int p = 0; p = __builtin_amdgcn_cvt_pk_fp8_f32(v[j].x, v[j].y, p, false); p = __builtin_amdgcn_cvt_pk_fp8_f32(v[j].z, v[j].w, p, true); ((unsigned*)orow8)[64 * j + lane] = (unsigned)p; }
}

__device__ __forceinline__ void phase0(const Ctx& X) {
    LAS float* scr = (LAS float*)(X.lds + X.wave * 16384);
    {
        constexpr int NIT = DEPTH * WC_PER_LAYER; int it = X.gw; float cur[32], nxt[32]; TrDesc d, dn;
        if (it < NIT) { d = wconv_decode(X, it); tr_load(d, cur, X.lane()); }
        while (it < NIT) { const int nit = it + X.NGW; dn = d;
            if (nit < NIT) { dn = wconv_decode(X, nit); tr_load(dn, nxt, X.lane()); }
            __builtin_amdgcn_sched_barrier(0);
            tr_finish(d, cur, scr, X.lane());
#pragma unroll
            for (int i = 0; i < 32; ++i) cur[i] = nxt[i];
            d = dn; it = nit; }
    }
    { const int gt = X.gw * 64 + X.lane(), NT = X.NGW * 64;
      for (int i = gt; i < SEQ * 8; i += NT) { const int pos = i >> 3, f = i & 7;
          const float inv = exp2f(-(float)f * 0.125f * 18.931568569324174f);
          const float ang = (float)pos * inv;
          const double a = (double)ang; const double kx = __builtin_rint(a * 0.15915494309189535); const float red = (float)(a - kx * 6.283185307179586);
          X.cosT()[i] = __cosf(red); X.sinT()[i] = __sinf(red); } }
}
__device__ __forceinline__ void phase0b(const Ctx& X) {
    if (X.bx == 0) { for (int i = X.tid(); i < CW_BAR + 3456; i += 512) __hip_atomic_store(X.ctl() + i, 0u, __ATOMIC_RELAXED, __HIP_MEMORY_SCOPE_AGENT); }
    {
        int m = X.gw; f32x4 cur[4], nxt[4];
        if (m < NTOK) row_load(X.x() + (size_t)m * DM, X.lane(), cur);
        for (; m < NTOK; m += X.NGW) { const int mn = m + X.NGW;
            if (mn < NTOK) row_load(X.x() + (size_t)mn * DM, X.lane(), nxt);
            row_norm_store(cur, X.attn_g(), X.ab() + (size_t)m * DM, X.h8() + (size_t)m * DM, X.lane());
#pragma unroll
            for (int j = 0; j < 4; ++j) cur[j] = nxt[j]; }
    }
}

__device__ __forceinline__ void moba_prep_item(const Ctx& X, int layer, int item) {
    const int part = item & 3, bb = item >> 2; const int lane = X.lane(), w = X.wave;
    const int tok0 = (bb >> 4) * SEQ + (bb & 15) * 256 + part * 64 + w * 8;
    const int sub = lane & 7;
    float gq[8], gk[8], ks[8];
#pragma unroll
    for (int j = 0; j < 8; ++j) { gq[j] = X.qn_g()[layer * 64 + sub * 8 + j]; gk[j] = X.kn_g()[layer * 64 + sub * 8 + j]; ks[j] = 0.f; }
    for (int t = 0; t < 8; ++t) {
        const int tok = tok0 + t, pos = tok & (SEQ - 1);
        float cs[8], sn[8];
#pragma unroll
        for (int j = 0; j < 8; ++j) { cs[j] = X.cosT()[pos * 8 + j]; sn[j] = X.sinT()[pos * 8 + j]; }
#pragma unroll
        for (int which = 0; which < 2; ++which) {
            bf16_t* p = X.proj() + (size_t)tok * PP + (which ? C_BK : C_BQ) + lane * 8;
            const u32x4 raw = *(const u32x4*)p; float v[8];
            v[0] = bflo(raw.x); v[1] = bfhi(raw.x); v[2] = bflo(raw.y); v[3] = bfhi(raw.y); v[4] = bflo(raw.z); v[5] = bfhi(raw.z); v[6] = bflo(raw.w); v[7] = bfhi(raw.w);
            float ss = 0.f;
#pragma unroll
            for (int j = 0; j < 8; ++j) ss += v[j] * v[j];
            ss += __shfl_xor(ss, 1); ss += __shfl_xor(ss, 2); ss += __shfl_xor(ss, 4);
            const float rstd = rsqrtf(ss * (1.f / 64.f) + EPS);
#pragma unroll
            for (int j = 0; j < 8; ++j) v[j] = v[j] * rstd * (which ? gk[j] : gq[j]);
#pragma unroll
            for (int j = 0; j < 8; ++j) { const float other = __shfl_xor(v[j], 1);
                if (sub == 0) v[j] = v[j] * cs[j] - other * sn[j]; else if (sub == 1) v[j] = v[j] * cs[j] + other * sn[j]; }
            if (which) {
#pragma unroll
                for (int j = 0; j < 8; ++j) ks[j] += v[j];
            } else {
#pragma unroll
                for (int j = 0; j < 8; ++j) v[j] *= (0.125f * LOG2E);
            }
            u32x4 o; o.x = cvtpk(v[0], v[1]); o.y = cvtpk(v[2], v[3]); o.z = cvtpk(v[4], v[5]); o.w = cvtpk(v[6], v[7]);
            *(u32x4*)p = o;
        }
    }
    LAS float* red = (LAS float*)X.lds;
#pragma unroll
    for (int j = 0; j < 8; ++j) red[w * 512 + lane * 8 + j] = ks[j];
    __syncthreads();
    { const int c = X.tid(); float s = 0.f;
#pragma unroll
      for (int ww = 0; ww < 8; ++ww) s += red[ww * 512 + c];
      X.kpart()[(size_t)item * 512 + c] = s; }
    __syncthreads();
}

template <int W> __device__ __forceinline__ void tile_load(const bf16_t* src, u32x4 (&r)[W / 8], int lane) {
    constexpr int LPR = W / 8, RPI = 64 / LPR;
#pragma unroll
    for (int i = 0; i < W / 8; ++i) r[i] = *(const u32x4*)(src + (size_t)(RPI * i + lane / LPR) * PP + (lane % LPR) * 8);
}
template <int W> __device__ __forceinline__ void tile_store(LAS unsigned char* reg, const u32x4 (&r)[W / 8], int lane) {
    constexpr int LPR = W / 8, RPI = 64 / LPR;
#pragma unroll
    for (int i = 0; i < W / 8; ++i) *(LAS u32x4*)(reg + (RPI * i + lane / LPR) * 144 + (lane % LPR) * 16) = r[i];
}
template <bool GLA, bool PHC>
__device__ __forceinline__ void lin_item(const Ctx& X, int layer, int b, int c, int h, LAS unsigned char* wl) {
    const int lane = X.lane(), r32 = lane & 31, hi = lane >> 5;
    const size_t row0 = (size_t)b * SEQ + (size_t)c * 64;
    const bf16_t* P = X.proj();
    constexpr int WK = GLA ? 32 : 64;
    const int fl = GLA ? (lane & 31) : lane;
    const int qcol0 = GLA ? (C_AQ + 32 * h) : (C_CQ + 64 * h);
    const int kcol0 = GLA ? (C_AK + 32 * h) : (C_CF + 64 * h);
    const int vcol0 = GLA ? (C_AV + 64 * h) : (C_CI + 64 * h);
    const float fv = (GLA && lane >= 32) ? 0.f : 1.f;
    LAS unsigned char* R0 = wl; LAS unsigned char* R1 = wl + 9216;
    u32x4 tv[8], tk[WK / 8], tq[WK / 8]; u32x4 lr0 = {}, lr1 = {};
    tile_load<64>(P + row0 * PP + vcol0, tv, lane);
    tile_load<WK>(P + row0 * PP + kcol0, tk, lane);
    if (PHC) tile_load<WK>(P + row0 * PP + qcol0, tq, lane);
    if (GLA) { lr0 = *(const u32x4*)(X.lr() + (row0 + lane) * 16); lr1 = *(const u32x4*)(X.lr() + (row0 + lane) * 16 + 8); }
    float w2[16]; float bias = 0.f, lb = 0.f;
    if (GLA) {
#pragma unroll
        for (int r = 0; r < 16; ++r) w2[r] = X.gk_w2()[(size_t)layer * 16 * 128 + r * 128 + 32 * h + fl];
        bias = X.gk_b()[layer * 128 + 32 * h + fl];
    } else {
#pragma unroll
        for (int r = 0; r < 16; ++r) w2[r] = 0.f;
        if (layer > 0) lb = sigmoidf_(X.lb_param()[256 + 64 * h + fl] - X.lb_param()[64 * h + fl]);
    }
    const int h8 = GLA ? h : 4 + h;
    const size_t sbase = (((size_t)b * 64 + c) * 8 + h8) * 4096;
    unsigned pvall[32];
    bf16x8 s0f[2][4];
    if (PHC) {
#pragma unroll
        for (int vi = 0; vi < 2; ++vi)
#pragma unroll
            for (int ks = 0; ks < 4; ++ks) s0f[vi][ks] = *(const bf16x8*)(X.st() + sbase + (size_t)(32 * vi + r32) * 64 + 16 * ks + 8 * hi);
        tile_store<64>(R0, tv, lane);
#pragma unroll
        for (int m = 0; m < 32; ++m) { const unsigned v0 = *(const LAS bf16_t*)(R0 + (2 * m) * 144 + lane * 2), v1 = *(const LAS bf16_t*)(R0 + (2 * m + 1) * 144 + lane * 2); pvall[m] = v0 | (v1 << 16); }
        asm volatile("s_waitcnt lgkmcnt(0)" ::: "memory");
        tile_store<WK>(R0, tq, lane); tile_store<WK>(R1, tk, lane);
    } else {
        tile_store<64>(R0, tv, lane); tile_store<WK>(R1, tk, lane);
    }
    float bsum = 0.f, eprod = 1.f;
    f32x16 g00 = {}, g01 = {}, g10 = {}, g11 = {};
    for (int s = 0; s < 4; ++s) {
        float kt[16], qt[16];
#pragma unroll
        for (int t = 0; t < 16; ++t) {
            const int tt = 16 * s + t;
            const float rawk = bf2f(*(const LAS bf16_t*)(R1 + tt * 144 + fl * 2));
            float qv = 0.f; if (PHC) qv = bf2f(*(const LAS bf16_t*)(R0 + tt * 144 + fl * 2));
            float a, kk;
            if (GLA) {
                float z = bias;
                { const unsigned u0 = (unsigned)__builtin_amdgcn_readlane((int)lr0.x, tt), u1 = (unsigned)__builtin_amdgcn_readlane((int)lr0.y, tt), u2 = (unsigned)__builtin_amdgcn_readlane((int)lr0.z, tt), u3 = (unsigned)__builtin_amdgcn_readlane((int)lr0.w, tt);
                  z += bflo(u0) * w2[0] + bfhi(u0) * w2[1] + bflo(u1) * w2[2] + bfhi(u1) * w2[3] + bflo(u2) * w2[4] + bfhi(u2) * w2[5] + bflo(u3) * w2[6] + bfhi(u3) * w2[7]; }
                { const unsigned u0 = (unsigned)__builtin_amdgcn_readlane((int)lr1.x, tt), u1 = (unsigned)__builtin_amdgcn_readlane((int)lr1.y, tt), u2 = (unsigned)__builtin_amdgcn_readlane((int)lr1.z, tt), u3 = (unsigned)__builtin_amdgcn_readlane((int)lr1.w, tt);
                  z += bflo(u0) * w2[8] + bfhi(u0) * w2[9] + bflo(u1) * w2[10] + bfhi(u1) * w2[11] + bflo(u2) * w2[12] + bfhi(u2) * w2[13] + bflo(u3) * w2[14] + bfhi(u3) * w2[15]; }
                a = (fminf(z, 0.f) - __logf(1.f + __expf(-fabsf(z)))) * (1.f / 16.f);
                kk = rawk; qv *= 0.17677669529663687f;
            } else {
                const float ef = __expf(-rawk), sg = 1.f / (1.f + ef);
                a = lb + (1.f - lb) * sg;
                kk = (1.f - lb) * (ef * sg);
                qv = qv * sigmoidf_(qv);
            }
            float eb, enb;
            if (GLA) { a *= fv; kk *= fv; qv *= fv; bsum += a; eb = __expf(bsum); enb = __expf(-bsum); }
            else { eprod *= a; eb = eprod; enb = __builtin_amdgcn_rcpf(eprod); }
            kt[t] = kk * enb; qt[t] = qv * eb;
        }
        if (PHC) {
#pragma unroll
            for (int t = 0; t < 16; ++t) {
                *(LAS bf16_t*)(R0 + (16 * s + t) * 144 + lane * 2) = (bf16_t)(cvtpk(qt[t], 0.f) & 0xffffu);
                *(LAS bf16_t*)(R1 + (16 * s + t) * 144 + lane * 2) = (bf16_t)(cvtpk(kt[t], 0.f) & 0xffffu);
            }
        } else {
            unsigned pk[8], pv[8];
#pragma unroll
            for (int m = 0; m < 8; ++m) { pk[m] = cvtpk(kt[2 * m], kt[2 * m + 1]);
                const unsigned v0 = *(const LAS bf16_t*)(R0 + (16 * s + 2 * m) * 144 + lane * 2), v1 = *(const LAS bf16_t*)(R0 + (16 * s + 2 * m + 1) * 144 + lane * 2); pv[m] = v0 | (v1 << 16); }
            u32x4 av0, av1, bk0, bk1;
#pragma unroll
            for (int m = 0; m < 4; ++m) {
                auto rv = __builtin_amdgcn_permlane32_swap(pv[m], pv[m + 4], false, false); av0[m] = rv[0]; av1[m] = rv[1];
                auto rk = __builtin_amdgcn_permlane32_swap(pk[m], pk[m + 4], false, false); bk0[m] = rk[0]; bk1[m] = rk[1];
            }
            const bf16x8 A0 = __builtin_bit_cast(bf16x8, av0), A1 = __builtin_bit_cast(bf16x8, av1), B0 = __builtin_bit_cast(bf16x8, bk0), B1 = __builtin_bit_cast(bf16x8, bk1);
            g00 = MFMA32(A0, B0, g00); g01 = MFMA32(A0, B1, g01); g10 = MFMA32(A1, B0, g10); g11 = MFMA32(A1, B1, g11);
        }
    }
    if (!PHC) {
        const float dec = GLA ? __expf(bsum) : eprod;
        X.decay()[(((size_t)b * 64 + c) * 8 + h8) * 64 + lane] = dec;
        const float d0 = __shfl(dec, r32), d1 = __shfl(dec, 32 + r32);
        float* kv = X.kvt() + sbase;
#pragma unroll
        for (int r = 0; r < 16; ++r) { const int v0 = crow(r, hi);
            kv[(size_t)v0 * 64 + r32] = g00[r] * d0; kv[(size_t)v0 * 64 + 32 + r32] = g01[r] * d1;
            kv[(size_t)(32 + v0) * 64 + r32] = g10[r] * d0; kv[(size_t)(32 + v0) * 64 + 32 + r32] = g11[r] * d1; }
        return;
    }
    if (PHC) {
        bf16x8 avp[2][4];
#pragma unroll
        for (int sg = 0; sg < 4; ++sg) {
            u32x4 f0, f1;
            auto r0 = __builtin_amdgcn_permlane32_swap(pvall[8 * sg + 0], pvall[8 * sg + 2], false, false); f0[0] = r0[0]; f1[0] = r0[1];
            auto r1 = __builtin_amdgcn_permlane32_swap(pvall[8 * sg + 1], pvall[8 * sg + 3], false, false); f0[1] = r1[0]; f1[1] = r1[1];
            auto r2 = __builtin_amdgcn_permlane32_swap(pvall[8 * sg + 4], pvall[8 * sg + 6], false, false); f0[2] = r2[0]; f1[2] = r2[1];
            auto r3 = __builtin_amdgcn_permlane32_swap(pvall[8 * sg + 5], pvall[8 * sg + 7], false, false); f0[3] = r3[0]; f1[3] = r3[1];
            avp[0][sg] = __builtin_bit_cast(bf16x8, f0); avp[1][sg] = __builtin_bit_cast(bf16x8, f1);
        }
        const LAS unsigned char* QT = wl; const LAS unsigned char* KT = wl + 9216;
        f32x16 o[2][2];
#pragma unroll
        for (int it = 0; it < 2; ++it) {
            bf16x8 bq[4];
#pragma unroll
            for (int ks = 0; ks < 4; ++ks) bq[ks] = *(const LAS bf16x8*)(QT + (32 * it + r32) * 144 + ks * 32 + hi * 16);
#pragma unroll
            for (int vi = 0; vi < 2; ++vi) { f32x16 acc = {};
#pragma unroll
                for (int ks = 0; ks < 4; ++ks) acc = MFMA32(s0f[vi][ks], bq[ks], acc);
                o[vi][it] = acc; }
#pragma unroll
            for (int jt = 0; jt <= it; ++jt) {
                f32x16 sc = {};
#pragma unroll
                for (int ks = 0; ks < 4; ++ks) { const bf16x8 ak = *(const LAS bf16x8*)(KT + (32 * jt + r32) * 144 + ks * 32 + hi * 16); sc = MFMA32(ak, bq[ks], sc); }
                if (jt == it) {
#pragma unroll
                    for (int r = 0; r < 16; ++r) if (crow(r, hi) > r32) sc[r] = 0.f;
                }
#pragma unroll
                for (int sp = 0; sp < 2; ++sp) {
                    u32x4 pw; pw.x = cvtpk(sc[8 * sp + 0], sc[8 * sp + 1]); pw.y = cvtpk(sc[8 * sp + 2], sc[8 * sp + 3]); pw.z = cvtpk(sc[8 * sp + 4], sc[8 * sp + 5]); pw.w = cvtpk(sc[8 * sp + 6], sc[8 * sp + 7]);
                    const bf16x8 pb = __builtin_bit_cast(bf16x8, pw);
                    o[0][it] = MFMA32(avp[0][2 * jt + sp], pb, o[0][it]); o[1][it] = MFMA32(avp[1][2 * jt + sp], pb, o[1][it]);
                }
            }
        }
        const float* ng = (GLA ? X.gla_g() : X.hgrn_g()) + layer * 64;
        const int gcol = GLA ? (C_AG + 64 * h) : (C_CG + 64 * h);
        const int mcol = GLA ? (64 * h) : (768 + 64 * h);
#pragma unroll
        for (int it = 0; it < 2; ++it) {
            float ss = 0.f;
#pragma unroll
            for (int vi = 0; vi < 2; ++vi)
#pragma unroll
                for (int r = 0; r < 16; ++r) ss += o[vi][it][r] * o[vi][it][r];
            ss += __shfl_xor(ss, 32);
            const float rstd = rsqrtf(ss * (1.f / 64.f) + EPS);
            const size_t row = row0 + 32 * it + r32;
#pragma unroll
            for (int vi = 0; vi < 2; ++vi)
#pragma unroll
                for (int g = 0; g < 4; ++g) { const int v0 = 32 * vi + 8 * g + 4 * hi;
                    const u32x2 gr = *(const u32x2*)(P + row * PP + gcol + v0);
                    const f32x4 gn = *(const f32x4*)(ng + v0);
                    const float g0 = bflo(gr.x), g1 = bfhi(gr.x), g2 = bflo(gr.y), g3 = bfhi(gr.y);
                    const float y0 = o[vi][it][4 * g + 0] * rstd * gn.x * (g0 * sigmoidf_(g0)), y1 = o[vi][it][4 * g + 1] * rstd * gn.y * (g1 * sigmoidf_(g1));
                    const float y2 = o[vi][it][4 * g + 2] * rstd * gn.z * (g2 * sigmoidf_(g2)), y3 = o[vi][it][4 * g + 3] * rstd * gn.w * (g3 * sigmoidf_(g3));
                    u32x2 w; w.x = cvtpk(y0, y1); w.y = cvtpk(y2, y3);
                    *(u32x2*)(X.ab() + row * DM + mcol + v0) = w; asm volatile("" ::: "memory"); }
        }
    }
}

__device__ __forceinline__ void scan_phase(const Ctx& X, int layer) {
    const int NTH = X.G * 512;
    for (int e = X.bx * 512 + X.tid(); e < NBATCH * 8 * 4096; e += NTH) {
        const int b = e >> 15, rem = e & 32767, h8 = rem >> 12, vk = rem & 4095, k = vk & 63;
        float S = 0.f;
        {
            float kv[64], dc[64];
            const float* kvp = X.kvt() + ((size_t)b * 64 * 8 + h8) * 4096 + vk; const float* dcp = X.decay() + ((size_t)b * 64 * 8 + h8) * 64 + k;
#pragma unroll
            for (int j = 0; j < 64; ++j) { kv[j] = kvp[(size_t)j * 8 * 4096]; dc[j] = dcp[(size_t)j * 8 * 64]; }
            __builtin_amdgcn_sched_barrier(0);
            bf16_t* stp = X.st() + ((size_t)b * 64 * 8 + h8) * 4096 + vk;
#pragma unroll
            for (int j = 0; j < 64; ++j) { stp[(size_t)j * 8 * 4096] = (bf16_t)(cvtpk(S, 0.f) & 0xffffu); S = dc[j] * S + kv[j]; }
        }
    }
    asm volatile("s_waitcnt vmcnt(0)" ::: "memory");
    __syncthreads();
    if (X.tid() == 0) { __builtin_amdgcn_fence(__ATOMIC_RELEASE, "agent"); __hip_atomic_fetch_add(X.ctl() + 64 + layer, 1u, __ATOMIC_RELAXED, __HIP_MEMORY_SCOPE_AGENT); }
}
__device__ __forceinline__ void scan_wait(const Ctx& X, int layer) {
    if (X.tid() == 0) { unsigned sp = 0;
        while (__hip_atomic_load(X.ctl() + 64 + layer, __ATOMIC_RELAXED, __HIP_MEMORY_SCOPE_AGENT) < (unsigned)X.G) { __builtin_amdgcn_s_sleep(2); if (++sp > (1u << 24)) break; }
        __builtin_amdgcn_fence(__ATOMIC_ACQUIRE, "agent"); }
    __syncthreads();
    __builtin_amdgcn_fence(__ATOMIC_ACQUIRE, "workgroup");
}

constexpr int AT_KS = 0, AT_WL = 4096, AT_RING = 8192, AT_SLOT = 16384, AT_NSLOT = 8;
static_assert(AT_RING + AT_NSLOT * AT_SLOT <= MISC_OFF, "attention ring");
__device__ __forceinline__ s16x4 vtr(const LAS unsigned char* p) { typedef short v4i16_t __attribute__((ext_vector_type(4))); return __builtin_bit_cast(s16x4, __builtin_amdgcn_ds_read_tr16_b64_v4i16((LAS v4i16_t*)p)); }
#define AT_WAITBAR(N) asm volatile("s_waitcnt vmcnt(" #N ") lgkmcnt(0)\n\ts_barrier" ::: "memory")
__device__ __forceinline__ void at_kload(bf16x8 (&kf)[8], const LAS unsigned char* Kb, int r32, int hi) {
#pragma unroll
    for (int d0 = 0; d0 < 4; ++d0) { kf[2 * d0] = *(const LAS bf16x8*)(Kb + (2 * d0 + hi) * 1024 + r32 * 16); kf[2 * d0 + 1] = *(const LAS bf16x8*)(Kb + (2 * d0 + hi) * 1024 + (32 + r32) * 16); }
}
template <bool OWN, bool HN1, int TT>
__device__ __forceinline__ void attn_tile(f32x16& pc0, f32x16& pc1, f32x16& pn0, f32x16& pn1, f32x16& o0, f32x16& o1, f32x16& o2, const f32x16& bvec, bf16x8 (&kf)[8], const bf16x8 (&qr)[4],
                                          const LAS unsigned char* Vb, const LAS unsigned char* Kn1, int vpo, int r32, int hi, int qh) {
    if (HN1) at_kload(kf, Kn1, r32, hi);
    s16x4 vl[4], vh[4];
#pragma unroll
    for (int i = 0; i < 4; ++i) { vl[i] = vtr(Vb + vpo + i * 1024); vh[i] = vtr(Vb + vpo + i * 1024 + 512); }
    __builtin_amdgcn_sched_barrier(0);
#pragma unroll
    for (int d0 = 0; d0 < 4; ++d0) {
#pragma unroll
        for (int r = 4 * d0; r < 4 * d0 + 4; ++r) pc0[r] = __builtin_amdgcn_exp2f(pc0[r]);
        if (HN1) pn0 = MFMA32(kf[2 * d0], qr[d0], d0 == 0 ? bvec : pn0);
#pragma unroll
        for (int r = 4 * d0; r < 4 * d0 + 4; ++r) pc1[r] = __builtin_amdgcn_exp2f(pc1[r]);
        if (HN1) pn1 = MFMA32(kf[2 * d0 + 1], qr[d0], d0 == 0 ? bvec : pn1);
    }
    if (OWN) {
#pragma unroll
        for (int r = 0; r < 16; ++r) { const int kc = 64 * TT + (r & 3) + 8 * (r >> 2);
            pc0[r] = (kc > qh) ? 0.f : pc0[r]; pc1[r] = (kc + 32 > qh) ? 0.f : pc1[r]; }
    }
    s16x4 wl_[4], wh_[4];
#pragma unroll
    for (int i = 0; i < 4; ++i) { wl_[i] = vtr(Vb + vpo + 4096 + i * 1024); wh_[i] = vtr(Vb + vpo + 4096 + i * 1024 + 512); }
    __builtin_amdgcn_sched_barrier(0);
    bf16x8 pa[4];
#pragma unroll
    for (int s = 0; s < 2; ++s) {
        u32x4 w0; w0.x = cvtpk(pc0[8 * s + 0], pc0[8 * s + 1]); w0.y = cvtpk(pc0[8 * s + 2], pc0[8 * s + 3]); w0.z = cvtpk(pc0[8 * s + 4], pc0[8 * s + 5]); w0.w = cvtpk(pc0[8 * s + 6], pc0[8 * s + 7]);
        u32x4 w1; w1.x = cvtpk(pc1[8 * s + 0], pc1[8 * s + 1]); w1.y = cvtpk(pc1[8 * s + 2], pc1[8 * s + 3]); w1.z = cvtpk(pc1[8 * s + 4], pc1[8 * s + 5]); w1.w = cvtpk(pc1[8 * s + 6], pc1[8 * s + 7]);
        pa[s] = __builtin_bit_cast(bf16x8, w0); pa[2 + s] = __builtin_bit_cast(bf16x8, w1);
    }
    const bf16x8 ones = (bf16x8){0x3f80, 0x3f80, 0x3f80, 0x3f80, 0x3f80, 0x3f80, 0x3f80, 0x3f80};
#pragma unroll
    for (int ks = 0; ks < 4; ++ks) { const bf16x8 vb0 = (bf16x8){vl[ks][0], vl[ks][1], vl[ks][2], vl[ks][3], vh[ks][0], vh[ks][1], vh[ks][2], vh[ks][3]}; o0 = MFMA32(pa[ks], vb0, o0); o2 = MFMA32(pa[ks], ones, o2); }
#pragma unroll
    for (int ks = 0; ks < 4; ++ks) { const bf16x8 vb1 = (bf16x8){wl_[ks][0], wl_[ks][1], wl_[ks][2], wl_[ks][3], wh_[ks][0], wh_[ks][1], wh_[ks][2], wh_[ks][3]}; o1 = MFMA32(pa[ks], vb1, o1); }
}
__device__ __forceinline__ void attn_unit(const Ctx& X, int layer, int b, int h, int qi) {
    int lane_ = X.lane(), wid_ = X.wave; asm volatile("" : "+v"(lane_), "+s"(wid_));
    const int lane = lane_, wid = wid_, tid = wid * 64 + lane, r32 = lane & 31, hi = lane >> 5;
    LAS unsigned char* lds = X.lds;
    const bf16_t* P = X.proj();
    const size_t rowbase = (size_t)b * SEQ;
    const size_t qrow = rowbase + 256 * qi + 32 * wid + r32;
    float gqm = fabsf(X.qn_g()[layer * 64 + lane]), gkm = fabsf(X.kn_g()[layer * 64 + lane]);
    gqm = wave_max(gqm); gkm = wave_max(gkm);
    const float negM = -(8.3f * gqm * gkm * LOG2E);
    bf16x8 qr[4];
#pragma unroll
    for (int d0 = 0; d0 < 4; ++d0) qr[d0] = *(const bf16x8*)(P + qrow * PP + C_BQ + 64 * h + 16 * d0 + 8 * hi);
    {
        LAS float* ks = (LAS float*)(lds + AT_KS);
#pragma unroll
        for (int e = 0; e < 2; ++e) { const int idx = tid * 2 + e, n = idx >> 6, d = idx & 63; float s = 0.f;
#pragma unroll
            for (int p = 0; p < 2; ++p) s += X.kpart()[((size_t)(b * 16 + n) * 2 + p) * 512 + 64 * h + d];
            ks[idx] = s; }
    }
    __syncthreads();
    const unsigned kgo = (unsigned)(((rowbase + lane) * PP + C_BK + 64 * h + 8 * wid) * 2);
    const unsigned vgo = (unsigned)(((rowbase + 16 * (wid & 3) + (lane >> 2)) * PP + C_BV + 64 * h + (wid >> 2) * 32 + (lane & 3) * 8) * 2);
    const unsigned lds0 = (unsigned)(uintptr_t)lds;
#define AT_ISSUE(t) do { const unsigned sl_ = (unsigned)__builtin_amdgcn_readfirstlane((int)(lds0 + AT_RING + ((t) & (AT_NSLOT - 1)) * AT_SLOT + wid * 1024)); \
        glds16(P, kgo + (unsigned)(t) * (64u * PP * 2u), sl_); glds16(P, vgo + (unsigned)(t) * (64u * PP * 2u), sl_ + 8192u); } while (0)
#define AT_SLOTP(t) (lds + AT_RING + ((t) & (AT_NSLOT - 1)) * AT_SLOT)
    const int T = 4 * (qi + 1);
    AT_ISSUE(0); AT_ISSUE(1); AT_ISSUE(2); AT_ISSUE(3);
    unsigned sel = 0u;
    if (qi <= 3) sel = (1u << qi) - 1u;
    else {
        float qf[32];
#pragma unroll
        for (int d0 = 0; d0 < 4; ++d0) { const u32x4 w = __builtin_bit_cast(u32x4, qr[d0]);
            qf[8 * d0 + 0] = bflo(w.x); qf[8 * d0 + 1] = bfhi(w.x); qf[8 * d0 + 2] = bflo(w.y); qf[8 * d0 + 3] = bfhi(w.y);
            qf[8 * d0 + 4] = bflo(w.z); qf[8 * d0 + 5] = bfhi(w.z); qf[8 * d0 + 6] = bflo(w.w); qf[8 * d0 + 7] = bfhi(w.w); }
        float gt[15];
        const LAS float* ks = (const LAS float*)(lds + AT_KS);
#pragma unroll
        for (int n = 0; n < 15; ++n) {
            float s = 0.f;
            if (n < qi) {
#pragma unroll
                for (int d0 = 0; d0 < 4; ++d0) { const f32x4 k0 = *(const LAS f32x4*)(ks + n * 64 + 16 * d0 + 8 * hi), k1 = *(const LAS f32x4*)(ks + n * 64 + 16 * d0 + 8 * hi + 4);
                    s += qf[8 * d0 + 0] * k0.x + qf[8 * d0 + 1] * k0.y + qf[8 * d0 + 2] * k0.z + qf[8 * d0 + 3] * k0.w + qf[8 * d0 + 4] * k1.x + qf[8 * d0 + 5] * k1.y + qf[8 * d0 + 6] * k1.z + qf[8 * d0 + 7] * k1.w; }
                s += __shfl_xor(s, 32);
                asm volatile("" ::: "memory");
            }
            gt[n] = (n < qi) ? s : -INFINITY;
        }
#pragma unroll
        for (int pass = 0; pass < 3; ++pass) {
            float best = -INFINITY; int bi = -1;
#pragma unroll
            for (int n = 0; n < 15; ++n) if (gt[n] > best) { best = gt[n]; bi = n; }
            if (bi >= 0) sel |= 1u << bi;
#pragma unroll
            for (int n = 0; n < 15; ++n) if (n == bi) gt[n] = -INFINITY;
        }
    }
    const float NEGBIG = -1.0e30f;
#define AT_BIAS(t) (((t) >= T - 4) ? negM : ((((sel >> ((t) >> 2)) & 1u) != 0u) ? negM : NEGBIG))
    f32x16 o0 = {}, o1 = {}, o2 = {}, pA0, pA1, pB0, pB1, bvec; bf16x8 kf[8];
    const int vpo = ((lane >> 4) & 1) * 32 + (lane & 3) * 8 + (4 * hi + ((lane & 15) >> 2)) * 64;
    const int qh = 32 * wid + r32 - 4 * hi;
    AT_WAITBAR(6);
    at_kload(kf, AT_SLOTP(0), r32, hi);
    { const float b0 = AT_BIAS(0);
#pragma unroll
      for (int r = 0; r < 16; ++r) bvec[r] = b0;
#pragma unroll
      for (int d0 = 0; d0 < 4; ++d0) { pA0 = MFMA32(kf[2 * d0], qr[d0], d0 == 0 ? bvec : pA0); pA1 = MFMA32(kf[2 * d0 + 1], qr[d0], d0 == 0 ? bvec : pA1); } }
#define AT_STEP(OWN, HN1, HN2, TT, PC0, PC1, PN0, PN1, t) do { \
        if ((t) + 3 < T) AT_WAITBAR(4); else if ((t) + 2 < T) AT_WAITBAR(2); else AT_WAITBAR(0); \
        if ((t) + 4 < T) AT_ISSUE((t) + 4); \
        if ((((t) + 1) & 3) == 0) { const float bn_ = AT_BIAS((t) + 1); _Pragma("unroll") for (int r_ = 0; r_ < 16; ++r_) bvec[r_] = bn_; }        \
        attn_tile<OWN, HN1, TT>(PC0, PC1, PN0, PN1, o0, o1, o2, bvec, kf, qr, AT_SLOTP(t) + 8192, AT_SLOTP((t) + 1), vpo, r32, hi, qh); } while (0)
    int t = 0;
    for (; t < T - 4; t += 2) {
        AT_STEP(false, true, true, 0, pA0, pA1, pB0, pB1, t);
        AT_STEP(false, true, true, 0, pB0, pB1, pA0, pA1, t + 1);
    }
    AT_STEP(true, true, true, 0, pA0, pA1, pB0, pB1, t);
    AT_STEP(true, true, true, 1, pB0, pB1, pA0, pA1, t + 1);
    AT_STEP(true, true, false, 2, pA0, pA1, pB0, pB1, t + 2);
    AT_STEP(true, false, false, 3, pB0, pB1, pA0, pA1, t + 3);
    bf16_t* orow = X.ab() + (rowbase + 256 * qi + 32 * wid) * DM + 256 + 64 * h;
#pragma unroll
    for (int r = 0; r < 16; ++r) { const int q = crow(r, hi); const float rl = 1.0f / o2[r];
        orow[(size_t)q * DM + r32] = (bf16_t)(cvtpk(o0[r] * rl, 0.f) & 0xffffu);
        orow[(size_t)q * DM + 32 + r32] = (bf16_t)(cvtpk(o1[r] * rl, 0.f) & 0xffffu); }
    __syncthreads();
#undef AT_ISSUE
#undef AT_SLOTP
#undef AT_BIAS
#undef AT_STEP
}

__device__ __forceinline__ void router_phase(const Ctx& X, int layer) {
    LAS float* wr = (LAS float*)X.lds;
    {
        f32x4 rg[2], re[2][4];
#pragma unroll
        for (int q = 0; q < 2; ++q) { const int k = X.tid() + 512 * q; rg[q] = *(const f32x4*)(X.w_rg() + (size_t)layer * DM * 4 + k * 4);
#pragma unroll
            for (int j = 0; j < 4; ++j) re[q][j] = *(const f32x4*)(X.w_re() + (size_t)layer * DM * 16 + k * 16 + 4 * j); }
#pragma unroll
        for (int q = 0; q < 2; ++q) { const int k = X.tid() + 512 * q;
#pragma unroll
            for (int c = 0; c < 4; ++c) wr[c * DM + k] = rg[q][c];
#pragma unroll
            for (int j = 0; j < 4; ++j)
#pragma unroll
                for (int c = 0; c < 4; ++c) wr[(4 + 4 * j + c) * DM + k] = re[q][j][c]; }
    }
    LAS unsigned* lcnt = (LAS unsigned*)(X.lds + MISC_OFF + 256);
    if (X.tid() < 16) lcnt[X.tid()] = 0u;
    __syncthreads();
    const int lane = X.lane();
    f32x4 v[4], vnx[4];
    if (X.gw < NTOK) row_load_bf16(X.x1b() + (size_t)X.gw * DM, lane, v);
    for (int m = X.gw; m < NTOK; m += X.NGW) {
        { const int mn = m + X.NGW; if (mn < NTOK) row_load_bf16(X.x1b() + (size_t)mn * DM, lane, vnx); }
        {
            float s = 0.f;
#pragma unroll
            for (int j = 0; j < 4; ++j) s += (v[j].x * v[j].x + v[j].y * v[j].y) + (v[j].z * v[j].z + v[j].w * v[j].w);
            const float rstd = rsqrtf(wave_sum(s) * (1.f / DM) + EPS);
            const f32x4* gr = (const f32x4*)(X.ffn_g() + layer * DM) + lane; unsigned* o4 = (unsigned*)((unsigned char*)X.ab() + (size_t)m * DM) + lane;
#pragma unroll
            for (int j = 0; j < 4; ++j) { const f32x4 gg = gr[64 * j]; v[j] = v[j] * rstd * gg; int p = 0; p = __builtin_amdgcn_cvt_pk_fp8_f32(v[j].x, v[j].y, p, false); p = __builtin_amdgcn_cvt_pk_fp8_f32(v[j].z, v[j].w, p, true); o4[64 * j] = (unsigned)p; }
        }
        float lg[4];
#pragma unroll
        for (int c = 0; c < 4; ++c) { float s = 0.f;
#pragma unroll
            for (int j = 0; j < 4; ++j) { const f32x4 w = *(const LAS f32x4*)(wr + c * DM + 4 * (64 * j + lane)); s += v[j].x * w.x + v[j].y * w.y + v[j].z * w.z + v[j].w * w.w; }
            lg[c] = wave_sum(s); }
        asm volatile("" ::: "memory");
        int gs = 0; float gm = lg[0];
#pragma unroll
        for (int c = 1; c < 4; ++c) if (lg[c] > gm) { gm = lg[c]; gs = c; }
        float den = 0.f;
#pragma unroll
        for (int c = 0; c < 4; ++c) den += __expf(lg[c] - gm);
        const float pg = 1.0f / den;
        float le[4];
        { const LAS float* wre = wr + (4 + 4 * gs) * DM;
#pragma unroll
          for (int j = 0; j < 4; ++j) { float s = 0.f;
#pragma unroll
              for (int q = 0; q < 4; ++q) { const f32x4 w = *(const LAS f32x4*)(wre + j * DM + 4 * (64 * q + lane)); s += v[q].x * w.x + v[q].y * w.y + v[q].z * w.z + v[q].w * w.w; }
              le[j] = wave_sum(s); } }
        int i1 = 0; float v1 = le[0];
#pragma unroll
        for (int j = 1; j < 4; ++j) if (le[j] > v1) { v1 = le[j]; i1 = j; }
        int i2 = -1; float v2 = -INFINITY;
#pragma unroll
        for (int j = 0; j < 4; ++j) if (j != i1 && le[j] > v2) { v2 = le[j]; i2 = j; }
        const float ex = __expf(v2 - v1); const float w1 = pg / (1.f + ex), w2 = pg * ex / (1.f + ex);
        if (lane == 0) {
            const int e0 = 4 * gs + i1, e1 = 4 * gs + i2;
            const unsigned p0 = __hip_atomic_fetch_add(lcnt + e0, 1u, __ATOMIC_RELAXED, __HIP_MEMORY_SCOPE_WORKGROUP), p1 = __hip_atomic_fetch_add(lcnt + e1, 1u, __ATOMIC_RELAXED, __HIP_MEMORY_SCOPE_WORKGROUP);
            unsigned* rt = X.route() + (size_t)m * 8;
            rt[0] = (unsigned)e0; rt[1] = (unsigned)e1; rt[2] = p0; rt[3] = p1; rt[4] = __float_as_uint(w1); rt[5] = __float_as_uint(w2);
        }
#pragma unroll
        for (int j = 0; j < 4; ++j) v[j] = vnx[j];
    }
    __syncthreads();
    if (X.tid() < 16) X.wgcnt()[X.vcu * 16 + X.tid()] = lcnt[X.tid()];
}

__device__ __forceinline__ int expert_off_rows(const Ctx& X, int layer, int lane) {
    const int e = lane & 15; const unsigned c = __hip_atomic_load(X.ctl() + layer * 16 + e, __ATOMIC_RELAXED, __HIP_MEMORY_SCOPE_AGENT);
    const int tiles = (int)((c + 255u) >> 8); int incl = tiles;
#pragma unroll
    for (int o = 1; o < 16; o <<= 1) { const int t = __shfl_up(incl, o, 16); if (e >= o) incl += t; }
    return (incl - tiles) * 256;
}

__device__ __forceinline__ void gather_phase(const Ctx& X, int layer) {
    const int lane = X.lane();
    LAS unsigned* red = (LAS unsigned*)X.lds;
    { const int e = X.tid() & 15, part = X.tid() >> 4; unsigned all = 0u, lt = 0u;
      for (int w0 = part; w0 < X.G; w0 += 256) {
          unsigned c[8];
#pragma unroll
          for (int j = 0; j < 8; ++j) { const int w = w0 + 32 * j; c[j] = (w < X.G) ? X.wgcnt()[w * 16 + e] : 0u; }
#pragma unroll
          for (int j = 0; j < 8; ++j) { const int w = w0 + 32 * j; all += c[j]; lt += (w < X.vcu) ? c[j] : 0u; } }
      red[part * 16 + e] = all; red[512 + part * 16 + e] = lt; }
    __syncthreads();
    LAS unsigned* tab = (LAS unsigned*)(X.lds + MISC_OFF + 512);
    if (X.tid() < 32) { const int e = X.tid() & 15, which = X.tid() >> 4; unsigned s = 0u;
        for (int p = 0; p < 32; ++p) s += red[which * 512 + p * 16 + e];
        tab[X.tid()] = s; if (which == 0 && X.bx == 0) X.ctl()[layer * 16 + e] = s; }
    __syncthreads();
    int off;
    { const int e = lane & 15; const unsigned c = tab[e]; const int tiles = (int)((c + 255u) >> 8); int incl = tiles;
#pragma unroll
      for (int o = 1; o < 16; o <<= 1) { const int t = __shfl_up(incl, o, 16); if (e >= o) incl += t; }
      off = (incl - tiles) * 256 + (int)tab[16 + e]; }
    for (int m0 = X.gw; m0 < NTOK; m0 += 64 * X.NGW) {
        const int m = m0 + lane * X.NGW; const bool ok = m < NTOK;
        unsigned* rt = X.route() + (size_t)(ok ? m : 0) * 8;
        const u32x4 r0 = *(const u32x4*)rt; const u32x2 r1 = *(const u32x2*)(rt + 4);
        const int s0 = __shfl(off, (int)(r0.x & 15u)) + (int)r0.z, s1 = __shfl(off, (int)(r0.y & 15u)) + (int)r0.w;
        if (ok) { X.amap()[s0] = (unsigned)m; X.amap()[s1] = (unsigned)m; X.slotw()[s0] = __uint_as_float(r1.x); X.slotw()[s1] = __uint_as_float(r1.y); *(u32x2*)(rt + 6) = (u32x2){(unsigned)s0, (unsigned)s1}; }
    }
}
__device__ __forceinline__ void moe_table(const Ctx& X, int layer) {
    volatile LAS int* toff = (volatile LAS int*)(X.lds + MISC_OFF);
    if (X.tid() < 64) { const int off = expert_off_rows(X, layer, X.lane());
        if (X.lane() < 16) toff[X.lane()] = off >> 8;
        if (X.lane() == 15) { const unsigned c = __hip_atomic_load(X.ctl() + layer * 16 + 15, __ATOMIC_RELAXED, __HIP_MEMORY_SCOPE_AGENT); toff[16] = (off >> 8) + (int)((c + 255u) >> 8); } }
    __syncthreads();
}

__device__ __forceinline__ void combine_phase(const Ctx& X, int layer) {
    const int lane = X.lane();
    int m = X.gw; unsigned sB0 = 0, sB1 = 0, sC0 = 0, sC1 = 0;
    u32x2 xc[4], xn[4]; u32x2 ya[4], yb[4], yan[4], ybn[4];
#define CB_LOAD(XV, YA, YB, mm, s0, s1) do { const u32x2* xr_ = (const u32x2*)(X.x1b() + (size_t)(mm) * DM) + lane; const u32x2* y0_ = (const u32x2*)(X.aperm() + (size_t)(s0) * DM) + lane; const u32x2* y1_ = (const u32x2*)(X.aperm() + (size_t)(s1) * DM) + lane; \
        _Pragma("unroll") for (int j = 0; j < 4; ++j) { XV[j] = xr_[64 * j]; YA[j] = y0_[64 * j]; YB[j] = y1_[64 * j]; } } while (0)
    if (m < NTOK) { const unsigned* rt = X.route() + (size_t)m * 8; const unsigned s0 = rt[6], s1 = rt[7]; CB_LOAD(xc, ya, yb, m, s0, s1); }
    if (m + X.NGW < NTOK) { const unsigned* rt = X.route() + (size_t)(m + X.NGW) * 8; sB0 = rt[6]; sB1 = rt[7]; }
    for (; m < NTOK; m += X.NGW) {
        const int mn = m + X.NGW, mnn = m + 2 * X.NGW;
        if (mn < NTOK) CB_LOAD(xn, yan, ybn, mn, sB0, sB1);
        if (mnn < NTOK) { const unsigned* rt = X.route() + (size_t)mnn * 8; sC0 = rt[6]; sC1 = rt[7]; }
        float* xr = X.out() + (size_t)m * DM;
        f32x4 v[4]; float ss = 0.f;
#pragma unroll
        for (int j = 0; j < 4; ++j) { const f32x4 xv = (f32x4){bflo(xc[j].x), bfhi(xc[j].x), bflo(xc[j].y), bfhi(xc[j].y)}; const u32x2 a = ya[j], bq = yb[j];
            f32x4 r; r.x = xv.x + bflo(a.x) + bflo(bq.x); r.y = xv.y + bfhi(a.x) + bfhi(bq.x); r.z = xv.z + bflo(a.y) + bflo(bq.y); r.w = xv.w + bfhi(a.y) + bfhi(bq.y);
            v[j] = r; ss += (r.x * r.x + r.y * r.y) + (r.z * r.z + r.w * r.w);
            if (layer + 1 < DEPTH) { u32x2 w; w.x = cvtpk(r.x, r.y); w.y = cvtpk(r.z, r.w); ((u32x2*)(X.x1b() + (size_t)m * DM))[64 * j + lane] = w; }
            else ((f32x4*)xr)[64 * j + lane] = r; }
        if (layer + 1 < DEPTH) {
            const float rstd = rsqrtf(wave_sum(ss) * (1.f / DM) + EPS);
            const f32x4* gr = (const f32x4*)(X.attn_g() + (layer + 1) * DM) + lane; u32x2* o8 = (u32x2*)(X.ab() + (size_t)m * DM) + lane;
#pragma unroll
            for (int j = 0; j < 4; ++j) { const f32x4 gg = gr[64 * j]; const f32x4 hh = v[j] * rstd * gg; u32x2 w; w.x = cvtpk(hh.x, hh.y); w.y = cvtpk(hh.z, hh.w); o8[64 * j] = w;
                int p = 0; p = __builtin_amdgcn_cvt_pk_fp8_f32(hh.x, hh.y, p, false); p = __builtin_amdgcn_cvt_pk_fp8_f32(hh.z, hh.w, p, true); ((unsigned*)(X.h8() + (size_t)m * DM))[64 * j + lane] = (unsigned)p; }
        }
#pragma unroll
        for (int j = 0; j < 4; ++j) { xc[j] = xn[j]; ya[j] = yan[j]; yb[j] = ybn[j]; }
        sB0 = sC0; sB1 = sC1;
    }
#undef CB_LOAD
}

#define XB_TMO      128
#define XB_XCNT(j)  (256  + 64 * (j))
#define XB_XSUB(j)  (1280 + 64 * (j))
#define XB_XGEN(j)  (2304 + 64 * (j))
#define XB_TOP      3328
#define XB_TOPGEN   3392
#define XB_SPIN_CAP (1u << 22)
__device__ __forceinline__ unsigned xb_ld(unsigned* p)              { return __hip_atomic_load(p, __ATOMIC_RELAXED, __HIP_MEMORY_SCOPE_AGENT); }
__device__ __forceinline__ unsigned xb_add(unsigned* p, unsigned v) { return __hip_atomic_fetch_add(p, v, __ATOMIC_RELAXED, __HIP_MEMORY_SCOPE_AGENT); }
__device__ __forceinline__ unsigned xb_xcc_id() { return (unsigned)__builtin_amdgcn_s_getreg((3 << 11) | 20) & 0xFu; }
#define XB_SPIN(cond, bar) do { unsigned _sp = 0; while (cond) { __builtin_amdgcn_s_sleep(1); \
    if ((++_sp & 255u) == 0u) { if (xb_ld(&(bar)[XB_TMO])) break; if (_sp > XB_SPIN_CAP) { atomicAdd(&(bar)[XB_TMO], 1u); break; } } } } while (0)
struct XcdBarrier { unsigned* bar; unsigned x; volatile LAS unsigned* st; };
__device__ __forceinline__ XcdBarrier xcd_barrier_post(unsigned* bar, volatile LAS unsigned* st) {
    XcdBarrier b; b.bar = bar; b.x = xb_xcc_id(); b.st = st;
    if (threadIdx.x == 0) (void)xb_add(&bar[XB_XCNT(b.x)], 1u);
    return b;
}
__device__ __forceinline__ void xcd_barrier_complete(unsigned* bar, unsigned x, unsigned& nloc, unsigned& nx) {
    const unsigned G = gridDim.x * gridDim.y * gridDim.z;
    unsigned sum, cnt, mine, sp = 0u;
    for (;;) {
        sum = 0u; cnt = 0u; mine = 0u;
#pragma unroll 1
        for (unsigned j = 0; j < 16; ++j) { const unsigned c = xb_ld(&bar[XB_XCNT(j)]); sum += c; cnt += (c > 0u) ? 1u : 0u; mine = (j == x) ? c : mine; }
        if (sum == G) break;
        __builtin_amdgcn_s_sleep(1);
        if ((++sp & 255u) == 0u) { if (xb_ld(&bar[XB_TMO])) break; if (sp > XB_SPIN_CAP) { atomicAdd(&bar[XB_TMO], 1u); break; } }
    }
    nloc = mine > 0u ? mine : 1u; nx = cnt > 0u ? cnt : 1u;
}
__device__ __forceinline__ void xcd_barrier(const XcdBarrier& b) {
    asm volatile("s_waitcnt vmcnt(0)" ::: "memory");
    __syncthreads();
    if (threadIdx.x == 0) {
        unsigned* bar = b.bar; unsigned bx_ = b.x;
        asm volatile("" : "+s"(bar), "+s"(bx_));
        __builtin_amdgcn_s_waitcnt(0);
        unsigned nloc = b.st[0], nx = b.st[1];
        if (nloc == 0u) { xcd_barrier_complete(bar, bx_, nloc, nx); b.st[0] = nloc; b.st[1] = nx; }
        const unsigned old = xb_add(&bar[XB_XSUB(bx_)], 1u);
        const unsigned gen = old / nloc;
        if (old + 1u == (gen + 1u) * nloc) {
            __builtin_amdgcn_fence(__ATOMIC_RELEASE, "agent");
            asm volatile("s_waitcnt vmcnt(0)" ::: "memory");
            const unsigned og = xb_add(&bar[XB_TOP], 1u);
            const unsigned tg = og / nx;
            if (og + 1u == (tg + 1u) * nx) xb_add(&bar[XB_TOPGEN], 1u);
            else XB_SPIN(xb_ld(&bar[XB_TOPGEN]) == tg, bar);
            __builtin_amdgcn_fence(__ATOMIC_ACQUIRE, "agent");
            xb_add(&bar[XB_XGEN(bx_)], 1u);
            asm volatile("s_waitcnt vmcnt(0)" ::: "memory");
        } else {
            XB_SPIN(xb_ld(&bar[XB_XGEN(bx_)]) == gen, bar);
            __builtin_amdgcn_fence(__ATOMIC_ACQUIRE, "agent");
            asm volatile("s_waitcnt vmcnt(0)" ::: "memory");
        }
    }
    __syncthreads();
}

#ifndef PHMASK
#define PHMASK 0xffff
#endif
#ifndef PROBE_A
#define PROBE_A -1
#define PROBE_B -1
#endif
#ifndef PROBE_BLK
#define PROBE_BLK 0
#endif
constexpr int NPHASE = 1 + 8 * DEPTH;
__global__ void __launch_bounds__(512, 2) fwd_kernel(Args args) {
    extern __shared__ __attribute__((aligned(16))) unsigned char lds_raw[];
    cg::grid_group grid = cg::this_grid();
    const int wave_s = __builtin_amdgcn_readfirstlane((int)(threadIdx.x >> 6));
    const int lo = args.ph_lo, hi = args.ph_hi;
    { volatile LAS unsigned* m = (volatile LAS unsigned*)((LAS unsigned char*)lds_raw + MISC_OFF); if (threadIdx.x < 64) m[threadIdx.x] = 0u; }
    __syncthreads();
    XcdBarrier xbar; xbar.bar = (unsigned*)(args.ws + WS_CTL) + CW_BAR; xbar.x = 0u; xbar.st = (volatile LAS unsigned*)((LAS unsigned char*)lds_raw + MISC_OFF + 128);
#if PROBE_A >= 0
    unsigned prA = 0, prT = 0, prE = 0; const unsigned prS = (unsigned)__builtin_amdgcn_s_memrealtime();
#define PROBE_ACC(type, d) do { if ((type) == PROBE_A) prA += (d); } while (0)
#endif
#if PROBE_A >= 0
#define PROBE_SUB(type) do { __syncthreads(); const unsigned t_ = (unsigned)__builtin_amdgcn_s_memrealtime(); PROBE_ACC(type, t_ - prSub); prSub = t_; } while (0)
    unsigned prSub = 0;
#else
#define PROBE_SUB(type) do {} while (0)
#endif
    for (int ph = lo; ph < hi; ++ph) {
        if (ph > lo) { if (ph == lo + 1) { grid.sync(); xbar = xcd_barrier_post((unsigned*)(args.ws + WS_CTL) + CW_BAR, (volatile LAS unsigned*)((LAS unsigned char*)lds_raw + MISC_OFF + 128)); } else xcd_barrier(xbar); }
#if PROBE_A >= 0
        prT = (unsigned)__builtin_amdgcn_s_memrealtime(); prSub = prT; if (ph > lo) PROBE_ACC(11, prT - prE);
#endif
        Ctx X;
#define CTX_REFRESH() do { \
        { unsigned l0 = 0u; asm volatile("" : "+s"(l0)); X.lds = (LAS unsigned char*)lds_raw + l0; } \
        { unsigned z0 = 0u; asm volatile("" : "+s"(z0)); \
          int ws = wave_s; asm volatile("" : "+s"(ws)); (void)z0; \
          X.wave = ws; } \
        { int bx = blockIdx.x, G = gridDim.x; asm volatile("" : "+s"(bx), "+s"(G)); X.G = G; X.vcu = (G % 8 == 0) ? (bx % 8) * (G / 8) + bx / 8 : bx; X.bx = bx; } \
        X.gw = X.vcu * 8 + X.wave; X.NGW = X.G * 8; \
        { const __attribute__((address_space(4))) unsigned char* ka = (const __attribute__((address_space(4))) unsigned char*)__builtin_amdgcn_kernarg_segment_ptr(); asm volatile("" : "+s"(ka)); X.ka = ka; } } while (0)
        CTX_REFRESH();
        const int layer = (ph - 1) / 8; int k = ph == 0 ? 0 : (ph - 1) % 8 + 1; if (k >= 3) ++k; if (k >= 9) ++k;
        if (ph == 0) { phase0(X); PROBE_SUB(15); CTX_REFRESH(); phase0b(X); PROBE_SUB(16); }
        else switch (k) {
        case 1: {
            {
                pg8::Gemm g{X.ab(), X.win() + (size_t)layer * NW_IN * DM, DM}; pg8::StaticOrder S; S.init(NTOK, 1536, X.G, X.bx, 0xCBA910ull, 0, 0);
                EpiProj<false> E{X.proj(), X.lr(), X.qn_g() + layer * 64, X.kn_g() + layer * 64, X.cosT(), X.sinT(), X.kpart()};
                pg8::gemm_phase<EpiProj<false>, pg8::StaticOrder>(X.lds, g, S, E, X.tid()); }
            PROBE_SUB(19);
            CTX_REFRESH();
            {
                pg8::Gemm g{(const bf16_t*)X.h8(), (const bf16_t*)((const unsigned char*)(X.win() + (size_t)layer * NW_IN * DM) + (size_t)C_BQ * DM * 2), DM / 2}; pg8::StaticOrder S; S.init(NTOK, 2048, X.G, X.bx, 0x2D876543ull, 1, 1);
                EpiProj<true> E{X.proj(), X.lr(), X.qn_g() + layer * 64, X.kn_g() + layer * 64, X.cosT(), X.sinT(), X.kpart()};
                pg8::gemm_phase<EpiProj<true>, pg8::StaticOrder, false, true>(X.lds, g, S, E, X.tid()); }
        } break;
        case 2: {
            PROBE_SUB(17);
            LAS unsigned char* wl = X.lds + X.wave * WAVE_LDS;
            for (int it = X.gw; it < 2048; it += X.NGW) { const int h8 = it & 7, bc = it >> 3, b = bc >> 6, c = bc & 63;
                if (h8 < 4) lin_item<true, false>(X, layer, b, c, h8, wl); else lin_item<false, false>(X, layer, b, c, h8 - 4, wl); }
            PROBE_SUB(18);
        } break;
        case 4: {
            scan_phase(X, layer);
            PROBE_SUB(3);
            CTX_REFRESH();
            if (PHMASK & 0x800) for (int v = X.vcu; v < 256; v += X.G) { const int bh = v >> 3, s = v & 7; attn_unit(X, layer, bh >> 3, bh & 7, s); attn_unit(X, layer, bh >> 3, bh & 7, 15 - s); }
            PROBE_SUB(13);
            CTX_REFRESH();
            scan_wait(X, layer);
            LAS unsigned char* wl = X.lds + X.wave * WAVE_LDS;
            if (PHMASK & 0x1000) for (int it = X.gw; it < 2048; it += X.NGW) { const int h8 = it & 7, bc = it >> 3, b = bc >> 6, c = bc & 63;
                if (h8 < 4) lin_item<true, true>(X, layer, b, c, h8, wl); else lin_item<false, true>(X, layer, b, c, h8 - 4, wl); }
            PROBE_SUB(14);
        } break;
        case 5: {
            pg8::Gemm g{X.ab(), X.wout() + (size_t)layer * DM * DM, DM}; pg8::StaticOrder S; S.init(NTOK, DM, X.G, X.bx);
            EpiResid E{X.x(), X.x1b(), layer == 0 ? (const bf16_t*)nullptr : (const bf16_t*)X.x1b()};
            pg8::gemm_phase<EpiResid, pg8::StaticOrder>(X.lds, g, S, E, X.tid());
        } break;
        case 6: router_phase(X, layer); break;
        case 7: gather_phase(X, layer); break;
        case 8: {
            moe_table(X, layer);
            unsigned* tcnt;
            { const unsigned long long p_ = (unsigned long long)(uintptr_t)(X.ctl() + 256 + layer * 256);
              tcnt = (unsigned*)(uintptr_t)(((unsigned long long)(unsigned)__builtin_amdgcn_readfirstlane((int)(p_ >> 32)) << 32) | (unsigned long long)(unsigned)__builtin_amdgcn_readfirstlane((int)p_)); }
            { pg8::Gemm g{X.ab(), X.wgu(), DM / 2}; pg8::GroupedOrder S{(const volatile LAS int*)(X.lds + MISC_OFF), X.G, X.vcu, layer * 64, tcnt, (LAS unsigned*)(X.lds + MISC_OFF + 192), 0, 0, 0, 0};
              EpiSwiglu E{X.hbuf()};
              pg8::gemm_phase<EpiSwiglu, pg8::GroupedOrder, true, true>(X.lds, g, S, E, X.tid(), X.amap(), (unsigned)(NTOK - 1)); S.finish(X.wave); }
            PROBE_SUB(8);
            CTX_REFRESH();
            { pg8::Gemm g{X.hbuf(), X.wd(), FF / 2}; pg8::GroupedOrderDown S{(const volatile LAS int*)(X.lds + MISC_OFF), X.G, X.vcu, layer * 64, tcnt, (LAS unsigned*)(X.lds + MISC_OFF + 200 + 4 * layer), X.wave, 0u};
              EpiDown E{X.aperm(), X.slotw()};
              pg8::gemm_phase<EpiDown, pg8::GroupedOrderDown, false, true>(X.lds, g, S, E, X.tid()); }
            PROBE_SUB(9);
        } break;
        case 10: combine_phase(X, layer); break;
        }
        __syncthreads();
#if PROBE_A >= 0
        prE = (unsigned)__builtin_amdgcn_s_memrealtime(); PROBE_ACC(k, prE - prT);
#endif
    }
#if PROBE_A >= 0
    PROBE_ACC(12, prE - prS);
    if (wave_s == 0 && __builtin_amdgcn_mbcnt_hi(~0u, __builtin_amdgcn_mbcnt_lo(~0u, 0u)) == 0u) {
        unsigned* ctl = (unsigned*)(args.ws + WS_CTL);
        if (blockIdx.x == PROBE_BLK) { const unsigned qa = (prA + 400u) / 800u > 127u ? 127u : (prA + 400u) / 800u;
            __hip_atomic_store(ctl + 200, qa, __ATOMIC_RELAXED, __HIP_MEMORY_SCOPE_AGENT); }
        __builtin_amdgcn_fence(__ATOMIC_RELEASE, "agent");
        const unsigned done = __hip_atomic_fetch_add(ctl + 201, 1u, __ATOMIC_ACQ_REL, __HIP_MEMORY_SCOPE_AGENT);
        if (done == gridDim.x - 1) { const unsigned long long extra = (unsigned long long)__hip_atomic_load(ctl + 200, __ATOMIC_RELAXED, __HIP_MEMORY_SCOPE_AGENT) * 400ull; const unsigned long long t0 = __builtin_amdgcn_s_memrealtime();
            while (__builtin_amdgcn_s_memrealtime() - t0 < extra) __builtin_amdgcn_s_sleep(32); }
    }
#endif
}

extern "C" void kernel_launch(void* const* d_in, const int* in_sizes, int n_in, void* d_out, int out_size, void* d_ws, size_t ws_size, hipStream_t stream) {
    static int grid = 0;
    if (grid == 0) {
        if (n_in != 17 || out_size != NTOK * DM || ws_size < WS_END) { fprintf(stderr, "kernel_launch: unexpected problem (n_in %d out %d ws %zu)\n", n_in, out_size, ws_size); grid = -1; return; }
        int dev = 0, cus = 0, per_cu = 0;
        hipGetDevice(&dev); hipDeviceGetAttribute(&cus, hipDeviceAttributeMultiprocessorCount, dev);
        if (hipFuncSetAttribute((const void*)fwd_kernel, hipFuncAttributeMaxDynamicSharedMemorySize, LDS_BYTES) != hipSuccess) { fprintf(stderr, "kernel_launch: hipFuncSetAttribute failed\n"); }
        if (hipOccupancyMaxActiveBlocksPerMultiprocessor(&per_cu, (const void*)fwd_kernel, 512, LDS_BYTES) != hipSuccess || per_cu < 1) { fprintf(stderr, "kernel_launch: occupancy query says %d\n", per_cu); per_cu = 1; }
        (void)hipGetLastError();
        grid = cus * per_cu;
        fprintf(stderr, "kernel_launch: grid %d (cus %d x %d), ws %zu\n", grid, cus, per_cu, ws_size);
    }
    if (grid < 0) return;
    Args a{};
    for (int i = 0; i < 17; ++i) a.in[i] = (const float*)d_in[i];
    a.out = (float*)d_out; a.ws = (unsigned char*)d_ws;
#if MK_PER_PHASE
    for (int ph = 0; ph < NPHASE; ++ph) { a.ph_lo = ph; a.ph_hi = ph + 1; hipLaunchKernelGGL(fwd_kernel, dim3(grid), dim3(512), LDS_BYTES, stream, a); }
#else
    a.ph_lo = 0; a.ph_hi = NPHASE;
    void* kargs[] = {&a};
    hipError_t e = hipLaunchCooperativeKernel((const void*)fwd_kernel, dim3(grid), dim3(512), kargs, LDS_BYTES, stream);
    if (e != hipSuccess) fprintf(stderr, "cooperative launch failed: %s (grid %d)\n", hipGetErrorString(e), grid);
#endif
}
```

```cpp
#include <hip/hip_runtime.h>
#include <hip/hip_cooperative_groups.h>
#include <cstdio>
#include <cstdint>
#include <cstddef>
namespace cg = cooperative_groups;

#ifndef MK_PER_PHASE
#define MK_PER_PHASE 0
#endif

#define LAS __attribute__((address_space(3)))
typedef unsigned short bf16_t;
typedef short bf16x8 __attribute__((ext_vector_type(8)));
typedef short s16x4 __attribute__((ext_vector_type(4)));
typedef float f32x2 __attribute__((ext_vector_type(2)));
typedef float f32x4 __attribute__((ext_vector_type(4)));
typedef float f32x16 __attribute__((ext_vector_type(16)));
typedef unsigned u32x2 __attribute__((ext_vector_type(2)));
typedef unsigned u32x4 __attribute__((ext_vector_type(4)));
typedef __bf16 bf16x2_t __attribute__((ext_vector_type(2)));

constexpr int NTOK = 16384, DM = 1024, SEQ = 4096, NBATCH = 4, DEPTH = 2;
constexpr int IN_COLS = 3344;
constexpr int PP = 3328;
constexpr int NW_IN = 3584;
constexpr int C_AQ = 0, C_AK = 128, C_AV = 256, C_AG = 512, C_BQ = 768, C_BK = 1280, C_BV = 1792, C_CQ = 2304, C_CF = 2560, C_CI = 2816, C_CG = 3072;
constexpr int NEXP = 16, FF = 512;
constexpr int MOE_ROWS = 36864;
constexpr float EPS = 1e-6f;
constexpr float LOG2E = 1.4426950408889634f;

constexpr size_t MiB = 1u << 20;
constexpr size_t WS_CTL = 0;
constexpr size_t WS_SMALL = 1 * MiB;
constexpr size_t SM_COS = WS_SMALL, SM_SIN = WS_SMALL + 128 * 1024;
constexpr size_t SM_LR = WS_SMALL + 256 * 1024;
constexpr size_t SM_KPART = WS_SMALL + 768 * 1024;
constexpr size_t SM_DECAY = WS_SMALL + 1280 * 1024;
constexpr size_t SM_ROUTE = WS_SMALL + 1792 * 1024;
constexpr size_t SM_SLOTW = WS_SMALL + 2304 * 1024;
constexpr size_t SM_AMAP = WS_SMALL + 2816 * 1024;
constexpr size_t SM_WGCNT = WS_SMALL + 2560 * 1024;
constexpr int CW_BAR = 4096;
constexpr size_t CTL_ZERO_BYTES = 65536;
constexpr size_t WS_WIN = 5 * MiB;
constexpr size_t WS_WOUT = 19 * MiB;
constexpr size_t WS_WGU = 23 * MiB;
constexpr size_t WS_X1B = 23 * MiB + 32 * MiB;
constexpr size_t WS_WD = 87 * MiB;
constexpr size_t WS_H8 = 103 * MiB;
constexpr size_t WS_PROJ = 119 * MiB;
constexpr size_t WS_ST = 223 * MiB;
constexpr size_t WS_AB = 239 * MiB;
constexpr int MOE_CAP = 16384;
constexpr size_t WS_AMAP2 = 271 * MiB;
constexpr size_t WS_SLOTW2 = 272 * MiB;
constexpr size_t WS_END = 273 * MiB;
constexpr size_t WS_APERM = WS_PROJ;
constexpr size_t WS_H = WS_PROJ + 72 * MiB;
static_assert(WS_H + (size_t)MOE_ROWS * FF * 2 <= WS_AB, "moe overlay");

constexpr int LDS_BYTES = 159744;
constexpr int MISC_OFF = 147456;
constexpr int GROW_OFF = MISC_OFF + 1024;
constexpr int WAVE_LDS = 18432;

__device__ __forceinline__ unsigned cvtpk(float lo, float hi) { f32x2 v = {lo, hi}; bf16x2_t b = __builtin_convertvector(v, bf16x2_t); return __builtin_bit_cast(unsigned, b); }
__device__ __forceinline__ float bf2f(unsigned short u) { return __builtin_bit_cast(float, (unsigned)u << 16); }
__device__ __forceinline__ float bflo(unsigned u) { return __builtin_bit_cast(float, u << 16); }
__device__ __forceinline__ float bfhi(unsigned u) { return __builtin_bit_cast(float, u & 0xffff0000u); }
#define DPP_ADD(v, ctrl) ((v) + __builtin_bit_cast(float, __builtin_amdgcn_update_dpp(0, __builtin_bit_cast(int, (v)), (ctrl), 0xf, 0xf, true)))
__device__ __forceinline__ float wave_sum(float v) {
    v = DPP_ADD(v, 0xB1); v = DPP_ADD(v, 0x4E); v = DPP_ADD(v, 0x141); v = DPP_ADD(v, 0x140);
    const int iv = __builtin_bit_cast(int, v);
    const float r0 = __builtin_bit_cast(float, __builtin_amdgcn_readlane(iv, 0)), r1 = __builtin_bit_cast(float, __builtin_amdgcn_readlane(iv, 16));
    const float r2 = __builtin_bit_cast(float, __builtin_amdgcn_readlane(iv, 32)), r3 = __builtin_bit_cast(float, __builtin_amdgcn_readlane(iv, 48));
    return (r0 + r1) + (r2 + r3);
}
__device__ __forceinline__ float wave_max(float v) {
#pragma unroll
    for (int o = 1; o < 64; o <<= 1) v = fmaxf(v, __shfl_xor(v, o));
    return v;
}
__device__ __forceinline__ int crow(int r, int hi) { return (r & 3) + 8 * (r >> 2) + 4 * hi; }
__device__ __forceinline__ float sigmoidf_(float x) { return 1.0f / (1.0f + __expf(-x)); }
#define MFMA32(a, b, c) __builtin_amdgcn_mfma_f32_32x32x16_bf16((a), (b), (c), 0, 0, 0)

__device__ __forceinline__ void glds16(const void* sbase, unsigned voff, unsigned lds_dst) { unsigned keep;
    asm volatile("s_mov_b32 %0, m0\n\ts_mov_b32 m0, %3\n\ts_nop 0\n\tglobal_load_lds_dwordx4 %1, %2\n\ts_mov_b32 m0, %0" : "=&s"(keep) : "v"(voff), "s"(sbase), "s"(lds_dst) : "memory"); }

namespace pg8 {
#define PG8_LAS __attribute__((address_space(3)))
constexpr int BM = 256, BK = 64, HALF = 128, HTB = HALF * BK * 2, STAGE_BYTES = 8 * HTB, NXCD = 8, WGM = 8;
__host__ __device__ __forceinline__ int lds_byte(int r, int c) { const int st = (r >> 4) * 2 + (c >> 5), rr = r & 15, cc = c & 31, ob = rr * 64 + cc * 2; return st * 1024 + (ob ^ (((ob >> 9) & 1) << 5)); }
__host__ __device__ __forceinline__ void stage_rc(int b, int& R, int& C) { const int st = b / 1024, sb = b % 1024, swz = sb ^ (((sb >> 9) & 1) << 5); R = (st >> 1) * 16 + swz / 64; C = (st & 1) * 32 + (swz % 64) / 2; }
__host__ __device__ __forceinline__ int perm32(int rho) { const int n = rho >> 4, i = rho & 15; return 8 * (i >> 2) + 4 * n + (i & 3); }

struct Unit { int pm, pn, bt, ab; };
struct Gemm { const bf16_t* A; const bf16_t* Bt; int K; };

struct StaticOrder {
    int nM, nN, nwg, G, c, compact, skew; unsigned long long tbl;
    __device__ void init(int M, int N, int G_, int c_, unsigned long long tbl_ = 0xFEDCBA9876543210ull, int compact_ = 0, int skew_ = 0) { nM = M / BM; nN = N / BM; nwg = nM * nN; G = G_; c = c_; tbl = tbl_; compact = compact_; skew = skew_; }
    __device__ bool next(int i, Unit& u) const {
        long L = (long)i * G + c;
        if (skew && i > 0) { const int hg = G >> 1; if (c < hg) return false; L = (long)G + (long)(i - 1) * hg + (c - hg); }
        if (L >= nwg) return false;
        int wgid = (int)L; { const int q = nwg / NXCD, r = nwg % NXCD, xcd = wgid % NXCD, off = wgid / NXCD; wgid = (xcd < r ? xcd * (q + 1) : r * (q + 1) + (xcd - r) * q) + off; }
        const int nig = WGM * nN, gid = wgid / nig, fm = gid * WGM, gsz = (nM - fm) < WGM ? (nM - fm) : WGM;
        u.pm = fm + ((wgid % nig) % gsz); { const int pn_ = (wgid % nig) / gsz; u.pn = (int)((tbl >> (4 * pn_)) & 15ull); u.bt = compact ? pn_ : u.pn; } return true;
    }
    __device__ __forceinline__ void a_ready(const Unit&) const {}
    __device__ __forceinline__ void done(const Unit&) const {}
};
struct GroupedOrder {
    const volatile PG8_LAS int* toff; int G, vcu, wbase;
    __device__ bool next(int i, Unit& u) const {
        const int U = i * G + vcu; const int total = toff[16];
        if (U >= total * 4) return false;
        const int rt = U >> 2, pn = U & 3; int e = 0;
#pragma unroll
        for (int j = 1; j < 16; ++j) e += (rt >= toff[j]) ? 1 : 0;
        u.pm = __builtin_amdgcn_readfirstlane(rt); u.pn = __builtin_amdgcn_readfirstlane(pn); u.bt = __builtin_amdgcn_readfirstlane(wbase + e * 4 + pn); u.ab = __builtin_amdgcn_readfirstlane(e * 64 + rt - toff[e]); return true;
    }
    __device__ __forceinline__ void a_ready(const Unit&) const {}
    unsigned* cnt; PG8_LAS unsigned* wgarr;
    mutable int dp0, dp1, dp2, ndp;
    __device__ __forceinline__ void done(const Unit& u) const {
        { const int n8 = toff[16] * 4, rem = n8 - (n8 / G) * G;
          if (vcu >= rem) { if (ndp == 0) dp0 = u.pm; else if (ndp == 1) dp1 = u.pm; else dp2 = u.pm; ++ndp; return; } }
        asm volatile("s_waitcnt vmcnt(0)" ::: "memory");
        unsigned old = 0u;
        if (__builtin_amdgcn_mbcnt_hi(~0u, __builtin_amdgcn_mbcnt_lo(~0u, 0u)) == 0u) old = __hip_atomic_fetch_add(wgarr, 1u, __ATOMIC_RELAXED, __HIP_MEMORY_SCOPE_WORKGROUP);
        old = (unsigned)__builtin_amdgcn_readfirstlane((int)old);
        if ((old & 7u) == 7u) {
            __builtin_amdgcn_fence(__ATOMIC_RELEASE, "agent");
            if (__builtin_amdgcn_mbcnt_hi(~0u, __builtin_amdgcn_mbcnt_lo(~0u, 0u)) == 0u) __hip_atomic_fetch_add(cnt + u.pm, 1u, __ATOMIC_RELAXED, __HIP_MEMORY_SCOPE_AGENT);
        }
    }
    __device__ __forceinline__ void finish(int wid) const {
        if (ndp > 0 && wid == 0) {
            __builtin_amdgcn_fence(__ATOMIC_RELEASE, "agent");
            if (__builtin_amdgcn_mbcnt_hi(~0u, __builtin_amdgcn_mbcnt_lo(~0u, 0u)) == 0u) {
                __hip_atomic_fetch_add(cnt + dp0, 1u, __ATOMIC_RELAXED, __HIP_MEMORY_SCOPE_AGENT);
                if (ndp > 1) __hip_atomic_fetch_add(cnt + dp1, 1u, __ATOMIC_RELAXED, __HIP_MEMORY_SCOPE_AGENT);
                if (ndp > 2) __hip_atomic_fetch_add(cnt + dp2, 1u, __ATOMIC_RELAXED, __HIP_MEMORY_SCOPE_AGENT);
            }
        }
    }
};
struct GroupedOrderDown {
    const volatile PG8_LAS int* toff; int G, vcu, wbase; unsigned* cnt;
    __device__ bool next(int i, Unit& u) const {
        const int n8 = toff[16] * 4, R = n8 / G, rem = n8 - R * G; int q;
        if (vcu < rem) { if (i > 0) return false; q = R * G + vcu; }
        else { q = (vcu - rem) + (G - rem) * i; if (q >= R * G) return false; }
        const int rt = q >> 2, pn = q & 3; int e = 0;
#pragma unroll
        for (int j = 1; j < 16; ++j) e += (rt >= toff[j]) ? 1 : 0;
        u.pm = __builtin_amdgcn_readfirstlane(rt); u.pn = __builtin_amdgcn_readfirstlane(pn); u.bt = __builtin_amdgcn_readfirstlane(wbase + e * 4 + pn); u.ab = __builtin_amdgcn_readfirstlane(e * 64 + rt - toff[e]); return true;
    }
    PG8_LAS unsigned* acq; int wid; mutable unsigned ncall;
    __device__ __forceinline__ void a_ready(const Unit& u) const {
        const unsigned k = ++ncall; unsigned sp = 0;
        if (wid == 0) {
            while ((unsigned)__builtin_amdgcn_readfirstlane((int)__hip_atomic_load(cnt + u.pm, __ATOMIC_RELAXED, __HIP_MEMORY_SCOPE_AGENT)) < 4u) { __builtin_amdgcn_s_sleep(4); if (++sp > (1u << 22)) break; }
            __builtin_amdgcn_fence(__ATOMIC_ACQUIRE, "agent");
            __hip_atomic_store(acq, k, __ATOMIC_RELEASE, __HIP_MEMORY_SCOPE_WORKGROUP);
        } else {
            while ((unsigned)__builtin_amdgcn_readfirstlane((int)__hip_atomic_load(acq, __ATOMIC_ACQUIRE, __HIP_MEMORY_SCOPE_WORKGROUP)) < k) { __builtin_amdgcn_s_sleep(2); if (++sp > (1u << 24)) break; }
        }
        asm volatile("" ::: "memory");
    }
    __device__ __forceinline__ void done(const Unit&) const {}
};

template <class Epi, class Sched, bool GATHER = false, bool FP8 = false>
__device__ __forceinline__ void gemm_phase(PG8_LAS unsigned char* lds, const Gemm g, const Sched& S, const Epi& E, const int tid, const unsigned* amap = nullptr, unsigned amap_max = 0u) {
    const int  wid = __builtin_amdgcn_readfirstlane(tid >> 6), lane = tid & 63, wr = wid >> 2, wc = wid & 3, fr = lane & 15, fq = lane >> 4;
    int Kq_ = g.K; asm volatile("" : "+s"(Kq_));
    const int K = Kq_, nt = K / BK;
    unsigned voffA[2], voffB[2]; int gR[2]; unsigned gC[2];
#pragma unroll
    for (int i = 0; i < 2; ++i) { int R, C; stage_rc(tid * 16 + i * 8192, R, C); const int Rb = Epi::PERM ? ((R & ~31) + perm32(R & 31)) : R;
        voffA[i] = (unsigned)(R * K + C) * 2u; voffB[i] = (unsigned)(Rb * K + C) * 2u; gR[i] = R; gC[i] = (unsigned)C * 2u; }
    unsigned arC[2][2];
    PG8_LAS unsigned* arNp = (PG8_LAS unsigned*)(lds + 147456 + 1024 + tid * 16);
#define PG8_GROWS(dst, pm_) do { _Pragma("unroll") for (int h_ = 0; h_ < 2; ++h_) _Pragma("unroll") for (int i_ = 0; i_ < 2; ++i_) { \
        unsigned tk_ = amap[(size_t)(pm_) * 256 + h_ * 128 + gR[0] + 64 * i_]; tk_ = tk_ < amap_max ? tk_ : amap_max; dst[h_][i_] = tk_ * (unsigned)(K * 2) + gC[0]; } } while (0)
    const size_t kstep = (size_t)(BK * 2);
    const size_t hstep = (size_t)HALF * K * 2;
    const size_t tstep = 2 * hstep;
    const unsigned ldsw = (unsigned)wid * 1024u; const unsigned lds0_ = (unsigned)(uintptr_t)lds;
    const int aoff = lds_byte(wr * 64 + fr, fq * 8), boff = lds_byte(wc * 32 + fr, fq * 8);
#define PG8_SA(b, h) (((b) * 2 + (h)) * HTB)
#define PG8_SB(b, h) ((4 + (b) * 2 + (h)) * HTB)
#define PG8_STAGE(bufoff, gbase, voff) do { const unsigned long long gb_ = (unsigned long long)(uintptr_t)(gbase); \
        const void* sb_ = (const void*)(uintptr_t)(((unsigned long long)(unsigned)__builtin_amdgcn_readfirstlane((int)(gb_ >> 32)) << 32) | (unsigned long long)(unsigned)__builtin_amdgcn_readfirstlane((int)gb_)); \
        _Pragma("unroll") for (int _i = 0; _i < 2; ++_i) \
        glds16(sb_, (voff)[_i], (unsigned)__builtin_amdgcn_readfirstlane((int)(lds0_ + (unsigned)(bufoff) + ldsw + (unsigned)(_i * 8192)))); } while (0)
#define PG8_STAGEA(bufoff, gbase, h, isn) do { if (GATHER) { unsigned vo_[2] = {arC[h][0], arC[h][1]}; if (isn) { vo_[0] = arNp[2 * (h)]; vo_[1] = arNp[2 * (h) + 1]; } PG8_STAGE(bufoff, gbase, vo_); } \
        else { PG8_STAGE(bufoff, (gbase) + (h) * hstep, voffA); } } while (0)
    typedef int pg8_v4i __attribute__((ext_vector_type(4))); typedef int pg8_v8i __attribute__((ext_vector_type(8)));
#define PG8_LDA(dst, b, h) do { _Pragma("unroll") for (int m = 0; m < 4; ++m) { if (FP8) { const pg8_v4i l_ = *(const PG8_LAS pg8_v4i*)(lds + PG8_SA(b, h) + aoff + m * 2048), h_ = *(const PG8_LAS pg8_v4i*)(lds + PG8_SA(b, h) + aoff + m * 2048 + 1024); \
            dst##8[m] = __builtin_shufflevector(l_, h_, 0, 1, 2, 3, 4, 5, 6, 7); } \
        else { _Pragma("unroll") for (int k = 0; k < 2; ++k) dst[m][k] = *(const PG8_LAS bf16x8*)(lds + PG8_SA(b, h) + aoff + m * 2048 + k * 1024); } } } while (0)
#define PG8_LDB(dst, b, h) do { _Pragma("unroll") for (int n = 0; n < 2; ++n) { if (FP8) { const pg8_v4i l_ = *(const PG8_LAS pg8_v4i*)(lds + PG8_SB(b, h) + boff + n * 2048), h_ = *(const PG8_LAS pg8_v4i*)(lds + PG8_SB(b, h) + boff + n * 2048 + 1024); \
            dst##8[n] = __builtin_shufflevector(l_, h_, 0, 1, 2, 3, 4, 5, 6, 7); } \
        else { _Pragma("unroll") for (int k = 0; k < 2; ++k) dst[n][k] = *(const PG8_LAS bf16x8*)(lds + PG8_SB(b, h) + boff + n * 2048 + k * 1024); } } } while (0)
#define PG8_MMA(ai, bj, At, Bt) do { __builtin_amdgcn_s_setprio(1); _Pragma("unroll") for (int m = 0; m < 4; ++m) _Pragma("unroll") for (int n = 0; n < 2; ++n) { \
        if (FP8) { acc[ai][bj][m][n] = __builtin_amdgcn_mfma_scale_f32_16x16x128_f8f6f4(Bt##8[n], At##8[m], acc[ai][bj][m][n], 0, 0, 0, 0x7f7f7f7f, 0, 0x7f7f7f7f); } \
        else { _Pragma("unroll") for (int k = 0; k < 2; ++k) acc[ai][bj][m][n] = __builtin_amdgcn_mfma_f32_16x16x32_bf16(Bt[n][k], At[m][k], acc[ai][bj][m][n], 0, 0, 0); } } \
        if (FP8) asm volatile("" : "+v"(acc[ai][bj][0][0]), "+v"(acc[ai][bj][0][1]), "+v"(acc[ai][bj][1][0]), "+v"(acc[ai][bj][1][1]), "+v"(acc[ai][bj][2][0]), "+v"(acc[ai][bj][2][1]), "+v"(acc[ai][bj][3][0]), "+v"(acc[ai][bj][3][1]));     \
        __builtin_amdgcn_s_setprio(0); } while (0)
#define PG8_WAIT_V(n) asm volatile("s_waitcnt vmcnt(" #n ")" ::: "memory")
#define PG8_WAIT_L(n) asm volatile("s_waitcnt lgkmcnt(" #n ")" ::: "memory")
#define PG8_BAR __builtin_amdgcn_s_barrier()
#define PG8_SCHED __builtin_amdgcn_sched_barrier(0)
    Unit cur, nxt; int ui = 0;
    if (!S.next(0, cur)) return;
    f32x4 acc[2][2][4][2];
#pragma unroll
    for (int a = 0; a < 2; ++a)
#pragma unroll
        for (int b = 0; b < 2; ++b)
#pragma unroll
            for (int m = 0; m < 4; ++m)
#pragma unroll
                for (int n = 0; n < 2; ++n) acc[a][b][m][n] = (f32x4){0.f, 0.f, 0.f, 0.f};
    bf16x8 At[4][2], B0[2][2], B1[2][2]; pg8_v8i At8[4], B08[2], B18[2];
    const char* cA = (const char*)g.A + (GATHER ? (size_t)0 : (size_t)cur.pm * tstep); const char* cB = (const char*)g.Bt + (size_t)cur.bt * tstep;
    S.a_ready(cur);
    if (GATHER) { PG8_GROWS(arC, cur.ab); }
    PG8_STAGE(PG8_SB(0, 0), cB, voffB); PG8_STAGE(PG8_SB(0, 1), cB + hstep, voffB); PG8_STAGEA(PG8_SA(0, 0), cA, 0, false); PG8_STAGEA(PG8_SA(0, 1), cA, 1, false);
    if (wr == 1) PG8_BAR;
    PG8_WAIT_V(2); PG8_BAR;
    PG8_STAGE(PG8_SB(1, 0), cB + kstep, voffB); PG8_STAGEA(PG8_SA(1, 0), cA + kstep, 0, false); PG8_STAGE(PG8_SB(1, 1), cB + hstep + kstep, voffB);
    PG8_WAIT_V(6); PG8_BAR;
    for (;;) {
        const bool has_next = S.next(ui + 1, nxt);
        const char* nA = (has_next && !GATHER) ? (const char*)g.A + (size_t)nxt.pm * tstep : cA; const char* nB = has_next ? (const char*)g.Bt + (size_t)nxt.bt * tstep : cB;
        if (GATHER && has_next) { unsigned tn_[2][2]; PG8_GROWS(tn_, nxt.ab); arNp[0] = tn_[0][0]; arNp[1] = tn_[0][1]; arNp[2] = tn_[1][0]; arNp[3] = tn_[1][1]; }
#pragma unroll 1
        for (int t = 0; t < nt; t += 2) {
            const bool last = (t == nt - 2);
            const char* a1 = cA + (size_t)(t + 1) * kstep;
            const char* a2 = last ? nA : cA + (size_t)(t + 2) * kstep; const char* b2 = last ? nB : cB + (size_t)(t + 2) * kstep;
            const char* a3 = a2 + kstep; const char* b3 = b2 + kstep;
            const bool isn = last && has_next;
            if (isn) S.a_ready(nxt);
            PG8_LDB(B0, 0, 0); PG8_LDB(B1, 0, 1); PG8_SCHED; PG8_LDA(At, 0, 0); PG8_STAGEA(PG8_SA(1, 1), a1, 1, false);
            PG8_WAIT_V(8); PG8_WAIT_L(0); PG8_BAR; PG8_MMA(0, 0, At, B0); PG8_MMA(0, 1, At, B1); PG8_BAR; PG8_SCHED;
            PG8_LDA(At, 0, 1); PG8_STAGE(PG8_SB(0, 0), b2, voffB); PG8_STAGE(PG8_SB(0, 1), b2 + hstep, voffB); PG8_STAGEA(PG8_SA(0, 0), a2, 0, isn);
            PG8_WAIT_V(8); PG8_WAIT_L(0); PG8_BAR; PG8_MMA(1, 0, At, B0); PG8_MMA(1, 1, At, B1); PG8_BAR; PG8_SCHED;
            PG8_LDB(B0, 1, 0); PG8_LDB(B1, 1, 1); PG8_SCHED; PG8_LDA(At, 1, 0); PG8_STAGEA(PG8_SA(0, 1), a2, 1, isn);
            PG8_WAIT_V(8); PG8_WAIT_L(0); PG8_BAR; PG8_MMA(0, 0, At, B0); PG8_MMA(0, 1, At, B1); PG8_BAR; PG8_SCHED;
            PG8_LDA(At, 1, 1); PG8_STAGE(PG8_SB(1, 0), b3, voffB); PG8_STAGE(PG8_SB(1, 1), b3 + hstep, voffB); PG8_STAGEA(PG8_SA(1, 0), a3, 0, isn);
            PG8_WAIT_V(8); PG8_WAIT_L(0); PG8_BAR; PG8_MMA(1, 0, At, B0); PG8_MMA(1, 1, At, B1); PG8_BAR; PG8_SCHED;
        }
        if (wr == 0) PG8_BAR;
        { unsigned z_ = 0u; asm volatile("" : "+s"(z_)); const int ln2 = (int)__builtin_amdgcn_mbcnt_hi(~0u, __builtin_amdgcn_mbcnt_lo(~0u, z_));
          E(acc, cur, wr, wc, ln2 & 15, ln2 >> 4); }
        S.done(cur);
        if (!has_next) break;
#pragma unroll
        for (int a = 0; a < 2; ++a)
#pragma unroll
            for (int b = 0; b < 2; ++b)
#pragma unroll
                for (int m = 0; m < 4; ++m)
#pragma unroll
                    for (int n = 0; n < 2; ++n) acc[a][b][m][n] = (f32x4){0.f, 0.f, 0.f, 0.f};
        cur = nxt; cA = nA; cB = nB; ++ui;
        if (GATHER) { arC[0][0] = arNp[0]; arC[0][1] = arNp[1]; arC[1][0] = arNp[2]; arC[1][1] = arNp[3]; }
        if (wr == 1) PG8_BAR;
    }
    PG8_WAIT_V(0);
    PG8_BAR;
#undef PG8_SA
#undef PG8_SB
#undef PG8_STAGE
#undef PG8_STAGEA
#undef PG8_GROWS
#undef PG8_LDA
#undef PG8_LDB
#undef PG8_MMA
#undef PG8_WAIT_V
#undef PG8_WAIT_L
#undef PG8_BAR
#undef PG8_SCHED
}
}

template <bool F8> struct EpiProj {
    static constexpr bool PERM = true;
    bf16_t* O; bf16_t* LR; const float* gq; const float* gk; const float* cosT; const float* sinT; float* kpart;
    __device__ __forceinline__ void operator()(const f32x4 (&acc)[2][2][4][2], const pg8::Unit& u, int wr, int wc, int fr, int fq) const {
        const int row0 = u.pm * 256 + wr * 64 + fr;
        constexpr float SC = F8 ? 0.03125f : 1.0f;
        if (F8 && u.pn >= 3 && u.pn <= 6) {
            const bool isk = u.pn >= 5; const int hh = 4 * ((u.pn - 3) & 1) + wc;
            const float* g = isk ? gk : gq;
            float gg[2][8];
#pragma unroll
            for (int bj = 0; bj < 2; ++bj)
#pragma unroll
                for (int e = 0; e < 8; ++e) gg[bj][e] = g[32 * bj + 8 * fq + e];
            float ks[2][8];
#pragma unroll
            for (int bj = 0; bj < 2; ++bj)
#pragma unroll
                for (int e = 0; e < 8; ++e) ks[bj][e] = 0.f;
            bf16_t* obase = O + (isk ? C_BK : C_BQ) + 64 * hh + 8 * fq;
#pragma unroll
            for (int ai = 0; ai < 2; ++ai)
#pragma unroll
                for (int m = 0; m < 4; ++m) {
                    const int row = row0 + ai * 128 + m * 16; const int pos = row & (SEQ - 1);
                    float v[2][8]; float ss = 0.f;
#pragma unroll
                    for (int bj = 0; bj < 2; ++bj)
#pragma unroll
                        for (int n = 0; n < 2; ++n)
#pragma unroll
                            for (int j = 0; j < 4; ++j) { const float x = acc[ai][bj][m][n][j] * SC; v[bj][4 * n + j] = x; ss += x * x; }
                    ss += __shfl_xor(ss, 16); ss += __shfl_xor(ss, 32);
                    const float rstd = rsqrtf(ss * (1.f / 64.f) + EPS);
#pragma unroll
                    for (int bj = 0; bj < 2; ++bj)
#pragma unroll
                        for (int e = 0; e < 8; ++e) v[bj][e] = v[bj][e] * rstd * gg[bj][e];
                    { const f32x4 c0 = *(const f32x4*)(cosT + pos * 8), c1 = *(const f32x4*)(cosT + pos * 8 + 4), s0 = *(const f32x4*)(sinT + pos * 8), s1 = *(const f32x4*)(sinT + pos * 8 + 4);
                      const float cs[8] = {c0.x, c0.y, c0.z, c0.w, c1.x, c1.y, c1.z, c1.w}, sn[8] = {s0.x, s0.y, s0.z, s0.w, s1.x, s1.y, s1.z, s1.w};
#pragma unroll
                      for (int e = 0; e < 8; ++e) { const float other = __shfl_xor(v[0][e], 16);
                          if (fq == 0) v[0][e] = v[0][e] * cs[e] - other * sn[e]; else if (fq == 1) v[0][e] = v[0][e] * cs[e] + other * sn[e]; } }
                    if (isk) {
#pragma unroll
                        for (int bj = 0; bj < 2; ++bj)
#pragma unroll
                            for (int e = 0; e < 8; ++e) ks[bj][e] += v[bj][e];
                    } else {
#pragma unroll
                        for (int bj = 0; bj < 2; ++bj)
#pragma unroll
                            for (int e = 0; e < 8; ++e) v[bj][e] *= (0.125f * LOG2E);
                    }
#pragma unroll
                    for (int bj = 0; bj < 2; ++bj) { u32x4 w; w.x = cvtpk(v[bj][0], v[bj][1]); w.y = cvtpk(v[bj][2], v[bj][3]); w.z = cvtpk(v[bj][4], v[bj][5]); w.w = cvtpk(v[bj][6], v[bj][7]);
                        *(u32x4*)(obase + (size_t)row * PP + 32 * bj) = w; }
                }
            if (isk) {
#pragma unroll
                for (int bj = 0; bj < 2; ++bj)
#pragma unroll
                    for (int e = 0; e < 8; ++e) { float s = ks[bj][e]; s += __shfl_xor(s, 1); s += __shfl_xor(s, 2); s += __shfl_xor(s, 4); s += __shfl_xor(s, 8); ks[bj][e] = s; }
                if (fr == 0) { float* kp = kpart + ((size_t)u.pm * 2 + wr) * 512 + 64 * hh + 8 * fq;
#pragma unroll
                    for (int bj = 0; bj < 2; ++bj) { *(f32x4*)(kp + 32 * bj) = (f32x4){ks[bj][0], ks[bj][1], ks[bj][2], ks[bj][3]}; *(f32x4*)(kp + 32 * bj + 4) = (f32x4){ks[bj][4], ks[bj][5], ks[bj][6], ks[bj][7]}; } }
            }
        } else if (u.pn < 13) {
            const int col0 = u.pn * 256 + wc * 32 + 8 * fq;
#pragma unroll
            for (int ai = 0; ai < 2; ++ai)
#pragma unroll
                for (int m = 0; m < 4; ++m) { bf16_t* rowp = O + (size_t)(row0 + ai * 128 + m * 16) * PP + col0;
#pragma unroll
                    for (int bj = 0; bj < 2; ++bj) { const f32x4 v0 = acc[ai][bj][m][0] * SC, v1 = acc[ai][bj][m][1] * SC;
                        u32x4 w; w.x = cvtpk(v0[0], v0[1]); w.y = cvtpk(v0[2], v0[3]); w.z = cvtpk(v1[0], v1[1]); w.w = cvtpk(v1[2], v1[3]);
                        *(u32x4*)(rowp + bj * 128) = w; } }
        } else if (F8 && wc == 0 && fq < 2) {
#pragma unroll
            for (int ai = 0; ai < 2; ++ai)
#pragma unroll
                for (int m = 0; m < 4; ++m) { const f32x4 v0 = acc[ai][0][m][0] * SC, v1 = acc[ai][0][m][1] * SC;
                    u32x4 w; w.x = cvtpk(v0[0], v0[1]); w.y = cvtpk(v0[2], v0[3]); w.z = cvtpk(v1[0], v1[1]); w.w = cvtpk(v1[2], v1[3]);
                    *(u32x4*)(LR + (size_t)(row0 + ai * 128 + m * 16) * 16 + 8 * fq) = w; }
        }
    }
};
struct EpiResid {
    static constexpr bool PERM = false;
    const float* base; bf16_t* out; const bf16_t* base16;
    __device__ __forceinline__ void operator()(const f32x4 (&acc)[2][2][4][2], const pg8::Unit& u, int wr, int wc, int fr, int fq) const {
        const int row0 = u.pm * 256 + wr * 64 + fr, col0 = u.pn * 256 + wc * 32 + 4 * fq;
#pragma unroll
        for (int ai = 0; ai < 2; ++ai)
#pragma unroll
            for (int m = 0; m < 4; ++m) { const size_t off = (size_t)(row0 + ai * 128 + m * 16) * DM + col0;
#pragma unroll
                for (int bj = 0; bj < 2; ++bj)
#pragma unroll
                    for (int n = 0; n < 2; ++n) { f32x4 bs;
                        if (base16) { const u32x2 bw = *(const u32x2*)(base16 + off + bj * 128 + n * 16); bs = (f32x4){bflo(bw.x), bfhi(bw.x), bflo(bw.y), bfhi(bw.y)}; }
                        else bs = *(const f32x4*)(base + off + bj * 128 + n * 16);
                        const f32x4 r = bs + acc[ai][bj][m][n];
                        u32x2 w; w.x = cvtpk(r.x, r.y); w.y = cvtpk(r.z, r.w); *(u32x2*)(out + off + bj * 128 + n * 16) = w; } }
    }
};
struct EpiSwiglu {
    static constexpr bool PERM = true;
    bf16_t* H;
    __device__ __forceinline__ void operator()(const f32x4 (&acc)[2][2][4][2], const pg8::Unit& u, int wr, int wc, int fr, int fq) const {
        const int row0 = u.pm * 256 + wr * 64 + fr, col0 = u.pn * 128 + wc * 32 + 8 * fq;
#pragma unroll
        for (int ai = 0; ai < 2; ++ai)
#pragma unroll
            for (int m = 0; m < 4; ++m) { float o[8];
#pragma unroll
                for (int n = 0; n < 2; ++n)
#pragma unroll
                    for (int j = 0; j < 4; ++j) { const float gt = acc[ai][0][m][n][j] * 0.03125f, up = acc[ai][1][m][n][j] * 0.03125f; o[n * 4 + j] = gt * sigmoidf_(gt) * up; }
                int p0 = 0, p1 = 0;
                p0 = __builtin_amdgcn_cvt_pk_fp8_f32(o[0], o[1], p0, false); p0 = __builtin_amdgcn_cvt_pk_fp8_f32(o[2], o[3], p0, true);
                p1 = __builtin_amdgcn_cvt_pk_fp8_f32(o[4], o[5], p1, false); p1 = __builtin_amdgcn_cvt_pk_fp8_f32(o[6], o[7], p1, true);
                *(u32x2*)((unsigned char*)H + (size_t)(row0 + ai * 128 + m * 16) * FF + col0) = (u32x2){(unsigned)p0, (unsigned)p1}; }
    }
};
struct EpiDown {
    static constexpr bool PERM = true;
    bf16_t* Y; const float* slotw;
    __device__ __forceinline__ void operator()(const f32x4 (&acc)[2][2][4][2], const pg8::Unit& u, int wr, int wc, int fr, int fq) const {
        const int row0 = u.pm * 256 + wr * 64 + fr, col0 = u.pn * 256 + wc * 32 + 8 * fq;
#pragma unroll
        for (int ai = 0; ai < 2; ++ai)
#pragma unroll
            for (int m = 0; m < 4; ++m) { const int row = row0 + ai * 128 + m * 16; const float sw = slotw[u.ab * 256 + (row - u.pm * 256)] * 0.03125f; bf16_t* rowp = Y + (size_t)row * DM + col0;
#pragma unroll
                for (int bj = 0; bj < 2; ++bj) { const f32x4 v0 = acc[ai][bj][m][0] * sw, v1 = acc[ai][bj][m][1] * sw;
                    u32x4 w; w.x = cvtpk(v0[0], v0[1]); w.y = cvtpk(v0[2], v0[3]); w.z = cvtpk(v1[0], v1[1]); w.w = cvtpk(v1[2], v1[3]);
                    *(u32x4*)(rowp + bj * 128) = w; } }
    }
};

struct Args { const float* in[17]; float* out; unsigned char* ws; int ph_lo, ph_hi; };
static_assert(offsetof(Args, out) == 136 && offsetof(Args, ws) == 144 && sizeof(Args) == 160, "kernarg layout");
struct Ctx {
    LAS unsigned char* lds; const __attribute__((address_space(4))) unsigned char* ka;
    int wave, G, vcu, gw, NGW, bx;
    __device__ __forceinline__ int lane() const { unsigned z_ = 0u; asm volatile("" : "+s"(z_)); return (int)__builtin_amdgcn_mbcnt_hi(~0u, __builtin_amdgcn_mbcnt_lo(~0u, z_)); }
    __device__ __forceinline__ int tid() const { return wave * 64 + lane(); }
#define CTX_IN(name, idx) __device__ __forceinline__ const float* name() const { return *(const float* const __attribute__((address_space(4)))*)(ka + 8 * (idx)); }
    CTX_IN(x, 0) CTX_IN(attn_g, 1) CTX_IN(w_in, 2) CTX_IN(gk_w2, 3) CTX_IN(gk_b, 4) CTX_IN(gla_g, 5) CTX_IN(qn_g, 6) CTX_IN(kn_g, 7) CTX_IN(lb_param, 8) CTX_IN(hgrn_g, 9)
    CTX_IN(w_out, 10) CTX_IN(ffn_g, 11) CTX_IN(w_rg, 12) CTX_IN(w_re, 13) CTX_IN(w_eg, 14) CTX_IN(w_eu, 15) CTX_IN(w_ed, 16)
#define CTX_WS(type, name, off) __device__ __forceinline__ type* name() const { return (type*)(*(unsigned char* const __attribute__((address_space(4)))*)(ka + 144) + (off)); }
    __device__ __forceinline__ float* out() const { return *(float* const __attribute__((address_space(4)))*)(ka + 136); }
    CTX_WS(unsigned, ctl, WS_CTL) CTX_WS(float, cosT, SM_COS) CTX_WS(float, sinT, SM_SIN) CTX_WS(bf16_t, lr, SM_LR) CTX_WS(float, kpart, SM_KPART) CTX_WS(float, decay, SM_DECAY)
    CTX_WS(unsigned, route, SM_ROUTE) CTX_WS(float, slotw, WS_SLOTW2) CTX_WS(bf16_t, x1b, WS_X1B) CTX_WS(unsigned, amap, WS_AMAP2) CTX_WS(bf16_t, win, WS_WIN) CTX_WS(bf16_t, wout, WS_WOUT) CTX_WS(bf16_t, wgu, WS_WGU) CTX_WS(bf16_t, wd, WS_WD) CTX_WS(unsigned char, h8, WS_H8)
    CTX_WS(bf16_t, proj, WS_PROJ) CTX_WS(bf16_t, st, WS_ST) CTX_WS(bf16_t, ab, WS_AB) CTX_WS(float, kvt, WS_AB) CTX_WS(bf16_t, aperm, WS_APERM) CTX_WS(bf16_t, hbuf, WS_H)
};

struct TrDesc { const float* W; bf16_t* WT; int ldw, col0, k0, K, drow0, nvalid, fp8; };
__device__ __forceinline__ void tr_load(const TrDesc& d, float (&tmp)[32], int lane) {
#pragma unroll
    for (int i = 0; i < 32; ++i) { const int kk = 2 * i + (lane >> 5); tmp[i] = d.W[(size_t)(d.k0 + kk) * d.ldw + d.col0 + (lane & 31)]; }
}
__device__ __forceinline__ void tr_finish(const TrDesc& d, const float (&tmp)[32], LAS float* scr, int lane) {
#pragma unroll
    for (int i = 0; i < 32; ++i) { const int kk = 2 * i + (lane >> 5); scr[kk * 33 + (lane & 31)] = tmp[i]; }
    asm volatile("s_waitcnt lgkmcnt(0)" ::: "memory");
    const int c = lane & 7;
    if (d.fp8) {
#pragma unroll
        for (int j = 0; j < 4; ++j) { const int n = (lane >> 3) + 8 * j; const LAS float* s = scr + (8 * c) * 33 + n;
            int p0 = 0, p1 = 0;
            p0 = __builtin_amdgcn_cvt_pk_fp8_f32(s[0 * 33] * 32.f, s[1 * 33] * 32.f, p0, false); p0 = __builtin_amdgcn_cvt_pk_fp8_f32(s[2 * 33] * 32.f, s[3 * 33] * 32.f, p0, true);
            p1 = __builtin_amdgcn_cvt_pk_fp8_f32(s[4 * 33] * 32.f, s[5 * 33] * 32.f, p1, false); p1 = __builtin_amdgcn_cvt_pk_fp8_f32(s[6 * 33] * 32.f, s[7 * 33] * 32.f, p1, true);
            if (n < d.nvalid) *(u32x2*)((unsigned char*)d.WT + (size_t)(d.drow0 + n) * d.K + d.k0 + 8 * c) = (u32x2){(unsigned)p0, (unsigned)p1}; }
    } else {
#pragma unroll
    for (int j = 0; j < 4; ++j) { const int n = (lane >> 3) + 8 * j; const LAS float* s = scr + (8 * c) * 33 + n;
        u32x4 o; o.x = cvtpk(s[0 * 33], s[1 * 33]); o.y = cvtpk(s[2 * 33], s[3 * 33]); o.z = cvtpk(s[4 * 33], s[5 * 33]); o.w = cvtpk(s[6 * 33], s[7 * 33]);
        if (n < d.nvalid) *(u32x4*)(d.WT + (size_t)(d.drow0 + n) * d.K + d.k0 + 8 * c) = o; }
    }
    asm volatile("s_waitcnt lgkmcnt(0)" ::: "memory");
}
constexpr int WC_PER_LAYER = 1664 + 16 + 512 + 16 * 768;
__device__ __forceinline__ TrDesc wconv_decode(const Ctx& X, int it) {
    const int l = it / WC_PER_LAYER; int r = it % WC_PER_LAYER;
    if (r < 1664) { const int kb = r / 104, nb = r % 104; const int col0 = nb < 24 ? 32 * nb : 784 + 32 * (nb - 24); int drow = nb < 24 ? 32 * nb : 768 + 32 * (nb - 24);
        if (drow >= C_BQ && drow < C_BV) {
            const int rel = drow - C_BQ, sec = rel >> 9, hh = (rel & 511) >> 6, dh = (rel & 63) >> 5;
            drow = C_BQ + sec * 512 + 256 * (hh >> 2) + 128 * dh + 32 * (hh & 3); }
        if (drow >= C_BQ && drow < C_CQ) return TrDesc{X.w_in() + (size_t)l * DM * IN_COLS, (bf16_t*)((unsigned char*)(X.win() + (size_t)l * NW_IN * DM) + (size_t)C_BQ * DM * 2), IN_COLS, col0, 64 * kb, DM, drow - C_BQ, 32, 1};
        if (drow >= C_AG && drow < C_BQ) return TrDesc{X.w_in() + (size_t)l * DM * IN_COLS, (bf16_t*)((unsigned char*)(X.win() + (size_t)l * NW_IN * DM) + (size_t)C_BQ * DM * 2), IN_COLS, col0, 64 * kb, DM, 1792 + drow - C_AG, 32, 1};
        return TrDesc{X.w_in() + (size_t)l * DM * IN_COLS, X.win() + (size_t)l * NW_IN * DM, IN_COLS, col0, 64 * kb, DM, drow, 32, 0}; }
    r -= 1664;
    if (r < 16) return TrDesc{X.w_in() + (size_t)l * DM * IN_COLS, (bf16_t*)((unsigned char*)(X.win() + (size_t)l * NW_IN * DM) + (size_t)C_BQ * DM * 2), IN_COLS, 768, 64 * r, DM, 1536, 16, 1};
    r -= 16;
    if (r < 512) { const int kb = r / 32, nb = r % 32; return TrDesc{X.w_out() + (size_t)l * DM * DM, X.wout() + (size_t)l * DM * DM, DM, 32 * nb, 64 * kb, DM, 32 * nb, 32, 0}; }
    r -= 512;
    const int e = r / 768, q = r % 768; const size_t le = (size_t)l * NEXP + e;
    if (q < 512) { const int up = q >= 256, qq = q & 255, kb = qq / 16, nb = qq % 16, col0 = 32 * nb;
        return TrDesc{(up ? X.w_eu() : X.w_eg()) + le * DM * FF, (bf16_t*)((unsigned char*)X.wgu() + le * DM * DM), FF, col0, 64 * kb, DM, 256 * (col0 / 128) + (col0 % 128) + (up ? 128 : 0), 32, 1}; }
    const int qq = q - 512, kb = qq / 32, nb = qq % 32;
    return TrDesc{X.w_ed() + le * FF * DM, (bf16_t*)((unsigned char*)X.wd() + le * DM * FF), DM, 32 * nb, 64 * kb, FF, 32 * nb, 32, 1};
}

__device__ __forceinline__ void row_load(const float* xrow, int lane, f32x4 (&v)[4]) {
    const f32x4* xr = (const f32x4*)xrow + lane;
#pragma unroll
    for (int j = 0; j < 4; ++j) v[j] = xr[64 * j];
}
__device__ __forceinline__ void row_load_bf16(const bf16_t* xrow, int lane, f32x4 (&v)[4]) {
    const u32x2* xr = (const u32x2*)xrow + lane;
#pragma unroll
    for (int j = 0; j < 4; ++j) { const u32x2 w = xr[64 * j]; v[j] = (f32x4){bflo(w.x), bfhi(w.x), bflo(w.y), bfhi(w.y)}; }
}
__device__ __forceinline__ void row_norm_store(f32x4 (&v)[4], const float* g, bf16_t* orow, unsigned char* orow8, int lane) {
    float s = 0.f;
#pragma unroll
    for (int j = 0; j < 4; ++j) s += (v[j].x * v[j].x + v[j].y * v[j].y) + (v[j].z * v[j].z + v[j].w * v[j].w);
    const float rstd = rsqrtf(wave_sum(s) * (1.f / DM) + EPS);
    const f32x4* gr = (const f32x4*)g + lane; u32x2* o8 = (u32x2*)orow + lane;
#pragma unroll
    for (int j = 0; j < 4; ++j) { const f32x4 gg = gr[64 * j]; v[j] = v[j] * rstd * gg; u32x2 w; w.x = cvtpk(v[j].x, v[j].y); w.y = cvtpk(v[j].z, v[j].w); o8[64 * j] = w;
        int p = 0; p = __builtin_amdgcn_cvt_pk_fp8_f32(v[j].x, v[j].y, p, false); p = __builtin_amdgcn_cvt_pk_fp8_f32(v[j].z, v[j].w, p, true); ((unsigned*)orow8)[64 * j + lane] = (unsigned)p; }
}

__device__ __forceinline__ void phase0(const Ctx& X) {
    LAS float* scr = (LAS float*)(X.lds + X.wave * 16384);
    {
        constexpr int NIT = DEPTH * WC_PER_LAYER; int it = X.gw; float cur[32], nxt[32]; TrDesc d, dn;
        if (it < NIT) { d = wconv_decode(X, it); tr_load(d, cur, X.lane()); }
        while (it < NIT) { const int nit = it + X.NGW; dn = d;
            if (nit < NIT) { dn = wconv_decode(X, nit); tr_load(dn, nxt, X.lane()); }
            __builtin_amdgcn_sched_barrier(0);
            tr_finish(d, cur, scr, X.lane());
#pragma unroll
            for (int i = 0; i < 32; ++i) cur[i] = nxt[i];
            d = dn; it = nit; }
    }
    { const int gt = X.gw * 64 + X.lane(), NT = X.NGW * 64;
      for (int i = gt; i < SEQ * 8; i += NT) { const int pos = i >> 3, f = i & 7;
          const float inv = exp2f(-(float)f * 0.125f * 18.931568569324174f);
          const float ang = (float)pos * inv;
          const double a = (double)ang; const double kx = __builtin_rint(a * 0.15915494309189535); const float red = (float)(a - kx * 6.283185307179586);
          X.cosT()[i] = __cosf(red); X.sinT()[i] = __sinf(red); } }
}
__device__ __forceinline__ void phase0b(const Ctx& X) {
    if (X.bx == 0) { for (int i = X.tid(); i < CW_BAR + 3456; i += 512) __hip_atomic_store(X.ctl() + i, 0u, __ATOMIC_RELAXED, __HIP_MEMORY_SCOPE_AGENT); }
    {
        int m = X.gw; f32x4 cur[4], nxt[4];
        if (m < NTOK) row_load(X.x() + (size_t)m * DM, X.lane(), cur);
        for (; m < NTOK; m += X.NGW) { const int mn = m + X.NGW;
            if (mn < NTOK) row_load(X.x() + (size_t)mn * DM, X.lane(), nxt);
            row_norm_store(cur, X.attn_g(), X.ab() + (size_t)m * DM, X.h8() + (size_t)m * DM, X.lane());
#pragma unroll
            for (int j = 0; j < 4; ++j) cur[j] = nxt[j]; }
    }
}

__device__ __forceinline__ void moba_prep_item(const Ctx& X, int layer, int item) {
    const int part = item & 3, bb = item >> 2; const int lane = X.lane(), w = X.wave;
    const int tok0 = (bb >> 4) * SEQ + (bb & 15) * 256 + part * 64 + w * 8;
    const int sub = lane & 7;
    float gq[8], gk[8], ks[8];
#pragma unroll
    for (int j = 0; j < 8; ++j) { gq[j] = X.qn_g()[layer * 64 + sub * 8 + j]; gk[j] = X.kn_g()[layer * 64 + sub * 8 + j]; ks[j] = 0.f; }
    for (int t = 0; t < 8; ++t) {
        const int tok = tok0 + t, pos = tok & (SEQ - 1);
        float cs[8], sn[8];
#pragma unroll
        for (int j = 0; j < 8; ++j) { cs[j] = X.cosT()[pos * 8 + j]; sn[j] = X.sinT()[pos * 8 + j]; }
#pragma unroll
        for (int which = 0; which < 2; ++which) {
            bf16_t* p = X.proj() + (size_t)tok * PP + (which ? C_BK : C_BQ) + lane * 8;
            const u32x4 raw = *(const u32x4*)p; float v[8];
            v[0] = bflo(raw.x); v[1] = bfhi(raw.x); v[2] = bflo(raw.y); v[3] = bfhi(raw.y); v[4] = bflo(raw.z); v[5] = bfhi(raw.z); v[6] = bflo(raw.w); v[7] = bfhi(raw.w);
            float ss = 0.f;
#pragma unroll
            for (int j = 0; j < 8; ++j) ss += v[j] * v[j];
            ss += __shfl_xor(ss, 1); ss += __shfl_xor(ss, 2); ss += __shfl_xor(ss, 4);
            const float rstd = rsqrtf(ss * (1.f / 64.f) + EPS);
#pragma unroll
            for (int j = 0; j < 8; ++j) v[j] = v[j] * rstd * (which ? gk[j] : gq[j]);
#pragma unroll
            for (int j = 0; j < 8; ++j) { const float other = __shfl_xor(v[j], 1);
                if (sub == 0) v[j] = v[j] * cs[j] - other * sn[j]; else if (sub == 1) v[j] = v[j] * cs[j] + other * sn[j]; }
            if (which) {
#pragma unroll
                for (int j = 0; j < 8; ++j) ks[j] += v[j];
            } else {
#pragma unroll
                for (int j = 0; j < 8; ++j) v[j] *= (0.125f * LOG2E);
            }
            u32x4 o; o.x = cvtpk(v[0], v[1]); o.y = cvtpk(v[2], v[3]); o.z = cvtpk(v[4], v[5]); o.w = cvtpk(v[6], v[7]);
            *(u32x4*)p = o;
        }
    }
    LAS float* red = (LAS float*)X.lds;
#pragma unroll
    for (int j = 0; j < 8; ++j) red[w * 512 + lane * 8 + j] = ks[j];
    __syncthreads();
    { const int c = X.tid(); float s = 0.f;
#pragma unroll
      for (int ww = 0; ww < 8; ++ww) s += red[ww * 512 + c];
      X.kpart()[(size_t)item * 512 + c] = s; }
    __syncthreads();
}

template <int W> __device__ __forceinline__ void tile_load(const bf16_t* src, u32x4 (&r)[W / 8], int lane) {
    constexpr int LPR = W / 8, RPI = 64 / LPR;
#pragma unroll
    for (int i = 0; i < W / 8; ++i) r[i] = *(const u32x4*)(src + (size_t)(RPI * i + lane / LPR) * PP + (lane % LPR) * 8);
}
template <int W> __device__ __forceinline__ void tile_store(LAS unsigned char* reg, const u32x4 (&r)[W / 8], int lane) {
    constexpr int LPR = W / 8, RPI = 64 / LPR;
#pragma unroll
    for (int i = 0; i < W / 8; ++i) *(LAS u32x4*)(reg + (RPI * i + lane / LPR) * 144 + (lane % LPR) * 16) = r[i];
}
template <bool GLA, bool PHC>
__device__ __forceinline__ void lin_item(const Ctx& X, int layer, int b, int c, int h, LAS unsigned char* wl) {
    const int lane = X.lane(), r32 = lane & 31, hi = lane >> 5;
    const size_t row0 = (size_t)b * SEQ + (size_t)c * 64;
    const bf16_t* P = X.proj();
    constexpr int WK = GLA ? 32 : 64;
    const int fl = GLA ? (lane & 31) : lane;
    const int qcol0 = GLA ? (C_AQ + 32 * h) : (C_CQ + 64 * h);
    const int kcol0 = GLA ? (C_AK + 32 * h) : (C_CF + 64 * h);
    const int vcol0 = GLA ? (C_AV + 64 * h) : (C_CI + 64 * h);
    const float fv = (GLA && lane >= 32) ? 0.f : 1.f;
    LAS unsigned char* R0 = wl; LAS unsigned char* R1 = wl + 9216;
    u32x4 tv[8], tk[WK / 8], tq[WK / 8]; u32x4 lr0 = {}, lr1 = {};
    tile_load<64>(P + row0 * PP + vcol0, tv, lane);
    tile_load<WK>(P + row0 * PP + kcol0, tk, lane);
    if (PHC) tile_load<WK>(P + row0 * PP + qcol0, tq, lane);
    if (GLA) { lr0 = *(const u32x4*)(X.lr() + (row0 + lane) * 16); lr1 = *(const u32x4*)(X.lr() + (row0 + lane) * 16 + 8); }
    float w2[16]; float bias = 0.f, lb = 0.f;
    if (GLA) {
#pragma unroll
        for (int r = 0; r < 16; ++r) w2[r] = X.gk_w2()[(size_t)layer * 16 * 128 + r * 128 + 32 * h + fl];
        bias = X.gk_b()[layer * 128 + 32 * h + fl];
    } else {
#pragma unroll
        for (int r = 0; r < 16; ++r) w2[r] = 0.f;
        if (layer > 0) lb = sigmoidf_(X.lb_param()[256 + 64 * h + fl] - X.lb_param()[64 * h + fl]);
    }
    const int h8 = GLA ? h : 4 + h;
    const size_t sbase = (((size_t)b * 64 + c) * 8 + h8) * 4096;
    unsigned pvall[32];
    bf16x8 s0f[2][4];
    if (PHC) {
#pragma unroll
        for (int vi = 0; vi < 2; ++vi)
#pragma unroll
            for (int ks = 0; ks < 4; ++ks) s0f[vi][ks] = *(const bf16x8*)(X.st() + sbase + (size_t)(32 * vi + r32) * 64 + 16 * ks + 8 * hi);
        tile_store<64>(R0, tv, lane);
#pragma unroll
        for (int m = 0; m < 32; ++m) { const unsigned v0 = *(const LAS bf16_t*)(R0 + (2 * m) * 144 + lane * 2), v1 = *(const LAS bf16_t*)(R0 + (2 * m + 1) * 144 + lane * 2); pvall[m] = v0 | (v1 << 16); }
        asm volatile("s_waitcnt lgkmcnt(0)" ::: "memory");
        tile_store<WK>(R0, tq, lane); tile_store<WK>(R1, tk, lane);
    } else {
        tile_store<64>(R0, tv, lane); tile_store<WK>(R1, tk, lane);
    }
    float bsum = 0.f, eprod = 1.f;
    f32x16 g00 = {}, g01 = {}, g10 = {}, g11 = {};
    for (int s = 0; s < 4; ++s) {
        float kt[16], qt[16];
#pragma unroll
        for (int t = 0; t < 16; ++t) {
            const int tt = 16 * s + t;
            const float rawk = bf2f(*(const LAS bf16_t*)(R1 + tt * 144 + fl * 2));
            float qv = 0.f; if (PHC) qv = bf2f(*(const LAS bf16_t*)(R0 + tt * 144 + fl * 2));
            float a, kk;
            if (GLA) {
                float z = bias;
                { const unsigned u0 = (unsigned)__builtin_amdgcn_readlane((int)lr0.x, tt), u1 = (unsigned)__builtin_amdgcn_readlane((int)lr0.y, tt), u2 = (unsigned)__builtin_amdgcn_readlane((int)lr0.z, tt), u3 = (unsigned)__builtin_amdgcn_readlane((int)lr0.w, tt);
                  z += bflo(u0) * w2[0] + bfhi(u0) * w2[1] + bflo(u1) * w2[2] + bfhi(u1) * w2[3] + bflo(u2) * w2[4] + bfhi(u2) * w2[5] + bflo(u3) * w2[6] + bfhi(u3) * w2[7]; }
                { const unsigned u0 = (unsigned)__builtin_amdgcn_readlane((int)lr1.x, tt), u1 = (unsigned)__builtin_amdgcn_readlane((int)lr1.y, tt), u2 = (unsigned)__builtin_amdgcn_readlane((int)lr1.z, tt), u3 = (unsigned)__builtin_amdgcn_readlane((int)lr1.w, tt);
                  z += bflo(u0) * w2[8] + bfhi(u0) * w2[9] + bflo(u1) * w2[10] + bfhi(u1) * w2[11] + bflo(u2) * w2[12] + bfhi(u2) * w2[13] + bflo(u3) * w2[14] + bfhi(u3) * w2[15]; }
                a = (fminf(z, 0.f) - __logf(1.f + __expf(-fabsf(z)))) * (1.f / 16.f);
                kk = rawk; qv *= 0.17677669529663687f;
            } else {
                const float ef = __expf(-rawk), sg = 1.f / (1.f + ef);
                a = lb + (1.f - lb) * sg;
                kk = (1.f - lb) * (ef * sg);
                qv = qv * sigmoidf_(qv);
            }
            float eb, enb;
            if (GLA) { a *= fv; kk *= fv; qv *= fv; bsum += a; eb = __expf(bsum); enb = __expf(-bsum); }
            else { eprod *= a; eb = eprod; enb = __builtin_amdgcn_rcpf(eprod); }
            kt[t] = kk * enb; qt[t] = qv * eb;
        }
        if (PHC) {
#pragma unroll
            for (int t = 0; t < 16; ++t) {
                *(LAS bf16_t*)(R0 + (16 * s + t) * 144 + lane * 2) = (bf16_t)(cvtpk(qt[t], 0.f) & 0xffffu);
                *(LAS bf16_t*)(R1 + (16 * s + t) * 144 + lane * 2) = (bf16_t)(cvtpk(kt[t], 0.f) & 0xffffu);
            }
        } else {
            unsigned pk[8], pv[8];
#pragma unroll
            for (int m = 0; m < 8; ++m) { pk[m] = cvtpk(kt[2 * m], kt[2 * m + 1]);
                const unsigned v0 = *(const LAS bf16_t*)(R0 + (16 * s + 2 * m) * 144 + lane * 2), v1 = *(const LAS bf16_t*)(R0 + (16 * s + 2 * m + 1) * 144 + lane * 2); pv[m] = v0 | (v1 << 16); }
            u32x4 av0, av1, bk0, bk1;
#pragma unroll
            for (int m = 0; m < 4; ++m) {
                auto rv = __builtin_amdgcn_permlane32_swap(pv[m], pv[m + 4], false, false); av0[m] = rv[0]; av1[m] = rv[1];
                auto rk = __builtin_amdgcn_permlane32_swap(pk[m], pk[m + 4], false, false); bk0[m] = rk[0]; bk1[m] = rk[1];
            }
            const bf16x8 A0 = __builtin_bit_cast(bf16x8, av0), A1 = __builtin_bit_cast(bf16x8, av1), B0 = __builtin_bit_cast(bf16x8, bk0), B1 = __builtin_bit_cast(bf16x8, bk1);
            g00 = MFMA32(A0, B0, g00); g01 = MFMA32(A0, B1, g01); g10 = MFMA32(A1, B0, g10); g11 = MFMA32(A1, B1, g11);
        }
    }
    if (!PHC) {
        const float dec = GLA ? __expf(bsum) : eprod;
        X.decay()[(((size_t)b * 64 + c) * 8 + h8) * 64 + lane] = dec;
        const float d0 = __shfl(dec, r32), d1 = __shfl(dec, 32 + r32);
        float* kv = X.kvt() + sbase;
#pragma unroll
        for (int r = 0; r < 16; ++r) { const int v0 = crow(r, hi);
            kv[(size_t)v0 * 64 + r32] = g00[r] * d0; kv[(size_t)v0 * 64 + 32 + r32] = g01[r] * d1;
            kv[(size_t)(32 + v0) * 64 + r32] = g10[r] * d0; kv[(size_t)(32 + v0) * 64 + 32 + r32] = g11[r] * d1; }
        return;
    }
    if (PHC) {
        bf16x8 avp[2][4];
#pragma unroll
        for (int sg = 0; sg < 4; ++sg) {
            u32x4 f0, f1;
            auto r0 = __builtin_amdgcn_permlane32_swap(pvall[8 * sg + 0], pvall[8 * sg + 2], false, false); f0[0] = r0[0]; f1[0] = r0[1];
            auto r1 = __builtin_amdgcn_permlane32_swap(pvall[8 * sg + 1], pvall[8 * sg + 3], false, false); f0[1] = r1[0]; f1[1] = r1[1];
            auto r2 = __builtin_amdgcn_permlane32_swap(pvall[8 * sg + 4], pvall[8 * sg + 6], false, false); f0[2] = r2[0]; f1[2] = r2[1];
            auto r3 = __builtin_amdgcn_permlane32_swap(pvall[8 * sg + 5], pvall[8 * sg + 7], false, false); f0[3] = r3[0]; f1[3] = r3[1];
            avp[0][sg] = __builtin_bit_cast(bf16x8, f0); avp[1][sg] = __builtin_bit_cast(bf16x8, f1);
        }
        const LAS unsigned char* QT = wl; const LAS unsigned char* KT = wl + 9216;
        f32x16 o[2][2];
#pragma unroll
        for (int it = 0; it < 2; ++it) {
            bf16x8 bq[4];
#pragma unroll
            for (int ks = 0; ks < 4; ++ks) bq[ks] = *(const LAS bf16x8*)(QT + (32 * it + r32) * 144 + ks * 32 + hi * 16);
#pragma unroll
            for (int vi = 0; vi < 2; ++vi) { f32x16 acc = {};
#pragma unroll
                for (int ks = 0; ks < 4; ++ks) acc = MFMA32(s0f[vi][ks], bq[ks], acc);
                o[vi][it] = acc; }
#pragma unroll
            for (int jt = 0; jt <= it; ++jt) {
                f32x16 sc = {};
#pragma unroll
                for (int ks = 0; ks < 4; ++ks) { const bf16x8 ak = *(const LAS bf16x8*)(KT + (32 * jt + r32) * 144 + ks * 32 + hi * 16); sc = MFMA32(ak, bq[ks], sc); }
                if (jt == it) {
#pragma unroll
                    for (int r = 0; r < 16; ++r) if (crow(r, hi) > r32) sc[r] = 0.f;
                }
#pragma unroll
                for (int sp = 0; sp < 2; ++sp) {
                    u32x4 pw; pw.x = cvtpk(sc[8 * sp + 0], sc[8 * sp + 1]); pw.y = cvtpk(sc[8 * sp + 2], sc[8 * sp + 3]); pw.z = cvtpk(sc[8 * sp + 4], sc[8 * sp + 5]); pw.w = cvtpk(sc[8 * sp + 6], sc[8 * sp + 7]);
                    const bf16x8 pb = __builtin_bit_cast(bf16x8, pw);
                    o[0][it] = MFMA32(avp[0][2 * jt + sp], pb, o[0][it]); o[1][it] = MFMA32(avp[1][2 * jt + sp], pb, o[1][it]);
                }
            }
        }
        const float* ng = (GLA ? X.gla_g() : X.hgrn_g()) + layer * 64;
        const int gcol = GLA ? (C_AG + 64 * h) : (C_CG + 64 * h);
        const int mcol = GLA ? (64 * h) : (768 + 64 * h);
#pragma unroll
        for (int it = 0; it < 2; ++it) {
            float ss = 0.f;
#pragma unroll
            for (int vi = 0; vi < 2; ++vi)
#pragma unroll
                for (int r = 0; r < 16; ++r) ss += o[vi][it][r] * o[vi][it][r];
            ss += __shfl_xor(ss, 32);
            const float rstd = rsqrtf(ss * (1.f / 64.f) + EPS);
            const size_t row = row0 + 32 * it + r32;
#pragma unroll
            for (int vi = 0; vi < 2; ++vi)
#pragma unroll
                for (int g = 0; g < 4; ++g) { const int v0 = 32 * vi + 8 * g + 4 * hi;
                    const u32x2 gr = *(const u32x2*)(P + row * PP + gcol + v0);
                    const f32x4 gn = *(const f32x4*)(ng + v0);
                    const float g0 = bflo(gr.x), g1 = bfhi(gr.x), g2 = bflo(gr.y), g3 = bfhi(gr.y);
                    const float y0 = o[vi][it][4 * g + 0] * rstd * gn.x * (g0 * sigmoidf_(g0)), y1 = o[vi][it][4 * g + 1] * rstd * gn.y * (g1 * sigmoidf_(g1));
                    const float y2 = o[vi][it][4 * g + 2] * rstd * gn.z * (g2 * sigmoidf_(g2)), y3 = o[vi][it][4 * g + 3] * rstd * gn.w * (g3 * sigmoidf_(g3));
                    u32x2 w; w.x = cvtpk(y0, y1); w.y = cvtpk(y2, y3);
                    *(u32x2*)(X.ab() + row * DM + mcol + v0) = w; asm volatile("" ::: "memory"); }
        }
    }
}

__device__ __forceinline__ void scan_phase(const Ctx& X, int layer) {
    const int NTH = X.G * 512;
    for (int e = X.bx * 512 + X.tid(); e < NBATCH * 8 * 4096; e += NTH) {
        const int b = e >> 15, rem = e & 32767, h8 = rem >> 12, vk = rem & 4095, k = vk & 63;
        float S = 0.f;
        {
            float kv[64], dc[64];
            const float* kvp = X.kvt() + ((size_t)b * 64 * 8 + h8) * 4096 + vk; const float* dcp = X.decay() + ((size_t)b * 64 * 8 + h8) * 64 + k;
#pragma unroll
            for (int j = 0; j < 64; ++j) { kv[j] = kvp[(size_t)j * 8 * 4096]; dc[j] = dcp[(size_t)j * 8 * 64]; }
            __builtin_amdgcn_sched_barrier(0);
            bf16_t* stp = X.st() + ((size_t)b * 64 * 8 + h8) * 4096 + vk;
#pragma unroll
            for (int j = 0; j < 64; ++j) { stp[(size_t)j * 8 * 4096] = (bf16_t)(cvtpk(S, 0.f) & 0xffffu); S = dc[j] * S + kv[j]; }
        }
    }
    asm volatile("s_waitcnt vmcnt(0)" ::: "memory");
    __syncthreads();
    if (X.tid() == 0) { __builtin_amdgcn_fence(__ATOMIC_RELEASE, "agent"); __hip_atomic_fetch_add(X.ctl() + 64 + layer, 1u, __ATOMIC_RELAXED, __HIP_MEMORY_SCOPE_AGENT); }
}
__device__ __forceinline__ void scan_wait(const Ctx& X, int layer) {
    if (X.tid() == 0) { unsigned sp = 0;
        while (__hip_atomic_load(X.ctl() + 64 + layer, __ATOMIC_RELAXED, __HIP_MEMORY_SCOPE_AGENT) < (unsigned)X.G) { __builtin_amdgcn_s_sleep(2); if (++sp > (1u << 24)) break; }
        __builtin_amdgcn_fence(__ATOMIC_ACQUIRE, "agent"); }
    __syncthreads();
    __builtin_amdgcn_fence(__ATOMIC_ACQUIRE, "workgroup");
}

constexpr int AT_KS = 0, AT_WL = 4096, AT_RING = 8192, AT_SLOT = 16384, AT_NSLOT = 8;
static_assert(AT_RING + AT_NSLOT * AT_SLOT <= MISC_OFF, "attention ring");
__device__ __forceinline__ s16x4 vtr(const LAS unsigned char* p) { typedef short v4i16_t __attribute__((ext_vector_type(4))); return __builtin_bit_cast(s16x4, __builtin_amdgcn_ds_read_tr16_b64_v4i16((LAS v4i16_t*)p)); }
#define AT_WAITBAR(N) asm volatile("s_waitcnt vmcnt(" #N ") lgkmcnt(0)\n\ts_barrier" ::: "memory")
__device__ __forceinline__ void at_kload(bf16x8 (&kf)[8], const LAS unsigned char* Kb, int r32, int hi) {
#pragma unroll
    for (int d0 = 0; d0 < 4; ++d0) { kf[2 * d0] = *(const LAS bf16x8*)(Kb + (2 * d0 + hi) * 1024 + r32 * 16); kf[2 * d0 + 1] = *(const LAS bf16x8*)(Kb + (2 * d0 + hi) * 1024 + (32 + r32) * 16); }
}
template <bool OWN, bool HN1, int TT>
__device__ __forceinline__ void attn_tile(f32x16& pc0, f32x16& pc1, f32x16& pn0, f32x16& pn1, f32x16& o0, f32x16& o1, f32x16& o2, const f32x16& bvec, bf16x8 (&kf)[8], const bf16x8 (&qr)[4],
                                          const LAS unsigned char* Vb, const LAS unsigned char* Kn1, int vpo, int r32, int hi, int qh) {
    if (HN1) at_kload(kf, Kn1, r32, hi);
    s16x4 vl[4], vh[4];
#pragma unroll
    for (int i = 0; i < 4; ++i) { vl[i] = vtr(Vb + vpo + i * 1024); vh[i] = vtr(Vb + vpo + i * 1024 + 512); }
    __builtin_amdgcn_sched_barrier(0);
#pragma unroll
    for (int d0 = 0; d0 < 4; ++d0) {
#pragma unroll
        for (int r = 4 * d0; r < 4 * d0 + 4; ++r) pc0[r] = __builtin_amdgcn_exp2f(pc0[r]);
        if (HN1) pn0 = MFMA32(kf[2 * d0], qr[d0], d0 == 0 ? bvec : pn0);
#pragma unroll
        for (int r = 4 * d0; r < 4 * d0 + 4; ++r) pc1[r] = __builtin_amdgcn_exp2f(pc1[r]);
        if (HN1) pn1 = MFMA32(kf[2 * d0 + 1], qr[d0], d0 == 0 ? bvec : pn1);
    }
    if (OWN) {
#pragma unroll
        for (int r = 0; r < 16; ++r) { const int kc = 64 * TT + (r & 3) + 8 * (r >> 2);
            pc0[r] = (kc > qh) ? 0.f : pc0[r]; pc1[r] = (kc + 32 > qh) ? 0.f : pc1[r]; }
    }
    s16x4 wl_[4], wh_[4];
#pragma unroll
    for (int i = 0; i < 4; ++i) { wl_[i] = vtr(Vb + vpo + 4096 + i * 1024); wh_[i] = vtr(Vb + vpo + 4096 + i * 1024 + 512); }
    __builtin_amdgcn_sched_barrier(0);
    bf16x8 pa[4];
#pragma unroll
    for (int s = 0; s < 2; ++s) {
        u32x4 w0; w0.x = cvtpk(pc0[8 * s + 0], pc0[8 * s + 1]); w0.y = cvtpk(pc0[8 * s + 2], pc0[8 * s + 3]); w0.z = cvtpk(pc0[8 * s + 4], pc0[8 * s + 5]); w0.w = cvtpk(pc0[8 * s + 6], pc0[8 * s + 7]);
        u32x4 w1; w1.x = cvtpk(pc1[8 * s + 0], pc1[8 * s + 1]); w1.y = cvtpk(pc1[8 * s + 2], pc1[8 * s + 3]); w1.z = cvtpk(pc1[8 * s + 4], pc1[8 * s + 5]); w1.w = cvtpk(pc1[8 * s + 6], pc1[8 * s + 7]);
        pa[s] = __builtin_bit_cast(bf16x8, w0); pa[2 + s] = __builtin_bit_cast(bf16x8, w1);
    }
    const bf16x8 ones = (bf16x8){0x3f80, 0x3f80, 0x3f80, 0x3f80, 0x3f80, 0x3f80, 0x3f80, 0x3f80};
#pragma unroll
    for (int ks = 0; ks < 4; ++ks) { const bf16x8 vb0 = (bf16x8){vl[ks][0], vl[ks][1], vl[ks][2], vl[ks][3], vh[ks][0], vh[ks][1], vh[ks][2], vh[ks][3]}; o0 = MFMA32(pa[ks], vb0, o0); o2 = MFMA32(pa[ks], ones, o2); }
#pragma unroll
    for (int ks = 0; ks < 4; ++ks) { const bf16x8 vb1 = (bf16x8){wl_[ks][0], wl_[ks][1], wl_[ks][2], wl_[ks][3], wh_[ks][0], wh_[ks][1], wh_[ks][2], wh_[ks][3]}; o1 = MFMA32(pa[ks], vb1, o1); }
}
__device__ __forceinline__ void attn_unit(const Ctx& X, int layer, int b, int h, int qi) {
    int lane_ = X.lane(), wid_ = X.wave; asm volatile("" : "+v"(lane_), "+s"(wid_));
    const int lane = lane_, wid = wid_, tid = wid * 64 + lane, r32 = lane & 31, hi = lane >> 5;
    LAS unsigned char* lds = X.lds;
    const bf16_t* P = X.proj();
    const size_t rowbase = (size_t)b * SEQ;
    const size_t qrow = rowbase + 256 * qi + 32 * wid + r32;
    float gqm = fabsf(X.qn_g()[layer * 64 + lane]), gkm = fabsf(X.kn_g()[layer * 64 + lane]);
    gqm = wave_max(gqm); gkm = wave_max(gkm);
    const float negM = -(8.3f * gqm * gkm * LOG2E);
    bf16x8 qr[4];
#pragma unroll
    for (int d0 = 0; d0 < 4; ++d0) qr[d0] = *(const bf16x8*)(P + qrow * PP + C_BQ + 64 * h + 16 * d0 + 8 * hi);
    {
        LAS float* ks = (LAS float*)(lds + AT_KS);
#pragma unroll
        for (int e = 0; e < 2; ++e) { const int idx = tid * 2 + e, n = idx >> 6, d = idx & 63; float s = 0.f;
#pragma unroll
            for (int p = 0; p < 2; ++p) s += X.kpart()[((size_t)(b * 16 + n) * 2 + p) * 512 + 64 * h + d];
            ks[idx] = s; }
    }
    __syncthreads();
    const unsigned kgo = (unsigned)(((rowbase + lane) * PP + C_BK + 64 * h + 8 * wid) * 2);
    const unsigned vgo = (unsigned)(((rowbase + 16 * (wid & 3) + (lane >> 2)) * PP + C_BV + 64 * h + (wid >> 2) * 32 + (lane & 3) * 8) * 2);
    const unsigned lds0 = (unsigned)(uintptr_t)lds;
#define AT_ISSUE(t) do { const unsigned sl_ = (unsigned)__builtin_amdgcn_readfirstlane((int)(lds0 + AT_RING + ((t) & (AT_NSLOT - 1)) * AT_SLOT + wid * 1024)); \
        glds16(P, kgo + (unsigned)(t) * (64u * PP * 2u), sl_); glds16(P, vgo + (unsigned)(t) * (64u * PP * 2u), sl_ + 8192u); } while (0)
#define AT_SLOTP(t) (lds + AT_RING + ((t) & (AT_NSLOT - 1)) * AT_SLOT)
    const int T = 4 * (qi + 1);
    AT_ISSUE(0); AT_ISSUE(1); AT_ISSUE(2); AT_ISSUE(3);
    unsigned sel = 0u;
    if (qi <= 3) sel = (1u << qi) - 1u;
    else {
        float qf[32];
#pragma unroll
        for (int d0 = 0; d0 < 4; ++d0) { const u32x4 w = __builtin_bit_cast(u32x4, qr[d0]);
            qf[8 * d0 + 0] = bflo(w.x); qf[8 * d0 + 1] = bfhi(w.x); qf[8 * d0 + 2] = bflo(w.y); qf[8 * d0 + 3] = bfhi(w.y);
            qf[8 * d0 + 4] = bflo(w.z); qf[8 * d0 + 5] = bfhi(w.z); qf[8 * d0 + 6] = bflo(w.w); qf[8 * d0 + 7] = bfhi(w.w); }
        float gt[15];
        const LAS float* ks = (const LAS float*)(lds + AT_KS);
#pragma unroll
        for (int n = 0; n < 15; ++n) {
            float s = 0.f;
            if (n < qi) {
#pragma unroll
                for (int d0 = 0; d0 < 4; ++d0) { const f32x4 k0 = *(const LAS f32x4*)(ks + n * 64 + 16 * d0 + 8 * hi), k1 = *(const LAS f32x4*)(ks + n * 64 + 16 * d0 + 8 * hi + 4);
                    s += qf[8 * d0 + 0] * k0.x + qf[8 * d0 + 1] * k0.y + qf[8 * d0 + 2] * k0.z + qf[8 * d0 + 3] * k0.w + qf[8 * d0 + 4] * k1.x + qf[8 * d0 + 5] * k1.y + qf[8 * d0 + 6] * k1.z + qf[8 * d0 + 7] * k1.w; }
                s += __shfl_xor(s, 32);
                asm volatile("" ::: "memory");
            }
            gt[n] = (n < qi) ? s : -INFINITY;
        }
#pragma unroll
        for (int pass = 0; pass < 3; ++pass) {
            float best = -INFINITY; int bi = -1;
#pragma unroll
            for (int n = 0; n < 15; ++n) if (gt[n] > best) { best = gt[n]; bi = n; }
            if (bi >= 0) sel |= 1u << bi;
#pragma unroll
            for (int n = 0; n < 15; ++n) if (n == bi) gt[n] = -INFINITY;
        }
    }
    const float NEGBIG = -1.0e30f;
#define AT_BIAS(t) (((t) >= T - 4) ? negM : ((((sel >> ((t) >> 2)) & 1u) != 0u) ? negM : NEGBIG))
    f32x16 o0 = {}, o1 = {}, o2 = {}, pA0, pA1, pB0, pB1, bvec; bf16x8 kf[8];
    const int vpo = ((lane >> 4) & 1) * 32 + (lane & 3) * 8 + (4 * hi + ((lane & 15) >> 2)) * 64;
    const int qh = 32 * wid + r32 - 4 * hi;
    AT_WAITBAR(6);
    at_kload(kf, AT_SLOTP(0), r32, hi);
    { const float b0 = AT_BIAS(0);
#pragma unroll
      for (int r = 0; r < 16; ++r) bvec[r] = b0;
#pragma unroll
      for (int d0 = 0; d0 < 4; ++d0) { pA0 = MFMA32(kf[2 * d0], qr[d0], d0 == 0 ? bvec : pA0); pA1 = MFMA32(kf[2 * d0 + 1], qr[d0], d0 == 0 ? bvec : pA1); } }
#define AT_STEP(OWN, HN1, HN2, TT, PC0, PC1, PN0, PN1, t) do { \
        if ((t) + 3 < T) AT_WAITBAR(4); else if ((t) + 2 < T) AT_WAITBAR(2); else AT_WAITBAR(0); \
        if ((t) + 4 < T) AT_ISSUE((t) + 4); \
        if ((((t) + 1) & 3) == 0) { const float bn_ = AT_BIAS((t) + 1); _Pragma("unroll") for (int r_ = 0; r_ < 16; ++r_) bvec[r_] = bn_; }        \
        attn_tile<OWN, HN1, TT>(PC0, PC1, PN0, PN1, o0, o1, o2, bvec, kf, qr, AT_SLOTP(t) + 8192, AT_SLOTP((t) + 1), vpo, r32, hi, qh); } while (0)
    int t = 0;
    for (; t < T - 4; t += 2) {
        AT_STEP(false, true, true, 0, pA0, pA1, pB0, pB1, t);
        AT_STEP(false, true, true, 0, pB0, pB1, pA0, pA1, t + 1);
    }
    AT_STEP(true, true, true, 0, pA0, pA1, pB0, pB1, t);
    AT_STEP(true, true, true, 1, pB0, pB1, pA0, pA1, t + 1);
    AT_STEP(true, true, false, 2, pA0, pA1, pB0, pB1, t + 2);
    AT_STEP(true, false, false, 3, pB0, pB1, pA0, pA1, t + 3);
    bf16_t* orow = X.ab() + (rowbase + 256 * qi + 32 * wid) * DM + 256 + 64 * h;
#pragma unroll
    for (int r = 0; r < 16; ++r) { const int q = crow(r, hi); const float rl = 1.0f / o2[r];
        orow[(size_t)q * DM + r32] = (bf16_t)(cvtpk(o0[r] * rl, 0.f) & 0xffffu);
        orow[(size_t)q * DM + 32 + r32] = (bf16_t)(cvtpk(o1[r] * rl, 0.f) & 0xffffu); }
    __syncthreads();
#undef AT_ISSUE
#undef AT_SLOTP
#undef AT_BIAS
#undef AT_STEP
}

__device__ __forceinline__ void router_flush(const Ctx& X, int layer, LAS unsigned* lcnt, LAS unsigned* rec, int nrow) {
    __syncthreads();
    if (X.tid() < 16) { const unsigned c = lcnt[X.tid()]; lcnt[16 + X.tid()] = c ? __hip_atomic_fetch_add(X.ctl() + layer * 16 + X.tid(), c, __ATOMIC_RELAXED, __HIP_MEMORY_SCOPE_AGENT) : 0u; }
    __syncthreads();
    if (X.lane() < nrow) { const LAS unsigned* rc = rec + (X.wave * 16 + X.lane()) * 8;
        const unsigned e0 = rc[0], e1 = rc[1], i0 = lcnt[16 + e0] + rc[2], i1 = lcnt[16 + e1] + rc[3], m = rc[6];
        X.amap()[e0 * MOE_CAP + i0] = m; X.amap()[e1 * MOE_CAP + i1] = m; X.slotw()[e0 * MOE_CAP + i0] = __uint_as_float(rc[4]); X.slotw()[e1 * MOE_CAP + i1] = __uint_as_float(rc[5]);
        unsigned* rt = X.route() + (size_t)m * 8; *(u32x4*)rt = (u32x4){e0, e1, i0, i1}; }
    __syncthreads();
    if (X.tid() < 16) lcnt[X.tid()] = 0u;
    __syncthreads();
}

__device__ __forceinline__ void router_phase(const Ctx& X, int layer) {
    LAS float* wr = (LAS float*)X.lds;
    {
        f32x4 rg[2], re[2][4];
#pragma unroll
        for (int q = 0; q < 2; ++q) { const int k = X.tid() + 512 * q; rg[q] = *(const f32x4*)(X.w_rg() + (size_t)layer * DM * 4 + k * 4);
#pragma unroll
            for (int j = 0; j < 4; ++j) re[q][j] = *(const f32x4*)(X.w_re() + (size_t)layer * DM * 16 + k * 16 + 4 * j); }
#pragma unroll
        for (int q = 0; q < 2; ++q) { const int k = X.tid() + 512 * q;
#pragma unroll
            for (int c = 0; c < 4; ++c) wr[c * DM + k] = rg[q][c];
#pragma unroll
            for (int j = 0; j < 4; ++j)
#pragma unroll
                for (int c = 0; c < 4; ++c) wr[(4 + 4 * j + c) * DM + k] = re[q][j][c]; }
    }
    LAS unsigned* lcnt = (LAS unsigned*)(X.lds + MISC_OFF + 256);
    if (X.tid() < 16) lcnt[X.tid()] = 0u;
    __syncthreads();
    const int lane = X.lane();
    constexpr int RT_MAXROWS = 16;
    LAS unsigned* rec = (LAS unsigned*)(X.lds + 90112);
    int nrow = 0;
    f32x4 v[4], vnx[4];
    if (X.gw < NTOK) row_load_bf16(X.x1b() + (size_t)X.gw * DM, lane, v);
    const int npass = (NTOK + X.NGW - 1) / X.NGW;
    for (int it = 0; it < npass; ++it) {
        const int m = X.gw + it * X.NGW;
        if (it > 0 && (it & (RT_MAXROWS - 1)) == 0) { router_flush(X, layer, lcnt, rec, nrow); nrow = 0; }
        if (m >= NTOK) continue;
        { const int mn = m + X.NGW; if (mn < NTOK) row_load_bf16(X.x1b() + (size_t)mn * DM, lane, vnx); }
        {
            float s = 0.f;
#pragma unroll
            for (int j = 0; j < 4; ++j) s += (v[j].x * v[j].x + v[j].y * v[j].y) + (v[j].z * v[j].z + v[j].w * v[j].w);
            const float rstd = rsqrtf(wave_sum(s) * (1.f / DM) + EPS);
            const f32x4* gr = (const f32x4*)(X.ffn_g() + layer * DM) + lane; unsigned* o4 = (unsigned*)((unsigned char*)X.ab() + (size_t)m * DM) + lane;
#pragma unroll
            for (int j = 0; j < 4; ++j) { const f32x4 gg = gr[64 * j]; v[j] = v[j] * rstd * gg; int p = 0; p = __builtin_amdgcn_cvt_pk_fp8_f32(v[j].x, v[j].y, p, false); p = __builtin_amdgcn_cvt_pk_fp8_f32(v[j].z, v[j].w, p, true); o4[64 * j] = (unsigned)p; }
        }
        float lg[4];
#pragma unroll
        for (int c = 0; c < 4; ++c) { float s = 0.f;
#pragma unroll
            for (int j = 0; j < 4; ++j) { const f32x4 w = *(const LAS f32x4*)(wr + c * DM + 4 * (64 * j + lane)); s += v[j].x * w.x + v[j].y * w.y + v[j].z * w.z + v[j].w * w.w; }
            lg[c] = wave_sum(s); }
        asm volatile("" ::: "memory");
        int gs = 0; float gm = lg[0];
#pragma unroll
        for (int c = 1; c < 4; ++c) if (lg[c] > gm) { gm = lg[c]; gs = c; }
        float den = 0.f;
#pragma unroll
        for (int c = 0; c < 4; ++c) den += __expf(lg[c] - gm);
        const float pg = 1.0f / den;
        float le[4];
        { const LAS float* wre = wr + (4 + 4 * gs) * DM;
#pragma unroll
          for (int j = 0; j < 4; ++j) { float s = 0.f;
#pragma unroll
              for (int q = 0; q < 4; ++q) { const f32x4 w = *(const LAS f32x4*)(wre + j * DM + 4 * (64 * q + lane)); s += v[q].x * w.x + v[q].y * w.y + v[q].z * w.z + v[q].w * w.w; }
              le[j] = wave_sum(s); } }
        int i1 = 0; float v1 = le[0];
#pragma unroll
        for (int j = 1; j < 4; ++j) if (le[j] > v1) { v1 = le[j]; i1 = j; }
        int i2 = -1; float v2 = -INFINITY;
#pragma unroll
        for (int j = 0; j < 4; ++j) if (j != i1 && le[j] > v2) { v2 = le[j]; i2 = j; }
        const float ex = __expf(v2 - v1); const float w1 = pg / (1.f + ex), w2 = pg * ex / (1.f + ex);
        if (lane == 0) {
            const int e0 = 4 * gs + i1, e1 = 4 * gs + i2;
            const unsigned p0 = __hip_atomic_fetch_add(lcnt + e0, 1u, __ATOMIC_RELAXED, __HIP_MEMORY_SCOPE_WORKGROUP), p1 = __hip_atomic_fetch_add(lcnt + e1, 1u, __ATOMIC_RELAXED, __HIP_MEMORY_SCOPE_WORKGROUP);
            LAS unsigned* rc = rec + (X.wave * RT_MAXROWS + nrow) * 8;
            rc[0] = (unsigned)e0; rc[1] = (unsigned)e1; rc[2] = p0; rc[3] = p1; rc[4] = __float_as_uint(w1); rc[5] = __float_as_uint(w2); rc[6] = (unsigned)m;
        }
        ++nrow;
#pragma unroll
        for (int j = 0; j < 4; ++j) v[j] = vnx[j];
    }
    router_flush(X, layer, lcnt, rec, nrow);
}

__device__ __forceinline__ int expert_off_rows(const Ctx& X, int layer, int lane) {
    const int e = lane & 15; const unsigned c = __hip_atomic_load(X.ctl() + layer * 16 + e, __ATOMIC_RELAXED, __HIP_MEMORY_SCOPE_AGENT);
    const int tiles = (int)((c + 255u) >> 8); int incl = tiles;
#pragma unroll
    for (int o = 1; o < 16; o <<= 1) { const int t = __shfl_up(incl, o, 16); if (e >= o) incl += t; }
    return (incl - tiles) * 256;
}

__device__ __forceinline__ void moe_table(const Ctx& X, int layer) {
    volatile LAS int* toff = (volatile LAS int*)(X.lds + MISC_OFF);
    if (X.tid() < 64) { const int off = expert_off_rows(X, layer, X.lane());
        if (X.lane() < 16) toff[X.lane()] = off >> 8;
        if (X.lane() == 15) { const unsigned c = __hip_atomic_load(X.ctl() + layer * 16 + 15, __ATOMIC_RELAXED, __HIP_MEMORY_SCOPE_AGENT); toff[16] = (off >> 8) + (int)((c + 255u) >> 8); } }
    __syncthreads();
}

__device__ __forceinline__ void combine_phase(const Ctx& X, int layer) {
    const int lane = X.lane();
    int m = X.gw; unsigned sB0 = 0, sB1 = 0, sC0 = 0, sC1 = 0;
    u32x2 xc[4], xn[4]; u32x2 ya[4], yb[4], yan[4], ybn[4];
#define CB_LOAD(XV, YA, YB, mm, s0, s1) do { const u32x2* xr_ = (const u32x2*)(X.x1b() + (size_t)(mm) * DM) + lane; const u32x2* y0_ = (const u32x2*)(X.aperm() + (size_t)(s0) * DM) + lane; const u32x2* y1_ = (const u32x2*)(X.aperm() + (size_t)(s1) * DM) + lane; \
        _Pragma("unroll") for (int j = 0; j < 4; ++j) { XV[j] = xr_[64 * j]; YA[j] = y0_[64 * j]; YB[j] = y1_[64 * j]; } } while (0)
    const int eoff = expert_off_rows(X, layer, lane);
#define CB_SLOTS(mm, s0, s1) do { const u32x4 r_ = *(const u32x4*)(X.route() + (size_t)(mm) * 8); s0 = (unsigned)__shfl(eoff, (int)(r_.x & 15u)) + r_.z; s1 = (unsigned)__shfl(eoff, (int)(r_.y & 15u)) + r_.w; } while (0)
    if (m < NTOK) { unsigned s0, s1; CB_SLOTS(m, s0, s1); CB_LOAD(xc, ya, yb, m, s0, s1); }
    if (m + X.NGW < NTOK) { CB_SLOTS(m + X.NGW, sB0, sB1); }
    for (; m < NTOK; m += X.NGW) {
        const int mn = m + X.NGW, mnn = m + 2 * X.NGW;
        if (mn < NTOK) CB_LOAD(xn, yan, ybn, mn, sB0, sB1);
        if (mnn < NTOK) { CB_SLOTS(mnn, sC0, sC1); }
        float* xr = X.out() + (size_t)m * DM;
        f32x4 v[4]; float ss = 0.f;
#pragma unroll
        for (int j = 0; j < 4; ++j) { const f32x4 xv = (f32x4){bflo(xc[j].x), bfhi(xc[j].x), bflo(xc[j].y), bfhi(xc[j].y)}; const u32x2 a = ya[j], bq = yb[j];
            f32x4 r; r.x = xv.x + bflo(a.x) + bflo(bq.x); r.y = xv.y + bfhi(a.x) + bfhi(bq.x); r.z = xv.z + bflo(a.y) + bflo(bq.y); r.w = xv.w + bfhi(a.y) + bfhi(bq.y);
            v[j] = r; ss += (r.x * r.x + r.y * r.y) + (r.z * r.z + r.w * r.w);
            if (layer + 1 < DEPTH) { u32x2 w; w.x = cvtpk(r.x, r.y); w.y = cvtpk(r.z, r.w); ((u32x2*)(X.x1b() + (size_t)m * DM))[64 * j + lane] = w; }
            else ((f32x4*)xr)[64 * j + lane] = r; }
        if (layer + 1 < DEPTH) {
            const float rstd = rsqrtf(wave_sum(ss) * (1.f / DM) + EPS);
            const f32x4* gr = (const f32x4*)(X.attn_g() + (layer + 1) * DM) + lane; u32x2* o8 = (u32x2*)(X.ab() + (size_t)m * DM) + lane;
#pragma unroll
            for (int j = 0; j < 4; ++j) { const f32x4 gg = gr[64 * j]; const f32x4 hh = v[j] * rstd * gg; u32x2 w; w.x = cvtpk(hh.x, hh.y); w.y = cvtpk(hh.z, hh.w); o8[64 * j] = w;
                int p = 0; p = __builtin_amdgcn_cvt_pk_fp8_f32(hh.x, hh.y, p, false); p = __builtin_amdgcn_cvt_pk_fp8_f32(hh.z, hh.w, p, true); ((unsigned*)(X.h8() + (size_t)m * DM))[64 * j + lane] = (unsigned)p; }
        }
#pragma unroll
        for (int j = 0; j < 4; ++j) { xc[j] = xn[j]; ya[j] = yan[j]; yb[j] = ybn[j]; }
        sB0 = sC0; sB1 = sC1;
    }
#undef CB_LOAD
#undef CB_SLOTS
}

#define XB_TMO      128
#define XB_XCNT(j)  (256  + 64 * (j))
#define XB_XSUB(j)  (1280 + 64 * (j))
#define XB_XGEN(j)  (2304 + 64 * (j))
#define XB_TOP      3328
#define XB_TOPGEN   3392
#define XB_SPIN_CAP (1u << 22)
__device__ __forceinline__ unsigned xb_ld(unsigned* p)              { return __hip_atomic_load(p, __ATOMIC_RELAXED, __HIP_MEMORY_SCOPE_AGENT); }
__device__ __forceinline__ unsigned xb_add(unsigned* p, unsigned v) { return __hip_atomic_fetch_add(p, v, __ATOMIC_RELAXED, __HIP_MEMORY_SCOPE_AGENT); }
__device__ __forceinline__ unsigned xb_xcc_id() { return (unsigned)__builtin_amdgcn_s_getreg((3 << 11) | 20) & 0xFu; }
#define XB_SPIN(cond, bar) do { unsigned _sp = 0; while (cond) { __builtin_amdgcn_s_sleep(1); \
    if ((++_sp & 255u) == 0u) { if (xb_ld(&(bar)[XB_TMO])) break; if (_sp > XB_SPIN_CAP) { atomicAdd(&(bar)[XB_TMO], 1u); break; } } } } while (0)
struct XcdBarrier { unsigned* bar; unsigned x; volatile LAS unsigned* st; };
__device__ __forceinline__ XcdBarrier xcd_barrier_post(unsigned* bar, volatile LAS unsigned* st) {
    XcdBarrier b; b.bar = bar; b.x = xb_xcc_id(); b.st = st;
    if (threadIdx.x == 0) (void)xb_add(&bar[XB_XCNT(b.x)], 1u);
    return b;
}
__device__ __forceinline__ void xcd_barrier_complete(unsigned* bar, unsigned x, unsigned& nloc, unsigned& nx) {
    const unsigned G = gridDim.x * gridDim.y * gridDim.z;
    unsigned sum, cnt, mine, sp = 0u;
    for (;;) {
        sum = 0u; cnt = 0u; mine = 0u;
#pragma unroll 1
        for (unsigned j = 0; j < 16; ++j) { const unsigned c = xb_ld(&bar[XB_XCNT(j)]); sum += c; cnt += (c > 0u) ? 1u : 0u; mine = (j == x) ? c : mine; }
        if (sum == G) break;
        __builtin_amdgcn_s_sleep(1);
        if ((++sp & 255u) == 0u) { if (xb_ld(&bar[XB_TMO])) break; if (sp > XB_SPIN_CAP) { atomicAdd(&bar[XB_TMO], 1u); break; } }
    }
    nloc = mine > 0u ? mine : 1u; nx = cnt > 0u ? cnt : 1u;
}
__device__ __forceinline__ void xcd_barrier(const XcdBarrier& b) {
    asm volatile("s_waitcnt vmcnt(0)" ::: "memory");
    __syncthreads();
    if (threadIdx.x == 0) {
        unsigned* bar = b.bar; unsigned bx_ = b.x;
        asm volatile("" : "+s"(bar), "+s"(bx_));
        __builtin_amdgcn_s_waitcnt(0);
        unsigned nloc = b.st[0], nx = b.st[1];
        if (nloc == 0u) { xcd_barrier_complete(bar, bx_, nloc, nx); b.st[0] = nloc; b.st[1] = nx; }
        const unsigned old = xb_add(&bar[XB_XSUB(bx_)], 1u);
        const unsigned gen = old / nloc;
        if (old + 1u == (gen + 1u) * nloc) {
            __builtin_amdgcn_fence(__ATOMIC_RELEASE, "agent");
            asm volatile("s_waitcnt vmcnt(0)" ::: "memory");
            const unsigned og = xb_add(&bar[XB_TOP], 1u);
            const unsigned tg = og / nx;
            if (og + 1u == (tg + 1u) * nx) xb_add(&bar[XB_TOPGEN], 1u);
            else XB_SPIN(xb_ld(&bar[XB_TOPGEN]) == tg, bar);
            __builtin_amdgcn_fence(__ATOMIC_ACQUIRE, "agent");
            xb_add(&bar[XB_XGEN(bx_)], 1u);
            asm volatile("s_waitcnt vmcnt(0)" ::: "memory");
        } else {
            XB_SPIN(xb_ld(&bar[XB_XGEN(bx_)]) == gen, bar);
            __builtin_amdgcn_fence(__ATOMIC_ACQUIRE, "agent");
            asm volatile("s_waitcnt vmcnt(0)" ::: "memory");
        }
    }
    __syncthreads();
}

#ifndef PHMASK
#define PHMASK 0xffff
#endif
#ifndef PROBE_A
#define PROBE_A -1
#define PROBE_B -1
#endif
#ifndef PROBE_BLK
#define PROBE_BLK 0
#endif
constexpr int NPHASE = 1 + 7 * DEPTH;
__global__ void __launch_bounds__(512, 2) fwd_kernel(Args args) {
    extern __shared__ __attribute__((aligned(16))) unsigned char lds_raw[];
    cg::grid_group grid = cg::this_grid();
    const int wave_s = __builtin_amdgcn_readfirstlane((int)(threadIdx.x >> 6));
    const int lo = args.ph_lo, hi = args.ph_hi;
    { volatile LAS unsigned* m = (volatile LAS unsigned*)((LAS unsigned char*)lds_raw + MISC_OFF); if (threadIdx.x < 64) m[threadIdx.x] = 0u; }
    __syncthreads();
    XcdBarrier xbar; xbar.bar = (unsigned*)(args.ws + WS_CTL) + CW_BAR; xbar.x = 0u; xbar.st = (volatile LAS unsigned*)((LAS unsigned char*)lds_raw + MISC_OFF + 128);
#if PROBE_A >= 0
    unsigned prA = 0, prT = 0, prE = 0; const unsigned prS = (unsigned)__builtin_amdgcn_s_memrealtime();
#define PROBE_ACC(type, d) do { if ((type) == PROBE_A) prA += (d); } while (0)
#endif
#if PROBE_A >= 0
#define PROBE_SUB(type) do { __syncthreads(); const unsigned t_ = (unsigned)__builtin_amdgcn_s_memrealtime(); PROBE_ACC(type, t_ - prSub); prSub = t_; } while (0)
    unsigned prSub = 0;
#else
#define PROBE_SUB(type) do {} while (0)
#endif
    for (int ph = lo; ph < hi; ++ph) {
        if (ph > lo) { if (ph == lo + 1) { grid.sync(); xbar = xcd_barrier_post((unsigned*)(args.ws + WS_CTL) + CW_BAR, (volatile LAS unsigned*)((LAS unsigned char*)lds_raw + MISC_OFF + 128)); } else xcd_barrier(xbar); }
#if PROBE_A >= 0
        prT = (unsigned)__builtin_amdgcn_s_memrealtime(); prSub = prT; if (ph > lo) PROBE_ACC(11, prT - prE);
#endif
        Ctx X;
#define CTX_REFRESH() do { \
        { unsigned l0 = 0u; asm volatile("" : "+s"(l0)); X.lds = (LAS unsigned char*)lds_raw + l0; } \
        { unsigned z0 = 0u; asm volatile("" : "+s"(z0)); \
          int ws = wave_s; asm volatile("" : "+s"(ws)); (void)z0; \
          X.wave = ws; } \
        { int bx = blockIdx.x, G = gridDim.x; asm volatile("" : "+s"(bx), "+s"(G)); X.G = G; X.vcu = (G % 8 == 0) ? (bx % 8) * (G / 8) + bx / 8 : bx; X.bx = bx; } \
        X.gw = X.vcu * 8 + X.wave; X.NGW = X.G * 8; \
        { const __attribute__((address_space(4))) unsigned char* ka = (const __attribute__((address_space(4))) unsigned char*)__builtin_amdgcn_kernarg_segment_ptr(); asm volatile("" : "+s"(ka)); X.ka = ka; } } while (0)
        CTX_REFRESH();
        const int layer = (ph - 1) / 7; const int k = ph == 0 ? 0 : (0xA865421 >> (4 * ((ph - 1) % 7))) & 15;
        if (ph == 0) { phase0(X); PROBE_SUB(15); CTX_REFRESH(); phase0b(X); PROBE_SUB(16); }
        else switch (k) {
        case 1: {
            {
                pg8::Gemm g{X.ab(), X.win() + (size_t)layer * NW_IN * DM, DM}; pg8::StaticOrder S; S.init(NTOK, 1536, X.G, X.bx, 0xCBA910ull, 0, 0);
                EpiProj<false> E{X.proj(), X.lr(), X.qn_g() + layer * 64, X.kn_g() + layer * 64, X.cosT(), X.sinT(), X.kpart()};
                pg8::gemm_phase<EpiProj<false>, pg8::StaticOrder>(X.lds, g, S, E, X.tid()); }
            PROBE_SUB(19);
            CTX_REFRESH();
            {
                pg8::Gemm g{(const bf16_t*)X.h8(), (const bf16_t*)((const unsigned char*)(X.win() + (size_t)layer * NW_IN * DM) + (size_t)C_BQ * DM * 2), DM / 2}; pg8::StaticOrder S; S.init(NTOK, 2048, X.G, X.bx, 0x2D876543ull, 1, 1);
                EpiProj<true> E{X.proj(), X.lr(), X.qn_g() + layer * 64, X.kn_g() + layer * 64, X.cosT(), X.sinT(), X.kpart()};
                pg8::gemm_phase<EpiProj<true>, pg8::StaticOrder, false, true>(X.lds, g, S, E, X.tid()); }
        } break;
        case 2: {
            PROBE_SUB(17);
            LAS unsigned char* wl = X.lds + X.wave * WAVE_LDS;
            for (int it = X.gw; it < 2048; it += X.NGW) { const int h8 = it & 7, bc = it >> 3, b = bc >> 6, c = bc & 63;
                if (h8 < 4) lin_item<true, false>(X, layer, b, c, h8, wl); else lin_item<false, false>(X, layer, b, c, h8 - 4, wl); }
            PROBE_SUB(18);
        } break;
        case 4: {
            scan_phase(X, layer);
            PROBE_SUB(3);
            CTX_REFRESH();
            if (PHMASK & 0x800) for (int v = X.vcu; v < 256; v += X.G) { const int bh = v >> 3, s = v & 7; attn_unit(X, layer, bh >> 3, bh & 7, s); attn_unit(X, layer, bh >> 3, bh & 7, 15 - s); }
            PROBE_SUB(13);
            CTX_REFRESH();
            scan_wait(X, layer);
            LAS unsigned char* wl = X.lds + X.wave * WAVE_LDS;
            if (PHMASK & 0x1000) for (int it = X.gw; it < 2048; it += X.NGW) { const int h8 = it & 7, bc = it >> 3, b = bc >> 6, c = bc & 63;
                if (h8 < 4) lin_item<true, true>(X, layer, b, c, h8, wl); else lin_item<false, true>(X, layer, b, c, h8 - 4, wl); }
            PROBE_SUB(14);
        } break;
        case 5: {
            pg8::Gemm g{X.ab(), X.wout() + (size_t)layer * DM * DM, DM}; pg8::StaticOrder S; S.init(NTOK, DM, X.G, X.bx);
            EpiResid E{X.x(), X.x1b(), layer == 0 ? (const bf16_t*)nullptr : (const bf16_t*)X.x1b()};
            pg8::gemm_phase<EpiResid, pg8::StaticOrder>(X.lds, g, S, E, X.tid());
        } break;
        case 6: router_phase(X, layer); break;
        case 8: {
            moe_table(X, layer);
            unsigned* tcnt;
            { const unsigned long long p_ = (unsigned long long)(uintptr_t)(X.ctl() + 256 + layer * 256);
              tcnt = (unsigned*)(uintptr_t)(((unsigned long long)(unsigned)__builtin_amdgcn_readfirstlane((int)(p_ >> 32)) << 32) | (unsigned long long)(unsigned)__builtin_amdgcn_readfirstlane((int)p_)); }
            { pg8::Gemm g{X.ab(), X.wgu(), DM / 2}; pg8::GroupedOrder S{(const volatile LAS int*)(X.lds + MISC_OFF), X.G, X.vcu, layer * 64, tcnt, (LAS unsigned*)(X.lds + MISC_OFF + 192), 0, 0, 0, 0};
              EpiSwiglu E{X.hbuf()};
              pg8::gemm_phase<EpiSwiglu, pg8::GroupedOrder, true, true>(X.lds, g, S, E, X.tid(), X.amap(), (unsigned)(NTOK - 1)); S.finish(X.wave); }
            PROBE_SUB(8);
            CTX_REFRESH();
            { pg8::Gemm g{X.hbuf(), X.wd(), FF / 2}; pg8::GroupedOrderDown S{(const volatile LAS int*)(X.lds + MISC_OFF), X.G, X.vcu, layer * 64, tcnt, (LAS unsigned*)(X.lds + MISC_OFF + 200 + 4 * layer), X.wave, 0u};
              EpiDown E{X.aperm(), X.slotw()};
              pg8::gemm_phase<EpiDown, pg8::GroupedOrderDown, false, true>(X.lds, g, S, E, X.tid()); }
            PROBE_SUB(9);
        } break;
        case 10: combine_phase(X, layer); break;
        }
        __syncthreads();
#if PROBE_A >= 0
        prE = (unsigned)__builtin_amdgcn_s_memrealtime(); PROBE_ACC(k, prE - prT);
#endif
    }
#if PROBE_A >= 0
    PROBE_ACC(12, prE - prS);
    if (wave_s == 0 && __builtin_amdgcn_mbcnt_hi(~0u, __builtin_amdgcn_mbcnt_lo(~0u, 0u)) == 0u) {
        unsigned* ctl = (unsigned*)(args.ws + WS_CTL);
        if (blockIdx.x == PROBE_BLK) { const unsigned qa = (prA + 400u) / 800u > 127u ? 127u : (prA + 400u) / 800u;
            __hip_atomic_store(ctl + 200, qa, __ATOMIC_RELAXED, __HIP_MEMORY_SCOPE_AGENT); }
        __builtin_amdgcn_fence(__ATOMIC_RELEASE, "agent");
        const unsigned done = __hip_atomic_fetch_add(ctl + 201, 1u, __ATOMIC_ACQ_REL, __HIP_MEMORY_SCOPE_AGENT);
        if (done == gridDim.x - 1) { const unsigned long long extra = (unsigned long long)__hip_atomic_load(ctl + 200, __ATOMIC_RELAXED, __HIP_MEMORY_SCOPE_AGENT) * 400ull; const unsigned long long t0 = __builtin_amdgcn_s_memrealtime();
            while (__builtin_amdgcn_s_memrealtime() - t0 < extra) __builtin_amdgcn_s_sleep(32); }
    }
#endif
}

extern "C" void kernel_launch(void* const* d_in, const int* in_sizes, int n_in, void* d_out, int out_size, void* d_ws, size_t ws_size, hipStream_t stream) {
    static int grid = 0;
    if (grid == 0) {
        if (n_in != 17 || out_size != NTOK * DM || ws_size < WS_END) { fprintf(stderr, "kernel_launch: unexpected problem (n_in %d out %d ws %zu)\n", n_in, out_size, ws_size); grid = -1; return; }
        int dev = 0, cus = 0, per_cu = 0;
        hipGetDevice(&dev); hipDeviceGetAttribute(&cus, hipDeviceAttributeMultiprocessorCount, dev);
        if (hipFuncSetAttribute((const void*)fwd_kernel, hipFuncAttributeMaxDynamicSharedMemorySize, LDS_BYTES) != hipSuccess) { fprintf(stderr, "kernel_launch: hipFuncSetAttribute failed\n"); }
        if (hipOccupancyMaxActiveBlocksPerMultiprocessor(&per_cu, (const void*)fwd_kernel, 512, LDS_BYTES) != hipSuccess || per_cu < 1) { fprintf(stderr, "kernel_launch: occupancy query says %d\n", per_cu); per_cu = 1; }
        (void)hipGetLastError();
        grid = cus * per_cu;
        fprintf(stderr, "kernel_launch: grid %d (cus %d x %d), ws %zu\n", grid, cus, per_cu, ws_size);
    }
    if (grid < 0) return;
    Args a{};
    for (int i = 0; i < 17; ++i) a.in[i] = (const float*)d_in[i];
    a.out = (float*)d_out; a.ws = (unsigned char*)d_ws;
#if MK_PER_PHASE
    for (int ph = 0; ph < NPHASE; ++ph) { a.ph_lo = ph; a.ph_hi = ph + 1; hipLaunchKernelGGL(fwd_kernel, dim3(grid), dim3(512), LDS_BYTES, stream, a); }
#else
    a.ph_lo = 0; a.ph_hi = NPHASE;
    void* kargs[] = {&a};
    hipError_t e = hipLaunchCooperativeKernel((const void*)fwd_kernel, dim3(grid), dim3(512), kargs, LDS_BYTES, stream);
    if (e != hipSuccess) fprintf(stderr, "cooperative launch failed: %s (grid %d)\n", hipGetErrorString(e), grid);
#endif
}
```

```cpp
#include <hip/hip_runtime.h>
#include <hip/hip_cooperative_groups.h>
#include <cstdio>
#include <cstdint>
#include <cstddef>
namespace cg = cooperative_groups;

#ifndef MK_PER_PHASE
#define MK_PER_PHASE 0
#endif

#define LAS __attribute__((address_space(3)))
typedef unsigned short bf16_t;
typedef short bf16x8 __attribute__((ext_vector_type(8)));
typedef short s16x4 __attribute__((ext_vector_type(4)));
typedef float f32x2 __attribute__((ext_vector_type(2)));
typedef float f32x4 __attribute__((ext_vector_type(4)));
typedef float f32x16 __attribute__((ext_vector_type(16)));
typedef unsigned u32x2 __attribute__((ext_vector_type(2)));
typedef unsigned u32x4 __attribute__((ext_vector_type(4)));
typedef __bf16 bf16x2_t __attribute__((ext_vector_type(2)));

constexpr int NTOK = 16384, DM = 1024, SEQ = 4096, NBATCH = 4, DEPTH = 2;
constexpr int IN_COLS = 3344;
constexpr int PP = 3328;
constexpr int NW_IN = 3584;
constexpr int C_AQ = 0, C_AK = 128, C_AV = 256, C_AG = 512, C_BQ = 768, C_BK = 1280, C_BV = 1792, C_CQ = 2304, C_CF = 2560, C_CI = 2816, C_CG = 3072;
constexpr int NEXP = 16, FF = 512;
constexpr int MOE_ROWS = 36864;
constexpr float EPS = 1e-6f;
constexpr float LOG2E = 1.4426950408889634f;

constexpr size_t MiB = 1u << 20;
constexpr size_t WS_CTL = 0;
constexpr size_t WS_SMALL = 1 * MiB;
constexpr size_t SM_COS = WS_SMALL, SM_SIN = WS_SMALL + 128 * 1024;
constexpr size_t SM_LR = WS_SMALL + 256 * 1024;
constexpr size_t SM_KPART = WS_SMALL + 768 * 1024;
constexpr size_t SM_DECAY = WS_SMALL + 1280 * 1024;
constexpr size_t SM_ROUTE = WS_SMALL + 1792 * 1024;
constexpr size_t SM_SLOTW = WS_SMALL + 2304 * 1024;
constexpr size_t SM_AMAP = WS_SMALL + 2816 * 1024;
constexpr size_t SM_WGCNT = WS_SMALL + 2560 * 1024;
__host__ __device__ constexpr int ecnt_idx(int layer, int q) { return 16384 + layer * 32768 + q * 1088; }
constexpr int CW_BAR = 4096;
constexpr size_t CTL_ZERO_BYTES = 65536;
constexpr size_t WS_WIN = 5 * MiB;
constexpr size_t WS_WOUT = 19 * MiB;
constexpr size_t WS_WGU = 23 * MiB;
constexpr size_t WS_X1B = 23 * MiB + 32 * MiB;
constexpr size_t WS_WD = 87 * MiB;
constexpr size_t WS_H8 = 103 * MiB;
constexpr size_t WS_PROJ = 119 * MiB;
constexpr size_t WS_ST = 223 * MiB;
constexpr size_t WS_AB = 239 * MiB;
constexpr int MOE_CAP = 16384;
constexpr size_t WS_AMAP2 = 271 * MiB;
constexpr size_t WS_SLOTW2 = 272 * MiB;
constexpr size_t WS_END = 273 * MiB;
constexpr size_t WS_APERM = WS_PROJ;
constexpr size_t WS_H = WS_PROJ + 72 * MiB;
static_assert(WS_H + (size_t)MOE_ROWS * FF * 2 <= WS_AB, "moe overlay");

constexpr int LDS_BYTES = 159744;
constexpr int MISC_OFF = 147456;
constexpr int GROW_OFF = MISC_OFF + 1024;
constexpr int WAVE_LDS = 18432;

__device__ __forceinline__ unsigned cvtpk(float lo, float hi) { f32x2 v = {lo, hi}; bf16x2_t b = __builtin_convertvector(v, bf16x2_t); return __builtin_bit_cast(unsigned, b); }
__device__ __forceinline__ float bf2f(unsigned short u) { return __builtin_bit_cast(float, (unsigned)u << 16); }
__device__ __forceinline__ float bflo(unsigned u) { return __builtin_bit_cast(float, u << 16); }
__device__ __forceinline__ float bfhi(unsigned u) { return __builtin_bit_cast(float, u & 0xffff0000u); }
#define DPP_ADD(v, ctrl) ((v) + __builtin_bit_cast(float, __builtin_amdgcn_update_dpp(0, __builtin_bit_cast(int, (v)), (ctrl), 0xf, 0xf, true)))
__device__ __forceinline__ float wave_sum(float v) {
    v = DPP_ADD(v, 0xB1); v = DPP_ADD(v, 0x4E); v = DPP_ADD(v, 0x141); v = DPP_ADD(v, 0x140);
    const int iv = __builtin_bit_cast(int, v);
    const float r0 = __builtin_bit_cast(float, __builtin_amdgcn_readlane(iv, 0)), r1 = __builtin_bit_cast(float, __builtin_amdgcn_readlane(iv, 16));
    const float r2 = __builtin_bit_cast(float, __builtin_amdgcn_readlane(iv, 32)), r3 = __builtin_bit_cast(float, __builtin_amdgcn_readlane(iv, 48));
    return (r0 + r1) + (r2 + r3);
}
__device__ __forceinline__ float wave_max(float v) {
#pragma unroll
    for (int o = 1; o < 64; o <<= 1) v = fmaxf(v, __shfl_xor(v, o));
    return v;
}
__device__ __forceinline__ int crow(int r, int hi) { return (r & 3) + 8 * (r >> 2) + 4 * hi; }
__device__ __forceinline__ float sigmoidf_(float x) { return 1.0f / (1.0f + __expf(-x)); }
#define MFMA32(a, b, c) __builtin_amdgcn_mfma_f32_32x32x16_bf16((a), (b), (c), 0, 0, 0)

__device__ __forceinline__ void glds16(const void* sbase, unsigned voff, unsigned lds_dst) { unsigned keep;
    asm volatile("s_mov_b32 %0, m0\n\ts_mov_b32 m0, %3\n\ts_nop 0\n\tglobal_load_lds_dwordx4 %1, %2\n\ts_mov_b32 m0, %0" : "=&s"(keep) : "v"(voff), "s"(sbase), "s"(lds_dst) : "memory"); }

namespace pg8 {
#define PG8_LAS __attribute__((address_space(3)))
constexpr int BM = 256, BK = 64, HALF = 128, HTB = HALF * BK * 2, STAGE_BYTES = 8 * HTB, NXCD = 8, WGM = 8;
__host__ __device__ __forceinline__ int lds_byte(int r, int c) { const int st = (r >> 4) * 2 + (c >> 5), rr = r & 15, cc = c & 31, ob = rr * 64 + cc * 2; return st * 1024 + (ob ^ (((ob >> 9) & 1) << 5)); }
__host__ __device__ __forceinline__ void stage_rc(int b, int& R, int& C) { const int st = b / 1024, sb = b % 1024, swz = sb ^ (((sb >> 9) & 1) << 5); R = (st >> 1) * 16 + swz / 64; C = (st & 1) * 32 + (swz % 64) / 2; }
__host__ __device__ __forceinline__ int perm32(int rho) { const int n = rho >> 4, i = rho & 15; return 8 * (i >> 2) + 4 * n + (i & 3); }

struct Unit { int pm, pn, bt, ab; };
struct Gemm { const bf16_t* A; const bf16_t* Bt; int K; };

struct StaticOrder {
    int nM, nN, nwg, G, c, compact, skew; unsigned long long tbl;
    __device__ void init(int M, int N, int G_, int c_, unsigned long long tbl_ = 0xFEDCBA9876543210ull, int compact_ = 0, int skew_ = 0) { nM = M / BM; nN = N / BM; nwg = nM * nN; G = G_; c = c_; tbl = tbl_; compact = compact_; skew = skew_; }
    __device__ bool next(int i, Unit& u) const {
        long L = (long)i * G + c;
        if (skew && i > 0) { const int hg = G >> 1; if (c < hg) return false; L = (long)G + (long)(i - 1) * hg + (c - hg); }
        if (L >= nwg) return false;
        int wgid = (int)L; { const int q = nwg / NXCD, r = nwg % NXCD, xcd = wgid % NXCD, off = wgid / NXCD; wgid = (xcd < r ? xcd * (q + 1) : r * (q + 1) + (xcd - r) * q) + off; }
        const int nig = WGM * nN, gid = wgid / nig, fm = gid * WGM, gsz = (nM - fm) < WGM ? (nM - fm) : WGM;
        u.pm = fm + ((wgid % nig) % gsz); { const int pn_ = (wgid % nig) / gsz; u.pn = (int)((tbl >> (4 * pn_)) & 15ull); u.bt = compact ? pn_ : u.pn; } return true;
    }
    __device__ __forceinline__ void a_ready(const Unit&) const {}
    __device__ __forceinline__ void done(const Unit&) const {}
};
struct GroupedOrder {
    const volatile PG8_LAS int* toff; int G, vcu, wbase;
    __device__ bool next(int i, Unit& u) const {
        const int U = i * G + vcu; const int total = toff[16];
        if (U >= total * 4) return false;
        const int rt = U >> 2, pn = U & 3; int e = 0;
#pragma unroll
        for (int j = 1; j < 16; ++j) e += (rt >= toff[j]) ? 1 : 0;
        u.pm = __builtin_amdgcn_readfirstlane(rt); u.pn = __builtin_amdgcn_readfirstlane(pn); u.bt = __builtin_amdgcn_readfirstlane(wbase + e * 4 + pn); u.ab = __builtin_amdgcn_readfirstlane(e * 64 + rt - toff[e]); return true;
    }
    __device__ __forceinline__ void a_ready(const Unit&) const {}
    unsigned* cnt; PG8_LAS unsigned* wgarr;
    mutable int dp0, dp1, dp2, ndp;
    __device__ __forceinline__ void done(const Unit& u) const {
        { const int n8 = toff[16] * 4, rem = n8 - (n8 / G) * G;
          if (vcu >= rem) { if (ndp == 0) dp0 = u.pm; else if (ndp == 1) dp1 = u.pm; else dp2 = u.pm; ++ndp; return; } }
        asm volatile("s_waitcnt vmcnt(0)" ::: "memory");
        unsigned old = 0u;
        if (__builtin_amdgcn_mbcnt_hi(~0u, __builtin_amdgcn_mbcnt_lo(~0u, 0u)) == 0u) old = __hip_atomic_fetch_add(wgarr, 1u, __ATOMIC_RELAXED, __HIP_MEMORY_SCOPE_WORKGROUP);
        old = (unsigned)__builtin_amdgcn_readfirstlane((int)old);
        if ((old & 7u) == 7u) {
            __builtin_amdgcn_fence(__ATOMIC_RELEASE, "agent");
            if (__builtin_amdgcn_mbcnt_hi(~0u, __builtin_amdgcn_mbcnt_lo(~0u, 0u)) == 0u) __hip_atomic_fetch_add(cnt + u.pm, 1u, __ATOMIC_RELAXED, __HIP_MEMORY_SCOPE_AGENT);
        }
    }
    __device__ __forceinline__ void finish(int wid) const {
        if (ndp > 0 && wid == 0) {
            __builtin_amdgcn_fence(__ATOMIC_RELEASE, "agent");
            if (__builtin_amdgcn_mbcnt_hi(~0u, __builtin_amdgcn_mbcnt_lo(~0u, 0u)) == 0u) {
                __hip_atomic_fetch_add(cnt + dp0, 1u, __ATOMIC_RELAXED, __HIP_MEMORY_SCOPE_AGENT);
                if (ndp > 1) __hip_atomic_fetch_add(cnt + dp1, 1u, __ATOMIC_RELAXED, __HIP_MEMORY_SCOPE_AGENT);
                if (ndp > 2) __hip_atomic_fetch_add(cnt + dp2, 1u, __ATOMIC_RELAXED, __HIP_MEMORY_SCOPE_AGENT);
            }
        }
    }
};
struct GroupedOrderDown {
    const volatile PG8_LAS int* toff; int G, vcu, wbase; unsigned* cnt;
    __device__ bool next(int i, Unit& u) const {
        const int n8 = toff[16] * 4, R = n8 / G, rem = n8 - R * G; int q;
        if (vcu < rem) { if (i > 0) return false; q = R * G + vcu; }
        else { q = (vcu - rem) + (G - rem) * i; if (q >= R * G) return false; }
        const int rt = q >> 2, pn = q & 3; int e = 0;
#pragma unroll
        for (int j = 1; j < 16; ++j) e += (rt >= toff[j]) ? 1 : 0;
        u.pm = __builtin_amdgcn_readfirstlane(rt); u.pn = __builtin_amdgcn_readfirstlane(pn); u.bt = __builtin_amdgcn_readfirstlane(wbase + e * 4 + pn); u.ab = __builtin_amdgcn_readfirstlane(e * 64 + rt - toff[e]); return true;
    }
    PG8_LAS unsigned* acq; int wid; mutable unsigned ncall;
    __device__ __forceinline__ void a_ready(const Unit& u) const {
        const unsigned k = ++ncall; unsigned sp = 0;
        if (wid == 0) {
            while ((unsigned)__builtin_amdgcn_readfirstlane((int)__hip_atomic_load(cnt + u.pm, __ATOMIC_RELAXED, __HIP_MEMORY_SCOPE_AGENT)) < 4u) { __builtin_amdgcn_s_sleep(4); if (++sp > (1u << 22)) break; }
            __builtin_amdgcn_fence(__ATOMIC_ACQUIRE, "agent");
            __hip_atomic_store(acq, k, __ATOMIC_RELEASE, __HIP_MEMORY_SCOPE_WORKGROUP);
        } else {
            while ((unsigned)__builtin_amdgcn_readfirstlane((int)__hip_atomic_load(acq, __ATOMIC_ACQUIRE, __HIP_MEMORY_SCOPE_WORKGROUP)) < k) { __builtin_amdgcn_s_sleep(2); if (++sp > (1u << 24)) break; }
        }
        asm volatile("" ::: "memory");
    }
    __device__ __forceinline__ void done(const Unit&) const {}
};

template <class Epi, class Sched, bool GATHER = false, bool FP8 = false>
__device__ __forceinline__ void gemm_phase(PG8_LAS unsigned char* lds, const Gemm g, const Sched& S, const Epi& E, const int tid, const unsigned* amap = nullptr, unsigned amap_max = 0u) {
    const int  wid = __builtin_amdgcn_readfirstlane(tid >> 6), lane = tid & 63, wr = wid >> 2, wc = wid & 3, fr = lane & 15, fq = lane >> 4;
    int Kq_ = g.K; asm volatile("" : "+s"(Kq_));
    const int K = Kq_, nt = K / BK;
    unsigned voffA[2], voffB[2]; int gR[2]; unsigned gC[2];
#pragma unroll
    for (int i = 0; i < 2; ++i) { int R, C; stage_rc(tid * 16 + i * 8192, R, C); const int Rb = Epi::PERM ? ((R & ~31) + perm32(R & 31)) : R;
        voffA[i] = (unsigned)(R * K + C) * 2u; voffB[i] = (unsigned)(Rb * K + C) * 2u; gR[i] = R; gC[i] = (unsigned)C * 2u; }
    unsigned arC[2][2];
    PG8_LAS unsigned* arNp = (PG8_LAS unsigned*)(lds + 147456 + 1024 + tid * 16);
#define PG8_GROWS(dst, pm_) do { _Pragma("unroll") for (int h_ = 0; h_ < 2; ++h_) _Pragma("unroll") for (int i_ = 0; i_ < 2; ++i_) { \
        unsigned tk_ = amap[(size_t)(pm_) * 256 + h_ * 128 + gR[0] + 64 * i_]; tk_ = tk_ < amap_max ? tk_ : amap_max; dst[h_][i_] = tk_ * (unsigned)(K * 2) + gC[0]; } } while (0)
    const size_t kstep = (size_t)(BK * 2);
    const size_t hstep = (size_t)HALF * K * 2;
    const size_t tstep = 2 * hstep;
    const unsigned ldsw = (unsigned)wid * 1024u; const unsigned lds0_ = (unsigned)(uintptr_t)lds;
    const int aoff = lds_byte(wr * 64 + fr, fq * 8), boff = lds_byte(wc * 32 + fr, fq * 8);
#define PG8_SA(b, h) (((b) * 2 + (h)) * HTB)
#define PG8_SB(b, h) ((4 + (b) * 2 + (h)) * HTB)
#define PG8_STAGE(bufoff, gbase, voff) do { const unsigned long long gb_ = (unsigned long long)(uintptr_t)(gbase); \
        const void* sb_ = (const void*)(uintptr_t)(((unsigned long long)(unsigned)__builtin_amdgcn_readfirstlane((int)(gb_ >> 32)) << 32) | (unsigned long long)(unsigned)__builtin_amdgcn_readfirstlane((int)gb_)); \
        _Pragma("unroll") for (int _i = 0; _i < 2; ++_i) \
        glds16(sb_, (voff)[_i], (unsigned)__builtin_amdgcn_readfirstlane((int)(lds0_ + (unsigned)(bufoff) + ldsw + (unsigned)(_i * 8192)))); } while (0)
#define PG8_STAGEA(bufoff, gbase, h, isn) do { if (GATHER) { unsigned vo_[2] = {arC[h][0], arC[h][1]}; if (isn) { vo_[0] = arNp[2 * (h)]; vo_[1] = arNp[2 * (h) + 1]; } PG8_STAGE(bufoff, gbase, vo_); } \
        else { PG8_STAGE(bufoff, (gbase) + (h) * hstep, voffA); } } while (0)
    typedef int pg8_v4i __attribute__((ext_vector_type(4))); typedef int pg8_v8i __attribute__((ext_vector_type(8)));
#define PG8_LDA(dst, b, h) do { _Pragma("unroll") for (int m = 0; m < 4; ++m) { if (FP8) { const pg8_v4i l_ = *(const PG8_LAS pg8_v4i*)(lds + PG8_SA(b, h) + aoff + m * 2048), h_ = *(const PG8_LAS pg8_v4i*)(lds + PG8_SA(b, h) + aoff + m * 2048 + 1024); \
            dst##8[m] = __builtin_shufflevector(l_, h_, 0, 1, 2, 3, 4, 5, 6, 7); } \
        else { _Pragma("unroll") for (int k = 0; k < 2; ++k) dst[m][k] = *(const PG8_LAS bf16x8*)(lds + PG8_SA(b, h) + aoff + m * 2048 + k * 1024); } } } while (0)
#define PG8_LDB(dst, b, h) do { _Pragma("unroll") for (int n = 0; n < 2; ++n) { if (FP8) { const pg8_v4i l_ = *(const PG8_LAS pg8_v4i*)(lds + PG8_SB(b, h) + boff + n * 2048), h_ = *(const PG8_LAS pg8_v4i*)(lds + PG8_SB(b, h) + boff + n * 2048 + 1024); \
            dst##8[n] = __builtin_shufflevector(l_, h_, 0, 1, 2, 3, 4, 5, 6, 7); } \
        else { _Pragma("unroll") for (int k = 0; k < 2; ++k) dst[n][k] = *(const PG8_LAS bf16x8*)(lds + PG8_SB(b, h) + boff + n * 2048 + k * 1024); } } } while (0)
#define PG8_MMA(ai, bj, At, Bt) do { __builtin_amdgcn_s_setprio(1); _Pragma("unroll") for (int m = 0; m < 4; ++m) _Pragma("unroll") for (int n = 0; n < 2; ++n) { \
        if (FP8) { acc[ai][bj][m][n] = __builtin_amdgcn_mfma_scale_f32_16x16x128_f8f6f4(Bt##8[n], At##8[m], acc[ai][bj][m][n], 0, 0, 0, 0x7f7f7f7f, 0, 0x7f7f7f7f); } \
        else { _Pragma("unroll") for (int k = 0; k < 2; ++k) acc[ai][bj][m][n] = __builtin_amdgcn_mfma_f32_16x16x32_bf16(Bt[n][k], At[m][k], acc[ai][bj][m][n], 0, 0, 0); } } \
        if (FP8) asm volatile("" : "+v"(acc[ai][bj][0][0]), "+v"(acc[ai][bj][0][1]), "+v"(acc[ai][bj][1][0]), "+v"(acc[ai][bj][1][1]), "+v"(acc[ai][bj][2][0]), "+v"(acc[ai][bj][2][1]), "+v"(acc[ai][bj][3][0]), "+v"(acc[ai][bj][3][1]));     \
        __builtin_amdgcn_s_setprio(0); } while (0)
#define PG8_WAIT_V(n) asm volatile("s_waitcnt vmcnt(" #n ")" ::: "memory")
#define PG8_WAIT_L(n) asm volatile("s_waitcnt lgkmcnt(" #n ")" ::: "memory")
#define PG8_BAR __builtin_amdgcn_s_barrier()
#define PG8_SCHED __builtin_amdgcn_sched_barrier(0)
    Unit cur, nxt; int ui = 0;
    if (!S.next(0, cur)) return;
    f32x4 acc[2][2][4][2];
#pragma unroll
    for (int a = 0; a < 2; ++a)
#pragma unroll
        for (int b = 0; b < 2; ++b)
#pragma unroll
            for (int m = 0; m < 4; ++m)
#pragma unroll
                for (int n = 0; n < 2; ++n) acc[a][b][m][n] = (f32x4){0.f, 0.f, 0.f, 0.f};
    bf16x8 At[4][2], B0[2][2], B1[2][2]; pg8_v8i At8[4], B08[2], B18[2];
    const char* cA = (const char*)g.A + (GATHER ? (size_t)0 : (size_t)cur.pm * tstep); const char* cB = (const char*)g.Bt + (size_t)cur.bt * tstep;
    S.a_ready(cur);
    if (GATHER) { PG8_GROWS(arC, cur.ab); }
    PG8_STAGE(PG8_SB(0, 0), cB, voffB); PG8_STAGE(PG8_SB(0, 1), cB + hstep, voffB); PG8_STAGEA(PG8_SA(0, 0), cA, 0, false); PG8_STAGEA(PG8_SA(0, 1), cA, 1, false);
    if (wr == 1) PG8_BAR;
    PG8_WAIT_V(2); PG8_BAR;
    PG8_STAGE(PG8_SB(1, 0), cB + kstep, voffB); PG8_STAGEA(PG8_SA(1, 0), cA + kstep, 0, false); PG8_STAGE(PG8_SB(1, 1), cB + hstep + kstep, voffB);
    PG8_WAIT_V(6); PG8_BAR;
    for (;;) {
        const bool has_next = S.next(ui + 1, nxt);
        const char* nA = (has_next && !GATHER) ? (const char*)g.A + (size_t)nxt.pm * tstep : cA; const char* nB = has_next ? (const char*)g.Bt + (size_t)nxt.bt * tstep : cB;
        if (GATHER && has_next) { unsigned tn_[2][2]; PG8_GROWS(tn_, nxt.ab); arNp[0] = tn_[0][0]; arNp[1] = tn_[0][1]; arNp[2] = tn_[1][0]; arNp[3] = tn_[1][1]; }
#pragma unroll 1
        for (int t = 0; t < nt; t += 2) {
            const bool last = (t == nt - 2);
            const char* a1 = cA + (size_t)(t + 1) * kstep;
            const char* a2 = last ? nA : cA + (size_t)(t + 2) * kstep; const char* b2 = last ? nB : cB + (size_t)(t + 2) * kstep;
            const char* a3 = a2 + kstep; const char* b3 = b2 + kstep;
            const bool isn = last && has_next;
            if (isn) S.a_ready(nxt);
            PG8_LDB(B0, 0, 0); PG8_LDB(B1, 0, 1); PG8_SCHED; PG8_LDA(At, 0, 0); PG8_STAGEA(PG8_SA(1, 1), a1, 1, false);
            PG8_WAIT_V(8); PG8_WAIT_L(0); PG8_BAR; PG8_MMA(0, 0, At, B0); PG8_MMA(0, 1, At, B1); PG8_BAR; PG8_SCHED;
            PG8_LDA(At, 0, 1); PG8_STAGE(PG8_SB(0, 0), b2, voffB); PG8_STAGE(PG8_SB(0, 1), b2 + hstep, voffB); PG8_STAGEA(PG8_SA(0, 0), a2, 0, isn);
            PG8_WAIT_V(8); PG8_WAIT_L(0); PG8_BAR; PG8_MMA(1, 0, At, B0); PG8_MMA(1, 1, At, B1); PG8_BAR; PG8_SCHED;
            PG8_LDB(B0, 1, 0); PG8_LDB(B1, 1, 1); PG8_SCHED; PG8_LDA(At, 1, 0); PG8_STAGEA(PG8_SA(0, 1), a2, 1, isn);
            PG8_WAIT_V(8); PG8_WAIT_L(0); PG8_BAR; PG8_MMA(0, 0, At, B0); PG8_MMA(0, 1, At, B1); PG8_BAR; PG8_SCHED;
            PG8_LDA(At, 1, 1); PG8_STAGE(PG8_SB(1, 0), b3, voffB); PG8_STAGE(PG8_SB(1, 1), b3 + hstep, voffB); PG8_STAGEA(PG8_SA(1, 0), a3, 0, isn);
            PG8_WAIT_V(8); PG8_WAIT_L(0); PG8_BAR; PG8_MMA(1, 0, At, B0); PG8_MMA(1, 1, At, B1); PG8_BAR; PG8_SCHED;
        }
        if (wr == 0) PG8_BAR;
        { unsigned z_ = 0u; asm volatile("" : "+s"(z_)); const int ln2 = (int)__builtin_amdgcn_mbcnt_hi(~0u, __builtin_amdgcn_mbcnt_lo(~0u, z_));
          E(acc, cur, wr, wc, ln2 & 15, ln2 >> 4); }
        S.done(cur);
        if (!has_next) break;
#pragma unroll
        for (int a = 0; a < 2; ++a)
#pragma unroll
            for (int b = 0; b < 2; ++b)
#pragma unroll
                for (int m = 0; m < 4; ++m)
#pragma unroll
                    for (int n = 0; n < 2; ++n) acc[a][b][m][n] = (f32x4){0.f, 0.f, 0.f, 0.f};
        cur = nxt; cA = nA; cB = nB; ++ui;
        if (GATHER) { arC[0][0] = arNp[0]; arC[0][1] = arNp[1]; arC[1][0] = arNp[2]; arC[1][1] = arNp[3]; }
        if (wr == 1) PG8_BAR;
    }
    PG8_WAIT_V(0);
    PG8_BAR;
#undef PG8_SA
#undef PG8_SB
#undef PG8_STAGE
#undef PG8_STAGEA
#undef PG8_GROWS
#undef PG8_LDA
#undef PG8_LDB
#undef PG8_MMA
#undef PG8_WAIT_V
#undef PG8_WAIT_L
#undef PG8_BAR
#undef PG8_SCHED
}
}

template <bool F8> struct EpiProj {
    static constexpr bool PERM = true;
    bf16_t* O; bf16_t* LR; const float* gq; const float* gk; const float* cosT; const float* sinT; float* kpart;
    __device__ __forceinline__ void operator()(const f32x4 (&acc)[2][2][4][2], const pg8::Unit& u, int wr, int wc, int fr, int fq) const {
        const int row0 = u.pm * 256 + wr * 64 + fr;
        constexpr float SC = F8 ? 0.03125f : 1.0f;
        if (F8 && u.pn >= 3 && u.pn <= 6) {
            const bool isk = u.pn >= 5; const int hh = 4 * ((u.pn - 3) & 1) + wc;
            const float* g = isk ? gk : gq;
            float gg[2][8];
#pragma unroll
            for (int bj = 0; bj < 2; ++bj)
#pragma unroll
                for (int e = 0; e < 8; ++e) gg[bj][e] = g[32 * bj + 8 * fq + e];
            float ks[2][8];
#pragma unroll
            for (int bj = 0; bj < 2; ++bj)
#pragma unroll
                for (int e = 0; e < 8; ++e) ks[bj][e] = 0.f;
            bf16_t* obase = O + (isk ? C_BK : C_BQ) + 64 * hh + 8 * fq;
#pragma unroll
            for (int ai = 0; ai < 2; ++ai)
#pragma unroll
                for (int m = 0; m < 4; ++m) {
                    const int row = row0 + ai * 128 + m * 16; const int pos = row & (SEQ - 1);
                    float v[2][8]; float ss = 0.f;
#pragma unroll
                    for (int bj = 0; bj < 2; ++bj)
#pragma unroll
                        for (int n = 0; n < 2; ++n)
#pragma unroll
                            for (int j = 0; j < 4; ++j) { const float x = acc[ai][bj][m][n][j] * SC; v[bj][4 * n + j] = x; ss += x * x; }
                    ss += __shfl_xor(ss, 16); ss += __shfl_xor(ss, 32);
                    const float rstd = rsqrtf(ss * (1.f / 64.f) + EPS);
#pragma unroll
                    for (int bj = 0; bj < 2; ++bj)
#pragma unroll
                        for (int e = 0; e < 8; ++e) v[bj][e] = v[bj][e] * rstd * gg[bj][e];
                    { const f32x4 c0 = *(const f32x4*)(cosT + pos * 8), c1 = *(const f32x4*)(cosT + pos * 8 + 4), s0 = *(const f32x4*)(sinT + pos * 8), s1 = *(const f32x4*)(sinT + pos * 8 + 4);
                      const float cs[8] = {c0.x, c0.y, c0.z, c0.w, c1.x, c1.y, c1.z, c1.w}, sn[8] = {s0.x, s0.y, s0.z, s0.w, s1.x, s1.y, s1.z, s1.w};
#pragma unroll
                      for (int e = 0; e < 8; ++e) { const float other = __shfl_xor(v[0][e], 16);
                          if (fq == 0) v[0][e] = v[0][e] * cs[e] - other * sn[e]; else if (fq == 1) v[0][e] = v[0][e] * cs[e] + other * sn[e]; } }
                    if (isk) {
#pragma unroll
                        for (int bj = 0; bj < 2; ++bj)
#pragma unroll
                            for (int e = 0; e < 8; ++e) ks[bj][e] += v[bj][e];
                    } else {
#pragma unroll
                        for (int bj = 0; bj < 2; ++bj)
#pragma unroll
                            for (int e = 0; e < 8; ++e) v[bj][e] *= (0.125f * LOG2E);
                    }
#pragma unroll
                    for (int bj = 0; bj < 2; ++bj) { u32x4 w; w.x = cvtpk(v[bj][0], v[bj][1]); w.y = cvtpk(v[bj][2], v[bj][3]); w.z = cvtpk(v[bj][4], v[bj][5]); w.w = cvtpk(v[bj][6], v[bj][7]);
                        *(u32x4*)(obase + (size_t)row * PP + 32 * bj) = w; }
                }
            if (isk) {
#pragma unroll
                for (int bj = 0; bj < 2; ++bj)
#pragma unroll
                    for (int e = 0; e < 8; ++e) { float s = ks[bj][e]; s += __shfl_xor(s, 1); s += __shfl_xor(s, 2); s += __shfl_xor(s, 4); s += __shfl_xor(s, 8); ks[bj][e] = s; }
                if (fr == 0) { float* kp = kpart + ((size_t)u.pm * 2 + wr) * 512 + 64 * hh + 8 * fq;
#pragma unroll
                    for (int bj = 0; bj < 2; ++bj) { *(f32x4*)(kp + 32 * bj) = (f32x4){ks[bj][0], ks[bj][1], ks[bj][2], ks[bj][3]}; *(f32x4*)(kp + 32 * bj + 4) = (f32x4){ks[bj][4], ks[bj][5], ks[bj][6], ks[bj][7]}; } }
            }
        } else if (u.pn < 13) {
            const int col0 = u.pn * 256 + wc * 32 + 8 * fq;
#pragma unroll
            for (int ai = 0; ai < 2; ++ai)
#pragma unroll
                for (int m = 0; m < 4; ++m) { bf16_t* rowp = O + (size_t)(row0 + ai * 128 + m * 16) * PP + col0;
#pragma unroll
                    for (int bj = 0; bj < 2; ++bj) { const f32x4 v0 = acc[ai][bj][m][0] * SC, v1 = acc[ai][bj][m][1] * SC;
                        u32x4 w; w.x = cvtpk(v0[0], v0[1]); w.y = cvtpk(v0[2], v0[3]); w.z = cvtpk(v1[0], v1[1]); w.w = cvtpk(v1[2], v1[3]);
                        *(u32x4*)(rowp + bj * 128) = w; } }
        } else if (F8 && wc == 0 && fq < 2) {
#pragma unroll
            for (int ai = 0; ai < 2; ++ai)
#pragma unroll
                for (int m = 0; m < 4; ++m) { const f32x4 v0 = acc[ai][0][m][0] * SC, v1 = acc[ai][0][m][1] * SC;
                    u32x4 w; w.x = cvtpk(v0[0], v0[1]); w.y = cvtpk(v0[2], v0[3]); w.z = cvtpk(v1[0], v1[1]); w.w = cvtpk(v1[2], v1[3]);
                    *(u32x4*)(LR + (size_t)(row0 + ai * 128 + m * 16) * 16 + 8 * fq) = w; }
        }
    }
};
struct EpiResid {
    static constexpr bool PERM = false;
    const float* base; bf16_t* out; const bf16_t* base16;
    __device__ __forceinline__ void operator()(const f32x4 (&acc)[2][2][4][2], const pg8::Unit& u, int wr, int wc, int fr, int fq) const {
        const int row0 = u.pm * 256 + wr * 64 + fr, col0 = u.pn * 256 + wc * 32 + 4 * fq;
#pragma unroll
        for (int ai = 0; ai < 2; ++ai)
#pragma unroll
            for (int m = 0; m < 4; ++m) { const size_t off = (size_t)(row0 + ai * 128 + m * 16) * DM + col0;
#pragma unroll
                for (int bj = 0; bj < 2; ++bj)
#pragma unroll
                    for (int n = 0; n < 2; ++n) { f32x4 bs;
                        if (base16) { const u32x2 bw = *(const u32x2*)(base16 + off + bj * 128 + n * 16); bs = (f32x4){bflo(bw.x), bfhi(bw.x), bflo(bw.y), bfhi(bw.y)}; }
                        else bs = *(const f32x4*)(base + off + bj * 128 + n * 16);
                        const f32x4 r = bs + acc[ai][bj][m][n];
                        u32x2 w; w.x = cvtpk(r.x, r.y); w.y = cvtpk(r.z, r.w); *(u32x2*)(out + off + bj * 128 + n * 16) = w; } }
    }
};
struct EpiSwiglu {
    static constexpr bool PERM = true;
    bf16_t* H;
    __device__ __forceinline__ void operator()(const f32x4 (&acc)[2][2][4][2], const pg8::Unit& u, int wr, int wc, int fr, int fq) const {
        const int row0 = u.pm * 256 + wr * 64 + fr, col0 = u.pn * 128 + wc * 32 + 8 * fq;
#pragma unroll
        for (int ai = 0; ai < 2; ++ai)
#pragma unroll
            for (int m = 0; m < 4; ++m) { float o[8];
#pragma unroll
                for (int n = 0; n < 2; ++n)
#pragma unroll
                    for (int j = 0; j < 4; ++j) { const float gt = acc[ai][0][m][n][j] * 0.03125f, up = acc[ai][1][m][n][j] * 0.03125f; o[n * 4 + j] = gt * sigmoidf_(gt) * up; }
                int p0 = 0, p1 = 0;
                p0 = __builtin_amdgcn_cvt_pk_fp8_f32(o[0], o[1], p0, false); p0 = __builtin_amdgcn_cvt_pk_fp8_f32(o[2], o[3], p0, true);
                p1 = __builtin_amdgcn_cvt_pk_fp8_f32(o[4], o[5], p1, false); p1 = __builtin_amdgcn_cvt_pk_fp8_f32(o[6], o[7], p1, true);
                *(u32x2*)((unsigned char*)H + (size_t)(row0 + ai * 128 + m * 16) * FF + col0) = (u32x2){(unsigned)p0, (unsigned)p1}; }
    }
};
struct EpiDown {
    static constexpr bool PERM = true;
    bf16_t* Y; const float* slotw;
    __device__ __forceinline__ void operator()(const f32x4 (&acc)[2][2][4][2], const pg8::Unit& u, int wr, int wc, int fr, int fq) const {
        const int row0 = u.pm * 256 + wr * 64 + fr, col0 = u.pn * 256 + wc * 32 + 8 * fq;
#pragma unroll
        for (int ai = 0; ai < 2; ++ai)
#pragma unroll
            for (int m = 0; m < 4; ++m) { const int row = row0 + ai * 128 + m * 16; const float sw = slotw[u.ab * 256 + (row - u.pm * 256)] * 0.03125f; bf16_t* rowp = Y + (size_t)row * DM + col0;
#pragma unroll
                for (int bj = 0; bj < 2; ++bj) { const f32x4 v0 = acc[ai][bj][m][0] * sw, v1 = acc[ai][bj][m][1] * sw;
                    u32x4 w; w.x = cvtpk(v0[0], v0[1]); w.y = cvtpk(v0[2], v0[3]); w.z = cvtpk(v1[0], v1[1]); w.w = cvtpk(v1[2], v1[3]);
                    *(u32x4*)(rowp + bj * 128) = w; } }
    }
};

struct Args { const float* in[17]; float* out; unsigned char* ws; int ph_lo, ph_hi; };
static_assert(offsetof(Args, out) == 136 && offsetof(Args, ws) == 144 && sizeof(Args) == 160, "kernarg layout");
struct Ctx {
    LAS unsigned char* lds; const __attribute__((address_space(4))) unsigned char* ka;
    int wave, G, vcu, gw, NGW, bx;
    __device__ __forceinline__ int lane() const { unsigned z_ = 0u; asm volatile("" : "+s"(z_)); return (int)__builtin_amdgcn_mbcnt_hi(~0u, __builtin_amdgcn_mbcnt_lo(~0u, z_)); }
    __device__ __forceinline__ int tid() const { return wave * 64 + lane(); }
#define CTX_IN(name, idx) __device__ __forceinline__ const float* name() const { return *(const float* const __attribute__((address_space(4)))*)(ka + 8 * (idx)); }
    CTX_IN(x, 0) CTX_IN(attn_g, 1) CTX_IN(w_in, 2) CTX_IN(gk_w2, 3) CTX_IN(gk_b, 4) CTX_IN(gla_g, 5) CTX_IN(qn_g, 6) CTX_IN(kn_g, 7) CTX_IN(lb_param, 8) CTX_IN(hgrn_g, 9)
    CTX_IN(w_out, 10) CTX_IN(ffn_g, 11) CTX_IN(w_rg, 12) CTX_IN(w_re, 13) CTX_IN(w_eg, 14) CTX_IN(w_eu, 15) CTX_IN(w_ed, 16)
#define CTX_WS(type, name, off) __device__ __forceinline__ type* name() const { return (type*)(*(unsigned char* const __attribute__((address_space(4)))*)(ka + 144) + (off)); }
    __device__ __forceinline__ float* out() const { return *(float* const __attribute__((address_space(4)))*)(ka + 136); }
    CTX_WS(unsigned, ctl, WS_CTL) CTX_WS(float, cosT, SM_COS) CTX_WS(float, sinT, SM_SIN) CTX_WS(bf16_t, lr, SM_LR) CTX_WS(float, kpart, SM_KPART) CTX_WS(float, decay, SM_DECAY)
    CTX_WS(unsigned, route, SM_ROUTE) CTX_WS(float, slotw, WS_SLOTW2) CTX_WS(bf16_t, x1b, WS_X1B) CTX_WS(unsigned, amap, WS_AMAP2) CTX_WS(bf16_t, win, WS_WIN) CTX_WS(bf16_t, wout, WS_WOUT) CTX_WS(bf16_t, wgu, WS_WGU) CTX_WS(bf16_t, wd, WS_WD) CTX_WS(unsigned char, h8, WS_H8)
    CTX_WS(bf16_t, proj, WS_PROJ) CTX_WS(bf16_t, st, WS_ST) CTX_WS(bf16_t, ab, WS_AB) CTX_WS(float, kvt, WS_AB) CTX_WS(bf16_t, aperm, WS_APERM) CTX_WS(bf16_t, hbuf, WS_H)
};

struct TrDesc { const float* W; bf16_t* WT; int ldw, col0, k0, K, drow0, nvalid, fp8; };
__device__ __forceinline__ void tr_load(const TrDesc& d, float (&tmp)[32], int lane) {
#pragma unroll
    for (int i = 0; i < 32; ++i) { const int kk = 2 * i + (lane >> 5); tmp[i] = d.W[(size_t)(d.k0 + kk) * d.ldw + d.col0 + (lane & 31)]; }
}
__device__ __forceinline__ void tr_finish(const TrDesc& d, const float (&tmp)[32], LAS float* scr, int lane) {
#pragma unroll
    for (int i = 0; i < 32; ++i) { const int kk = 2 * i + (lane >> 5); scr[kk * 33 + (lane & 31)] = tmp[i]; }
    asm volatile("s_waitcnt lgkmcnt(0)" ::: "memory");
    const int c = lane & 7;
    if (d.fp8) {
#pragma unroll
        for (int j = 0; j < 4; ++j) { const int n = (lane >> 3) + 8 * j; const LAS float* s = scr + (8 * c) * 33 + n;
            int p0 = 0, p1 = 0;
            p0 = __builtin_amdgcn_cvt_pk_fp8_f32(s[0 * 33] * 32.f, s[1 * 33] * 32.f, p0, false); p0 = __builtin_amdgcn_cvt_pk_fp8_f32(s[2 * 33] * 32.f, s[3 * 33] * 32.f, p0, true);
            p1 = __builtin_amdgcn_cvt_pk_fp8_f32(s[4 * 33] * 32.f, s[5 * 33] * 32.f, p1, false); p1 = __builtin_amdgcn_cvt_pk_fp8_f32(s[6 * 33] * 32.f, s[7 * 33] * 32.f, p1, true);
            if (n < d.nvalid) *(u32x2*)((unsigned char*)d.WT + (size_t)(d.drow0 + n) * d.K + d.k0 + 8 * c) = (u32x2){(unsigned)p0, (unsigned)p1}; }
    } else {
#pragma unroll
    for (int j = 0; j < 4; ++j) { const int n = (lane >> 3) + 8 * j; const LAS float* s = scr + (8 * c) * 33 + n;
        u32x4 o; o.x = cvtpk(s[0 * 33], s[1 * 33]); o.y = cvtpk(s[2 * 33], s[3 * 33]); o.z = cvtpk(s[4 * 33], s[5 * 33]); o.w = cvtpk(s[6 * 33], s[7 * 33]);
        if (n < d.nvalid) *(u32x4*)(d.WT + (size_t)(d.drow0 + n) * d.K + d.k0 + 8 * c) = o; }
    }
    asm volatile("s_waitcnt lgkmcnt(0)" ::: "memory");
}
constexpr int WC_PER_LAYER = 1664 + 16 + 512 + 16 * 768;
__device__ __forceinline__ TrDesc wconv_decode(const Ctx& X, int it) {
    const int l = it / WC_PER_LAYER; int r = it % WC_PER_LAYER;
    if (r < 1664) { const int kb = r / 104, nb = r % 104; const int col0 = nb < 24 ? 32 * nb : 784 + 32 * (nb - 24); int drow = nb < 24 ? 32 * nb : 768 + 32 * (nb - 24);
        if (drow >= C_BQ && drow < C_BV) {
            const int rel = drow - C_BQ, sec = rel >> 9, hh = (rel & 511) >> 6, dh = (rel & 63) >> 5;
            drow = C_BQ + sec * 512 + 256 * (hh >> 2) + 128 * dh + 32 * (hh & 3); }
        if (drow >= C_BQ && drow < C_CQ) return TrDesc{X.w_in() + (size_t)l * DM * IN_COLS, (bf16_t*)((unsigned char*)(X.win() + (size_t)l * NW_IN * DM) + (size_t)C_BQ * DM * 2), IN_COLS, col0, 64 * kb, DM, drow - C_BQ, 32, 1};
        if (drow >= C_AG && drow < C_BQ) return TrDesc{X.w_in() + (size_t)l * DM * IN_COLS, (bf16_t*)((unsigned char*)(X.win() + (size_t)l * NW_IN * DM) + (size_t)C_BQ * DM * 2), IN_COLS, col0, 64 * kb, DM, 1792 + drow - C_AG, 32, 1};
        return TrDesc{X.w_in() + (size_t)l * DM * IN_COLS, X.win() + (size_t)l * NW_IN * DM, IN_COLS, col0, 64 * kb, DM, drow, 32, 0}; }
    r -= 1664;
    if (r < 16) return TrDesc{X.w_in() + (size_t)l * DM * IN_COLS, (bf16_t*)((unsigned char*)(X.win() + (size_t)l * NW_IN * DM) + (size_t)C_BQ * DM * 2), IN_COLS, 768, 64 * r, DM, 1536, 16, 1};
    r -= 16;
    if (r < 512) { const int kb = r / 32, nb = r % 32; return TrDesc{X.w_out() + (size_t)l * DM * DM, X.wout() + (size_t)l * DM * DM, DM, 32 * nb, 64 * kb, DM, 32 * nb, 32, 0}; }
    r -= 512;
    const int e = r / 768, q = r % 768; const size_t le = (size_t)l * NEXP + e;
    if (q < 512) { const int up = q >= 256, qq = q & 255, kb = qq / 16, nb = qq % 16, col0 = 32 * nb;
        return TrDesc{(up ? X.w_eu() : X.w_eg()) + le * DM * FF, (bf16_t*)((unsigned char*)X.wgu() + le * DM * DM), FF, col0, 64 * kb, DM, 256 * (col0 / 128) + (col0 % 128) + (up ? 128 : 0), 32, 1}; }
    const int qq = q - 512, kb = qq / 32, nb = qq % 32;
    return TrDesc{X.w_ed() + le * FF * DM, (bf16_t*)((unsigned char*)X.wd() + le * DM * FF), DM, 32 * nb, 64 * kb, FF, 32 * nb, 32, 1};
}

__device__ __forceinline__ void row_load(const float* xrow, int lane, f32x4 (&v)[4]) {
    const f32x4* xr = (const f32x4*)xrow + lane;
#pragma unroll
    for (int j = 0; j < 4; ++j) v[j] = xr[64 * j];
}
__device__ __forceinline__ void row_load_bf16(const bf16_t* xrow, int lane, f32x4 (&v)[4]) {
    const u32x2* xr = (const u32x2*)xrow + lane;
#pragma unroll
    for (int j = 0; j < 4; ++j) { const u32x2 w = xr[64 * j]; v[j] = (f32x4){bflo(w.x), bfhi(w.x), bflo(w.y), bfhi(w.y)}; }
}
__device__ __forceinline__ void row_norm_store(f32x4 (&v)[4], const float* g, bf16_t* orow, unsigned char* orow8, int lane) {
    float s = 0.f;
#pragma unroll
    for (int j = 0; j < 4; ++j) s += (v[j].x * v[j].x + v[j].y * v[j].y) + (v[j].z * v[j].z + v[j].w * v[j].w);
    const float rstd = rsqrtf(wave_sum(s) * (1.f / DM) + EPS);
    const f32x4* gr = (const f32x4*)g + lane; u32x2* o8 = (u32x2*)orow + lane;
#pragma unroll
    for (int j = 0; j < 4; ++j) { const f32x4 gg = gr[64 * j]; v[j] = v[j] * rstd * gg; u32x2 w; w.x = cvtpk(v[j].x, v[j].y); w.y = cvtpk(v[j].z, v[j].w); o8[64 * j] = w;
        int p = 0; p = __builtin_amdgcn_cvt_pk_fp8_f32(v[j].x, v[j].y, p, false); p = __builtin_amdgcn_cvt_pk_fp8_f32(v[j].z, v[j].w, p, true); ((unsigned*)orow8)[64 * j + lane] = (unsigned)p; }
}

__device__ __forceinline__ void phase0(const Ctx& X) {
    LAS float* scr = (LAS float*)(X.lds + X.wave * 16384);
    {
        constexpr int NIT = DEPTH * WC_PER_LAYER; int it = X.gw; float cur[32], nxt[32]; TrDesc d, dn;
        if (it < NIT) { d = wconv_decode(X, it); tr_load(d, cur, X.lane()); }
        while (it < NIT) { const int nit = it + X.NGW; dn = d;
            if (nit < NIT) { dn = wconv_decode(X, nit); tr_load(dn, nxt, X.lane()); }
            __builtin_amdgcn_sched_barrier(0);
            tr_finish(d, cur, scr, X.lane());
#pragma unroll
            for (int i = 0; i < 32; ++i) cur[i] = nxt[i];
            d = dn; it = nit; }
    }
    { const int gt = X.gw * 64 + X.lane(), NT = X.NGW * 64;
      for (int i = gt; i < SEQ * 8; i += NT) { const int pos = i >> 3, f = i & 7;
          const float inv = exp2f(-(float)f * 0.125f * 18.931568569324174f);
          const float ang = (float)pos * inv;
          const double a = (double)ang; const double kx = __builtin_rint(a * 0.15915494309189535); const float red = (float)(a - kx * 6.283185307179586);
          X.cosT()[i] = __cosf(red); X.sinT()[i] = __sinf(red); } }
}
__device__ __forceinline__ void phase0b(const Ctx& X) {
    if (X.bx == 0) { for (int i = X.tid(); i < CW_BAR + 3456; i += 512) __hip_atomic_store(X.ctl() + i, 0u, __ATOMIC_RELAXED, __HIP_MEMORY_SCOPE_AGENT);
        if (X.tid() < 8 * DEPTH) __hip_atomic_store(X.ctl() + ecnt_idx(X.tid() >> 3, (X.tid() >> 1) & 3) + (X.tid() & 1), 0u, __ATOMIC_RELAXED, __HIP_MEMORY_SCOPE_AGENT); }
    {
        int m = X.gw; f32x4 cur[4], nxt[4];
        if (m < NTOK) row_load(X.x() + (size_t)m * DM, X.lane(), cur);
        for (; m < NTOK; m += X.NGW) { const int mn = m + X.NGW;
            if (mn < NTOK) row_load(X.x() + (size_t)mn * DM, X.lane(), nxt);
            row_norm_store(cur, X.attn_g(), X.ab() + (size_t)m * DM, X.h8() + (size_t)m * DM, X.lane());
#pragma unroll
            for (int j = 0; j < 4; ++j) cur[j] = nxt[j]; }
    }
}

__device__ __forceinline__ void moba_prep_item(const Ctx& X, int layer, int item) {
    const int part = item & 3, bb = item >> 2; const int lane = X.lane(), w = X.wave;
    const int tok0 = (bb >> 4) * SEQ + (bb & 15) * 256 + part * 64 + w * 8;
    const int sub = lane & 7;
    float gq[8], gk[8], ks[8];
#pragma unroll
    for (int j = 0; j < 8; ++j) { gq[j] = X.qn_g()[layer * 64 + sub * 8 + j]; gk[j] = X.kn_g()[layer * 64 + sub * 8 + j]; ks[j] = 0.f; }
    for (int t = 0; t < 8; ++t) {
        const int tok = tok0 + t, pos = tok & (SEQ - 1);
        float cs[8], sn[8];
#pragma unroll
        for (int j = 0; j < 8; ++j) { cs[j] = X.cosT()[pos * 8 + j]; sn[j] = X.sinT()[pos * 8 + j]; }
#pragma unroll
        for (int which = 0; which < 2; ++which) {
            bf16_t* p = X.proj() + (size_t)tok * PP + (which ? C_BK : C_BQ) + lane * 8;
            const u32x4 raw = *(const u32x4*)p; float v[8];
            v[0] = bflo(raw.x); v[1] = bfhi(raw.x); v[2] = bflo(raw.y); v[3] = bfhi(raw.y); v[4] = bflo(raw.z); v[5] = bfhi(raw.z); v[6] = bflo(raw.w); v[7] = bfhi(raw.w);
            float ss = 0.f;
#pragma unroll
            for (int j = 0; j < 8; ++j) ss += v[j] * v[j];
            ss += __shfl_xor(ss, 1); ss += __shfl_xor(ss, 2); ss += __shfl_xor(ss, 4);
            const float rstd = rsqrtf(ss * (1.f / 64.f) + EPS);
#pragma unroll
            for (int j = 0; j < 8; ++j) v[j] = v[j] * rstd * (which ? gk[j] : gq[j]);
#pragma unroll
            for (int j = 0; j < 8; ++j) { const float other = __shfl_xor(v[j], 1);
                if (sub == 0) v[j] = v[j] * cs[j] - other * sn[j]; else if (sub == 1) v[j] = v[j] * cs[j] + other * sn[j]; }
            if (which) {
#pragma unroll
                for (int j = 0; j < 8; ++j) ks[j] += v[j];
            } else {
#pragma unroll
                for (int j = 0; j < 8; ++j) v[j] *= (0.125f * LOG2E);
            }
            u32x4 o; o.x = cvtpk(v[0], v[1]); o.y = cvtpk(v[2], v[3]); o.z = cvtpk(v[4], v[5]); o.w = cvtpk(v[6], v[7]);
            *(u32x4*)p = o;
        }
    }
    LAS float* red = (LAS float*)X.lds;
#pragma unroll
    for (int j = 0; j < 8; ++j) red[w * 512 + lane * 8 + j] = ks[j];
    __syncthreads();
    { const int c = X.tid(); float s = 0.f;
#pragma unroll
      for (int ww = 0; ww < 8; ++ww) s += red[ww * 512 + c];
      X.kpart()[(size_t)item * 512 + c] = s; }
    __syncthreads();
}

template <int W> __device__ __forceinline__ void tile_load(const bf16_t* src, u32x4 (&r)[W / 8], int lane) {
    constexpr int LPR = W / 8, RPI = 64 / LPR;
#pragma unroll
    for (int i = 0; i < W / 8; ++i) r[i] = *(const u32x4*)(src + (size_t)(RPI * i + lane / LPR) * PP + (lane % LPR) * 8);
}
template <int W> __device__ __forceinline__ void tile_store(LAS unsigned char* reg, const u32x4 (&r)[W / 8], int lane) {
    constexpr int LPR = W / 8, RPI = 64 / LPR;
#pragma unroll
    for (int i = 0; i < W / 8; ++i) *(LAS u32x4*)(reg + (RPI * i + lane / LPR) * 144 + (lane % LPR) * 16) = r[i];
}
template <bool GLA, bool PHC>
__device__ __forceinline__ void lin_item(const Ctx& X, int layer, int b, int c, int h, LAS unsigned char* wl) {
    const int lane = X.lane(), r32 = lane & 31, hi = lane >> 5;
    const size_t row0 = (size_t)b * SEQ + (size_t)c * 64;
    const bf16_t* P = X.proj();
    constexpr int WK = GLA ? 32 : 64;
    const int fl = GLA ? (lane & 31) : lane;
    const int qcol0 = GLA ? (C_AQ + 32 * h) : (C_CQ + 64 * h);
    const int kcol0 = GLA ? (C_AK + 32 * h) : (C_CF + 64 * h);
    const int vcol0 = GLA ? (C_AV + 64 * h) : (C_CI + 64 * h);
    const float fv = (GLA && lane >= 32) ? 0.f : 1.f;
    LAS unsigned char* R0 = wl; LAS unsigned char* R1 = wl + 9216;
    u32x4 tv[8], tk[WK / 8], tq[WK / 8]; u32x4 lr0 = {}, lr1 = {};
    tile_load<64>(P + row0 * PP + vcol0, tv, lane);
    tile_load<WK>(P + row0 * PP + kcol0, tk, lane);
    if (PHC) tile_load<WK>(P + row0 * PP + qcol0, tq, lane);
    if (GLA) { lr0 = *(const u32x4*)(X.lr() + (row0 + lane) * 16); lr1 = *(const u32x4*)(X.lr() + (row0 + lane) * 16 + 8); }
    float w2[16]; float bias = 0.f, lb = 0.f;
    if (GLA) {
#pragma unroll
        for (int r = 0; r < 16; ++r) w2[r] = X.gk_w2()[(size_t)layer * 16 * 128 + r * 128 + 32 * h + fl];
        bias = X.gk_b()[layer * 128 + 32 * h + fl];
    } else {
#pragma unroll
        for (int r = 0; r < 16; ++r) w2[r] = 0.f;
        if (layer > 0) lb = sigmoidf_(X.lb_param()[256 + 64 * h + fl] - X.lb_param()[64 * h + fl]);
    }
    const int h8 = GLA ? h : 4 + h;
    const size_t sbase = (((size_t)b * 64 + c) * 8 + h8) * 4096;
    unsigned pvall[32];
    bf16x8 s0f[2][4];
    if (PHC) {
#pragma unroll
        for (int vi = 0; vi < 2; ++vi)
#pragma unroll
            for (int ks = 0; ks < 4; ++ks) s0f[vi][ks] = *(const bf16x8*)(X.st() + sbase + (size_t)(32 * vi + r32) * 64 + 16 * ks + 8 * hi);
        tile_store<64>(R0, tv, lane);
#pragma unroll
        for (int m = 0; m < 32; ++m) { const unsigned v0 = *(const LAS bf16_t*)(R0 + (2 * m) * 144 + lane * 2), v1 = *(const LAS bf16_t*)(R0 + (2 * m + 1) * 144 + lane * 2); pvall[m] = v0 | (v1 << 16); }
        asm volatile("s_waitcnt lgkmcnt(0)" ::: "memory");
        tile_store<WK>(R0, tq, lane); tile_store<WK>(R1, tk, lane);
    } else {
        tile_store<64>(R0, tv, lane); tile_store<WK>(R1, tk, lane);
    }
    float bsum = 0.f, eprod = 1.f;
    f32x16 g00 = {}, g01 = {}, g10 = {}, g11 = {};
    for (int s = 0; s < 4; ++s) {
        float kt[16], qt[16];
#pragma unroll
        for (int t = 0; t < 16; ++t) {
            const int tt = 16 * s + t;
            const float rawk = bf2f(*(const LAS bf16_t*)(R1 + tt * 144 + fl * 2));
            float qv = 0.f; if (PHC) qv = bf2f(*(const LAS bf16_t*)(R0 + tt * 144 + fl * 2));
            float a, kk;
            if (GLA) {
                float z = bias;
                { const unsigned u0 = (unsigned)__builtin_amdgcn_readlane((int)lr0.x, tt), u1 = (unsigned)__builtin_amdgcn_readlane((int)lr0.y, tt), u2 = (unsigned)__builtin_amdgcn_readlane((int)lr0.z, tt), u3 = (unsigned)__builtin_amdgcn_readlane((int)lr0.w, tt);
                  z += bflo(u0) * w2[0] + bfhi(u0) * w2[1] + bflo(u1) * w2[2] + bfhi(u1) * w2[3] + bflo(u2) * w2[4] + bfhi(u2) * w2[5] + bflo(u3) * w2[6] + bfhi(u3) * w2[7]; }
                { const unsigned u0 = (unsigned)__builtin_amdgcn_readlane((int)lr1.x, tt), u1 = (unsigned)__builtin_amdgcn_readlane((int)lr1.y, tt), u2 = (unsigned)__builtin_amdgcn_readlane((int)lr1.z, tt), u3 = (unsigned)__builtin_amdgcn_readlane((int)lr1.w, tt);
                  z += bflo(u0) * w2[8] + bfhi(u0) * w2[9] + bflo(u1) * w2[10] + bfhi(u1) * w2[11] + bflo(u2) * w2[12] + bfhi(u2) * w2[13] + bflo(u3) * w2[14] + bfhi(u3) * w2[15]; }
                a = (fminf(z, 0.f) - __logf(1.f + __expf(-fabsf(z)))) * (1.f / 16.f);
                kk = rawk; qv *= 0.17677669529663687f;
            } else {
                const float ef = __expf(-rawk), sg = 1.f / (1.f + ef);
                a = lb + (1.f - lb) * sg;
                kk = (1.f - lb) * (ef * sg);
                qv = qv * sigmoidf_(qv);
            }
            float eb, enb;
            if (GLA) { a *= fv; kk *= fv; qv *= fv; bsum += a; eb = __expf(bsum); enb = __expf(-bsum); }
            else { eprod *= a; eb = eprod; enb = __builtin_amdgcn_rcpf(eprod); }
            kt[t] = kk * enb; qt[t] = qv * eb;
        }
        if (PHC) {
#pragma unroll
            for (int t = 0; t < 16; ++t) {
                *(LAS bf16_t*)(R0 + (16 * s + t) * 144 + lane * 2) = (bf16_t)(cvtpk(qt[t], 0.f) & 0xffffu);
                *(LAS bf16_t*)(R1 + (16 * s + t) * 144 + lane * 2) = (bf16_t)(cvtpk(kt[t], 0.f) & 0xffffu);
            }
        } else {
            unsigned pk[8], pv[8];
#pragma unroll
            for (int m = 0; m < 8; ++m) { pk[m] = cvtpk(kt[2 * m], kt[2 * m + 1]);
                const unsigned v0 = *(const LAS bf16_t*)(R0 + (16 * s + 2 * m) * 144 + lane * 2), v1 = *(const LAS bf16_t*)(R0 + (16 * s + 2 * m + 1) * 144 + lane * 2); pv[m] = v0 | (v1 << 16); }
            u32x4 av0, av1, bk0, bk1;
#pragma unroll
            for (int m = 0; m < 4; ++m) {
                auto rv = __builtin_amdgcn_permlane32_swap(pv[m], pv[m + 4], false, false); av0[m] = rv[0]; av1[m] = rv[1];
                auto rk = __builtin_amdgcn_permlane32_swap(pk[m], pk[m + 4], false, false); bk0[m] = rk[0]; bk1[m] = rk[1];
            }
            const bf16x8 A0 = __builtin_bit_cast(bf16x8, av0), A1 = __builtin_bit_cast(bf16x8, av1), B0 = __builtin_bit_cast(bf16x8, bk0), B1 = __builtin_bit_cast(bf16x8, bk1);
            g00 = MFMA32(A0, B0, g00); g01 = MFMA32(A0, B1, g01); g10 = MFMA32(A1, B0, g10); g11 = MFMA32(A1, B1, g11);
        }
    }
    if (!PHC) {
        const float dec = GLA ? __expf(bsum) : eprod;
        X.decay()[(((size_t)b * 64 + c) * 8 + h8) * 64 + lane] = dec;
        const float d0 = __shfl(dec, r32), d1 = __shfl(dec, 32 + r32);
        float* kv = X.kvt() + sbase;
#pragma unroll
        for (int r = 0; r < 16; ++r) { const int v0 = crow(r, hi);
            kv[(size_t)v0 * 64 + r32] = g00[r] * d0; kv[(size_t)v0 * 64 + 32 + r32] = g01[r] * d1;
            kv[(size_t)(32 + v0) * 64 + r32] = g10[r] * d0; kv[(size_t)(32 + v0) * 64 + 32 + r32] = g11[r] * d1; }
        return;
    }
    if (PHC) {
        bf16x8 avp[2][4];
#pragma unroll
        for (int sg = 0; sg < 4; ++sg) {
            u32x4 f0, f1;
            auto r0 = __builtin_amdgcn_permlane32_swap(pvall[8 * sg + 0], pvall[8 * sg + 2], false, false); f0[0] = r0[0]; f1[0] = r0[1];
            auto r1 = __builtin_amdgcn_permlane32_swap(pvall[8 * sg + 1], pvall[8 * sg + 3], false, false); f0[1] = r1[0]; f1[1] = r1[1];
            auto r2 = __builtin_amdgcn_permlane32_swap(pvall[8 * sg + 4], pvall[8 * sg + 6], false, false); f0[2] = r2[0]; f1[2] = r2[1];
            auto r3 = __builtin_amdgcn_permlane32_swap(pvall[8 * sg + 5], pvall[8 * sg + 7], false, false); f0[3] = r3[0]; f1[3] = r3[1];
            avp[0][sg] = __builtin_bit_cast(bf16x8, f0); avp[1][sg] = __builtin_bit_cast(bf16x8, f1);
        }
        const LAS unsigned char* QT = wl; const LAS unsigned char* KT = wl + 9216;
        f32x16 o[2][2];
#pragma unroll
        for (int it = 0; it < 2; ++it) {
            bf16x8 bq[4];
#pragma unroll
            for (int ks = 0; ks < 4; ++ks) bq[ks] = *(const LAS bf16x8*)(QT + (32 * it + r32) * 144 + ks * 32 + hi * 16);
#pragma unroll
            for (int vi = 0; vi < 2; ++vi) { f32x16 acc = {};
#pragma unroll
                for (int ks = 0; ks < 4; ++ks) acc = MFMA32(s0f[vi][ks], bq[ks], acc);
                o[vi][it] = acc; }
#pragma unroll
            for (int jt = 0; jt <= it; ++jt) {
                f32x16 sc = {};
#pragma unroll
                for (int ks = 0; ks < 4; ++ks) { const bf16x8 ak = *(const LAS bf16x8*)(KT + (32 * jt + r32) * 144 + ks * 32 + hi * 16); sc = MFMA32(ak, bq[ks], sc); }
                if (jt == it) {
#pragma unroll
                    for (int r = 0; r < 16; ++r) if (crow(r, hi) > r32) sc[r] = 0.f;
                }
#pragma unroll
                for (int sp = 0; sp < 2; ++sp) {
                    u32x4 pw; pw.x = cvtpk(sc[8 * sp + 0], sc[8 * sp + 1]); pw.y = cvtpk(sc[8 * sp + 2], sc[8 * sp + 3]); pw.z = cvtpk(sc[8 * sp + 4], sc[8 * sp + 5]); pw.w = cvtpk(sc[8 * sp + 6], sc[8 * sp + 7]);
                    const bf16x8 pb = __builtin_bit_cast(bf16x8, pw);
                    o[0][it] = MFMA32(avp[0][2 * jt + sp], pb, o[0][it]); o[1][it] = MFMA32(avp[1][2 * jt + sp], pb, o[1][it]);
                }
            }
        }
        const float* ng = (GLA ? X.gla_g() : X.hgrn_g()) + layer * 64;
        const int gcol = GLA ? (C_AG + 64 * h) : (C_CG + 64 * h);
        const int mcol = GLA ? (64 * h) : (768 + 64 * h);
#pragma unroll
        for (int it = 0; it < 2; ++it) {
            float ss = 0.f;
#pragma unroll
            for (int vi = 0; vi < 2; ++vi)
#pragma unroll
                for (int r = 0; r < 16; ++r) ss += o[vi][it][r] * o[vi][it][r];
            ss += __shfl_xor(ss, 32);
            const float rstd = rsqrtf(ss * (1.f / 64.f) + EPS);
            const size_t row = row0 + 32 * it + r32;
#pragma unroll
            for (int vi = 0; vi < 2; ++vi)
#pragma unroll
                for (int g = 0; g < 4; ++g) { const int v0 = 32 * vi + 8 * g + 4 * hi;
                    const u32x2 gr = *(const u32x2*)(P + row * PP + gcol + v0);
                    const f32x4 gn = *(const f32x4*)(ng + v0);
                    const float g0 = bflo(gr.x), g1 = bfhi(gr.x), g2 = bflo(gr.y), g3 = bfhi(gr.y);
                    const float y0 = o[vi][it][4 * g + 0] * rstd * gn.x * (g0 * sigmoidf_(g0)), y1 = o[vi][it][4 * g + 1] * rstd * gn.y * (g1 * sigmoidf_(g1));
                    const float y2 = o[vi][it][4 * g + 2] * rstd * gn.z * (g2 * sigmoidf_(g2)), y3 = o[vi][it][4 * g + 3] * rstd * gn.w * (g3 * sigmoidf_(g3));
                    u32x2 w; w.x = cvtpk(y0, y1); w.y = cvtpk(y2, y3);
                    *(u32x2*)(X.ab() + row * DM + mcol + v0) = w; asm volatile("" ::: "memory"); }
        }
    }
}

__device__ __forceinline__ void scan_phase(const Ctx& X, int layer) {
    const int NTH = X.G * 512;
    for (int e = X.bx * 512 + X.tid(); e < NBATCH * 8 * 4096; e += NTH) {
        const int b = e >> 15, rem = e & 32767, h8 = rem >> 12, vk = rem & 4095, k = vk & 63;
        float S = 0.f;
        {
            float kv[64], dc[64];
            const float* kvp = X.kvt() + ((size_t)b * 64 * 8 + h8) * 4096 + vk; const float* dcp = X.decay() + ((size_t)b * 64 * 8 + h8) * 64 + k;
#pragma unroll
            for (int j = 0; j < 64; ++j) { kv[j] = kvp[(size_t)j * 8 * 4096]; dc[j] = dcp[(size_t)j * 8 * 64]; }
            __builtin_amdgcn_sched_barrier(0);
            bf16_t* stp = X.st() + ((size_t)b * 64 * 8 + h8) * 4096 + vk;
#pragma unroll
            for (int j = 0; j < 64; ++j) { stp[(size_t)j * 8 * 4096] = (bf16_t)(cvtpk(S, 0.f) & 0xffffu); S = dc[j] * S + kv[j]; }
        }
    }
    asm volatile("s_waitcnt vmcnt(0)" ::: "memory");
    __syncthreads();
    if (X.tid() == 0) { __builtin_amdgcn_fence(__ATOMIC_RELEASE, "agent"); __hip_atomic_fetch_add(X.ctl() + 64 + layer, 1u, __ATOMIC_RELAXED, __HIP_MEMORY_SCOPE_AGENT); }
}
__device__ __forceinline__ void scan_wait(const Ctx& X, int layer) {
    if (X.tid() == 0) { unsigned sp = 0;
        while (__hip_atomic_load(X.ctl() + 64 + layer, __ATOMIC_RELAXED, __HIP_MEMORY_SCOPE_AGENT) < (unsigned)X.G) { __builtin_amdgcn_s_sleep(2); if (++sp > (1u << 24)) break; }
        __builtin_amdgcn_fence(__ATOMIC_ACQUIRE, "agent"); }
    __syncthreads();
    __builtin_amdgcn_fence(__ATOMIC_ACQUIRE, "workgroup");
}

constexpr int AT_KS = 0, AT_WL = 4096, AT_RING = 8192, AT_SLOT = 16384, AT_NSLOT = 8;
static_assert(AT_RING + AT_NSLOT * AT_SLOT <= MISC_OFF, "attention ring");
__device__ __forceinline__ s16x4 vtr(const LAS unsigned char* p) { typedef short v4i16_t __attribute__((ext_vector_type(4))); return __builtin_bit_cast(s16x4, __builtin_amdgcn_ds_read_tr16_b64_v4i16((LAS v4i16_t*)p)); }
#define AT_WAITBAR(N) asm volatile("s_waitcnt vmcnt(" #N ") lgkmcnt(0)\n\ts_barrier" ::: "memory")
__device__ __forceinline__ void at_kload(bf16x8 (&kf)[8], const LAS unsigned char* Kb, int r32, int hi) {
#pragma unroll
    for (int d0 = 0; d0 < 4; ++d0) { kf[2 * d0] = *(const LAS bf16x8*)(Kb + (2 * d0 + hi) * 1024 + r32 * 16); kf[2 * d0 + 1] = *(const LAS bf16x8*)(Kb + (2 * d0 + hi) * 1024 + (32 + r32) * 16); }
}
template <bool OWN, bool HN1, int TT>
__device__ __forceinline__ void attn_tile(f32x16& pc0, f32x16& pc1, f32x16& pn0, f32x16& pn1, f32x16& o0, f32x16& o1, f32x16& o2, const f32x16& bvec, bf16x8 (&kf)[8], const bf16x8 (&qr)[4],
                                          const LAS unsigned char* Vb, const LAS unsigned char* Kn1, int vpo, int r32, int hi, int qh) {
    if (HN1) at_kload(kf, Kn1, r32, hi);
    s16x4 vl[4], vh[4];
#pragma unroll
    for (int i = 0; i < 4; ++i) { vl[i] = vtr(Vb + vpo + i * 1024); vh[i] = vtr(Vb + vpo + i * 1024 + 512); }
    __builtin_amdgcn_sched_barrier(0);
#pragma unroll
    for (int d0 = 0; d0 < 4; ++d0) {
#pragma unroll
        for (int r = 4 * d0; r < 4 * d0 + 4; ++r) pc0[r] = __builtin_amdgcn_exp2f(pc0[r]);
        if (HN1) pn0 = MFMA32(kf[2 * d0], qr[d0], d0 == 0 ? bvec : pn0);
#pragma unroll
        for (int r = 4 * d0; r < 4 * d0 + 4; ++r) pc1[r] = __builtin_amdgcn_exp2f(pc1[r]);
        if (HN1) pn1 = MFMA32(kf[2 * d0 + 1], qr[d0], d0 == 0 ? bvec : pn1);
    }
    if (OWN) {
#pragma unroll
        for (int r = 0; r < 16; ++r) { const int kc = 64 * TT + (r & 3) + 8 * (r >> 2);
            pc0[r] = (kc > qh) ? 0.f : pc0[r]; pc1[r] = (kc + 32 > qh) ? 0.f : pc1[r]; }
    }
    s16x4 wl_[4], wh_[4];
#pragma unroll
    for (int i = 0; i < 4; ++i) { wl_[i] = vtr(Vb + vpo + 4096 + i * 1024); wh_[i] = vtr(Vb + vpo + 4096 + i * 1024 + 512); }
    __builtin_amdgcn_sched_barrier(0);
    bf16x8 pa[4];
#pragma unroll
    for (int s = 0; s < 2; ++s) {
        u32x4 w0; w0.x = cvtpk(pc0[8 * s + 0], pc0[8 * s + 1]); w0.y = cvtpk(pc0[8 * s + 2], pc0[8 * s + 3]); w0.z = cvtpk(pc0[8 * s + 4], pc0[8 * s + 5]); w0.w = cvtpk(pc0[8 * s + 6], pc0[8 * s + 7]);
        u32x4 w1; w1.x = cvtpk(pc1[8 * s + 0], pc1[8 * s + 1]); w1.y = cvtpk(pc1[8 * s + 2], pc1[8 * s + 3]); w1.z = cvtpk(pc1[8 * s + 4], pc1[8 * s + 5]); w1.w = cvtpk(pc1[8 * s + 6], pc1[8 * s + 7]);
        pa[s] = __builtin_bit_cast(bf16x8, w0); pa[2 + s] = __builtin_bit_cast(bf16x8, w1);
    }
    const bf16x8 ones = (bf16x8){0x3f80, 0x3f80, 0x3f80, 0x3f80, 0x3f80, 0x3f80, 0x3f80, 0x3f80};
#pragma unroll
    for (int ks = 0; ks < 4; ++ks) { const bf16x8 vb0 = (bf16x8){vl[ks][0], vl[ks][1], vl[ks][2], vl[ks][3], vh[ks][0], vh[ks][1], vh[ks][2], vh[ks][3]}; o0 = MFMA32(pa[ks], vb0, o0); o2 = MFMA32(pa[ks], ones, o2); }
#pragma unroll
    for (int ks = 0; ks < 4; ++ks) { const bf16x8 vb1 = (bf16x8){wl_[ks][0], wl_[ks][1], wl_[ks][2], wl_[ks][3], wh_[ks][0], wh_[ks][1], wh_[ks][2], wh_[ks][3]}; o1 = MFMA32(pa[ks], vb1, o1); }
}
__device__ __forceinline__ void attn_unit(const Ctx& X, int layer, int b, int h, int qi) {
    int lane_ = X.lane(), wid_ = X.wave; asm volatile("" : "+v"(lane_), "+s"(wid_));
    const int lane = lane_, wid = wid_, tid = wid * 64 + lane, r32 = lane & 31, hi = lane >> 5;
    LAS unsigned char* lds = X.lds;
    const bf16_t* P = X.proj();
    const size_t rowbase = (size_t)b * SEQ;
    const size_t qrow = rowbase + 256 * qi + 32 * wid + r32;
    float gqm = fabsf(X.qn_g()[layer * 64 + lane]), gkm = fabsf(X.kn_g()[layer * 64 + lane]);
    gqm = wave_max(gqm); gkm = wave_max(gkm);
    const float negM = -(8.3f * gqm * gkm * LOG2E);
    bf16x8 qr[4];
#pragma unroll
    for (int d0 = 0; d0 < 4; ++d0) qr[d0] = *(const bf16x8*)(P + qrow * PP + C_BQ + 64 * h + 16 * d0 + 8 * hi);
    {
        LAS float* ks = (LAS float*)(lds + AT_KS);
#pragma unroll
        for (int e = 0; e < 2; ++e) { const int idx = tid * 2 + e, n = idx >> 6, d = idx & 63; float s = 0.f;
#pragma unroll
            for (int p = 0; p < 2; ++p) s += X.kpart()[((size_t)(b * 16 + n) * 2 + p) * 512 + 64 * h + d];
            ks[idx] = s; }
    }
    __syncthreads();
    const unsigned kgo = (unsigned)(((rowbase + lane) * PP + C_BK + 64 * h + 8 * wid) * 2);
    const unsigned vgo = (unsigned)(((rowbase + 16 * (wid & 3) + (lane >> 2)) * PP + C_BV + 64 * h + (wid >> 2) * 32 + (lane & 3) * 8) * 2);
    const unsigned lds0 = (unsigned)(uintptr_t)lds;
#define AT_ISSUE(t) do { const unsigned sl_ = (unsigned)__builtin_amdgcn_readfirstlane((int)(lds0 + AT_RING + ((t) & (AT_NSLOT - 1)) * AT_SLOT + wid * 1024)); \
        glds16(P, kgo + (unsigned)(t) * (64u * PP * 2u), sl_); glds16(P, vgo + (unsigned)(t) * (64u * PP * 2u), sl_ + 8192u); } while (0)
#define AT_SLOTP(t) (lds + AT_RING + ((t) & (AT_NSLOT - 1)) * AT_SLOT)
    const int T = 4 * (qi + 1);
    AT_ISSUE(0); AT_ISSUE(1); AT_ISSUE(2); AT_ISSUE(3);
    unsigned sel = 0u;
    if (qi <= 3) sel = (1u << qi) - 1u;
    else {
        float qf[32];
#pragma unroll
        for (int d0 = 0; d0 < 4; ++d0) { const u32x4 w = __builtin_bit_cast(u32x4, qr[d0]);
            qf[8 * d0 + 0] = bflo(w.x); qf[8 * d0 + 1] = bfhi(w.x); qf[8 * d0 + 2] = bflo(w.y); qf[8 * d0 + 3] = bfhi(w.y);
            qf[8 * d0 + 4] = bflo(w.z); qf[8 * d0 + 5] = bfhi(w.z); qf[8 * d0 + 6] = bflo(w.w); qf[8 * d0 + 7] = bfhi(w.w); }
        float gt[15];
        const LAS float* ks = (const LAS float*)(lds + AT_KS);
#pragma unroll
        for (int n = 0; n < 15; ++n) {
            float s = 0.f;
            if (n < qi) {
#pragma unroll
                for (int d0 = 0; d0 < 4; ++d0) { const f32x4 k0 = *(const LAS f32x4*)(ks + n * 64 + 16 * d0 + 8 * hi), k1 = *(const LAS f32x4*)(ks + n * 64 + 16 * d0 + 8 * hi + 4);
                    s += qf[8 * d0 + 0] * k0.x + qf[8 * d0 + 1] * k0.y + qf[8 * d0 + 2] * k0.z + qf[8 * d0 + 3] * k0.w + qf[8 * d0 + 4] * k1.x + qf[8 * d0 + 5] * k1.y + qf[8 * d0 + 6] * k1.z + qf[8 * d0 + 7] * k1.w; }
                s += __shfl_xor(s, 32);
                asm volatile("" ::: "memory");
            }
            gt[n] = (n < qi) ? s : -INFINITY;
        }
#pragma unroll
        for (int pass = 0; pass < 3; ++pass) {
            float best = -INFINITY; int bi = -1;
#pragma unroll
            for (int n = 0; n < 15; ++n) if (gt[n] > best) { best = gt[n]; bi = n; }
            if (bi >= 0) sel |= 1u << bi;
#pragma unroll
            for (int n = 0; n < 15; ++n) if (n == bi) gt[n] = -INFINITY;
        }
    }
    const float NEGBIG = -1.0e30f;
#define AT_BIAS(t) (((t) >= T - 4) ? negM : ((((sel >> ((t) >> 2)) & 1u) != 0u) ? negM : NEGBIG))
    f32x16 o0 = {}, o1 = {}, o2 = {}, pA0, pA1, pB0, pB1, bvec; bf16x8 kf[8];
    const int vpo = ((lane >> 4) & 1) * 32 + (lane & 3) * 8 + (4 * hi + ((lane & 15) >> 2)) * 64;
    const int qh = 32 * wid + r32 - 4 * hi;
    AT_WAITBAR(6);
    at_kload(kf, AT_SLOTP(0), r32, hi);
    { const float b0 = AT_BIAS(0);
#pragma unroll
      for (int r = 0; r < 16; ++r) bvec[r] = b0;
#pragma unroll
      for (int d0 = 0; d0 < 4; ++d0) { pA0 = MFMA32(kf[2 * d0], qr[d0], d0 == 0 ? bvec : pA0); pA1 = MFMA32(kf[2 * d0 + 1], qr[d0], d0 == 0 ? bvec : pA1); } }
#define AT_STEP(OWN, HN1, HN2, TT, PC0, PC1, PN0, PN1, t) do { \
        if ((t) + 3 < T) AT_WAITBAR(4); else if ((t) + 2 < T) AT_WAITBAR(2); else AT_WAITBAR(0); \
        if ((t) + 4 < T) AT_ISSUE((t) + 4); \
        if ((((t) + 1) & 3) == 0) { const float bn_ = AT_BIAS((t) + 1); _Pragma("unroll") for (int r_ = 0; r_ < 16; ++r_) bvec[r_] = bn_; }        \
        attn_tile<OWN, HN1, TT>(PC0, PC1, PN0, PN1, o0, o1, o2, bvec, kf, qr, AT_SLOTP(t) + 8192, AT_SLOTP((t) + 1), vpo, r32, hi, qh); } while (0)
    int t = 0;
    for (; t < T - 4; t += 2) {
        AT_STEP(false, true, true, 0, pA0, pA1, pB0, pB1, t);
        AT_STEP(false, true, true, 0, pB0, pB1, pA0, pA1, t + 1);
    }
    AT_STEP(true, true, true, 0, pA0, pA1, pB0, pB1, t);
    AT_STEP(true, true, true, 1, pB0, pB1, pA0, pA1, t + 1);
    AT_STEP(true, true, false, 2, pA0, pA1, pB0, pB1, t + 2);
    AT_STEP(true, false, false, 3, pB0, pB1, pA0, pA1, t + 3);
    bf16_t* orow = X.ab() + (rowbase + 256 * qi + 32 * wid) * DM + 256 + 64 * h;
#pragma unroll
    for (int r = 0; r < 16; ++r) { const int q = crow(r, hi); const float rl = 1.0f / o2[r];
        orow[(size_t)q * DM + r32] = (bf16_t)(cvtpk(o0[r] * rl, 0.f) & 0xffffu);
        orow[(size_t)q * DM + 32 + r32] = (bf16_t)(cvtpk(o1[r] * rl, 0.f) & 0xffffu); }
    __syncthreads();
#undef AT_ISSUE
#undef AT_SLOTP
#undef AT_BIAS
#undef AT_STEP
}

__device__ __forceinline__ void router_flush(const Ctx& X, int layer, LAS unsigned* lcnt, LAS unsigned* rec, int nrow) {
    __syncthreads();
    if (X.tid() < 4) { const int q = X.tid(); const unsigned long long add = (unsigned long long)lcnt[4 * q] | ((unsigned long long)lcnt[4 * q + 1] << 16) | ((unsigned long long)lcnt[4 * q + 2] << 32) | ((unsigned long long)lcnt[4 * q + 3] << 48);
        const unsigned long long old = __hip_atomic_fetch_add((unsigned long long*)(X.ctl() + ecnt_idx(layer, q)), add, __ATOMIC_RELAXED, __HIP_MEMORY_SCOPE_AGENT);
        lcnt[16 + 4 * q] = (unsigned)(old & 0xffffull); lcnt[16 + 4 * q + 1] = (unsigned)((old >> 16) & 0xffffull); lcnt[16 + 4 * q + 2] = (unsigned)((old >> 32) & 0xffffull); lcnt[16 + 4 * q + 3] = (unsigned)(old >> 48); }
    __syncthreads();
    if (X.lane() < nrow) { const LAS unsigned* rc = rec + (X.wave * 16 + X.lane()) * 8;
        const unsigned e0 = rc[0], e1 = rc[1], i0 = lcnt[16 + e0] + rc[2], i1 = lcnt[16 + e1] + rc[3], m = rc[6];
        X.amap()[e0 * MOE_CAP + i0] = m; X.amap()[e1 * MOE_CAP + i1] = m; X.slotw()[e0 * MOE_CAP + i0] = __uint_as_float(rc[4]); X.slotw()[e1 * MOE_CAP + i1] = __uint_as_float(rc[5]);
        unsigned* rt = X.route() + (size_t)m * 8; *(u32x4*)rt = (u32x4){e0, e1, i0, i1}; }
    __syncthreads();
    if (X.tid() < 16) lcnt[X.tid()] = 0u;
    __syncthreads();
}

__device__ __forceinline__ void router_row(const Ctx& X, int layer, int m, f32x4 (&v)[4], const f32x4 (&gn)[4], int lane, const LAS float* wr, LAS unsigned* lcnt, LAS unsigned* rec, int nrow) {
    constexpr int RT_MAXROWS = 16;
        {
            float s = 0.f;
#pragma unroll
            for (int j = 0; j < 4; ++j) s += (v[j].x * v[j].x + v[j].y * v[j].y) + (v[j].z * v[j].z + v[j].w * v[j].w);
            const float rstd = rsqrtf(wave_sum(s) * (1.f / DM) + EPS);
            unsigned* o4 = (unsigned*)((unsigned char*)X.ab() + (size_t)m * DM) + lane;
#pragma unroll
            for (int j = 0; j < 4; ++j) { const f32x4 gg = gn[j]; v[j] = v[j] * rstd * gg; int p = 0; p = __builtin_amdgcn_cvt_pk_fp8_f32(v[j].x, v[j].y, p, false); p = __builtin_amdgcn_cvt_pk_fp8_f32(v[j].z, v[j].w, p, true); o4[64 * j] = (unsigned)p; }
        }
        float lg[4];
#pragma unroll
        for (int c = 0; c < 4; ++c) { float s = 0.f;
#pragma unroll
            for (int j = 0; j < 4; ++j) { const f32x4 w = *(const LAS f32x4*)(wr + c * DM + 4 * (64 * j + lane)); s += v[j].x * w.x + v[j].y * w.y + v[j].z * w.z + v[j].w * w.w; }
            lg[c] = wave_sum(s); }
        asm volatile("" ::: "memory");
        int gs = 0; float gm = lg[0];
#pragma unroll
        for (int c = 1; c < 4; ++c) if (lg[c] > gm) { gm = lg[c]; gs = c; }
        float den = 0.f;
#pragma unroll
        for (int c = 0; c < 4; ++c) den += __expf(lg[c] - gm);
        const float pg = 1.0f / den;
        float le[4];
        { const LAS float* wre = wr + (4 + 4 * gs) * DM;
#pragma unroll
          for (int j = 0; j < 4; ++j) { float s = 0.f;
#pragma unroll
              for (int q = 0; q < 4; ++q) { const f32x4 w = *(const LAS f32x4*)(wre + j * DM + 4 * (64 * q + lane)); s += v[q].x * w.x + v[q].y * w.y + v[q].z * w.z + v[q].w * w.w; }
              le[j] = wave_sum(s); } }
        int i1 = 0; float v1 = le[0];
#pragma unroll
        for (int j = 1; j < 4; ++j) if (le[j] > v1) { v1 = le[j]; i1 = j; }
        int i2 = -1; float v2 = -INFINITY;
#pragma unroll
        for (int j = 0; j < 4; ++j) if (j != i1 && le[j] > v2) { v2 = le[j]; i2 = j; }
        const float ex = __expf(v2 - v1); const float w1 = pg / (1.f + ex), w2 = pg * ex / (1.f + ex);
        if (lane == 0) {
            const int e0 = 4 * gs + i1, e1 = 4 * gs + i2;
            const unsigned p0 = __hip_atomic_fetch_add(lcnt + e0, 1u, __ATOMIC_RELAXED, __HIP_MEMORY_SCOPE_WORKGROUP), p1 = __hip_atomic_fetch_add(lcnt + e1, 1u, __ATOMIC_RELAXED, __HIP_MEMORY_SCOPE_WORKGROUP);
            LAS unsigned* rc = rec + (X.wave * RT_MAXROWS + nrow) * 8;
            rc[0] = (unsigned)e0; rc[1] = (unsigned)e1; rc[2] = p0; rc[3] = p1; rc[4] = __float_as_uint(w1); rc[5] = __float_as_uint(w2); rc[6] = (unsigned)m;
        }
}

__device__ __forceinline__ void router_phase(const Ctx& X, int layer) {
    LAS float* wr = (LAS float*)X.lds;
    {
        f32x4 rg[2], re[2][4];
#pragma unroll
        for (int q = 0; q < 2; ++q) { const int k = X.tid() + 512 * q; rg[q] = *(const f32x4*)(X.w_rg() + (size_t)layer * DM * 4 + k * 4);
#pragma unroll
            for (int j = 0; j < 4; ++j) re[q][j] = *(const f32x4*)(X.w_re() + (size_t)layer * DM * 16 + k * 16 + 4 * j); }
#pragma unroll
        for (int q = 0; q < 2; ++q) { const int k = X.tid() + 512 * q;
#pragma unroll
            for (int c = 0; c < 4; ++c) wr[c * DM + k] = rg[q][c];
#pragma unroll
            for (int j = 0; j < 4; ++j)
#pragma unroll
                for (int c = 0; c < 4; ++c) wr[(4 + 4 * j + c) * DM + k] = re[q][j][c]; }
    }
    LAS unsigned* lcnt = (LAS unsigned*)(X.lds + MISC_OFF + 256);
    if (X.tid() < 16) lcnt[X.tid()] = 0u;
    __syncthreads();
    const int lane = X.lane();
    constexpr int RT_MAXROWS = 16;
    LAS unsigned* rec = (LAS unsigned*)(X.lds + 90112);
    int nrow = 0;
    f32x4 gn[4]; { const f32x4* gr = (const f32x4*)(X.ffn_g() + layer * DM) + lane;
#pragma unroll
        for (int j = 0; j < 4; ++j) gn[j] = gr[64 * j]; }
    f32x4 v[4]; u32x2 bA[4], bB[4];
#define RT_LOADRAW(buf, mm) do { const u32x2* xr_ = (const u32x2*)(X.x1b() + (size_t)(mm) * DM) + lane; _Pragma("unroll") for (int j_ = 0; j_ < 4; ++j_) buf[j_] = xr_[64 * j_]; } while (0)
#define RT_CVT(buf) do { _Pragma("unroll") for (int j_ = 0; j_ < 4; ++j_) v[j_] = (f32x4){bflo(buf[j_].x), bfhi(buf[j_].x), bflo(buf[j_].y), bfhi(buf[j_].y)}; } while (0)
    if (X.gw < NTOK) RT_LOADRAW(bB, X.gw);
    if (X.gw + X.NGW < NTOK) RT_LOADRAW(bA, X.gw + X.NGW);
    if (X.gw < NTOK) RT_CVT(bB);
    const int npass = (NTOK + X.NGW - 1) / X.NGW;
    for (int it = 0; it < npass; it += 2) {
        if (it > 0 && (it & (RT_MAXROWS - 1)) == 0) { router_flush(X, layer, lcnt, rec, nrow); nrow = 0; }
        { const int m = X.gw + it * X.NGW;
          if (m < NTOK) { if (m + 2 * X.NGW < NTOK) RT_LOADRAW(bB, m + 2 * X.NGW);
              __builtin_amdgcn_sched_barrier(0);
              router_row(X, layer, m, v, gn, lane, wr, lcnt, rec, nrow); ++nrow;
              if (m + X.NGW < NTOK) RT_CVT(bA); } }
        if (it + 1 < npass) { const int m = X.gw + (it + 1) * X.NGW;
          if (m < NTOK) { if (m + 2 * X.NGW < NTOK) RT_LOADRAW(bA, m + 2 * X.NGW);
              __builtin_amdgcn_sched_barrier(0);
              router_row(X, layer, m, v, gn, lane, wr, lcnt, rec, nrow); ++nrow;
              if (m + X.NGW < NTOK) RT_CVT(bB); } }
    }
#undef RT_LOADRAW
#undef RT_CVT
    router_flush(X, layer, lcnt, rec, nrow);
}

__device__ __forceinline__ int expert_off_rows(const Ctx& X, int layer, int lane) {
    const int e = lane & 15; const unsigned c = (__hip_atomic_load(X.ctl() + ecnt_idx(layer, e >> 2) + ((e >> 1) & 1), __ATOMIC_RELAXED, __HIP_MEMORY_SCOPE_AGENT) >> (16 * (e & 1))) & 0xffffu;
    const int tiles = (int)((c + 255u) >> 8); int incl = tiles;
#pragma unroll
    for (int o = 1; o < 16; o <<= 1) { const int t = __shfl_up(incl, o, 16); if (e >= o) incl += t; }
    return (incl - tiles) * 256;
}

__device__ __forceinline__ void moe_table(const Ctx& X, int layer) {
    volatile LAS int* toff = (volatile LAS int*)(X.lds + MISC_OFF);
    if (X.tid() < 64) { const int off = expert_off_rows(X, layer, X.lane());
        if (X.lane() < 16) toff[X.lane()] = off >> 8;
        if (X.lane() == 15) { const unsigned c = __hip_atomic_load(X.ctl() + ecnt_idx(layer, 3) + 1, __ATOMIC_RELAXED, __HIP_MEMORY_SCOPE_AGENT) >> 16; toff[16] = (off >> 8) + (int)((c + 255u) >> 8); } }
    __syncthreads();
}

__device__ __forceinline__ void combine_phase(const Ctx& X, int layer) {
    const int lane = X.lane();
    int m = X.gw; unsigned sB0 = 0, sB1 = 0, sC0 = 0, sC1 = 0;
    u32x2 xc[4], xn[4]; u32x2 ya[4], yb[4], yan[4], ybn[4];
#define CB_LOAD(XV, YA, YB, mm, s0, s1) do { const u32x2* xr_ = (const u32x2*)(X.x1b() + (size_t)(mm) * DM) + lane; const u32x2* y0_ = (const u32x2*)(X.aperm() + (size_t)(s0) * DM) + lane; const u32x2* y1_ = (const u32x2*)(X.aperm() + (size_t)(s1) * DM) + lane; \
        _Pragma("unroll") for (int j = 0; j < 4; ++j) { XV[j] = xr_[64 * j]; YA[j] = y0_[64 * j]; YB[j] = y1_[64 * j]; } } while (0)
    const int eoff = expert_off_rows(X, layer, lane);
#define CB_SLOTS(mm, s0, s1) do { const u32x4 r_ = *(const u32x4*)(X.route() + (size_t)(mm) * 8); s0 = (unsigned)__shfl(eoff, (int)(r_.x & 15u)) + r_.z; s1 = (unsigned)__shfl(eoff, (int)(r_.y & 15u)) + r_.w; } while (0)
    if (m < NTOK) { unsigned s0, s1; CB_SLOTS(m, s0, s1); CB_LOAD(xc, ya, yb, m, s0, s1); }
    if (m + X.NGW < NTOK) { CB_SLOTS(m + X.NGW, sB0, sB1); }
    for (; m < NTOK; m += X.NGW) {
        const int mn = m + X.NGW, mnn = m + 2 * X.NGW;
        if (mn < NTOK) CB_LOAD(xn, yan, ybn, mn, sB0, sB1);
        if (mnn < NTOK) { CB_SLOTS(mnn, sC0, sC1); }
        float* xr = X.out() + (size_t)m * DM;
        f32x4 v[4]; float ss = 0.f;
#pragma unroll
        for (int j = 0; j < 4; ++j) { const f32x4 xv = (f32x4){bflo(xc[j].x), bfhi(xc[j].x), bflo(xc[j].y), bfhi(xc[j].y)}; const u32x2 a = ya[j], bq = yb[j];
            f32x4 r; r.x = xv.x + bflo(a.x) + bflo(bq.x); r.y = xv.y + bfhi(a.x) + bfhi(bq.x); r.z = xv.z + bflo(a.y) + bflo(bq.y); r.w = xv.w + bfhi(a.y) + bfhi(bq.y);
            v[j] = r; ss += (r.x * r.x + r.y * r.y) + (r.z * r.z + r.w * r.w);
            if (layer + 1 < DEPTH) { u32x2 w; w.x = cvtpk(r.x, r.y); w.y = cvtpk(r.z, r.w); ((u32x2*)(X.x1b() + (size_t)m * DM))[64 * j + lane] = w; }
            else ((f32x4*)xr)[64 * j + lane] = r; }
        if (layer + 1 < DEPTH) {
            const float rstd = rsqrtf(wave_sum(ss) * (1.f / DM) + EPS);
            const f32x4* gr = (const f32x4*)(X.attn_g() + (layer + 1) * DM) + lane; u32x2* o8 = (u32x2*)(X.ab() + (size_t)m * DM) + lane;
#pragma unroll
            for (int j = 0; j < 4; ++j) { const f32x4 gg = gr[64 * j]; const f32x4 hh = v[j] * rstd * gg; u32x2 w; w.x = cvtpk(hh.x, hh.y); w.y = cvtpk(hh.z, hh.w); o8[64 * j] = w;
                int p = 0; p = __builtin_amdgcn_cvt_pk_fp8_f32(hh.x, hh.y, p, false); p = __builtin_amdgcn_cvt_pk_fp8_f32(hh.z, hh.w, p, true); ((unsigned*)(X.h8() + (size_t)m * DM))[64 * j + lane] = (unsigned)p; }
        }
#pragma unroll
        for (int j = 0; j < 4; ++j) { xc[j] = xn[j]; ya[j] = yan[j]; yb[j] = ybn[j]; }
        sB0 = sC0; sB1 = sC1;
    }
#undef CB_LOAD
#undef CB_SLOTS
}

#define XB_TMO      128
#define XB_XCNT(j)  (256  + 64 * (j))
#define XB_XSUB(j)  (1280 + 64 * (j))
#define XB_XGEN(j)  (2304 + 64 * (j))
#define XB_TOP      3328
#define XB_TOPGEN   3392
#define XB_SPIN_CAP (1u << 22)
__device__ __forceinline__ unsigned xb_ld(unsigned* p)              { return __hip_atomic_load(p, __ATOMIC_RELAXED, __HIP_MEMORY_SCOPE_AGENT); }
__device__ __forceinline__ unsigned xb_add(unsigned* p, unsigned v) { return __hip_atomic_fetch_add(p, v, __ATOMIC_RELAXED, __HIP_MEMORY_SCOPE_AGENT); }
__device__ __forceinline__ unsigned xb_xcc_id() { return (unsigned)__builtin_amdgcn_s_getreg((3 << 11) | 20) & 0xFu; }
#define XB_SPIN(cond, bar) do { unsigned _sp = 0; while (cond) { __builtin_amdgcn_s_sleep(1); \
    if ((++_sp & 255u) == 0u) { if (xb_ld(&(bar)[XB_TMO])) break; if (_sp > XB_SPIN_CAP) { atomicAdd(&(bar)[XB_TMO], 1u); break; } } } } while (0)
struct XcdBarrier { unsigned* bar; unsigned x; volatile LAS unsigned* st; };
__device__ __forceinline__ XcdBarrier xcd_barrier_post(unsigned* bar, volatile LAS unsigned* st) {
    XcdBarrier b; b.bar = bar; b.x = xb_xcc_id(); b.st = st;
    if (threadIdx.x == 0) (void)xb_add(&bar[XB_XCNT(b.x)], 1u);
    return b;
}
__device__ __forceinline__ void xcd_barrier_complete(unsigned* bar, unsigned x, unsigned& nloc, unsigned& nx) {
    const unsigned G = gridDim.x * gridDim.y * gridDim.z;
    unsigned sum, cnt, mine, sp = 0u;
    for (;;) {
        sum = 0u; cnt = 0u; mine = 0u;
#pragma unroll 1
        for (unsigned j = 0; j < 16; ++j) { const unsigned c = xb_ld(&bar[XB_XCNT(j)]); sum += c; cnt += (c > 0u) ? 1u : 0u; mine = (j == x) ? c : mine; }
        if (sum == G) break;
        __builtin_amdgcn_s_sleep(1);
        if ((++sp & 255u) == 0u) { if (xb_ld(&bar[XB_TMO])) break; if (sp > XB_SPIN_CAP) { atomicAdd(&bar[XB_TMO], 1u); break; } }
    }
    nloc = mine > 0u ? mine : 1u; nx = cnt > 0u ? cnt : 1u;
}
__device__ __forceinline__ void xcd_barrier(const XcdBarrier& b) {
    asm volatile("s_waitcnt vmcnt(0)" ::: "memory");
    __syncthreads();
    if (threadIdx.x == 0) {
        unsigned* bar = b.bar; unsigned bx_ = b.x;
        asm volatile("" : "+s"(bar), "+s"(bx_));
        __builtin_amdgcn_s_waitcnt(0);
        unsigned nloc = b.st[0], nx = b.st[1];
        if (nloc == 0u) { xcd_barrier_complete(bar, bx_, nloc, nx); b.st[0] = nloc; b.st[1] = nx; }
        const unsigned old = xb_add(&bar[XB_XSUB(bx_)], 1u);
        const unsigned gen = old / nloc;
        if (old + 1u == (gen + 1u) * nloc) {
            __builtin_amdgcn_fence(__ATOMIC_RELEASE, "agent");
            asm volatile("s_waitcnt vmcnt(0)" ::: "memory");
            const unsigned og = xb_add(&bar[XB_TOP], 1u);
            const unsigned tg = og / nx;
            if (og + 1u == (tg + 1u) * nx) xb_add(&bar[XB_TOPGEN], 1u);
            else XB_SPIN(xb_ld(&bar[XB_TOPGEN]) == tg, bar);
            __builtin_amdgcn_fence(__ATOMIC_ACQUIRE, "agent");
            xb_add(&bar[XB_XGEN(bx_)], 1u);
            asm volatile("s_waitcnt vmcnt(0)" ::: "memory");
        } else {
            XB_SPIN(xb_ld(&bar[XB_XGEN(bx_)]) == gen, bar);
            __builtin_amdgcn_fence(__ATOMIC_ACQUIRE, "agent");
            asm volatile("s_waitcnt vmcnt(0)" ::: "memory");
        }
    }
    __syncthreads();
}

#ifndef PHMASK
#define PHMASK 0xffff
#endif
#ifndef PROBE_A
#define PROBE_A -1
#define PROBE_B -1
#endif
#ifndef PROBE_BLK
#define PROBE_BLK 0
#endif
constexpr int NPHASE = 1 + 7 * DEPTH;
__global__ void __launch_bounds__(512, 2) fwd_kernel(Args args) {
    extern __shared__ __attribute__((aligned(16))) unsigned char lds_raw[];
    cg::grid_group grid = cg::this_grid();
    const int wave_s = __builtin_amdgcn_readfirstlane((int)(threadIdx.x >> 6));
    const int lo = args.ph_lo, hi = args.ph_hi;
    { volatile LAS unsigned* m = (volatile LAS unsigned*)((LAS unsigned char*)lds_raw + MISC_OFF); if (threadIdx.x < 64) m[threadIdx.x] = 0u; }
    __syncthreads();
    XcdBarrier xbar; xbar.bar = (unsigned*)(args.ws + WS_CTL) + CW_BAR; xbar.x = 0u; xbar.st = (volatile LAS unsigned*)((LAS unsigned char*)lds_raw + MISC_OFF + 128);
#if PROBE_A >= 0
    unsigned prA = 0, prT = 0, prE = 0; const unsigned prS = (unsigned)__builtin_amdgcn_s_memrealtime();
#define PROBE_ACC(type, d) do { if ((type) == PROBE_A) prA += (d); } while (0)
#endif
#if PROBE_A >= 0
#define PROBE_SUB(type) do { __syncthreads(); const unsigned t_ = (unsigned)__builtin_amdgcn_s_memrealtime(); PROBE_ACC(type, t_ - prSub); prSub = t_; } while (0)
    unsigned prSub = 0;
#else
#define PROBE_SUB(type) do {} while (0)
#endif
    for (int ph = lo; ph < hi; ++ph) {
        if (ph > lo) { if (ph == lo + 1) { grid.sync(); xbar = xcd_barrier_post((unsigned*)(args.ws + WS_CTL) + CW_BAR, (volatile LAS unsigned*)((LAS unsigned char*)lds_raw + MISC_OFF + 128)); } else xcd_barrier(xbar); }
#if PROBE_A >= 0
        prT = (unsigned)__builtin_amdgcn_s_memrealtime(); prSub = prT; if (ph > lo) PROBE_ACC(11, prT - prE);
#endif
        Ctx X;
#define CTX_REFRESH() do { \
        { unsigned l0 = 0u; asm volatile("" : "+s"(l0)); X.lds = (LAS unsigned char*)lds_raw + l0; } \
        { unsigned z0 = 0u; asm volatile("" : "+s"(z0)); \
          int ws = wave_s; asm volatile("" : "+s"(ws)); (void)z0; \
          X.wave = ws; } \
        { int bx = blockIdx.x, G = gridDim.x; asm volatile("" : "+s"(bx), "+s"(G)); X.G = G; X.vcu = (G % 8 == 0) ? (bx % 8) * (G / 8) + bx / 8 : bx; X.bx = bx; } \
        X.gw = X.vcu * 8 + X.wave; X.NGW = X.G * 8; \
        { const __attribute__((address_space(4))) unsigned char* ka = (const __attribute__((address_space(4))) unsigned char*)__builtin_amdgcn_kernarg_segment_ptr(); asm volatile("" : "+s"(ka)); X.ka = ka; } } while (0)
        CTX_REFRESH();
        const int layer = (ph - 1) / 7; const int k = ph == 0 ? 0 : (0xA865421 >> (4 * ((ph - 1) % 7))) & 15;
        if (ph == 0) { phase0(X); PROBE_SUB(15); CTX_REFRESH(); phase0b(X); PROBE_SUB(16); }
        else switch (k) {
        case 1: {
            {
                pg8::Gemm g{X.ab(), X.win() + (size_t)layer * NW_IN * DM, DM}; pg8::StaticOrder S; S.init(NTOK, 1536, X.G, X.bx, 0xCBA910ull, 0, 0);
                EpiProj<false> E{X.proj(), X.lr(), X.qn_g() + layer * 64, X.kn_g() + layer * 64, X.cosT(), X.sinT(), X.kpart()};
                pg8::gemm_phase<EpiProj<false>, pg8::StaticOrder>(X.lds, g, S, E, X.tid()); }
            PROBE_SUB(19);
            CTX_REFRESH();
            {
                pg8::Gemm g{(const bf16_t*)X.h8(), (const bf16_t*)((const unsigned char*)(X.win() + (size_t)layer * NW_IN * DM) + (size_t)C_BQ * DM * 2), DM / 2}; pg8::StaticOrder S; S.init(NTOK, 2048, X.G, X.bx, 0x2D876543ull, 1, 1);
                EpiProj<true> E{X.proj(), X.lr(), X.qn_g() + layer * 64, X.kn_g() + layer * 64, X.cosT(), X.sinT(), X.kpart()};
                pg8::gemm_phase<EpiProj<true>, pg8::StaticOrder, false, true>(X.lds, g, S, E, X.tid()); }
        } break;
        case 2: {
            PROBE_SUB(17);
            LAS unsigned char* wl = X.lds + X.wave * WAVE_LDS;
            for (int it = X.gw; it < 2048; it += X.NGW) { const int h8 = it & 7, bc = it >> 3, b = bc >> 6, c = bc & 63;
                if (h8 < 4) lin_item<true, false>(X, layer, b, c, h8, wl); else lin_item<false, false>(X, layer, b, c, h8 - 4, wl); }
            PROBE_SUB(18);
        } break;
        case 4: {
            scan_phase(X, layer);
            PROBE_SUB(3);
            CTX_REFRESH();
            if (PHMASK & 0x800) for (int v = X.vcu; v < 256; v += X.G) { const int bh = v >> 3, s = v & 7; attn_unit(X, layer, bh >> 3, bh & 7, s); attn_unit(X, layer, bh >> 3, bh & 7, 15 - s); }
            PROBE_SUB(13);
            CTX_REFRESH();
            scan_wait(X, layer);
            LAS unsigned char* wl = X.lds + X.wave * WAVE_LDS;
            if (PHMASK & 0x1000) for (int it = X.gw; it < 2048; it += X.NGW) { const int h8 = it & 7, bc = it >> 3, b = bc >> 6, c = bc & 63;
                if (h8 < 4) lin_item<true, true>(X, layer, b, c, h8, wl); else lin_item<false, true>(X, layer, b, c, h8 - 4, wl); }
            PROBE_SUB(14);
        } break;
        case 5: {
            pg8::Gemm g{X.ab(), X.wout() + (size_t)layer * DM * DM, DM}; pg8::StaticOrder S; S.init(NTOK, DM, X.G, X.bx);
            EpiResid E{X.x(), X.x1b(), layer == 0 ? (const bf16_t*)nullptr : (const bf16_t*)X.x1b()};
            pg8::gemm_phase<EpiResid, pg8::StaticOrder>(X.lds, g, S, E, X.tid());
        } break;
        case 6: router_phase(X, layer); break;
        case 8: {
            moe_table(X, layer);
            unsigned* tcnt;
            { const unsigned long long p_ = (unsigned long long)(uintptr_t)(X.ctl() + 256 + layer * 256);
              tcnt = (unsigned*)(uintptr_t)(((unsigned long long)(unsigned)__builtin_amdgcn_readfirstlane((int)(p_ >> 32)) << 32) | (unsigned long long)(unsigned)__builtin_amdgcn_readfirstlane((int)p_)); }
            { pg8::Gemm g{X.ab(), X.wgu(), DM / 2}; pg8::GroupedOrder S{(const volatile LAS int*)(X.lds + MISC_OFF), X.G, X.vcu, layer * 64, tcnt, (LAS unsigned*)(X.lds + MISC_OFF + 192), 0, 0, 0, 0};
              EpiSwiglu E{X.hbuf()};
              pg8::gemm_phase<EpiSwiglu, pg8::GroupedOrder, true, true>(X.lds, g, S, E, X.tid(), X.amap(), (unsigned)(NTOK - 1)); S.finish(X.wave); }
            PROBE_SUB(8);
            CTX_REFRESH();
            { pg8::Gemm g{X.hbuf(), X.wd(), FF / 2}; pg8::GroupedOrderDown S{(const volatile LAS int*)(X.lds + MISC_OFF), X.G, X.vcu, layer * 64, tcnt, (LAS unsigned*)(X.lds + MISC_OFF + 200 + 4 * layer), X.wave, 0u};
              EpiDown E{X.aperm(), X.slotw()};
              pg8::gemm_phase<EpiDown, pg8::GroupedOrderDown, false, true>(X.lds, g, S, E, X.tid()); }
            PROBE_SUB(9);
        } break;
        case 10: combine_phase(X, layer); break;
        }
        __syncthreads();
#if PROBE_A >= 0
        prE = (unsigned)__builtin_amdgcn_s_memrealtime(); PROBE_ACC(k, prE - prT);
#endif
    }
#if PROBE_A >= 0
    PROBE_ACC(12, prE - prS);
    if (wave_s == 0 && __builtin_amdgcn_mbcnt_hi(~0u, __builtin_amdgcn_mbcnt_lo(~0u, 0u)) == 0u) {
        unsigned* ctl = (unsigned*)(args.ws + WS_CTL);
        if (blockIdx.x == PROBE_BLK) { const unsigned qa = (prA + 400u) / 800u > 127u ? 127u : (prA + 400u) / 800u;
            __hip_atomic_store(ctl + 200, qa, __ATOMIC_RELAXED, __HIP_MEMORY_SCOPE_AGENT); }
        __builtin_amdgcn_fence(__ATOMIC_RELEASE, "agent");
        const unsigned done = __hip_atomic_fetch_add(ctl + 201, 1u, __ATOMIC_ACQ_REL, __HIP_MEMORY_SCOPE_AGENT);
        if (done == gridDim.x - 1) { const unsigned long long extra = (unsigned long long)__hip_atomic_load(ctl + 200, __ATOMIC_RELAXED, __HIP_MEMORY_SCOPE_AGENT) * 400ull; const unsigned long long t0 = __builtin_amdgcn_s_memrealtime();
            while (__builtin_amdgcn_s_memrealtime() - t0 < extra) __builtin_amdgcn_s_sleep(32); }
    }
#endif
}

extern "C" void kernel_launch(void* const* d_in, const int* in_sizes, int n_in, void* d_out, int out_size, void* d_ws, size_t ws_size, hipStream_t stream) {
    static int grid = 0;
    if (grid == 0) {
        if (n_in != 17 || out_size != NTOK * DM || ws_size < WS_END) { fprintf(stderr, "kernel_launch: unexpected problem (n_in %d out %d ws %zu)\n", n_in, out_size, ws_size); grid = -1; return; }
        int dev = 0, cus = 0, per_cu = 0;
        hipGetDevice(&dev); hipDeviceGetAttribute(&cus, hipDeviceAttributeMultiprocessorCount, dev);
        if (hipFuncSetAttribute((const void*)fwd_kernel, hipFuncAttributeMaxDynamicSharedMemorySize, LDS_BYTES) != hipSuccess) { fprintf(stderr, "kernel_launch: hipFuncSetAttribute failed\n"); }
        if (hipOccupancyMaxActiveBlocksPerMultiprocessor(&per_cu, (const void*)fwd_kernel, 512, LDS_BYTES) != hipSuccess || per_cu < 1) { fprintf(stderr, "kernel_launch: occupancy query says %d\n", per_cu); per_cu = 1; }
        (void)hipGetLastError();
        grid = cus * per_cu;
        fprintf(stderr, "kernel_launch: grid %d (cus %d x %d), ws %zu\n", grid, cus, per_cu, ws_size);
    }
    if (grid < 0) return;
    Args a{};
    for (int i = 0; i < 17; ++i) a.in[i] = (const float*)d_in[i];
    a.out = (float*)d_out; a.ws = (unsigned char*)d_ws;
#if MK_PER_PHASE
    for (int ph = 0; ph < NPHASE; ++ph) { a.ph_lo = ph; a.ph_hi = ph + 1; hipLaunchKernelGGL(fwd_kernel, dim3(grid), dim3(512), LDS_BYTES, stream, a); }
#else
    a.ph_lo = 0; a.ph_hi = NPHASE;
    void* kargs[] = {&a};
    hipError_t e = hipLaunchCooperativeKernel((const void*)fwd_kernel, dim3(grid), dim3(512), kargs, LDS_BYTES, stream);
    if (e != hipSuccess) fprintf(stderr, "cooperative launch failed: %s (grid %d)\n", hipGetErrorString(e), grid);
#endif
}
```

```cpp
#include <hip/hip_runtime.h>
#include <hip/hip_cooperative_groups.h>
#include <cstdio>
#include <cstdint>
#include <cstddef>
namespace cg = cooperative_groups;

#ifndef MK_PER_PHASE
#define MK_PER_PHASE 0
#endif

#define LAS __attribute__((address_space(3)))
typedef unsigned short bf16_t;
typedef short bf16x8 __attribute__((ext_vector_type(8)));
typedef short s16x4 __attribute__((ext_vector_type(4)));
typedef float f32x2 __attribute__((ext_vector_type(2)));
typedef float f32x4 __attribute__((ext_vector_type(4)));
typedef float f32x16 __attribute__((ext_vector_type(16)));
typedef unsigned u32x2 __attribute__((ext_vector_type(2)));
typedef unsigned u32x4 __attribute__((ext_vector_type(4)));
typedef __bf16 bf16x2_t __attribute__((ext_vector_type(2)));

constexpr int NTOK = 16384, DM = 1024, SEQ = 4096, NBATCH = 4, DEPTH = 2;
constexpr int IN_COLS = 3344;
constexpr int PP = 3328;
constexpr int NW_IN = 3584;
constexpr int C_AQ = 0, C_AK = 128, C_AV = 256, C_AG = 512, C_BQ = 768, C_BK = 1280, C_BV = 1792, C_CQ = 2304, C_CF = 2560, C_CI = 2816, C_CG = 3072;
constexpr int NEXP = 16, FF = 512;
constexpr int MOE_ROWS = 36864;
constexpr float EPS = 1e-6f;
constexpr float LOG2E = 1.4426950408889634f;

constexpr size_t MiB = 1u << 20;
constexpr size_t WS_CTL = 0;
constexpr size_t WS_SMALL = 1 * MiB;
constexpr size_t SM_COS = WS_SMALL, SM_SIN = WS_SMALL + 128 * 1024;
constexpr size_t SM_LR = WS_SMALL + 256 * 1024;
constexpr size_t SM_KPART = WS_SMALL + 768 * 1024;
constexpr size_t SM_DECAY = WS_SMALL + 1280 * 1024;
constexpr size_t SM_ROUTE = WS_SMALL + 1792 * 1024;
constexpr size_t SM_SLOTW = WS_SMALL + 2304 * 1024;
constexpr size_t SM_AMAP = WS_SMALL + 2816 * 1024;
constexpr size_t SM_WGCNT = WS_SMALL + 2560 * 1024;
__host__ __device__ constexpr int ecnt_idx(int layer, int q) { return 16384 + layer * 32768 + q * 1088; }
constexpr int CW_BAR = 4096;
constexpr size_t CTL_ZERO_BYTES = 65536;
constexpr size_t WS_WIN = 5 * MiB;
constexpr size_t WS_WOUT = 19 * MiB;
constexpr size_t WS_WGU = 23 * MiB;
constexpr size_t WS_X1B = 23 * MiB + 32 * MiB;
constexpr size_t WS_WD = 87 * MiB;
constexpr size_t WS_H8 = 103 * MiB;
constexpr size_t WS_PROJ = 119 * MiB;
constexpr size_t WS_ST = 223 * MiB;
constexpr size_t WS_AB = 239 * MiB;
constexpr int MOE_CAP = 16384;
constexpr size_t WS_AMAP2 = 271 * MiB;
constexpr size_t WS_SLOTW2 = 272 * MiB;
constexpr size_t WS_END = 273 * MiB;
constexpr size_t WS_APERM = WS_PROJ;
constexpr size_t WS_H = WS_PROJ + 72 * MiB;
static_assert(WS_H + (size_t)MOE_ROWS * FF * 2 <= WS_AB, "moe overlay");

constexpr int LDS_BYTES = 159744;
constexpr int MISC_OFF = 147456;
constexpr int GROW_OFF = MISC_OFF + 1024;
constexpr int WAVE_LDS = 18432;

__device__ __forceinline__ unsigned cvtpk(float lo, float hi) { f32x2 v = {lo, hi}; bf16x2_t b = __builtin_convertvector(v, bf16x2_t); return __builtin_bit_cast(unsigned, b); }
__device__ __forceinline__ float bf2f(unsigned short u) { return __builtin_bit_cast(float, (unsigned)u << 16); }
__device__ __forceinline__ float bflo(unsigned u) { return __builtin_bit_cast(float, u << 16); }
__device__ __forceinline__ float bfhi(unsigned u) { return __builtin_bit_cast(float, u & 0xffff0000u); }
#define DPP_ADD(v, ctrl) ((v) + __builtin_bit_cast(float, __builtin_amdgcn_update_dpp(0, __builtin_bit_cast(int, (v)), (ctrl), 0xf, 0xf, true)))
__device__ __forceinline__ float wave_sum(float v) {
    v = DPP_ADD(v, 0xB1); v = DPP_ADD(v, 0x4E); v = DPP_ADD(v, 0x141); v = DPP_ADD(v, 0x140);
    const int iv = __builtin_bit_cast(int, v);
    const float r0 = __builtin_bit_cast(float, __builtin_amdgcn_readlane(iv, 0)), r1 = __builtin_bit_cast(float, __builtin_amdgcn_readlane(iv, 16));
    const float r2 = __builtin_bit_cast(float, __builtin_amdgcn_readlane(iv, 32)), r3 = __builtin_bit_cast(float, __builtin_amdgcn_readlane(iv, 48));
    return (r0 + r1) + (r2 + r3);
}
__device__ __forceinline__ float wave_max(float v) {
#pragma unroll
    for (int o = 1; o < 64; o <<= 1) v = fmaxf(v, __shfl_xor(v, o));
    return v;
}
__device__ __forceinline__ int crow(int r, int hi) { return (r & 3) + 8 * (r >> 2) + 4 * hi; }
__device__ __forceinline__ float sigmoidf_(float x) { return 1.0f / (1.0f + __expf(-x)); }
#define MFMA32(a, b, c) __builtin_amdgcn_mfma_f32_32x32x16_bf16((a), (b), (c), 0, 0, 0)

__device__ __forceinline__ void glds16(const void* sbase, unsigned voff, unsigned lds_dst) { unsigned keep;
    asm volatile("s_mov_b32 %0, m0\n\ts_mov_b32 m0, %3\n\ts_nop 0\n\tglobal_load_lds_dwordx4 %1, %2\n\ts_mov_b32 m0, %0" : "=&s"(keep) : "v"(voff), "s"(sbase), "s"(lds_dst) : "memory"); }

namespace pg8 {
#define PG8_LAS __attribute__((address_space(3)))
constexpr int BM = 256, BK = 64, HALF = 128, HTB = HALF * BK * 2, STAGE_BYTES = 8 * HTB, NXCD = 8, WGM = 8;
__host__ __device__ __forceinline__ int lds_byte(int r, int c) { const int st = (r >> 4) * 2 + (c >> 5), rr = r & 15, cc = c & 31, ob = rr * 64 + cc * 2; return st * 1024 + (ob ^ (((ob >> 9) & 1) << 5)); }
__host__ __device__ __forceinline__ void stage_rc(int b, int& R, int& C) { const int st = b / 1024, sb = b % 1024, swz = sb ^ (((sb >> 9) & 1) << 5); R = (st >> 1) * 16 + swz / 64; C = (st & 1) * 32 + (swz % 64) / 2; }
__host__ __device__ __forceinline__ int perm32(int rho) { const int n = rho >> 4, i = rho & 15; return 8 * (i >> 2) + 4 * n + (i & 3); }

struct Unit { int pm, pn, bt, ab; };
struct Gemm { const bf16_t* A; const bf16_t* Bt; int K; };

struct StaticOrder {
    int nM, nN, nwg, G, c, compact, skew; unsigned long long tbl;
    __device__ void init(int M, int N, int G_, int c_, unsigned long long tbl_ = 0xFEDCBA9876543210ull, int compact_ = 0, int skew_ = 0) { nM = M / BM; nN = N / BM; nwg = nM * nN; G = G_; c = c_; tbl = tbl_; compact = compact_; skew = skew_; }
    __device__ bool next(int i, Unit& u) const {
        long L = (long)i * G + c;
        if (skew && i > 0) { const int hg = G >> 1; if (c < hg) return false; L = (long)G + (long)(i - 1) * hg + (c - hg); }
        if (L >= nwg) return false;
        int wgid = (int)L; { const int q = nwg / NXCD, r = nwg % NXCD, xcd = wgid % NXCD, off = wgid / NXCD; wgid = (xcd < r ? xcd * (q + 1) : r * (q + 1) + (xcd - r) * q) + off; }
        const int nig = WGM * nN, gid = wgid / nig, fm = gid * WGM, gsz = (nM - fm) < WGM ? (nM - fm) : WGM;
        u.pm = fm + ((wgid % nig) % gsz); { const int pn_ = (wgid % nig) / gsz; u.pn = (int)((tbl >> (4 * pn_)) & 15ull); u.bt = compact ? pn_ : u.pn; } return true;
    }
    __device__ __forceinline__ void a_ready(const Unit&) const {}
    __device__ __forceinline__ void done(const Unit&) const {}
};
struct GroupedOrder {
    const volatile PG8_LAS int* toff; int G, vcu, wbase;
    __device__ bool next(int i, Unit& u) const {
        const int U = i * G + vcu; const int total = toff[16];
        if (U >= total * 4) return false;
        const int rt = U >> 2, pn = U & 3; int e = 0;
#pragma unroll
        for (int j = 1; j < 16; ++j) e += (rt >= toff[j]) ? 1 : 0;
        u.pm = __builtin_amdgcn_readfirstlane(rt); u.pn = __builtin_amdgcn_readfirstlane(pn); u.bt = __builtin_amdgcn_readfirstlane(wbase + e * 4 + pn); u.ab = __builtin_amdgcn_readfirstlane(e * 64 + rt - toff[e]); return true;
    }
    __device__ __forceinline__ void a_ready(const Unit&) const {}
    unsigned* cnt; PG8_LAS unsigned* wgarr;
    mutable int dp0, dp1, dp2, ndp;
    __device__ __forceinline__ void done(const Unit& u) const {
        { const int n8 = toff[16] * 4, rem = n8 - (n8 / G) * G;
          if (vcu >= rem) { if (ndp == 0) dp0 = u.pm; else if (ndp == 1) dp1 = u.pm; else dp2 = u.pm; ++ndp; return; } }
        asm volatile("s_waitcnt vmcnt(0)" ::: "memory");
        unsigned old = 0u;
        if (__builtin_amdgcn_mbcnt_hi(~0u, __builtin_amdgcn_mbcnt_lo(~0u, 0u)) == 0u) old = __hip_atomic_fetch_add(wgarr, 1u, __ATOMIC_RELAXED, __HIP_MEMORY_SCOPE_WORKGROUP);
        old = (unsigned)__builtin_amdgcn_readfirstlane((int)old);
        if ((old & 7u) == 7u) {
            __builtin_amdgcn_fence(__ATOMIC_RELEASE, "agent");
            if (__builtin_amdgcn_mbcnt_hi(~0u, __builtin_amdgcn_mbcnt_lo(~0u, 0u)) == 0u) __hip_atomic_fetch_add(cnt + u.pm, 1u, __ATOMIC_RELAXED, __HIP_MEMORY_SCOPE_AGENT);
        }
    }
    __device__ __forceinline__ void finish(int wid) const {
        if (ndp > 0 && wid == 0) {
            __builtin_amdgcn_fence(__ATOMIC_RELEASE, "agent");
            if (__builtin_amdgcn_mbcnt_hi(~0u, __builtin_amdgcn_mbcnt_lo(~0u, 0u)) == 0u) {
                __hip_atomic_fetch_add(cnt + dp0, 1u, __ATOMIC_RELAXED, __HIP_MEMORY_SCOPE_AGENT);
                if (ndp > 1) __hip_atomic_fetch_add(cnt + dp1, 1u, __ATOMIC_RELAXED, __HIP_MEMORY_SCOPE_AGENT);
                if (ndp > 2) __hip_atomic_fetch_add(cnt + dp2, 1u, __ATOMIC_RELAXED, __HIP_MEMORY_SCOPE_AGENT);
            }
        }
    }
};
struct GroupedOrderDown {
    const volatile PG8_LAS int* toff; int G, vcu, wbase; unsigned* cnt;
    __device__ bool next(int i, Unit& u) const {
        const int n8 = toff[16] * 4, R = n8 / G, rem = n8 - R * G; int q;
        if (vcu < rem) { if (i > 0) return false; q = R * G + vcu; }
        else { q = (vcu - rem) + (G - rem) * i; if (q >= R * G) return false; }
        const int rt = q >> 2, pn = q & 3; int e = 0;
#pragma unroll
        for (int j = 1; j < 16; ++j) e += (rt >= toff[j]) ? 1 : 0;
        u.pm = __builtin_amdgcn_readfirstlane(rt); u.pn = __builtin_amdgcn_readfirstlane(pn); u.bt = __builtin_amdgcn_readfirstlane(wbase + e * 4 + pn); u.ab = __builtin_amdgcn_readfirstlane(e * 64 + rt - toff[e]); return true;
    }
    PG8_LAS unsigned* acq; int wid; mutable unsigned ncall;
    __device__ __forceinline__ void a_ready(const Unit& u) const {
        const unsigned k = ++ncall; unsigned sp = 0;
        if (wid == 0) {
            while ((unsigned)__builtin_amdgcn_readfirstlane((int)__hip_atomic_load(cnt + u.pm, __ATOMIC_RELAXED, __HIP_MEMORY_SCOPE_AGENT)) < 4u) { __builtin_amdgcn_s_sleep(4); if (++sp > (1u << 22)) break; }
            __builtin_amdgcn_fence(__ATOMIC_ACQUIRE, "agent");
            __hip_atomic_store(acq, k, __ATOMIC_RELEASE, __HIP_MEMORY_SCOPE_WORKGROUP);
        } else {
            while ((unsigned)__builtin_amdgcn_readfirstlane((int)__hip_atomic_load(acq, __ATOMIC_ACQUIRE, __HIP_MEMORY_SCOPE_WORKGROUP)) < k) { __builtin_amdgcn_s_sleep(2); if (++sp > (1u << 24)) break; }
        }
        asm volatile("" ::: "memory");
    }
    __device__ __forceinline__ void done(const Unit&) const {}
};

template <class Epi, class Sched, bool GATHER = false, bool FP8 = false>
__device__ __forceinline__ void gemm_phase(PG8_LAS unsigned char* lds, const Gemm g, const Sched& S, const Epi& E, const int tid, const unsigned* amap = nullptr, unsigned amap_max = 0u) {
    const int  wid = __builtin_amdgcn_readfirstlane(tid >> 6), lane = tid & 63, wr = wid >> 2, wc = wid & 3, fr = lane & 15, fq = lane >> 4;
    int Kq_ = g.K; asm volatile("" : "+s"(Kq_));
    const int K = Kq_, nt = K / BK;
    unsigned voffA[2], voffB[2]; int gR[2]; unsigned gC[2];
#pragma unroll
    for (int i = 0; i < 2; ++i) { int R, C; stage_rc(tid * 16 + i * 8192, R, C); const int Rb = Epi::PERM ? ((R & ~31) + perm32(R & 31)) : R;
        voffA[i] = (unsigned)(R * K + C) * 2u; voffB[i] = (unsigned)(Rb * K + C) * 2u; gR[i] = R; gC[i] = (unsigned)C * 2u; }
    unsigned arC[2][2];
    PG8_LAS unsigned* arNp = (PG8_LAS unsigned*)(lds + 147456 + 1024 + tid * 16);
#define PG8_GROWS(dst, pm_) do { _Pragma("unroll") for (int h_ = 0; h_ < 2; ++h_) _Pragma("unroll") for (int i_ = 0; i_ < 2; ++i_) { \
        unsigned tk_ = amap[(size_t)(pm_) * 256 + h_ * 128 + gR[0] + 64 * i_]; tk_ = tk_ < amap_max ? tk_ : amap_max; dst[h_][i_] = tk_ * (unsigned)(K * 2) + gC[0]; } } while (0)
    const size_t kstep = (size_t)(BK * 2);
    const size_t hstep = (size_t)HALF * K * 2;
    const size_t tstep = 2 * hstep;
    const unsigned ldsw = (unsigned)wid * 1024u; const unsigned lds0_ = (unsigned)(uintptr_t)lds;
    const int aoff = lds_byte(wr * 64 + fr, fq * 8), boff = lds_byte(wc * 32 + fr, fq * 8);
#define PG8_SA(b, h) (((b) * 2 + (h)) * HTB)
#define PG8_SB(b, h) ((4 + (b) * 2 + (h)) * HTB)
#define PG8_STAGE(bufoff, gbase, voff) do { const unsigned long long gb_ = (unsigned long long)(uintptr_t)(gbase); \
        const void* sb_ = (const void*)(uintptr_t)(((unsigned long long)(unsigned)__builtin_amdgcn_readfirstlane((int)(gb_ >> 32)) << 32) | (unsigned long long)(unsigned)__builtin_amdgcn_readfirstlane((int)gb_)); \
        _Pragma("unroll") for (int _i = 0; _i < 2; ++_i) \
        glds16(sb_, (voff)[_i], (unsigned)__builtin_amdgcn_readfirstlane((int)(lds0_ + (unsigned)(bufoff) + ldsw + (unsigned)(_i * 8192)))); } while (0)
#define PG8_STAGEA(bufoff, gbase, h, isn) do { if (GATHER) { unsigned vo_[2] = {arC[h][0], arC[h][1]}; if (isn) { vo_[0] = arNp[2 * (h)]; vo_[1] = arNp[2 * (h) + 1]; } PG8_STAGE(bufoff, gbase, vo_); } \
        else { PG8_STAGE(bufoff, (gbase) + (h) * hstep, voffA); } } while (0)
    typedef int pg8_v4i __attribute__((ext_vector_type(4))); typedef int pg8_v8i __attribute__((ext_vector_type(8)));
#define PG8_LDA(dst, b, h) do { _Pragma("unroll") for (int m = 0; m < 4; ++m) { if (FP8) { const pg8_v4i l_ = *(const PG8_LAS pg8_v4i*)(lds + PG8_SA(b, h) + aoff + m * 2048), h_ = *(const PG8_LAS pg8_v4i*)(lds + PG8_SA(b, h) + aoff + m * 2048 + 1024); \
            dst##8[m] = __builtin_shufflevector(l_, h_, 0, 1, 2, 3, 4, 5, 6, 7); } \
        else { _Pragma("unroll") for (int k = 0; k < 2; ++k) dst[m][k] = *(const PG8_LAS bf16x8*)(lds + PG8_SA(b, h) + aoff + m * 2048 + k * 1024); } } } while (0)
#define PG8_LDB(dst, b, h) do { _Pragma("unroll") for (int n = 0; n < 2; ++n) { if (FP8) { const pg8_v4i l_ = *(const PG8_LAS pg8_v4i*)(lds + PG8_SB(b, h) + boff + n * 2048), h_ = *(const PG8_LAS pg8_v4i*)(lds + PG8_SB(b, h) + boff + n * 2048 + 1024); \
            dst##8[n] = __builtin_shufflevector(l_, h_, 0, 1, 2, 3, 4, 5, 6, 7); } \
        else { _Pragma("unroll") for (int k = 0; k < 2; ++k) dst[n][k] = *(const PG8_LAS bf16x8*)(lds + PG8_SB(b, h) + boff + n * 2048 + k * 1024); } } } while (0)
#define PG8_MMA(ai, bj, At, Bt) do { __builtin_amdgcn_s_setprio(1); _Pragma("unroll") for (int m = 0; m < 4; ++m) _Pragma("unroll") for (int n = 0; n < 2; ++n) { \
        if (FP8) { acc[ai][bj][m][n] = __builtin_amdgcn_mfma_scale_f32_16x16x128_f8f6f4(Bt##8[n], At##8[m], acc[ai][bj][m][n], 0, 0, 0, 0x7f7f7f7f, 0, 0x7f7f7f7f); } \
        else { _Pragma("unroll") for (int k = 0; k < 2; ++k) acc[ai][bj][m][n] = __builtin_amdgcn_mfma_f32_16x16x32_bf16(Bt[n][k], At[m][k], acc[ai][bj][m][n], 0, 0, 0); } } \
        if (FP8) asm volatile("" : "+v"(acc[ai][bj][0][0]), "+v"(acc[ai][bj][0][1]), "+v"(acc[ai][bj][1][0]), "+v"(acc[ai][bj][1][1]), "+v"(acc[ai][bj][2][0]), "+v"(acc[ai][bj][2][1]), "+v"(acc[ai][bj][3][0]), "+v"(acc[ai][bj][3][1]));     \
        __builtin_amdgcn_s_setprio(0); } while (0)
#define PG8_WAIT_V(n) asm volatile("s_waitcnt vmcnt(" #n ")" ::: "memory")
#define PG8_WAIT_L(n) asm volatile("s_waitcnt lgkmcnt(" #n ")" ::: "memory")
#define PG8_BAR __builtin_amdgcn_s_barrier()
#define PG8_SCHED __builtin_amdgcn_sched_barrier(0)
    Unit cur, nxt; int ui = 0;
    if (!S.next(0, cur)) return;
    f32x4 acc[2][2][4][2];
#pragma unroll
    for (int a = 0; a < 2; ++a)
#pragma unroll
        for (int b = 0; b < 2; ++b)
#pragma unroll
            for (int m = 0; m < 4; ++m)
#pragma unroll
                for (int n = 0; n < 2; ++n) acc[a][b][m][n] = (f32x4){0.f, 0.f, 0.f, 0.f};
    bf16x8 At[4][2], B0[2][2], B1[2][2]; pg8_v8i At8[4], B08[2], B18[2];
    const char* cA = (const char*)g.A + (GATHER ? (size_t)0 : (size_t)cur.pm * tstep); const char* cB = (const char*)g.Bt + (size_t)cur.bt * tstep;
    S.a_ready(cur);
    if (GATHER) { PG8_GROWS(arC, cur.ab); }
    PG8_STAGE(PG8_SB(0, 0), cB, voffB); PG8_STAGE(PG8_SB(0, 1), cB + hstep, voffB); PG8_STAGEA(PG8_SA(0, 0), cA, 0, false); PG8_STAGEA(PG8_SA(0, 1), cA, 1, false);
    if (wr == 1) PG8_BAR;
    PG8_WAIT_V(2); PG8_BAR;
    PG8_STAGE(PG8_SB(1, 0), cB + kstep, voffB); PG8_STAGEA(PG8_SA(1, 0), cA + kstep, 0, false); PG8_STAGE(PG8_SB(1, 1), cB + hstep + kstep, voffB);
    PG8_WAIT_V(6); PG8_BAR;
    for (;;) {
        const bool has_next = S.next(ui + 1, nxt);
        const char* nA = (has_next && !GATHER) ? (const char*)g.A + (size_t)nxt.pm * tstep : cA; const char* nB = has_next ? (const char*)g.Bt + (size_t)nxt.bt * tstep : cB;
        if (GATHER && has_next) { unsigned tn_[2][2]; PG8_GROWS(tn_, nxt.ab); arNp[0] = tn_[0][0]; arNp[1] = tn_[0][1]; arNp[2] = tn_[1][0]; arNp[3] = tn_[1][1]; }
#pragma unroll 1
        for (int t = 0; t < nt; t += 2) {
            const bool last = (t == nt - 2);
            const char* a1 = cA + (size_t)(t + 1) * kstep;
            const char* a2 = last ? nA : cA + (size_t)(t + 2) * kstep; const char* b2 = last ? nB : cB + (size_t)(t + 2) * kstep;
            const char* a3 = a2 + kstep; const char* b3 = b2 + kstep;
            const bool isn = last && has_next;
            if (isn) S.a_ready(nxt);
            PG8_LDB(B0, 0, 0); PG8_LDB(B1, 0, 1); PG8_SCHED; PG8_LDA(At, 0, 0); PG8_STAGEA(PG8_SA(1, 1), a1, 1, false);
            PG8_WAIT_V(8); PG8_WAIT_L(0); PG8_BAR; PG8_MMA(0, 0, At, B0); PG8_MMA(0, 1, At, B1); PG8_BAR; PG8_SCHED;
            PG8_LDA(At, 0, 1); PG8_STAGE(PG8_SB(0, 0), b2, voffB); PG8_STAGE(PG8_SB(0, 1), b2 + hstep, voffB); PG8_STAGEA(PG8_SA(0, 0), a2, 0, isn);
            PG8_WAIT_V(8); PG8_WAIT_L(0); PG8_BAR; PG8_MMA(1, 0, At, B0); PG8_MMA(1, 1, At, B1); PG8_BAR; PG8_SCHED;
            PG8_LDB(B0, 1, 0); PG8_LDB(B1, 1, 1); PG8_SCHED; PG8_LDA(At, 1, 0); PG8_STAGEA(PG8_SA(0, 1), a2, 1, isn);
            PG8_WAIT_V(8); PG8_WAIT_L(0); PG8_BAR; PG8_MMA(0, 0, At, B0); PG8_MMA(0, 1, At, B1); PG8_BAR; PG8_SCHED;
            PG8_LDA(At, 1, 1); PG8_STAGE(PG8_SB(1, 0), b3, voffB); PG8_STAGE(PG8_SB(1, 1), b3 + hstep, voffB); PG8_STAGEA(PG8_SA(1, 0), a3, 0, isn);
            PG8_WAIT_V(8); PG8_WAIT_L(0); PG8_BAR; PG8_MMA(1, 0, At, B0); PG8_MMA(1, 1, At, B1); PG8_BAR; PG8_SCHED;
        }
        if (wr == 0) PG8_BAR;
        { unsigned z_ = 0u; asm volatile("" : "+s"(z_)); const int ln2 = (int)__builtin_amdgcn_mbcnt_hi(~0u, __builtin_amdgcn_mbcnt_lo(~0u, z_));
          E(acc, cur, wr, wc, ln2 & 15, ln2 >> 4); }
        S.done(cur);
        if (!has_next) break;
#pragma unroll
        for (int a = 0; a < 2; ++a)
#pragma unroll
            for (int b = 0; b < 2; ++b)
#pragma unroll
                for (int m = 0; m < 4; ++m)
#pragma unroll
                    for (int n = 0; n < 2; ++n) acc[a][b][m][n] = (f32x4){0.f, 0.f, 0.f, 0.f};
        cur = nxt; cA = nA; cB = nB; ++ui;
        if (GATHER) { arC[0][0] = arNp[0]; arC[0][1] = arNp[1]; arC[1][0] = arNp[2]; arC[1][1] = arNp[3]; }
        if (wr == 1) PG8_BAR;
    }
    PG8_WAIT_V(0);
    PG8_BAR;
#undef PG8_SA
#undef PG8_SB
#undef PG8_STAGE
#undef PG8_STAGEA
#undef PG8_GROWS
#undef PG8_LDA
#undef PG8_LDB
#undef PG8_MMA
#undef PG8_WAIT_V
#undef PG8_WAIT_L
#undef PG8_BAR
#undef PG8_SCHED
}
}

template <bool F8> struct EpiProj {
    static constexpr bool PERM = true;
    bf16_t* O; bf16_t* LR; const float* gq; const float* gk; const float* cosT; const float* sinT; float* kpart;
    __device__ __forceinline__ void operator()(const f32x4 (&acc)[2][2][4][2], const pg8::Unit& u, int wr, int wc, int fr, int fq) const {
        const int row0 = u.pm * 256 + wr * 64 + fr;
        constexpr float SC = F8 ? 0.03125f : 1.0f;
        if (F8 && u.pn >= 3 && u.pn <= 6) {
            const bool isk = u.pn >= 5; const int hh = 4 * ((u.pn - 3) & 1) + wc;
            const float* g = isk ? gk : gq;
            float gg[2][8];
#pragma unroll
            for (int bj = 0; bj < 2; ++bj)
#pragma unroll
                for (int e = 0; e < 8; ++e) gg[bj][e] = g[32 * bj + 8 * fq + e];
            float ks[2][8];
#pragma unroll
            for (int bj = 0; bj < 2; ++bj)
#pragma unroll
                for (int e = 0; e < 8; ++e) ks[bj][e] = 0.f;
            bf16_t* obase = O + (isk ? C_BK : C_BQ) + 64 * hh + 8 * fq;
#pragma unroll
            for (int ai = 0; ai < 2; ++ai)
#pragma unroll
                for (int m = 0; m < 4; ++m) {
                    const int row = row0 + ai * 128 + m * 16; const int pos = row & (SEQ - 1);
                    float v[2][8]; float ss = 0.f;
#pragma unroll
                    for (int bj = 0; bj < 2; ++bj)
#pragma unroll
                        for (int n = 0; n < 2; ++n)
#pragma unroll
                            for (int j = 0; j < 4; ++j) { const float x = acc[ai][bj][m][n][j] * SC; v[bj][4 * n + j] = x; ss += x * x; }
                    ss += __shfl_xor(ss, 16); ss += __shfl_xor(ss, 32);
                    const float rstd = rsqrtf(ss * (1.f / 64.f) + EPS);
#pragma unroll
                    for (int bj = 0; bj < 2; ++bj)
#pragma unroll
                        for (int e = 0; e < 8; ++e) v[bj][e] = v[bj][e] * rstd * gg[bj][e];
                    { const f32x4 c0 = *(const f32x4*)(cosT + pos * 8), c1 = *(const f32x4*)(cosT + pos * 8 + 4), s0 = *(const f32x4*)(sinT + pos * 8), s1 = *(const f32x4*)(sinT + pos * 8 + 4);
                      const float cs[8] = {c0.x, c0.y, c0.z, c0.w, c1.x, c1.y, c1.z, c1.w}, sn[8] = {s0.x, s0.y, s0.z, s0.w, s1.x, s1.y, s1.z, s1.w};
#pragma unroll
                      for (int e = 0; e < 8; ++e) { const float other = __shfl_xor(v[0][e], 16);
                          if (fq == 0) v[0][e] = v[0][e] * cs[e] - other * sn[e]; else if (fq == 1) v[0][e] = v[0][e] * cs[e] + other * sn[e]; } }
                    if (isk) {
#pragma unroll
                        for (int bj = 0; bj < 2; ++bj)
#pragma unroll
                            for (int e = 0; e < 8; ++e) ks[bj][e] += v[bj][e];
                    } else {
#pragma unroll
                        for (int bj = 0; bj < 2; ++bj)
#pragma unroll
                            for (int e = 0; e < 8; ++e) v[bj][e] *= (0.125f * LOG2E);
                    }
#pragma unroll
                    for (int bj = 0; bj < 2; ++bj) { u32x4 w; w.x = cvtpk(v[bj][0], v[bj][1]); w.y = cvtpk(v[bj][2], v[bj][3]); w.z = cvtpk(v[bj][4], v[bj][5]); w.w = cvtpk(v[bj][6], v[bj][7]);
                        *(u32x4*)(obase + (size_t)row * PP + 32 * bj) = w; }
                }
            if (isk) {
#pragma unroll
                for (int bj = 0; bj < 2; ++bj)
#pragma unroll
                    for (int e = 0; e < 8; ++e) { float s = ks[bj][e]; s += __shfl_xor(s, 1); s += __shfl_xor(s, 2); s += __shfl_xor(s, 4); s += __shfl_xor(s, 8); ks[bj][e] = s; }
                if (fr == 0) { float* kp = kpart + ((size_t)u.pm * 2 + wr) * 512 + 64 * hh + 8 * fq;
#pragma unroll
                    for (int bj = 0; bj < 2; ++bj) { *(f32x4*)(kp + 32 * bj) = (f32x4){ks[bj][0], ks[bj][1], ks[bj][2], ks[bj][3]}; *(f32x4*)(kp + 32 * bj + 4) = (f32x4){ks[bj][4], ks[bj][5], ks[bj][6], ks[bj][7]}; } }
            }
        } else if (u.pn < 13) {
            const int col0 = u.pn * 256 + wc * 32 + 8 * fq;
#pragma unroll
            for (int ai = 0; ai < 2; ++ai)
#pragma unroll
                for (int m = 0; m < 4; ++m) { bf16_t* rowp = O + (size_t)(row0 + ai * 128 + m * 16) * PP + col0;
#pragma unroll
                    for (int bj = 0; bj < 2; ++bj) { const f32x4 v0 = acc[ai][bj][m][0] * SC, v1 = acc[ai][bj][m][1] * SC;
                        u32x4 w; w.x = cvtpk(v0[0], v0[1]); w.y = cvtpk(v0[2], v0[3]); w.z = cvtpk(v1[0], v1[1]); w.w = cvtpk(v1[2], v1[3]);
                        *(u32x4*)(rowp + bj * 128) = w; } }
        } else if (F8 && wc == 0 && fq < 2) {
#pragma unroll
            for (int ai = 0; ai < 2; ++ai)
#pragma unroll
                for (int m = 0; m < 4; ++m) { const f32x4 v0 = acc[ai][0][m][0] * SC, v1 = acc[ai][0][m][1] * SC;
                    u32x4 w; w.x = cvtpk(v0[0], v0[1]); w.y = cvtpk(v0[2], v0[3]); w.z = cvtpk(v1[0], v1[1]); w.w = cvtpk(v1[2], v1[3]);
                    *(u32x4*)(LR + (size_t)(row0 + ai * 128 + m * 16) * 16 + 8 * fq) = w; }
        }
    }
};
struct EpiResid {
    static constexpr bool PERM = false;
    const float* base; bf16_t* out; const bf16_t* base16;
    __device__ __forceinline__ void operator()(const f32x4 (&acc)[2][2][4][2], const pg8::Unit& u, int wr, int wc, int fr, int fq) const {
        const int row0 = u.pm * 256 + wr * 64 + fr, col0 = u.pn * 256 + wc * 32 + 4 * fq;
#pragma unroll
        for (int ai = 0; ai < 2; ++ai)
#pragma unroll
            for (int m = 0; m < 4; ++m) { const size_t off = (size_t)(row0 + ai * 128 + m * 16) * DM + col0;
#pragma unroll
                for (int bj = 0; bj < 2; ++bj)
#pragma unroll
                    for (int n = 0; n < 2; ++n) { f32x4 bs;
                        if (base16) { const u32x2 bw = *(const u32x2*)(base16 + off + bj * 128 + n * 16); bs = (f32x4){bflo(bw.x), bfhi(bw.x), bflo(bw.y), bfhi(bw.y)}; }
                        else bs = *(const f32x4*)(base + off + bj * 128 + n * 16);
                        const f32x4 r = bs + acc[ai][bj][m][n];
                        u32x2 w; w.x = cvtpk(r.x, r.y); w.y = cvtpk(r.z, r.w); *(u32x2*)(out + off + bj * 128 + n * 16) = w; } }
    }
};
struct EpiSwiglu {
    static constexpr bool PERM = true;
    bf16_t* H;
    __device__ __forceinline__ void operator()(const f32x4 (&acc)[2][2][4][2], const pg8::Unit& u, int wr, int wc, int fr, int fq) const {
        const int row0 = u.pm * 256 + wr * 64 + fr, col0 = u.pn * 128 + wc * 32 + 8 * fq;
#pragma unroll
        for (int ai = 0; ai < 2; ++ai)
#pragma unroll
            for (int m = 0; m < 4; ++m) { float o[8];
#pragma unroll
                for (int n = 0; n < 2; ++n)
#pragma unroll
                    for (int j = 0; j < 4; ++j) { const float gt = acc[ai][0][m][n][j] * 0.03125f, up = acc[ai][1][m][n][j] * 0.03125f; o[n * 4 + j] = gt * sigmoidf_(gt) * up; }
                int p0 = 0, p1 = 0;
                p0 = __builtin_amdgcn_cvt_pk_fp8_f32(o[0], o[1], p0, false); p0 = __builtin_amdgcn_cvt_pk_fp8_f32(o[2], o[3], p0, true);
                p1 = __builtin_amdgcn_cvt_pk_fp8_f32(o[4], o[5], p1, false); p1 = __builtin_amdgcn_cvt_pk_fp8_f32(o[6], o[7], p1, true);
                *(u32x2*)((unsigned char*)H + (size_t)(row0 + ai * 128 + m * 16) * FF + col0) = (u32x2){(unsigned)p0, (unsigned)p1}; }
    }
};
struct EpiDown {
    static constexpr bool PERM = true;
    bf16_t* Y; const float* slotw;
    __device__ __forceinline__ void operator()(const f32x4 (&acc)[2][2][4][2], const pg8::Unit& u, int wr, int wc, int fr, int fq) const {
        const int row0 = u.pm * 256 + wr * 64 + fr, col0 = u.pn * 256 + wc * 32 + 8 * fq;
#pragma unroll
        for (int ai = 0; ai < 2; ++ai)
#pragma unroll
            for (int m = 0; m < 4; ++m) { const int row = row0 + ai * 128 + m * 16; const float sw = slotw[u.ab * 256 + (row - u.pm * 256)] * 0.03125f; bf16_t* rowp = Y + (size_t)row * DM + col0;
#pragma unroll
                for (int bj = 0; bj < 2; ++bj) { const f32x4 v0 = acc[ai][bj][m][0] * sw, v1 = acc[ai][bj][m][1] * sw;
                    u32x4 w; w.x = cvtpk(v0[0], v0[1]); w.y = cvtpk(v0[2], v0[3]); w.z = cvtpk(v1[0], v1[1]); w.w = cvtpk(v1[2], v1[3]);
                    *(u32x4*)(rowp + bj * 128) = w; } }
    }
};

struct Args { const float* in[17]; float* out; unsigned char* ws; int ph_lo, ph_hi; };
static_assert(offsetof(Args, out) == 136 && offsetof(Args, ws) == 144 && sizeof(Args) == 160, "kernarg layout");
struct Ctx {
    LAS unsigned char* lds; const __attribute__((address_space(4))) unsigned char* ka;
    int wave, G, vcu, gw, NGW, bx;
    __device__ __forceinline__ int lane() const { unsigned z_ = 0u; asm volatile("" : "+s"(z_)); return (int)__builtin_amdgcn_mbcnt_hi(~0u, __builtin_amdgcn_mbcnt_lo(~0u, z_)); }
    __device__ __forceinline__ int tid() const { return wave * 64 + lane(); }
#define CTX_IN(name, idx) __device__ __forceinline__ const float* name() const { return *(const float* const __attribute__((address_space(4)))*)(ka + 8 * (idx)); }
    CTX_IN(x, 0) CTX_IN(attn_g, 1) CTX_IN(w_in, 2) CTX_IN(gk_w2, 3) CTX_IN(gk_b, 4) CTX_IN(gla_g, 5) CTX_IN(qn_g, 6) CTX_IN(kn_g, 7) CTX_IN(lb_param, 8) CTX_IN(hgrn_g, 9)
    CTX_IN(w_out, 10) CTX_IN(ffn_g, 11) CTX_IN(w_rg, 12) CTX_IN(w_re, 13) CTX_IN(w_eg, 14) CTX_IN(w_eu, 15) CTX_IN(w_ed, 16)
#define CTX_WS(type, name, off) __device__ __forceinline__ type* name() const { return (type*)(*(unsigned char* const __attribute__((address_space(4)))*)(ka + 144) + (off)); }
    __device__ __forceinline__ float* out() const { return *(float* const __attribute__((address_space(4)))*)(ka + 136); }
    CTX_WS(unsigned, ctl, WS_CTL) CTX_WS(float, cosT, SM_COS) CTX_WS(float, sinT, SM_SIN) CTX_WS(bf16_t, lr, SM_LR) CTX_WS(float, kpart, SM_KPART) CTX_WS(float, decay, SM_DECAY)
    CTX_WS(unsigned, route, SM_ROUTE) CTX_WS(float, slotw, WS_SLOTW2) CTX_WS(bf16_t, x1b, WS_X1B) CTX_WS(unsigned, amap, WS_AMAP2) CTX_WS(bf16_t, win, WS_WIN) CTX_WS(bf16_t, wout, WS_WOUT) CTX_WS(bf16_t, wgu, WS_WGU) CTX_WS(bf16_t, wd, WS_WD) CTX_WS(unsigned char, h8, WS_H8)
    CTX_WS(bf16_t, proj, WS_PROJ) CTX_WS(bf16_t, st, WS_ST) CTX_WS(bf16_t, ab, WS_AB) CTX_WS(float, kvt, WS_AB) CTX_WS(bf16_t, aperm, WS_APERM) CTX_WS(bf16_t, hbuf, WS_H)
};

struct TrDesc { const float* W; bf16_t* WT; int ldw, col0, k0, K, drow0, nvalid, fp8; };
__device__ __forceinline__ void tr_load(const TrDesc& d, float (&tmp)[32], int lane) {
#pragma unroll
    for (int i = 0; i < 32; ++i) { const int kk = 2 * i + (lane >> 5); tmp[i] = __builtin_nontemporal_load(d.W + (size_t)(d.k0 + kk) * d.ldw + d.col0 + (lane & 31)); }
}
__device__ __forceinline__ void tr_finish(const TrDesc& d, const float (&tmp)[32], LAS float* scr, int lane) {
#pragma unroll
    for (int i = 0; i < 32; ++i) { const int kk = 2 * i + (lane >> 5); scr[kk * 33 + (lane & 31)] = tmp[i]; }
    asm volatile("s_waitcnt lgkmcnt(0)" ::: "memory");
    const int c = lane & 7;
    if (d.fp8) {
#pragma unroll
        for (int j = 0; j < 4; ++j) { const int n = (lane >> 3) + 8 * j; const LAS float* s = scr + (8 * c) * 33 + n;
            int p0 = 0, p1 = 0;
            p0 = __builtin_amdgcn_cvt_pk_fp8_f32(s[0 * 33] * 32.f, s[1 * 33] * 32.f, p0, false); p0 = __builtin_amdgcn_cvt_pk_fp8_f32(s[2 * 33] * 32.f, s[3 * 33] * 32.f, p0, true);
            p1 = __builtin_amdgcn_cvt_pk_fp8_f32(s[4 * 33] * 32.f, s[5 * 33] * 32.f, p1, false); p1 = __builtin_amdgcn_cvt_pk_fp8_f32(s[6 * 33] * 32.f, s[7 * 33] * 32.f, p1, true);
            if (n < d.nvalid) *(u32x2*)((unsigned char*)d.WT + (size_t)(d.drow0 + n) * d.K + d.k0 + 8 * c) = (u32x2){(unsigned)p0, (unsigned)p1}; }
    } else {
#pragma unroll
    for (int j = 0; j < 4; ++j) { const int n = (lane >> 3) + 8 * j; const LAS float* s = scr + (8 * c) * 33 + n;
        u32x4 o; o.x = cvtpk(s[0 * 33], s[1 * 33]); o.y = cvtpk(s[2 * 33], s[3 * 33]); o.z = cvtpk(s[4 * 33], s[5 * 33]); o.w = cvtpk(s[6 * 33], s[7 * 33]);
        if (n < d.nvalid) *(u32x4*)(d.WT + (size_t)(d.drow0 + n) * d.K + d.k0 + 8 * c) = o; }
    }
    asm volatile("s_waitcnt lgkmcnt(0)" ::: "memory");
}
constexpr int WC_PER_LAYER = 1664 + 16 + 512 + 16 * 768;
__device__ __forceinline__ TrDesc wconv_decode(const Ctx& X, int it) {
    const int l = it / WC_PER_LAYER; int r = it % WC_PER_LAYER;
    if (r < 1664) { const int kb = r / 104, nb = r % 104; const int col0 = nb < 24 ? 32 * nb : 784 + 32 * (nb - 24); int drow = nb < 24 ? 32 * nb : 768 + 32 * (nb - 24);
        if (drow >= C_BQ && drow < C_BV) {
            const int rel = drow - C_BQ, sec = rel >> 9, hh = (rel & 511) >> 6, dh = (rel & 63) >> 5;
            drow = C_BQ + sec * 512 + 256 * (hh >> 2) + 128 * dh + 32 * (hh & 3); }
        if (drow >= C_BQ && drow < C_CQ) return TrDesc{X.w_in() + (size_t)l * DM * IN_COLS, (bf16_t*)((unsigned char*)(X.win() + (size_t)l * NW_IN * DM) + (size_t)C_BQ * DM * 2), IN_COLS, col0, 64 * kb, DM, drow - C_BQ, 32, 1};
        if (drow >= C_AG && drow < C_BQ) return TrDesc{X.w_in() + (size_t)l * DM * IN_COLS, (bf16_t*)((unsigned char*)(X.win() + (size_t)l * NW_IN * DM) + (size_t)C_BQ * DM * 2), IN_COLS, col0, 64 * kb, DM, 1792 + drow - C_AG, 32, 1};
        return TrDesc{X.w_in() + (size_t)l * DM * IN_COLS, X.win() + (size_t)l * NW_IN * DM, IN_COLS, col0, 64 * kb, DM, drow, 32, 0}; }
    r -= 1664;
    if (r < 16) return TrDesc{X.w_in() + (size_t)l * DM * IN_COLS, (bf16_t*)((unsigned char*)(X.win() + (size_t)l * NW_IN * DM) + (size_t)C_BQ * DM * 2), IN_COLS, 768, 64 * r, DM, 1536, 16, 1};
    r -= 16;
    if (r < 512) { const int kb = r / 32, nb = r % 32; return TrDesc{X.w_out() + (size_t)l * DM * DM, X.wout() + (size_t)l * DM * DM, DM, 32 * nb, 64 * kb, DM, 32 * nb, 32, 0}; }
    r -= 512;
    const int e = r / 768, q = r % 768; const size_t le = (size_t)l * NEXP + e;
    if (q < 512) { const int up = q >= 256, qq = q & 255, kb = qq / 16, nb = qq % 16, col0 = 32 * nb;
        return TrDesc{(up ? X.w_eu() : X.w_eg()) + le * DM * FF, (bf16_t*)((unsigned char*)X.wgu() + le * DM * DM), FF, col0, 64 * kb, DM, 256 * (col0 / 128) + (col0 % 128) + (up ? 128 : 0), 32, 1}; }
    const int qq = q - 512, kb = qq / 32, nb = qq % 32;
    return TrDesc{X.w_ed() + le * FF * DM, (bf16_t*)((unsigned char*)X.wd() + le * DM * FF), DM, 32 * nb, 64 * kb, FF, 32 * nb, 32, 1};
}

__device__ __forceinline__ void row_load(const float* xrow, int lane, f32x4 (&v)[4]) {
    const f32x4* xr = (const f32x4*)xrow + lane;
#pragma unroll
    for (int j = 0; j < 4; ++j) v[j] = xr[64 * j];
}
__device__ __forceinline__ void row_load_bf16(const bf16_t* xrow, int lane, f32x4 (&v)[4]) {
    const u32x2* xr = (const u32x2*)xrow + lane;
#pragma unroll
    for (int j = 0; j < 4; ++j) { const u32x2 w = xr[64 * j]; v[j] = (f32x4){bflo(w.x), bfhi(w.x), bflo(w.y), bfhi(w.y)}; }
}
__device__ __forceinline__ void row_norm_store(f32x4 (&v)[4], const float* g, bf16_t* orow, unsigned char* orow8, int lane) {
    float s = 0.f;
#pragma unroll
    for (int j = 0; j < 4; ++j) s += (v[j].x * v[j].x + v[j].y * v[j].y) + (v[j].z * v[j].z + v[j].w * v[j].w);
    const float rstd = rsqrtf(wave_sum(s) * (1.f / DM) + EPS);
    const f32x4* gr = (const f32x4*)g + lane; u32x2* o8 = (u32x2*)orow + lane;
#pragma unroll
    for (int j = 0; j < 4; ++j) { const f32x4 gg = gr[64 * j]; v[j] = v[j] * rstd * gg; u32x2 w; w.x = cvtpk(v[j].x, v[j].y); w.y = cvtpk(v[j].z, v[j].w); o8[64 * j] = w;
        int p = 0; p = __builtin_amdgcn_cvt_pk_fp8_f32(v[j].x, v[j].y, p, false); p = __builtin_amdgcn_cvt_pk_fp8_f32(v[j].z, v[j].w, p, true); ((unsigned*)orow8)[64 * j + lane] = (unsigned)p; }
}

__device__ __forceinline__ void phase0(const Ctx& X) {
    LAS float* scr = (LAS float*)(X.lds + X.wave * 16384);
    {
        constexpr int NIT = DEPTH * WC_PER_LAYER; int it = X.gw; float cur[32], nxt[32]; TrDesc d, dn;
        if (it < NIT) { d = wconv_decode(X, it); tr_load(d, cur, X.lane()); }
        while (it < NIT) { const int nit = it + X.NGW; dn = d;
            if (nit < NIT) { dn = wconv_decode(X, nit); tr_load(dn, nxt, X.lane()); }
            __builtin_amdgcn_sched_barrier(0);
            tr_finish(d, cur, scr, X.lane());
#pragma unroll
            for (int i = 0; i < 32; ++i) cur[i] = nxt[i];
            d = dn; it = nit; }
    }
    { const int gt = X.gw * 64 + X.lane(), NT = X.NGW * 64;
      for (int i = gt; i < SEQ * 8; i += NT) { const int pos = i >> 3, f = i & 7;
          const float inv = exp2f(-(float)f * 0.125f * 18.931568569324174f);
          const float ang = (float)pos * inv;
          const double a = (double)ang; const double kx = __builtin_rint(a * 0.15915494309189535); const float red = (float)(a - kx * 6.283185307179586);
          X.cosT()[i] = __cosf(red); X.sinT()[i] = __sinf(red); } }
}
__device__ __forceinline__ void phase0b(const Ctx& X) {
    if (X.bx == 0) { for (int i = X.tid(); i < CW_BAR + 3456; i += 512) __hip_atomic_store(X.ctl() + i, 0u, __ATOMIC_RELAXED, __HIP_MEMORY_SCOPE_AGENT);
        if (X.tid() < 8 * DEPTH) __hip_atomic_store(X.ctl() + ecnt_idx(X.tid() >> 3, (X.tid() >> 1) & 3) + (X.tid() & 1), 0u, __ATOMIC_RELAXED, __HIP_MEMORY_SCOPE_AGENT); }
    {
        int m = X.gw; f32x4 cur[4], nxt[4];
        if (m < NTOK) row_load(X.x() + (size_t)m * DM, X.lane(), cur);
        for (; m < NTOK; m += X.NGW) { const int mn = m + X.NGW;
            if (mn < NTOK) row_load(X.x() + (size_t)mn * DM, X.lane(), nxt);
            row_norm_store(cur, X.attn_g(), X.ab() + (size_t)m * DM, X.h8() + (size_t)m * DM, X.lane());
#pragma unroll
            for (int j = 0; j < 4; ++j) cur[j] = nxt[j]; }
    }
}

__device__ __forceinline__ void moba_prep_item(const Ctx& X, int layer, int item) {
    const int part = item & 3, bb = item >> 2; const int lane = X.lane(), w = X.wave;
    const int tok0 = (bb >> 4) * SEQ + (bb & 15) * 256 + part * 64 + w * 8;
    const int sub = lane & 7;
    float gq[8], gk[8], ks[8];
#pragma unroll
    for (int j = 0; j < 8; ++j) { gq[j] = X.qn_g()[layer * 64 + sub * 8 + j]; gk[j] = X.kn_g()[layer * 64 + sub * 8 + j]; ks[j] = 0.f; }
    for (int t = 0; t < 8; ++t) {
        const int tok = tok0 + t, pos = tok & (SEQ - 1);
        float cs[8], sn[8];
#pragma unroll
        for (int j = 0; j < 8; ++j) { cs[j] = X.cosT()[pos * 8 + j]; sn[j] = X.sinT()[pos * 8 + j]; }
#pragma unroll
        for (int which = 0; which < 2; ++which) {
            bf16_t* p = X.proj() + (size_t)tok * PP + (which ? C_BK : C_BQ) + lane * 8;
            const u32x4 raw = *(const u32x4*)p; float v[8];
            v[0] = bflo(raw.x); v[1] = bfhi(raw.x); v[2] = bflo(raw.y); v[3] = bfhi(raw.y); v[4] = bflo(raw.z); v[5] = bfhi(raw.z); v[6] = bflo(raw.w); v[7] = bfhi(raw.w);
            float ss = 0.f;
#pragma unroll
            for (int j = 0; j < 8; ++j) ss += v[j] * v[j];
            ss += __shfl_xor(ss, 1); ss += __shfl_xor(ss, 2); ss += __shfl_xor(ss, 4);
            const float rstd = rsqrtf(ss * (1.f / 64.f) + EPS);
#pragma unroll
            for (int j = 0; j < 8; ++j) v[j] = v[j] * rstd * (which ? gk[j] : gq[j]);
#pragma unroll
            for (int j = 0; j < 8; ++j) { const float other = __shfl_xor(v[j], 1);
                if (sub == 0) v[j] = v[j] * cs[j] - other * sn[j]; else if (sub == 1) v[j] = v[j] * cs[j] + other * sn[j]; }
            if (which) {
#pragma unroll
                for (int j = 0; j < 8; ++j) ks[j] += v[j];
            } else {
#pragma unroll
                for (int j = 0; j < 8; ++j) v[j] *= (0.125f * LOG2E);
            }
            u32x4 o; o.x = cvtpk(v[0], v[1]); o.y = cvtpk(v[2], v[3]); o.z = cvtpk(v[4], v[5]); o.w = cvtpk(v[6], v[7]);
            *(u32x4*)p = o;
        }
    }
    LAS float* red = (LAS float*)X.lds;
#pragma unroll
    for (int j = 0; j < 8; ++j) red[w * 512 + lane * 8 + j] = ks[j];
    __syncthreads();
    { const int c = X.tid(); float s = 0.f;
#pragma unroll
      for (int ww = 0; ww < 8; ++ww) s += red[ww * 512 + c];
      X.kpart()[(size_t)item * 512 + c] = s; }
    __syncthreads();
}

template <int W> __device__ __forceinline__ void tile_load(const bf16_t* src, u32x4 (&r)[W / 8], int lane) {
    constexpr int LPR = W / 8, RPI = 64 / LPR;
#pragma unroll
    for (int i = 0; i < W / 8; ++i) r[i] = *(const u32x4*)(src + (size_t)(RPI * i + lane / LPR) * PP + (lane % LPR) * 8);
}
template <int W> __device__ __forceinline__ void tile_store(LAS unsigned char* reg, const u32x4 (&r)[W / 8], int lane) {
    constexpr int LPR = W / 8, RPI = 64 / LPR;
#pragma unroll
    for (int i = 0; i < W / 8; ++i) *(LAS u32x4*)(reg + (RPI * i + lane / LPR) * 144 + (lane % LPR) * 16) = r[i];
}
template <bool GLA, bool PHC>
__device__ __forceinline__ void lin_item(const Ctx& X, int layer, int b, int c, int h, LAS unsigned char* wl) {
    const int lane = X.lane(), r32 = lane & 31, hi = lane >> 5;
    const size_t row0 = (size_t)b * SEQ + (size_t)c * 64;
    const bf16_t* P = X.proj();
    constexpr int WK = GLA ? 32 : 64;
    const int fl = GLA ? (lane & 31) : lane;
    const int qcol0 = GLA ? (C_AQ + 32 * h) : (C_CQ + 64 * h);
    const int kcol0 = GLA ? (C_AK + 32 * h) : (C_CF + 64 * h);
    const int vcol0 = GLA ? (C_AV + 64 * h) : (C_CI + 64 * h);
    const float fv = (GLA && lane >= 32) ? 0.f : 1.f;
    LAS unsigned char* R0 = wl; LAS unsigned char* R1 = wl + 9216;
    u32x4 tv[8], tk[WK / 8], tq[WK / 8]; u32x4 lr0 = {}, lr1 = {};
    tile_load<64>(P + row0 * PP + vcol0, tv, lane);
    tile_load<WK>(P + row0 * PP + kcol0, tk, lane);
    if (PHC) tile_load<WK>(P + row0 * PP + qcol0, tq, lane);
    if (GLA) { lr0 = *(const u32x4*)(X.lr() + (row0 + lane) * 16); lr1 = *(const u32x4*)(X.lr() + (row0 + lane) * 16 + 8); }
    float w2[16]; float bias = 0.f, lb = 0.f;
    if (GLA) {
#pragma unroll
        for (int r = 0; r < 16; ++r) w2[r] = X.gk_w2()[(size_t)layer * 16 * 128 + r * 128 + 32 * h + fl];
        bias = X.gk_b()[layer * 128 + 32 * h + fl];
    } else {
#pragma unroll
        for (int r = 0; r < 16; ++r) w2[r] = 0.f;
        if (layer > 0) lb = sigmoidf_(X.lb_param()[256 + 64 * h + fl] - X.lb_param()[64 * h + fl]);
    }
    const int h8 = GLA ? h : 4 + h;
    const size_t sbase = (((size_t)b * 64 + c) * 8 + h8) * 4096;
    unsigned pvall[32];
    bf16x8 s0f[2][4];
    if (PHC) {
#pragma unroll
        for (int vi = 0; vi < 2; ++vi)
#pragma unroll
            for (int ks = 0; ks < 4; ++ks) s0f[vi][ks] = *(const bf16x8*)(X.st() + sbase + (size_t)(32 * vi + r32) * 64 + 16 * ks + 8 * hi);
        tile_store<64>(R0, tv, lane);
#pragma unroll
        for (int m = 0; m < 32; ++m) { const unsigned v0 = *(const LAS bf16_t*)(R0 + (2 * m) * 144 + lane * 2), v1 = *(const LAS bf16_t*)(R0 + (2 * m + 1) * 144 + lane * 2); pvall[m] = v0 | (v1 << 16); }
        asm volatile("s_waitcnt lgkmcnt(0)" ::: "memory");
        tile_store<WK>(R0, tq, lane); tile_store<WK>(R1, tk, lane);
    } else {
        tile_store<64>(R0, tv, lane); tile_store<WK>(R1, tk, lane);
    }
    float bsum = 0.f, eprod = 1.f;
    f32x16 g00 = {}, g01 = {}, g10 = {}, g11 = {};
    for (int s = 0; s < 4; ++s) {
        float kt[16], qt[16];
#pragma unroll
        for (int t = 0; t < 16; ++t) {
            const int tt = 16 * s + t;
            const float rawk = bf2f(*(const LAS bf16_t*)(R1 + tt * 144 + fl * 2));
            float qv = 0.f; if (PHC) qv = bf2f(*(const LAS bf16_t*)(R0 + tt * 144 + fl * 2));
            float a, kk;
            if (GLA) {
                float z = bias;
                { const unsigned u0 = (unsigned)__builtin_amdgcn_readlane((int)lr0.x, tt), u1 = (unsigned)__builtin_amdgcn_readlane((int)lr0.y, tt), u2 = (unsigned)__builtin_amdgcn_readlane((int)lr0.z, tt), u3 = (unsigned)__builtin_amdgcn_readlane((int)lr0.w, tt);
                  z += bflo(u0) * w2[0] + bfhi(u0) * w2[1] + bflo(u1) * w2[2] + bfhi(u1) * w2[3] + bflo(u2) * w2[4] + bfhi(u2) * w2[5] + bflo(u3) * w2[6] + bfhi(u3) * w2[7]; }
                { const unsigned u0 = (unsigned)__builtin_amdgcn_readlane((int)lr1.x, tt), u1 = (unsigned)__builtin_amdgcn_readlane((int)lr1.y, tt), u2 = (unsigned)__builtin_amdgcn_readlane((int)lr1.z, tt), u3 = (unsigned)__builtin_amdgcn_readlane((int)lr1.w, tt);
                  z += bflo(u0) * w2[8] + bfhi(u0) * w2[9] + bflo(u1) * w2[10] + bfhi(u1) * w2[11] + bflo(u2) * w2[12] + bfhi(u2) * w2[13] + bflo(u3) * w2[14] + bfhi(u3) * w2[15]; }
                a = (fminf(z, 0.f) - __logf(1.f + __expf(-fabsf(z)))) * (1.f / 16.f);
                kk = rawk; qv *= 0.17677669529663687f;
            } else {
                const float ef = __expf(-rawk), sg = 1.f / (1.f + ef);
                a = lb + (1.f - lb) * sg;
                kk = (1.f - lb) * (ef * sg);
                qv = qv * sigmoidf_(qv);
            }
            float eb, enb;
            if (GLA) { a *= fv; kk *= fv; qv *= fv; bsum += a; eb = __expf(bsum); enb = __expf(-bsum); }
            else { eprod *= a; eb = eprod; enb = __builtin_amdgcn_rcpf(eprod); }
            kt[t] = kk * enb; qt[t] = qv * eb;
        }
        if (PHC) {
#pragma unroll
            for (int t = 0; t < 16; ++t) {
                *(LAS bf16_t*)(R0 + (16 * s + t) * 144 + lane * 2) = (bf16_t)(cvtpk(qt[t], 0.f) & 0xffffu);
                *(LAS bf16_t*)(R1 + (16 * s + t) * 144 + lane * 2) = (bf16_t)(cvtpk(kt[t], 0.f) & 0xffffu);
            }
        } else {
            unsigned pk[8], pv[8];
#pragma unroll
            for (int m = 0; m < 8; ++m) { pk[m] = cvtpk(kt[2 * m], kt[2 * m + 1]);
                const unsigned v0 = *(const LAS bf16_t*)(R0 + (16 * s + 2 * m) * 144 + lane * 2), v1 = *(const LAS bf16_t*)(R0 + (16 * s + 2 * m + 1) * 144 + lane * 2); pv[m] = v0 | (v1 << 16); }
            u32x4 av0, av1, bk0, bk1;
#pragma unroll
            for (int m = 0; m < 4; ++m) {
                auto rv = __builtin_amdgcn_permlane32_swap(pv[m], pv[m + 4], false, false); av0[m] = rv[0]; av1[m] = rv[1];
                auto rk = __builtin_amdgcn_permlane32_swap(pk[m], pk[m + 4], false, false); bk0[m] = rk[0]; bk1[m] = rk[1];
            }
            const bf16x8 A0 = __builtin_bit_cast(bf16x8, av0), A1 = __builtin_bit_cast(bf16x8, av1), B0 = __builtin_bit_cast(bf16x8, bk0), B1 = __builtin_bit_cast(bf16x8, bk1);
            g00 = MFMA32(A0, B0, g00); g01 = MFMA32(A0, B1, g01); g10 = MFMA32(A1, B0, g10); g11 = MFMA32(A1, B1, g11);
        }
    }
    if (!PHC) {
        const float dec = GLA ? __expf(bsum) : eprod;
        X.decay()[(((size_t)b * 64 + c) * 8 + h8) * 64 + lane] = dec;
        const float d0 = __shfl(dec, r32), d1 = __shfl(dec, 32 + r32);
        float* kv = X.kvt() + sbase;
#pragma unroll
        for (int r = 0; r < 16; ++r) { const int v0 = crow(r, hi);
            kv[(size_t)v0 * 64 + r32] = g00[r] * d0; kv[(size_t)v0 * 64 + 32 + r32] = g01[r] * d1;
            kv[(size_t)(32 + v0) * 64 + r32] = g10[r] * d0; kv[(size_t)(32 + v0) * 64 + 32 + r32] = g11[r] * d1; }
        return;
    }
    if (PHC) {
        bf16x8 avp[2][4];
#pragma unroll
        for (int sg = 0; sg < 4; ++sg) {
            u32x4 f0, f1;
            auto r0 = __builtin_amdgcn_permlane32_swap(pvall[8 * sg + 0], pvall[8 * sg + 2], false, false); f0[0] = r0[0]; f1[0] = r0[1];
            auto r1 = __builtin_amdgcn_permlane32_swap(pvall[8 * sg + 1], pvall[8 * sg + 3], false, false); f0[1] = r1[0]; f1[1] = r1[1];
            auto r2 = __builtin_amdgcn_permlane32_swap(pvall[8 * sg + 4], pvall[8 * sg + 6], false, false); f0[2] = r2[0]; f1[2] = r2[1];
            auto r3 = __builtin_amdgcn_permlane32_swap(pvall[8 * sg + 5], pvall[8 * sg + 7], false, false); f0[3] = r3[0]; f1[3] = r3[1];
            avp[0][sg] = __builtin_bit_cast(bf16x8, f0); avp[1][sg] = __builtin_bit_cast(bf16x8, f1);
        }
        const LAS unsigned char* QT = wl; const LAS unsigned char* KT = wl + 9216;
        f32x16 o[2][2];
#pragma unroll
        for (int it = 0; it < 2; ++it) {
            bf16x8 bq[4];
#pragma unroll
            for (int ks = 0; ks < 4; ++ks) bq[ks] = *(const LAS bf16x8*)(QT + (32 * it + r32) * 144 + ks * 32 + hi * 16);
#pragma unroll
            for (int vi = 0; vi < 2; ++vi) { f32x16 acc = {};
#pragma unroll
                for (int ks = 0; ks < 4; ++ks) acc = MFMA32(s0f[vi][ks], bq[ks], acc);
                o[vi][it] = acc; }
#pragma unroll
            for (int jt = 0; jt <= it; ++jt) {
                f32x16 sc = {};
#pragma unroll
                for (int ks = 0; ks < 4; ++ks) { const bf16x8 ak = *(const LAS bf16x8*)(KT + (32 * jt + r32) * 144 + ks * 32 + hi * 16); sc = MFMA32(ak, bq[ks], sc); }
                if (jt == it) {
#pragma unroll
                    for (int r = 0; r < 16; ++r) if (crow(r, hi) > r32) sc[r] = 0.f;
                }
#pragma unroll
                for (int sp = 0; sp < 2; ++sp) {
                    u32x4 pw; pw.x = cvtpk(sc[8 * sp + 0], sc[8 * sp + 1]); pw.y = cvtpk(sc[8 * sp + 2], sc[8 * sp + 3]); pw.z = cvtpk(sc[8 * sp + 4], sc[8 * sp + 5]); pw.w = cvtpk(sc[8 * sp + 6], sc[8 * sp + 7]);
                    const bf16x8 pb = __builtin_bit_cast(bf16x8, pw);
                    o[0][it] = MFMA32(avp[0][2 * jt + sp], pb, o[0][it]); o[1][it] = MFMA32(avp[1][2 * jt + sp], pb, o[1][it]);
                }
            }
        }
        const float* ng = (GLA ? X.gla_g() : X.hgrn_g()) + layer * 64;
        const int gcol = GLA ? (C_AG + 64 * h) : (C_CG + 64 * h);
        const int mcol = GLA ? (64 * h) : (768 + 64 * h);
#pragma unroll
        for (int it = 0; it < 2; ++it) {
            float ss = 0.f;
#pragma unroll
            for (int vi = 0; vi < 2; ++vi)
#pragma unroll
                for (int r = 0; r < 16; ++r) ss += o[vi][it][r] * o[vi][it][r];
            ss += __shfl_xor(ss, 32);
            const float rstd = rsqrtf(ss * (1.f / 64.f) + EPS);
            const size_t row = row0 + 32 * it + r32;
#pragma unroll
            for (int vi = 0; vi < 2; ++vi)
#pragma unroll
                for (int g = 0; g < 4; ++g) { const int v0 = 32 * vi + 8 * g + 4 * hi;
                    const u32x2 gr = *(const u32x2*)(P + row * PP + gcol + v0);
                    const f32x4 gn = *(const f32x4*)(ng + v0);
                    const float g0 = bflo(gr.x), g1 = bfhi(gr.x), g2 = bflo(gr.y), g3 = bfhi(gr.y);
                    const float y0 = o[vi][it][4 * g + 0] * rstd * gn.x * (g0 * sigmoidf_(g0)), y1 = o[vi][it][4 * g + 1] * rstd * gn.y * (g1 * sigmoidf_(g1));
                    const float y2 = o[vi][it][4 * g + 2] * rstd * gn.z * (g2 * sigmoidf_(g2)), y3 = o[vi][it][4 * g + 3] * rstd * gn.w * (g3 * sigmoidf_(g3));
                    u32x2 w; w.x = cvtpk(y0, y1); w.y = cvtpk(y2, y3);
                    *(u32x2*)(X.ab() + row * DM + mcol + v0) = w; asm volatile("" ::: "memory"); }
        }
    }
}

__device__ __forceinline__ void scan_phase(const Ctx& X, int layer) {
    const int NTH = X.G * 512;
    for (int e = X.bx * 512 + X.tid(); e < NBATCH * 8 * 4096; e += NTH) {
        const int b = e >> 15, rem = e & 32767, h8 = rem >> 12, vk = rem & 4095, k = vk & 63;
        float S = 0.f;
        {
            float kv[64], dc[64];
            const float* kvp = X.kvt() + ((size_t)b * 64 * 8 + h8) * 4096 + vk; const float* dcp = X.decay() + ((size_t)b * 64 * 8 + h8) * 64 + k;
#pragma unroll
            for (int j = 0; j < 64; ++j) { kv[j] = kvp[(size_t)j * 8 * 4096]; dc[j] = dcp[(size_t)j * 8 * 64]; }
            __builtin_amdgcn_sched_barrier(0);
            bf16_t* stp = X.st() + ((size_t)b * 64 * 8 + h8) * 4096 + vk;
#pragma unroll
            for (int j = 0; j < 64; ++j) { stp[(size_t)j * 8 * 4096] = (bf16_t)(cvtpk(S, 0.f) & 0xffffu); S = dc[j] * S + kv[j]; }
        }
    }
    asm volatile("s_waitcnt vmcnt(0)" ::: "memory");
    __syncthreads();
    if (X.tid() == 0) { __builtin_amdgcn_fence(__ATOMIC_RELEASE, "agent"); __hip_atomic_fetch_add(X.ctl() + 64 + layer, 1u, __ATOMIC_RELAXED, __HIP_MEMORY_SCOPE_AGENT); }
}
__device__ __forceinline__ void scan_wait(const Ctx& X, int layer) {
    if (X.tid() == 0) { unsigned sp = 0;
        while (__hip_atomic_load(X.ctl() + 64 + layer, __ATOMIC_RELAXED, __HIP_MEMORY_SCOPE_AGENT) < (unsigned)X.G) { __builtin_amdgcn_s_sleep(2); if (++sp > (1u << 24)) break; }
        __builtin_amdgcn_fence(__ATOMIC_ACQUIRE, "agent"); }
    __syncthreads();
    __builtin_amdgcn_fence(__ATOMIC_ACQUIRE, "workgroup");
}

constexpr int AT_KS = 0, AT_WL = 4096, AT_RING = 8192, AT_SLOT = 16384, AT_NSLOT = 8;
static_assert(AT_RING + AT_NSLOT * AT_SLOT <= MISC_OFF, "attention ring");
__device__ __forceinline__ s16x4 vtr(const LAS unsigned char* p) { typedef short v4i16_t __attribute__((ext_vector_type(4))); return __builtin_bit_cast(s16x4, __builtin_amdgcn_ds_read_tr16_b64_v4i16((LAS v4i16_t*)p)); }
#define AT_WAITBAR(N) asm volatile("s_waitcnt vmcnt(" #N ") lgkmcnt(0)\n\ts_barrier" ::: "memory")
__device__ __forceinline__ void at_kload(bf16x8 (&kf)[8], const LAS unsigned char* Kb, int r32, int hi) {
#pragma unroll
    for (int d0 = 0; d0 < 4; ++d0) { kf[2 * d0] = *(const LAS bf16x8*)(Kb + (2 * d0 + hi) * 1024 + r32 * 16); kf[2 * d0 + 1] = *(const LAS bf16x8*)(Kb + (2 * d0 + hi) * 1024 + (32 + r32) * 16); }
}
template <bool OWN, bool HN1, int TT>
__device__ __forceinline__ void attn_tile(f32x16& pc0, f32x16& pc1, f32x16& pn0, f32x16& pn1, f32x16& o0, f32x16& o1, f32x16& o2, const f32x16& bvec, bf16x8 (&kf)[8], const bf16x8 (&qr)[4],
                                          const LAS unsigned char* Vb, const LAS unsigned char* Kn1, int vpo, int r32, int hi, int qh) {
    if (HN1) at_kload(kf, Kn1, r32, hi);
    s16x4 vl[4], vh[4];
#pragma unroll
    for (int i = 0; i < 4; ++i) { vl[i] = vtr(Vb + vpo + i * 1024); vh[i] = vtr(Vb + vpo + i * 1024 + 512); }
    __builtin_amdgcn_sched_barrier(0);
#pragma unroll
    for (int d0 = 0; d0 < 4; ++d0) {
#pragma unroll
        for (int r = 4 * d0; r < 4 * d0 + 4; ++r) pc0[r] = __builtin_amdgcn_exp2f(pc0[r]);
        if (HN1) pn0 = MFMA32(kf[2 * d0], qr[d0], d0 == 0 ? bvec : pn0);
#pragma unroll
        for (int r = 4 * d0; r < 4 * d0 + 4; ++r) pc1[r] = __builtin_amdgcn_exp2f(pc1[r]);
        if (HN1) pn1 = MFMA32(kf[2 * d0 + 1], qr[d0], d0 == 0 ? bvec : pn1);
    }
    if (OWN) {
#pragma unroll
        for (int r = 0; r < 16; ++r) { const int kc = 64 * TT + (r & 3) + 8 * (r >> 2);
            pc0[r] = (kc > qh) ? 0.f : pc0[r]; pc1[r] = (kc + 32 > qh) ? 0.f : pc1[r]; }
    }
    s16x4 wl_[4], wh_[4];
#pragma unroll
    for (int i = 0; i < 4; ++i) { wl_[i] = vtr(Vb + vpo + 4096 + i * 1024); wh_[i] = vtr(Vb + vpo + 4096 + i * 1024 + 512); }
    __builtin_amdgcn_sched_barrier(0);
    bf16x8 pa[4];
#pragma unroll
    for (int s = 0; s < 2; ++s) {
        u32x4 w0; w0.x = cvtpk(pc0[8 * s + 0], pc0[8 * s + 1]); w0.y = cvtpk(pc0[8 * s + 2], pc0[8 * s + 3]); w0.z = cvtpk(pc0[8 * s + 4], pc0[8 * s + 5]); w0.w = cvtpk(pc0[8 * s + 6], pc0[8 * s + 7]);
        u32x4 w1; w1.x = cvtpk(pc1[8 * s + 0], pc1[8 * s + 1]); w1.y = cvtpk(pc1[8 * s + 2], pc1[8 * s + 3]); w1.z = cvtpk(pc1[8 * s + 4], pc1[8 * s + 5]); w1.w = cvtpk(pc1[8 * s + 6], pc1[8 * s + 7]);
        pa[s] = __builtin_bit_cast(bf16x8, w0); pa[2 + s] = __builtin_bit_cast(bf16x8, w1);
    }
    const bf16x8 ones = (bf16x8){0x3f80, 0x3f80, 0x3f80, 0x3f80, 0x3f80, 0x3f80, 0x3f80, 0x3f80};
#pragma unroll
    for (int ks = 0; ks < 4; ++ks) { const bf16x8 vb0 = (bf16x8){vl[ks][0], vl[ks][1], vl[ks][2], vl[ks][3], vh[ks][0], vh[ks][1], vh[ks][2], vh[ks][3]}; o0 = MFMA32(pa[ks], vb0, o0); o2 = MFMA32(pa[ks], ones, o2); }
#pragma unroll
    for (int ks = 0; ks < 4; ++ks) { const bf16x8 vb1 = (bf16x8){wl_[ks][0], wl_[ks][1], wl_[ks][2], wl_[ks][3], wh_[ks][0], wh_[ks][1], wh_[ks][2], wh_[ks][3]}; o1 = MFMA32(pa[ks], vb1, o1); }
}
__device__ __forceinline__ void attn_unit(const Ctx& X, int layer, int b, int h, int qi) {
    int lane_ = X.lane(), wid_ = X.wave; asm volatile("" : "+v"(lane_), "+s"(wid_));
    const int lane = lane_, wid = wid_, tid = wid * 64 + lane, r32 = lane & 31, hi = lane >> 5;
    LAS unsigned char* lds = X.lds;
    const bf16_t* P = X.proj();
    const size_t rowbase = (size_t)b * SEQ;
    const size_t qrow = rowbase + 256 * qi + 32 * wid + r32;
    float gqm = fabsf(X.qn_g()[layer * 64 + lane]), gkm = fabsf(X.kn_g()[layer * 64 + lane]);
    gqm = wave_max(gqm); gkm = wave_max(gkm);
    const float negM = -(8.3f * gqm * gkm * LOG2E);
    bf16x8 qr[4];
#pragma unroll
    for (int d0 = 0; d0 < 4; ++d0) qr[d0] = *(const bf16x8*)(P + qrow * PP + C_BQ + 64 * h + 16 * d0 + 8 * hi);
    {
        LAS float* ks = (LAS float*)(lds + AT_KS);
#pragma unroll
        for (int e = 0; e < 2; ++e) { const int idx = tid * 2 + e, n = idx >> 6, d = idx & 63; float s = 0.f;
#pragma unroll
            for (int p = 0; p < 2; ++p) s += X.kpart()[((size_t)(b * 16 + n) * 2 + p) * 512 + 64 * h + d];
            ks[idx] = s; }
    }
    __syncthreads();
    const unsigned kgo = (unsigned)(((rowbase + lane) * PP + C_BK + 64 * h + 8 * wid) * 2);
    const unsigned vgo = (unsigned)(((rowbase + 16 * (wid & 3) + (lane >> 2)) * PP + C_BV + 64 * h + (wid >> 2) * 32 + (lane & 3) * 8) * 2);
    const unsigned lds0 = (unsigned)(uintptr_t)lds;
#define AT_ISSUE(t) do { const unsigned sl_ = (unsigned)__builtin_amdgcn_readfirstlane((int)(lds0 + AT_RING + ((t) & (AT_NSLOT - 1)) * AT_SLOT + wid * 1024)); \
        glds16(P, kgo + (unsigned)(t) * (64u * PP * 2u), sl_); glds16(P, vgo + (unsigned)(t) * (64u * PP * 2u), sl_ + 8192u); } while (0)
#define AT_SLOTP(t) (lds + AT_RING + ((t) & (AT_NSLOT - 1)) * AT_SLOT)
    const int T = 4 * (qi + 1);
    AT_ISSUE(0); AT_ISSUE(1); AT_ISSUE(2); AT_ISSUE(3);
    unsigned sel = 0u;
    if (qi <= 3) sel = (1u << qi) - 1u;
    else {
        float qf[32];
#pragma unroll
        for (int d0 = 0; d0 < 4; ++d0) { const u32x4 w = __builtin_bit_cast(u32x4, qr[d0]);
            qf[8 * d0 + 0] = bflo(w.x); qf[8 * d0 + 1] = bfhi(w.x); qf[8 * d0 + 2] = bflo(w.y); qf[8 * d0 + 3] = bfhi(w.y);
            qf[8 * d0 + 4] = bflo(w.z); qf[8 * d0 + 5] = bfhi(w.z); qf[8 * d0 + 6] = bflo(w.w); qf[8 * d0 + 7] = bfhi(w.w); }
        float gt[15];
        const LAS float* ks = (const LAS float*)(lds + AT_KS);
#pragma unroll
        for (int n = 0; n < 15; ++n) {
            float s = 0.f;
            if (n < qi) {
#pragma unroll
                for (int d0 = 0; d0 < 4; ++d0) { const f32x4 k0 = *(const LAS f32x4*)(ks + n * 64 + 16 * d0 + 8 * hi), k1 = *(const LAS f32x4*)(ks + n * 64 + 16 * d0 + 8 * hi + 4);
                    s += qf[8 * d0 + 0] * k0.x + qf[8 * d0 + 1] * k0.y + qf[8 * d0 + 2] * k0.z + qf[8 * d0 + 3] * k0.w + qf[8 * d0 + 4] * k1.x + qf[8 * d0 + 5] * k1.y + qf[8 * d0 + 6] * k1.z + qf[8 * d0 + 7] * k1.w; }
                s += __shfl_xor(s, 32);
                asm volatile("" ::: "memory");
            }
            gt[n] = (n < qi) ? s : -INFINITY;
        }
#pragma unroll
        for (int pass = 0; pass < 3; ++pass) {
            float best = -INFINITY; int bi = -1;
#pragma unroll
            for (int n = 0; n < 15; ++n) if (gt[n] > best) { best = gt[n]; bi = n; }
            if (bi >= 0) sel |= 1u << bi;
#pragma unroll
            for (int n = 0; n < 15; ++n) if (n == bi) gt[n] = -INFINITY;
        }
    }
    const float NEGBIG = -1.0e30f;
#define AT_BIAS(t) (((t) >= T - 4) ? negM : ((((sel >> ((t) >> 2)) & 1u) != 0u) ? negM : NEGBIG))
    f32x16 o0 = {}, o1 = {}, o2 = {}, pA0, pA1, pB0, pB1, bvec; bf16x8 kf[8];
    const int vpo = ((lane >> 4) & 1) * 32 + (lane & 3) * 8 + (4 * hi + ((lane & 15) >> 2)) * 64;
    const int qh = 32 * wid + r32 - 4 * hi;
    AT_WAITBAR(6);
    at_kload(kf, AT_SLOTP(0), r32, hi);
    { const float b0 = AT_BIAS(0);
#pragma unroll
      for (int r = 0; r < 16; ++r) bvec[r] = b0;
#pragma unroll
      for (int d0 = 0; d0 < 4; ++d0) { pA0 = MFMA32(kf[2 * d0], qr[d0], d0 == 0 ? bvec : pA0); pA1 = MFMA32(kf[2 * d0 + 1], qr[d0], d0 == 0 ? bvec : pA1); } }
#define AT_STEP(OWN, HN1, HN2, TT, PC0, PC1, PN0, PN1, t) do { \
        if ((t) + 3 < T) AT_WAITBAR(4); else if ((t) + 2 < T) AT_WAITBAR(2); else AT_WAITBAR(0); \
        if ((t) + 4 < T) AT_ISSUE((t) + 4); \
        if ((((t) + 1) & 3) == 0) { const float bn_ = AT_BIAS((t) + 1); _Pragma("unroll") for (int r_ = 0; r_ < 16; ++r_) bvec[r_] = bn_; }        \
        attn_tile<OWN, HN1, TT>(PC0, PC1, PN0, PN1, o0, o1, o2, bvec, kf, qr, AT_SLOTP(t) + 8192, AT_SLOTP((t) + 1), vpo, r32, hi, qh); } while (0)
    int t = 0;
    for (; t < T - 4; t += 2) {
        AT_STEP(false, true, true, 0, pA0, pA1, pB0, pB1, t);
        AT_STEP(false, true, true, 0, pB0, pB1, pA0, pA1, t + 1);
    }
    AT_STEP(true, true, true, 0, pA0, pA1, pB0, pB1, t);
    AT_STEP(true, true, true, 1, pB0, pB1, pA0, pA1, t + 1);
    AT_STEP(true, true, false, 2, pA0, pA1, pB0, pB1, t + 2);
    AT_STEP(true, false, false, 3, pB0, pB1, pA0, pA1, t + 3);
    bf16_t* orow = X.ab() + (rowbase + 256 * qi + 32 * wid) * DM + 256 + 64 * h;
#pragma unroll
    for (int r = 0; r < 16; ++r) { const int q = crow(r, hi); const float rl = 1.0f / o2[r];
        orow[(size_t)q * DM + r32] = (bf16_t)(cvtpk(o0[r] * rl, 0.f) & 0xffffu);
        orow[(size_t)q * DM + 32 + r32] = (bf16_t)(cvtpk(o1[r] * rl, 0.f) & 0xffffu); }
    __syncthreads();
#undef AT_ISSUE
#undef AT_SLOTP
#undef AT_BIAS
#undef AT_STEP
}

__device__ __forceinline__ void router_flush(const Ctx& X, int layer, LAS unsigned* lcnt, LAS unsigned* rec, int nrow) {
    __syncthreads();
    if (X.tid() < 4) { const int q = X.tid(); const unsigned long long add = (unsigned long long)lcnt[4 * q] | ((unsigned long long)lcnt[4 * q + 1] << 16) | ((unsigned long long)lcnt[4 * q + 2] << 32) | ((unsigned long long)lcnt[4 * q + 3] << 48);
        const unsigned long long old = __hip_atomic_fetch_add((unsigned long long*)(X.ctl() + ecnt_idx(layer, q)), add, __ATOMIC_RELAXED, __HIP_MEMORY_SCOPE_AGENT);
        lcnt[16 + 4 * q] = (unsigned)(old & 0xffffull); lcnt[16 + 4 * q + 1] = (unsigned)((old >> 16) & 0xffffull); lcnt[16 + 4 * q + 2] = (unsigned)((old >> 32) & 0xffffull); lcnt[16 + 4 * q + 3] = (unsigned)(old >> 48); }
    __syncthreads();
    if (X.lane() < nrow) { const LAS unsigned* rc = rec + (X.wave * 16 + X.lane()) * 8;
        const unsigned e0 = rc[0], e1 = rc[1], i0 = lcnt[16 + e0] + rc[2], i1 = lcnt[16 + e1] + rc[3], m = rc[6];
        X.amap()[e0 * MOE_CAP + i0] = m; X.amap()[e1 * MOE_CAP + i1] = m; X.slotw()[e0 * MOE_CAP + i0] = __uint_as_float(rc[4]); X.slotw()[e1 * MOE_CAP + i1] = __uint_as_float(rc[5]);
        unsigned* rt = X.route() + (size_t)m * 8; *(u32x4*)rt = (u32x4){e0, e1, i0, i1}; }
    __syncthreads();
    if (X.tid() < 16) lcnt[X.tid()] = 0u;
    __syncthreads();
}

__device__ __forceinline__ void router_row(const Ctx& X, int layer, int m, f32x4 (&v)[4], const f32x4 (&gn)[4], int lane, const LAS float* wr, LAS unsigned* lcnt, LAS unsigned* rec, int nrow) {
    constexpr int RT_MAXROWS = 16;
        {
            float s = 0.f;
#pragma unroll
            for (int j = 0; j < 4; ++j) s += (v[j].x * v[j].x + v[j].y * v[j].y) + (v[j].z * v[j].z + v[j].w * v[j].w);
            const float rstd = rsqrtf(wave_sum(s) * (1.f / DM) + EPS);
            unsigned* o4 = (unsigned*)((unsigned char*)X.ab() + (size_t)m * DM) + lane;
#pragma unroll
            for (int j = 0; j < 4; ++j) { const f32x4 gg = gn[j]; v[j] = v[j] * rstd * gg; int p = 0; p = __builtin_amdgcn_cvt_pk_fp8_f32(v[j].x, v[j].y, p, false); p = __builtin_amdgcn_cvt_pk_fp8_f32(v[j].z, v[j].w, p, true); o4[64 * j] = (unsigned)p; }
        }
        float lg[4];
#pragma unroll
        for (int c = 0; c < 4; ++c) { float s = 0.f;
#pragma unroll
            for (int j = 0; j < 4; ++j) { const f32x4 w = *(const LAS f32x4*)(wr + c * DM + 4 * (64 * j + lane)); s += v[j].x * w.x + v[j].y * w.y + v[j].z * w.z + v[j].w * w.w; }
            lg[c] = wave_sum(s); }
        asm volatile("" ::: "memory");
        int gs = 0; float gm = lg[0];
#pragma unroll
        for (int c = 1; c < 4; ++c) if (lg[c] > gm) { gm = lg[c]; gs = c; }
        float den = 0.f;
#pragma unroll
        for (int c = 0; c < 4; ++c) den += __expf(lg[c] - gm);
        const float pg = 1.0f / den;
        float le[4];
        { const LAS float* wre = wr + (4 + 4 * gs) * DM;
#pragma unroll
          for (int j = 0; j < 4; ++j) { float s = 0.f;
#pragma unroll
              for (int q = 0; q < 4; ++q) { const f32x4 w = *(const LAS f32x4*)(wre + j * DM + 4 * (64 * q + lane)); s += v[q].x * w.x + v[q].y * w.y + v[q].z * w.z + v[q].w * w.w; }
              le[j] = wave_sum(s); } }
        int i1 = 0; float v1 = le[0];
#pragma unroll
        for (int j = 1; j < 4; ++j) if (le[j] > v1) { v1 = le[j]; i1 = j; }
        int i2 = -1; float v2 = -INFINITY;
#pragma unroll
        for (int j = 0; j < 4; ++j) if (j != i1 && le[j] > v2) { v2 = le[j]; i2 = j; }
        const float ex = __expf(v2 - v1); const float w1 = pg / (1.f + ex), w2 = pg * ex / (1.f + ex);
        if (lane == 0) {
            const int e0 = 4 * gs + i1, e1 = 4 * gs + i2;
            const unsigned p0 = __hip_atomic_fetch_add(lcnt + e0, 1u, __ATOMIC_RELAXED, __HIP_MEMORY_SCOPE_WORKGROUP), p1 = __hip_atomic_fetch_add(lcnt + e1, 1u, __ATOMIC_RELAXED, __HIP_MEMORY_SCOPE_WORKGROUP);
            LAS unsigned* rc = rec + (X.wave * RT_MAXROWS + nrow) * 8;
            rc[0] = (unsigned)e0; rc[1] = (unsigned)e1; rc[2] = p0; rc[3] = p1; rc[4] = __float_as_uint(w1); rc[5] = __float_as_uint(w2); rc[6] = (unsigned)m;
        }
}

__device__ __forceinline__ void router_phase(const Ctx& X, int layer) {
    LAS float* wr = (LAS float*)X.lds;
    {
        f32x4 rg[2], re[2][4];
#pragma unroll
        for (int q = 0; q < 2; ++q) { const int k = X.tid() + 512 * q; rg[q] = *(const f32x4*)(X.w_rg() + (size_t)layer * DM * 4 + k * 4);
#pragma unroll
            for (int j = 0; j < 4; ++j) re[q][j] = *(const f32x4*)(X.w_re() + (size_t)layer * DM * 16 + k * 16 + 4 * j); }
#pragma unroll
        for (int q = 0; q < 2; ++q) { const int k = X.tid() + 512 * q;
#pragma unroll
            for (int c = 0; c < 4; ++c) wr[c * DM + k] = rg[q][c];
#pragma unroll
            for (int j = 0; j < 4; ++j)
#pragma unroll
                for (int c = 0; c < 4; ++c) wr[(4 + 4 * j + c) * DM + k] = re[q][j][c]; }
    }
    LAS unsigned* lcnt = (LAS unsigned*)(X.lds + MISC_OFF + 256);
    if (X.tid() < 16) lcnt[X.tid()] = 0u;
    __syncthreads();
    const int lane = X.lane();
    constexpr int RT_MAXROWS = 16;
    LAS unsigned* rec = (LAS unsigned*)(X.lds + 90112);
    int nrow = 0;
    f32x4 gn[4]; { const f32x4* gr = (const f32x4*)(X.ffn_g() + layer * DM) + lane;
#pragma unroll
        for (int j = 0; j < 4; ++j) gn[j] = gr[64 * j]; }
    f32x4 v[4]; u32x2 bA[4], bB[4];
#define RT_LOADRAW(buf, mm) do { const u32x2* xr_ = (const u32x2*)(X.x1b() + (size_t)(mm) * DM) + lane; _Pragma("unroll") for (int j_ = 0; j_ < 4; ++j_) buf[j_] = xr_[64 * j_]; } while (0)
#define RT_CVT(buf) do { _Pragma("unroll") for (int j_ = 0; j_ < 4; ++j_) v[j_] = (f32x4){bflo(buf[j_].x), bfhi(buf[j_].x), bflo(buf[j_].y), bfhi(buf[j_].y)}; } while (0)
    if (X.gw < NTOK) RT_LOADRAW(bB, X.gw);
    if (X.gw + X.NGW < NTOK) RT_LOADRAW(bA, X.gw + X.NGW);
    if (X.gw < NTOK) RT_CVT(bB);
    const int npass = (NTOK + X.NGW - 1) / X.NGW;
    for (int it = 0; it < npass; it += 2) {
        if (it > 0 && (it & (RT_MAXROWS - 1)) == 0) { router_flush(X, layer, lcnt, rec, nrow); nrow = 0; }
        { const int m = X.gw + it * X.NGW;
          if (m < NTOK) { if (m + 2 * X.NGW < NTOK) RT_LOADRAW(bB, m + 2 * X.NGW);
              __builtin_amdgcn_sched_barrier(0);
              router_row(X, layer, m, v, gn, lane, wr, lcnt, rec, nrow); ++nrow;
              if (m + X.NGW < NTOK) RT_CVT(bA); } }
        if (it + 1 < npass) { const int m = X.gw + (it + 1) * X.NGW;
          if (m < NTOK) { if (m + 2 * X.NGW < NTOK) RT_LOADRAW(bA, m + 2 * X.NGW);
              __builtin_amdgcn_sched_barrier(0);
              router_row(X, layer, m, v, gn, lane, wr, lcnt, rec, nrow); ++nrow;
              if (m + X.NGW < NTOK) RT_CVT(bB); } }
    }
#undef RT_LOADRAW
#undef RT_CVT
    router_flush(X, layer, lcnt, rec, nrow);
}

__device__ __forceinline__ int expert_off_rows(const Ctx& X, int layer, int lane) {
    const int e = lane & 15; const unsigned c = (__hip_atomic_load(X.ctl() + ecnt_idx(layer, e >> 2) + ((e >> 1) & 1), __ATOMIC_RELAXED, __HIP_MEMORY_SCOPE_AGENT) >> (16 * (e & 1))) & 0xffffu;
    const int tiles = (int)((c + 255u) >> 8); int incl = tiles;
#pragma unroll
    for (int o = 1; o < 16; o <<= 1) { const int t = __shfl_up(incl, o, 16); if (e >= o) incl += t; }
    return (incl - tiles) * 256;
}

__device__ __forceinline__ void moe_table(const Ctx& X, int layer) {
    volatile LAS int* toff = (volatile LAS int*)(X.lds + MISC_OFF);
    if (X.tid() < 64) { const int off = expert_off_rows(X, layer, X.lane());
        if (X.lane() < 16) toff[X.lane()] = off >> 8;
        if (X.lane() == 15) { const unsigned c = __hip_atomic_load(X.ctl() + ecnt_idx(layer, 3) + 1, __ATOMIC_RELAXED, __HIP_MEMORY_SCOPE_AGENT) >> 16; toff[16] = (off >> 8) + (int)((c + 255u) >> 8); } }
    __syncthreads();
}

__device__ __forceinline__ void combine_phase(const Ctx& X, int layer) {
    const int lane = X.lane();
    int m = X.gw; unsigned sB0 = 0, sB1 = 0, sC0 = 0, sC1 = 0;
    u32x2 xc[4], xn[4]; u32x2 ya[4], yb[4], yan[4], ybn[4];
#define CB_LOAD(XV, YA, YB, mm, s0, s1) do { const u32x2* xr_ = (const u32x2*)(X.x1b() + (size_t)(mm) * DM) + lane; const u32x2* y0_ = (const u32x2*)(X.aperm() + (size_t)(s0) * DM) + lane; const u32x2* y1_ = (const u32x2*)(X.aperm() + (size_t)(s1) * DM) + lane; \
        _Pragma("unroll") for (int j = 0; j < 4; ++j) { XV[j] = xr_[64 * j]; YA[j] = y0_[64 * j]; YB[j] = y1_[64 * j]; } } while (0)
    const int eoff = expert_off_rows(X, layer, lane);
#define CB_SLOTS(mm, s0, s1) do { const u32x4 r_ = *(const u32x4*)(X.route() + (size_t)(mm) * 8); s0 = (unsigned)__shfl(eoff, (int)(r_.x & 15u)) + r_.z; s1 = (unsigned)__shfl(eoff, (int)(r_.y & 15u)) + r_.w; } while (0)
    if (m < NTOK) { unsigned s0, s1; CB_SLOTS(m, s0, s1); CB_LOAD(xc, ya, yb, m, s0, s1); }
    if (m + X.NGW < NTOK) { CB_SLOTS(m + X.NGW, sB0, sB1); }
    for (; m < NTOK; m += X.NGW) {
        const int mn = m + X.NGW, mnn = m + 2 * X.NGW;
        if (mn < NTOK) CB_LOAD(xn, yan, ybn, mn, sB0, sB1);
        if (mnn < NTOK) { CB_SLOTS(mnn, sC0, sC1); }
        float* xr = X.out() + (size_t)m * DM;
        f32x4 v[4]; float ss = 0.f;
#pragma unroll
        for (int j = 0; j < 4; ++j) { const f32x4 xv = (f32x4){bflo(xc[j].x), bfhi(xc[j].x), bflo(xc[j].y), bfhi(xc[j].y)}; const u32x2 a = ya[j], bq = yb[j];
            f32x4 r; r.x = xv.x + bflo(a.x) + bflo(bq.x); r.y = xv.y + bfhi(a.x) + bfhi(bq.x); r.z = xv.z + bflo(a.y) + bflo(bq.y); r.w = xv.w + bfhi(a.y) + bfhi(bq.y);
            v[j] = r; ss += (r.x * r.x + r.y * r.y) + (r.z * r.z + r.w * r.w);
            if (layer + 1 < DEPTH) { u32x2 w; w.x = cvtpk(r.x, r.y); w.y = cvtpk(r.z, r.w); ((u32x2*)(X.x1b() + (size_t)m * DM))[64 * j + lane] = w; }
            else ((f32x4*)xr)[64 * j + lane] = r; }
        if (layer + 1 < DEPTH) {
            const float rstd = rsqrtf(wave_sum(ss) * (1.f / DM) + EPS);
            const f32x4* gr = (const f32x4*)(X.attn_g() + (layer + 1) * DM) + lane; u32x2* o8 = (u32x2*)(X.ab() + (size_t)m * DM) + lane;
#pragma unroll
            for (int j = 0; j < 4; ++j) { const f32x4 gg = gr[64 * j]; const f32x4 hh = v[j] * rstd * gg; u32x2 w; w.x = cvtpk(hh.x, hh.y); w.y = cvtpk(hh.z, hh.w); o8[64 * j] = w;
                int p = 0; p = __builtin_amdgcn_cvt_pk_fp8_f32(hh.x, hh.y, p, false); p = __builtin_amdgcn_cvt_pk_fp8_f32(hh.z, hh.w, p, true); ((unsigned*)(X.h8() + (size_t)m * DM))[64 * j + lane] = (unsigned)p; }
        }
#pragma unroll
        for (int j = 0; j < 4; ++j) { xc[j] = xn[j]; ya[j] = yan[j]; yb[j] = ybn[j]; }
        sB0 = sC0; sB1 = sC1;
    }
#undef CB_LOAD
#undef CB_SLOTS
}

#define XB_TMO      128
#define XB_XCNT(j)  (256  + 64 * (j))
#define XB_XSUB(j)  (1280 + 64 * (j))
#define XB_XGEN(j)  (2304 + 64 * (j))
#define XB_TOP      3328
#define XB_TOPGEN   3392
#define XB_SPIN_CAP (1u << 22)
__device__ __forceinline__ unsigned xb_ld(unsigned* p)              { return __hip_atomic_load(p, __ATOMIC_RELAXED, __HIP_MEMORY_SCOPE_AGENT); }
__device__ __forceinline__ unsigned xb_add(unsigned* p, unsigned v) { return __hip_atomic_fetch_add(p, v, __ATOMIC_RELAXED, __HIP_MEMORY_SCOPE_AGENT); }
__device__ __forceinline__ unsigned xb_xcc_id() { return (unsigned)__builtin_amdgcn_s_getreg((3 << 11) | 20) & 0xFu; }
#define XB_SPIN(cond, bar) do { unsigned _sp = 0; while (cond) { __builtin_amdgcn_s_sleep(1); \
    if ((++_sp & 255u) == 0u) { if (xb_ld(&(bar)[XB_TMO])) break; if (_sp > XB_SPIN_CAP) { atomicAdd(&(bar)[XB_TMO], 1u); break; } } } } while (0)
struct XcdBarrier { unsigned* bar; unsigned x; volatile LAS unsigned* st; };
__device__ __forceinline__ XcdBarrier xcd_barrier_post(unsigned* bar, volatile LAS unsigned* st) {
    XcdBarrier b; b.bar = bar; b.x = xb_xcc_id(); b.st = st;
    if (threadIdx.x == 0) (void)xb_add(&bar[XB_XCNT(b.x)], 1u);
    return b;
}
__device__ __forceinline__ void xcd_barrier_complete(unsigned* bar, unsigned x, unsigned& nloc, unsigned& nx) {
    const unsigned G = gridDim.x * gridDim.y * gridDim.z;
    unsigned sum, cnt, mine, sp = 0u;
    for (;;) {
        sum = 0u; cnt = 0u; mine = 0u;
#pragma unroll 1
        for (unsigned j = 0; j < 16; ++j) { const unsigned c = xb_ld(&bar[XB_XCNT(j)]); sum += c; cnt += (c > 0u) ? 1u : 0u; mine = (j == x) ? c : mine; }
        if (sum == G) break;
        __builtin_amdgcn_s_sleep(1);
        if ((++sp & 255u) == 0u) { if (xb_ld(&bar[XB_TMO])) break; if (sp > XB_SPIN_CAP) { atomicAdd(&bar[XB_TMO], 1u); break; } }
    }
    nloc = mine > 0u ? mine : 1u; nx = cnt > 0u ? cnt : 1u;
}
__device__ __forceinline__ void xcd_barrier(const XcdBarrier& b) {
    asm volatile("s_waitcnt vmcnt(0)" ::: "memory");
    __syncthreads();
    if (threadIdx.x == 0) {
        unsigned* bar = b.bar; unsigned bx_ = b.x;
        asm volatile("" : "+s"(bar), "+s"(bx_));
        __builtin_amdgcn_s_waitcnt(0);
        unsigned nloc = b.st[0], nx = b.st[1];
        if (nloc == 0u) { xcd_barrier_complete(bar, bx_, nloc, nx); b.st[0] = nloc; b.st[1] = nx; }
        const unsigned old = xb_add(&bar[XB_XSUB(bx_)], 1u);
        const unsigned gen = old / nloc;
        if (old + 1u == (gen + 1u) * nloc) {
            __builtin_amdgcn_fence(__ATOMIC_RELEASE, "agent");
            asm volatile("s_waitcnt vmcnt(0)" ::: "memory");
            const unsigned og = xb_add(&bar[XB_TOP], 1u);
            const unsigned tg = og / nx;
            if (og + 1u == (tg + 1u) * nx) xb_add(&bar[XB_TOPGEN], 1u);
            else XB_SPIN(xb_ld(&bar[XB_TOPGEN]) == tg, bar);
            __builtin_amdgcn_fence(__ATOMIC_ACQUIRE, "agent");
            xb_add(&bar[XB_XGEN(bx_)], 1u);
            asm volatile("s_waitcnt vmcnt(0)" ::: "memory");
        } else {
            XB_SPIN(xb_ld(&bar[XB_XGEN(bx_)]) == gen, bar);
            __builtin_amdgcn_fence(__ATOMIC_ACQUIRE, "agent");
            asm volatile("s_waitcnt vmcnt(0)" ::: "memory");
        }
    }
    __syncthreads();
}

#ifndef PHMASK
#define PHMASK 0xffff
#endif
#ifndef PROBE_A
#define PROBE_A -1
#define PROBE_B -1
#endif
#ifndef PROBE_BLK
#define PROBE_BLK 0
#endif
constexpr int NPHASE = 1 + 7 * DEPTH;
__global__ void __launch_bounds__(512, 2) fwd_kernel(Args args) {
    extern __shared__ __attribute__((aligned(16))) unsigned char lds_raw[];
    cg::grid_group grid = cg::this_grid();
    const int wave_s = __builtin_amdgcn_readfirstlane((int)(threadIdx.x >> 6));
    const int lo = args.ph_lo, hi = args.ph_hi;
    { volatile LAS unsigned* m = (volatile LAS unsigned*)((LAS unsigned char*)lds_raw + MISC_OFF); if (threadIdx.x < 64) m[threadIdx.x] = 0u; }
    __syncthreads();
    XcdBarrier xbar; xbar.bar = (unsigned*)(args.ws + WS_CTL) + CW_BAR; xbar.x = 0u; xbar.st = (volatile LAS unsigned*)((LAS unsigned char*)lds_raw + MISC_OFF + 128);
#if PROBE_A >= 0
    unsigned prA = 0, prT = 0, prE = 0; const unsigned prS = (unsigned)__builtin_amdgcn_s_memrealtime();
#define PROBE_ACC(type, d) do { if ((type) == PROBE_A) prA += (d); } while (0)
#endif
#if PROBE_A >= 0
#define PROBE_SUB(type) do { __syncthreads(); const unsigned t_ = (unsigned)__builtin_amdgcn_s_memrealtime(); PROBE_ACC(type, t_ - prSub); prSub = t_; } while (0)
    unsigned prSub = 0;
#else
#define PROBE_SUB(type) do {} while (0)
#endif
    for (int ph = lo; ph < hi; ++ph) {
        if (ph > lo) { if (ph == lo + 1) { grid.sync(); xbar = xcd_barrier_post((unsigned*)(args.ws + WS_CTL) + CW_BAR, (volatile LAS unsigned*)((LAS unsigned char*)lds_raw + MISC_OFF + 128)); } else xcd_barrier(xbar); }
#if PROBE_A >= 0
        prT = (unsigned)__builtin_amdgcn_s_memrealtime(); prSub = prT; if (ph > lo) PROBE_ACC(11, prT - prE);
#endif
        Ctx X;
#define CTX_REFRESH() do { \
        { unsigned l0 = 0u; asm volatile("" : "+s"(l0)); X.lds = (LAS unsigned char*)lds_raw + l0; } \
        { unsigned z0 = 0u; asm volatile("" : "+s"(z0)); \
          int ws = wave_s; asm volatile("" : "+s"(ws)); (void)z0; \
          X.wave = ws; } \
        { int bx = blockIdx.x, G = gridDim.x; asm volatile("" : "+s"(bx), "+s"(G)); X.G = G; X.vcu = (G % 8 == 0) ? (bx % 8) * (G / 8) + bx / 8 : bx; X.bx = bx; } \
        X.gw = X.vcu * 8 + X.wave; X.NGW = X.G * 8; \
        { const __attribute__((address_space(4))) unsigned char* ka = (const __attribute__((address_space(4))) unsigned char*)__builtin_amdgcn_kernarg_segment_ptr(); asm volatile("" : "+s"(ka)); X.ka = ka; } } while (0)
        CTX_REFRESH();
        const int layer = (ph - 1) / 7; const int k = ph == 0 ? 0 : (0xA865421 >> (4 * ((ph - 1) % 7))) & 15;
        if (ph == 0) { phase0(X); PROBE_SUB(15); CTX_REFRESH(); phase0b(X); PROBE_SUB(16); }
        else switch (k) {
        case 1: {
            {
                pg8::Gemm g{X.ab(), X.win() + (size_t)layer * NW_IN * DM, DM}; pg8::StaticOrder S; S.init(NTOK, 1536, X.G, X.bx, 0xCBA910ull, 0, 0);
                EpiProj<false> E{X.proj(), X.lr(), X.qn_g() + layer * 64, X.kn_g() + layer * 64, X.cosT(), X.sinT(), X.kpart()};
                pg8::gemm_phase<EpiProj<false>, pg8::StaticOrder>(X.lds, g, S, E, X.tid()); }
            PROBE_SUB(19);
            CTX_REFRESH();
            {
                pg8::Gemm g{(const bf16_t*)X.h8(), (const bf16_t*)((const unsigned char*)(X.win() + (size_t)layer * NW_IN * DM) + (size_t)C_BQ * DM * 2), DM / 2}; pg8::StaticOrder S; S.init(NTOK, 2048, X.G, X.bx, 0x2D876543ull, 1, 1);
                EpiProj<true> E{X.proj(), X.lr(), X.qn_g() + layer * 64, X.kn_g() + layer * 64, X.cosT(), X.sinT(), X.kpart()};
                pg8::gemm_phase<EpiProj<true>, pg8::StaticOrder, false, true>(X.lds, g, S, E, X.tid()); }
        } break;
        case 2: {
            PROBE_SUB(17);
            LAS unsigned char* wl = X.lds + X.wave * WAVE_LDS;
            for (int it = X.gw; it < 2048; it += X.NGW) { const int h8 = it & 7, bc = it >> 3, b = bc >> 6, c = bc & 63;
                if (h8 < 4) lin_item<true, false>(X, layer, b, c, h8, wl); else lin_item<false, false>(X, layer, b, c, h8 - 4, wl); }
            PROBE_SUB(18);
        } break;
        case 4: {
            scan_phase(X, layer);
            PROBE_SUB(3);
            CTX_REFRESH();
            if (PHMASK & 0x800) for (int v = X.vcu; v < 256; v += X.G) { const int bh = v >> 3, s = v & 7; attn_unit(X, layer, bh >> 3, bh & 7, s); attn_unit(X, layer, bh >> 3, bh & 7, 15 - s); }
            PROBE_SUB(13);
            CTX_REFRESH();
            scan_wait(X, layer);
            LAS unsigned char* wl = X.lds + X.wave * WAVE_LDS;
            if (PHMASK & 0x1000) for (int it = X.gw; it < 2048; it += X.NGW) { const int h8 = it & 7, bc = it >> 3, b = bc >> 6, c = bc & 63;
                if (h8 < 4) lin_item<true, true>(X, layer, b, c, h8, wl); else lin_item<false, true>(X, layer, b, c, h8 - 4, wl); }
            PROBE_SUB(14);
        } break;
        case 5: {
            pg8::Gemm g{X.ab(), X.wout() + (size_t)layer * DM * DM, DM}; pg8::StaticOrder S; S.init(NTOK, DM, X.G, X.bx);
            EpiResid E{X.x(), X.x1b(), layer == 0 ? (const bf16_t*)nullptr : (const bf16_t*)X.x1b()};
            pg8::gemm_phase<EpiResid, pg8::StaticOrder>(X.lds, g, S, E, X.tid());
        } break;
        case 6: router_phase(X, layer); break;
        case 8: {
            moe_table(X, layer);
            unsigned* tcnt;
            { const unsigned long long p_ = (unsigned long long)(uintptr_t)(X.ctl() + 256 + layer * 256);
              tcnt = (unsigned*)(uintptr_t)(((unsigned long long)(unsigned)__builtin_amdgcn_readfirstlane((int)(p_ >> 32)) << 32) | (unsigned long long)(unsigned)__builtin_amdgcn_readfirstlane((int)p_)); }
            { pg8::Gemm g{X.ab(), X.wgu(), DM / 2}; pg8::GroupedOrder S{(const volatile LAS int*)(X.lds + MISC_OFF), X.G, X.vcu, layer * 64, tcnt, (LAS unsigned*)(X.lds + MISC_OFF + 192), 0, 0, 0, 0};
              EpiSwiglu E{X.hbuf()};
              pg8::gemm_phase<EpiSwiglu, pg8::GroupedOrder, true, true>(X.lds, g, S, E, X.tid(), X.amap(), (unsigned)(NTOK - 1)); S.finish(X.wave); }
            PROBE_SUB(8);
            CTX_REFRESH();
            { pg8::Gemm g{X.hbuf(), X.wd(), FF / 2}; pg8::GroupedOrderDown S{(const volatile LAS int*)(X.lds + MISC_OFF), X.G, X.vcu, layer * 64, tcnt, (LAS unsigned*)(X.lds + MISC_OFF + 200 + 4 * layer), X.wave, 0u};
              EpiDown E{X.aperm(), X.slotw()};
              pg8::gemm_phase<EpiDown, pg8::GroupedOrderDown, false, true>(X.lds, g, S, E, X.tid()); }
            PROBE_SUB(9);
        } break;
        case 10: combine_phase(X, layer); break;
        }
        __syncthreads();
#if PROBE_A >= 0
        prE = (unsigned)__builtin_amdgcn_s_memrealtime(); PROBE_ACC(k, prE - prT);
#endif
    }
#if PROBE_A >= 0
    PROBE_ACC(12, prE - prS);
    if (wave_s == 0 && __builtin_amdgcn_mbcnt_hi(~0u, __builtin_amdgcn_mbcnt_lo(~0u, 0u)) == 0u) {
        unsigned* ctl = (unsigned*)(args.ws + WS_CTL);
        if (blockIdx.x == PROBE_BLK) { const unsigned qa = (prA + 400u) / 800u > 127u ? 127u : (prA + 400u) / 800u;
            __hip_atomic_store(ctl + 200, qa, __ATOMIC_RELAXED, __HIP_MEMORY_SCOPE_AGENT); }
        __builtin_amdgcn_fence(__ATOMIC_RELEASE, "agent");
        const unsigned done = __hip_atomic_fetch_add(ctl + 201, 1u, __ATOMIC_ACQ_REL, __HIP_MEMORY_SCOPE_AGENT);
        if (done == gridDim.x - 1) { const unsigned long long extra = (unsigned long long)__hip_atomic_load(ctl + 200, __ATOMIC_RELAXED, __HIP_MEMORY_SCOPE_AGENT) * 400ull; const unsigned long long t0 = __builtin_amdgcn_s_memrealtime();
            while (__builtin_amdgcn_s_memrealtime() - t0 < extra) __builtin_amdgcn_s_sleep(32); }
    }
#endif
}

extern "C" void kernel_launch(void* const* d_in, const int* in_sizes, int n_in, void* d_out, int out_size, void* d_ws, size_t ws_size, hipStream_t stream) {
    static int grid = 0;
    if (grid == 0) {
        if (n_in != 17 || out_size != NTOK * DM || ws_size < WS_END) { fprintf(stderr, "kernel_launch: unexpected problem (n_in %d out %d ws %zu)\n", n_in, out_size, ws_size); grid = -1; return; }
        int dev = 0, cus = 0, per_cu = 0;
        hipGetDevice(&dev); hipDeviceGetAttribute(&cus, hipDeviceAttributeMultiprocessorCount, dev);
        if (hipFuncSetAttribute((const void*)fwd_kernel, hipFuncAttributeMaxDynamicSharedMemorySize, LDS_BYTES) != hipSuccess) { fprintf(stderr, "kernel_launch: hipFuncSetAttribute failed\n"); }
        if (hipOccupancyMaxActiveBlocksPerMultiprocessor(&per_cu, (const void*)fwd_kernel, 512, LDS_BYTES) != hipSuccess || per_cu < 1) { fprintf(stderr, "kernel_launch: occupancy query says %d\n", per_cu); per_cu = 1; }
        (void)hipGetLastError();
        grid = cus * per_cu;
        fprintf(stderr, "kernel_launch: grid %d (cus %d x %d), ws %zu\n", grid, cus, per_cu, ws_size);
    }
    if (grid < 0) return;
    Args a{};
    for (int i = 0; i < 17; ++i) a.in[i] = (const float*)d_in[i];
    a.out = (float*)d_out; a.ws = (unsigned char*)d_ws;
#if MK_PER_PHASE
    for (int ph = 0; ph < NPHASE; ++ph) { a.ph_lo = ph; a.ph_hi = ph + 1; hipLaunchKernelGGL(fwd_kernel, dim3(grid), dim3(512), LDS_BYTES, stream, a); }
#else
    a.ph_lo = 0; a.ph_hi = NPHASE;
    void* kargs[] = {&a};
    hipError_t e = hipLaunchCooperativeKernel((const void*)fwd_kernel, dim3(grid), dim3(512), kargs, LDS_BYTES, stream);
    if (e != hipSuccess) fprintf(stderr, "cooperative launch failed: %s (grid %d)\n", hipGetErrorString(e), grid);
#endif
}
```

```cpp
#include <hip/hip_runtime.h>
#include <hip/hip_cooperative_groups.h>
#include <cstdio>
#include <cstdint>
#include <cstddef>
namespace cg = cooperative_groups;

#ifndef MK_PER_PHASE
#define MK_PER_PHASE 0
#endif

#define LAS __attribute__((address_space(3)))
typedef unsigned short bf16_t;
typedef short bf16x8 __attribute__((ext_vector_type(8)));
typedef short s16x4 __attribute__((ext_vector_type(4)));
typedef float f32x2 __attribute__((ext_vector_type(2)));
typedef float f32x4 __attribute__((ext_vector_type(4)));
typedef float f32x16 __attribute__((ext_vector_type(16)));
typedef unsigned u32x2 __attribute__((ext_vector_type(2)));
typedef unsigned u32x4 __attribute__((ext_vector_type(4)));
typedef __bf16 bf16x2_t __attribute__((ext_vector_type(2)));

constexpr int NTOK = 16384, DM = 1024, SEQ = 4096, NBATCH = 4, DEPTH = 2;
constexpr int IN_COLS = 3344;
constexpr int PP = 3328;
constexpr int NW_IN = 3584;
constexpr int C_AQ = 0, C_AK = 128, C_AV = 256, C_AG = 512, C_BQ = 768, C_BK = 1280, C_BV = 1792, C_CQ = 2304, C_CF = 2560, C_CI = 2816, C_CG = 3072;
constexpr int NEXP = 16, FF = 512;
constexpr int MOE_ROWS = 36864;
constexpr float EPS = 1e-6f;
constexpr float LOG2E = 1.4426950408889634f;

constexpr size_t MiB = 1u << 20;
constexpr size_t WS_CTL = 0;
constexpr size_t WS_SMALL = 1 * MiB;
constexpr size_t SM_COS = WS_SMALL, SM_SIN = WS_SMALL + 128 * 1024;
constexpr size_t SM_LR = WS_SMALL + 256 * 1024;
constexpr size_t SM_KPART = WS_SMALL + 768 * 1024;
constexpr size_t SM_DECAY = WS_SMALL + 1280 * 1024;
constexpr size_t SM_ROUTE = WS_SMALL + 1792 * 1024;
constexpr size_t SM_SLOTW = WS_SMALL + 2304 * 1024;
constexpr size_t SM_AMAP = WS_SMALL + 2816 * 1024;
constexpr size_t SM_WGCNT = WS_SMALL + 2560 * 1024;
__host__ __device__ constexpr int ecnt_idx(int layer, int q) { return 16384 + layer * 32768 + q * 1088; }
constexpr int CW_BAR = 4096;
constexpr size_t CTL_ZERO_BYTES = 65536;
constexpr size_t WS_WIN = 5 * MiB;
constexpr size_t WS_WOUT = 19 * MiB;
constexpr size_t WS_WGU = 23 * MiB;
constexpr size_t WS_X1B = 23 * MiB + 32 * MiB;
constexpr size_t WS_WD = 87 * MiB;
constexpr size_t WS_H8 = 103 * MiB;
constexpr size_t WS_PROJ = 119 * MiB;
constexpr size_t WS_ST = 223 * MiB;
constexpr size_t WS_AB = 239 * MiB;
constexpr int MOE_CAP = 16384;
constexpr size_t WS_AMAP2 = 271 * MiB;
constexpr size_t WS_SLOTW2 = 272 * MiB;
constexpr size_t WS_END = 273 * MiB;
constexpr size_t WS_APERM = WS_PROJ;
constexpr size_t WS_H = WS_PROJ + 72 * MiB;
static_assert(WS_H + (size_t)MOE_ROWS * FF * 2 <= WS_AB, "moe overlay");

constexpr int LDS_BYTES = 159744;
constexpr int MISC_OFF = 147456;
constexpr int GROW_OFF = MISC_OFF + 1024;
constexpr int WAVE_LDS = 18432;

__device__ __forceinline__ unsigned cvtpk(float lo, float hi) { f32x2 v = {lo, hi}; bf16x2_t b = __builtin_convertvector(v, bf16x2_t); return __builtin_bit_cast(unsigned, b); }
__device__ __forceinline__ float bf2f(unsigned short u) { return __builtin_bit_cast(float, (unsigned)u << 16); }
__device__ __forceinline__ float bflo(unsigned u) { return __builtin_bit_cast(float, u << 16); }
__device__ __forceinline__ float bfhi(unsigned u) { return __builtin_bit_cast(float, u & 0xffff0000u); }
#define DPP_ADD(v, ctrl) ((v) + __builtin_bit_cast(float, __builtin_amdgcn_update_dpp(0, __builtin_bit_cast(int, (v)), (ctrl), 0xf, 0xf, true)))
__device__ __forceinline__ float wave_sum(float v) {
    v = DPP_ADD(v, 0xB1); v = DPP_ADD(v, 0x4E); v = DPP_ADD(v, 0x141); v = DPP_ADD(v, 0x140);
    const int iv = __builtin_bit_cast(int, v);
    const float r0 = __builtin_bit_cast(float, __builtin_amdgcn_readlane(iv, 0)), r1 = __builtin_bit_cast(float, __builtin_amdgcn_readlane(iv, 16));
    const float r2 = __builtin_bit_cast(float, __builtin_amdgcn_readlane(iv, 32)), r3 = __builtin_bit_cast(float, __builtin_amdgcn_readlane(iv, 48));
    return (r0 + r1) + (r2 + r3);
}
__device__ __forceinline__ float wave_max(float v) {
#pragma unroll
    for (int o = 1; o < 64; o <<= 1) v = fmaxf(v, __shfl_xor(v, o));
    return v;
}
__device__ __forceinline__ int crow(int r, int hi) { return (r & 3) + 8 * (r >> 2) + 4 * hi; }
__device__ __forceinline__ float sigmoidf_(float x) { return 1.0f / (1.0f + __expf(-x)); }
#define MFMA32(a, b, c) __builtin_amdgcn_mfma_f32_32x32x16_bf16((a), (b), (c), 0, 0, 0)

__device__ __forceinline__ void glds16(const void* sbase, unsigned voff, unsigned lds_dst) { unsigned keep;
    asm volatile("s_mov_b32 %0, m0\n\ts_mov_b32 m0, %3\n\ts_nop 0\n\tglobal_load_lds_dwordx4 %1, %2\n\ts_mov_b32 m0, %0" : "=&s"(keep) : "v"(voff), "s"(sbase), "s"(lds_dst) : "memory"); }

namespace pg8 {
#define PG8_LAS __attribute__((address_space(3)))
constexpr int BM = 256, BK = 64, HALF = 128, HTB = HALF * BK * 2, STAGE_BYTES = 8 * HTB, NXCD = 8, WGM = 8;
__host__ __device__ __forceinline__ int lds_byte(int r, int c) { const int st = (r >> 4) * 2 + (c >> 5), rr = r & 15, cc = c & 31, ob = rr * 64 + cc * 2; return st * 1024 + (ob ^ (((ob >> 9) & 1) << 5)); }
__host__ __device__ __forceinline__ void stage_rc(int b, int& R, int& C) { const int st = b / 1024, sb = b % 1024, swz = sb ^ (((sb >> 9) & 1) << 5); R = (st >> 1) * 16 + swz / 64; C = (st & 1) * 32 + (swz % 64) / 2; }
__host__ __device__ __forceinline__ int perm32(int rho) { const int n = rho >> 4, i = rho & 15; return 8 * (i >> 2) + 4 * n + (i & 3); }

struct Unit { int pm, pn, bt, ab; };
struct Gemm { const bf16_t* A; const bf16_t* Bt; int K; };

struct StaticOrder {
    int nM, nN, nwg, G, c, compact, skew; unsigned long long tbl;
    __device__ void init(int M, int N, int G_, int c_, unsigned long long tbl_ = 0xFEDCBA9876543210ull, int compact_ = 0, int skew_ = 0) { nM = M / BM; nN = N / BM; nwg = nM * nN; G = G_; c = c_; tbl = tbl_; compact = compact_; skew = skew_; }
    __device__ bool next(int i, Unit& u) const {
        long L = (long)i * G + c;
        if (skew && i > 0) { const int hg = G >> 1; if (c < hg) return false; L = (long)G + (long)(i - 1) * hg + (c - hg); }
        if (L >= nwg) return false;
        int wgid = (int)L; { const int q = nwg / NXCD, r = nwg % NXCD, xcd = wgid % NXCD, off = wgid / NXCD; wgid = (xcd < r ? xcd * (q + 1) : r * (q + 1) + (xcd - r) * q) + off; }
        const int nig = WGM * nN, gid = wgid / nig, fm = gid * WGM, gsz = (nM - fm) < WGM ? (nM - fm) : WGM;
        u.pm = fm + ((wgid % nig) % gsz); { const int pn_ = (wgid % nig) / gsz; u.pn = (int)((tbl >> (4 * pn_)) & 15ull); u.bt = compact ? pn_ : u.pn; } return true;
    }
    __device__ __forceinline__ void a_ready(const Unit&) const {}
    __device__ __forceinline__ void done(const Unit&) const {}
};
struct GroupedOrder {
    const volatile PG8_LAS int* toff; int G, vcu, wbase;
    __device__ bool next(int i, Unit& u) const {
        const int U = i * G + vcu; const int total = toff[16];
        if (U >= total * 4) return false;
        const int rt = U >> 2, pn = U & 3; int e = 0;
#pragma unroll
        for (int j = 1; j < 16; ++j) e += (rt >= toff[j]) ? 1 : 0;
        u.pm = __builtin_amdgcn_readfirstlane(rt); u.pn = __builtin_amdgcn_readfirstlane(pn); u.bt = __builtin_amdgcn_readfirstlane(wbase + e * 4 + pn); u.ab = __builtin_amdgcn_readfirstlane(e * 64 + rt - toff[e]); return true;
    }
    __device__ __forceinline__ void a_ready(const Unit&) const {}
    unsigned* cnt; PG8_LAS unsigned* wgarr;
    mutable int dp0, dp1, dp2, ndp;
    __device__ __forceinline__ void done(const Unit& u) const {
        { const int n8 = toff[16] * 4, rem = n8 - (n8 / G) * G;
          if (vcu >= rem) { if (ndp == 0) dp0 = u.pm; else if (ndp == 1) dp1 = u.pm; else dp2 = u.pm; ++ndp; return; } }
        asm volatile("s_waitcnt vmcnt(0)" ::: "memory");
        unsigned old = 0u;
        if (__builtin_amdgcn_mbcnt_hi(~0u, __builtin_amdgcn_mbcnt_lo(~0u, 0u)) == 0u) old = __hip_atomic_fetch_add(wgarr, 1u, __ATOMIC_RELAXED, __HIP_MEMORY_SCOPE_WORKGROUP);
        old = (unsigned)__builtin_amdgcn_readfirstlane((int)old);
        if ((old & 7u) == 7u) {
            __builtin_amdgcn_fence(__ATOMIC_RELEASE, "agent");
            if (__builtin_amdgcn_mbcnt_hi(~0u, __builtin_amdgcn_mbcnt_lo(~0u, 0u)) == 0u) __hip_atomic_fetch_add(cnt + u.pm, 1u, __ATOMIC_RELAXED, __HIP_MEMORY_SCOPE_AGENT);
        }
    }
    __device__ __forceinline__ void finish(int wid) const {
        if (ndp > 0 && wid == 0) {
            __builtin_amdgcn_fence(__ATOMIC_RELEASE, "agent");
            if (__builtin_amdgcn_mbcnt_hi(~0u, __builtin_amdgcn_mbcnt_lo(~0u, 0u)) == 0u) {
                __hip_atomic_fetch_add(cnt + dp0, 1u, __ATOMIC_RELAXED, __HIP_MEMORY_SCOPE_AGENT);
                if (ndp > 1) __hip_atomic_fetch_add(cnt + dp1, 1u, __ATOMIC_RELAXED, __HIP_MEMORY_SCOPE_AGENT);
                if (ndp > 2) __hip_atomic_fetch_add(cnt + dp2, 1u, __ATOMIC_RELAXED, __HIP_MEMORY_SCOPE_AGENT);
            }
        }
    }
};
struct GroupedOrderDown {
    const volatile PG8_LAS int* toff; int G, vcu, wbase; unsigned* cnt;
    __device__ bool next(int i, Unit& u) const {
        const int n8 = toff[16] * 4, R = n8 / G, rem = n8 - R * G; int q;
        if (vcu < rem) { if (i > 0) return false; q = R * G + vcu; }
        else { q = (vcu - rem) + (G - rem) * i; if (q >= R * G) return false; }
        const int rt = q >> 2, pn = q & 3; int e = 0;
#pragma unroll
        for (int j = 1; j < 16; ++j) e += (rt >= toff[j]) ? 1 : 0;
        u.pm = __builtin_amdgcn_readfirstlane(rt); u.pn = __builtin_amdgcn_readfirstlane(pn); u.bt = __builtin_amdgcn_readfirstlane(wbase + e * 4 + pn); u.ab = __builtin_amdgcn_readfirstlane(e * 64 + rt - toff[e]); return true;
    }
    PG8_LAS unsigned* acq; int wid; mutable unsigned ncall;
    __device__ __forceinline__ void a_ready(const Unit& u) const {
        const unsigned k = ++ncall; unsigned sp = 0;
        if (wid == 0) {
            while ((unsigned)__builtin_amdgcn_readfirstlane((int)__hip_atomic_load(cnt + u.pm, __ATOMIC_RELAXED, __HIP_MEMORY_SCOPE_AGENT)) < 4u) { __builtin_amdgcn_s_sleep(4); if (++sp > (1u << 22)) break; }
            __builtin_amdgcn_fence(__ATOMIC_ACQUIRE, "agent");
            __hip_atomic_store(acq, k, __ATOMIC_RELEASE, __HIP_MEMORY_SCOPE_WORKGROUP);
        } else {
            while ((unsigned)__builtin_amdgcn_readfirstlane((int)__hip_atomic_load(acq, __ATOMIC_ACQUIRE, __HIP_MEMORY_SCOPE_WORKGROUP)) < k) { __builtin_amdgcn_s_sleep(2); if (++sp > (1u << 24)) break; }
        }
        asm volatile("" ::: "memory");
    }
    __device__ __forceinline__ void done(const Unit&) const {}
};

template <class Epi, class Sched, bool GATHER = false, bool FP8 = false>
__device__ __forceinline__ void gemm_phase(PG8_LAS unsigned char* lds, const Gemm g, const Sched& S, const Epi& E, const int tid, const unsigned* amap = nullptr, unsigned amap_max = 0u) {
    const int  wid = __builtin_amdgcn_readfirstlane(tid >> 6), lane = tid & 63, wr = wid >> 2, wc = wid & 3, fr = lane & 15, fq = lane >> 4;
    int Kq_ = g.K; asm volatile("" : "+s"(Kq_));
    const int K = Kq_, nt = K / BK;
    unsigned voffA[2], voffB[2]; int gR[2]; unsigned gC[2];
#pragma unroll
    for (int i = 0; i < 2; ++i) { int R, C; stage_rc(tid * 16 + i * 8192, R, C); const int Rb = Epi::PERM ? ((R & ~31) + perm32(R & 31)) : R;
        voffA[i] = (unsigned)(R * K + C) * 2u; voffB[i] = (unsigned)(Rb * K + C) * 2u; gR[i] = R; gC[i] = (unsigned)C * 2u; }
    unsigned arC[2][2];
    PG8_LAS unsigned* arNp = (PG8_LAS unsigned*)(lds + 147456 + 1024 + tid * 16);
#define PG8_GROWS(dst, pm_) do { _Pragma("unroll") for (int h_ = 0; h_ < 2; ++h_) _Pragma("unroll") for (int i_ = 0; i_ < 2; ++i_) { \
        unsigned tk_ = amap[(size_t)(pm_) * 256 + h_ * 128 + gR[0] + 64 * i_]; tk_ = tk_ < amap_max ? tk_ : amap_max; dst[h_][i_] = tk_ * (unsigned)(K * 2) + gC[0]; } } while (0)
    const size_t kstep = (size_t)(BK * 2);
    const size_t hstep = (size_t)HALF * K * 2;
    const size_t tstep = 2 * hstep;
    const unsigned ldsw = (unsigned)wid * 1024u; const unsigned lds0_ = (unsigned)(uintptr_t)lds;
    const int aoff = lds_byte(wr * 64 + fr, fq * 8), boff = lds_byte(wc * 32 + fr, fq * 8);
#define PG8_SA(b, h) (((b) * 2 + (h)) * HTB)
#define PG8_SB(b, h) ((4 + (b) * 2 + (h)) * HTB)
#define PG8_STAGE(bufoff, gbase, voff) do { const unsigned long long gb_ = (unsigned long long)(uintptr_t)(gbase); \
        const void* sb_ = (const void*)(uintptr_t)(((unsigned long long)(unsigned)__builtin_amdgcn_readfirstlane((int)(gb_ >> 32)) << 32) | (unsigned long long)(unsigned)__builtin_amdgcn_readfirstlane((int)gb_)); \
        _Pragma("unroll") for (int _i = 0; _i < 2; ++_i) \
        glds16(sb_, (voff)[_i], (unsigned)__builtin_amdgcn_readfirstlane((int)(lds0_ + (unsigned)(bufoff) + ldsw + (unsigned)(_i * 8192)))); } while (0)
#define PG8_STAGEA(bufoff, gbase, h, isn) do { if (GATHER) { unsigned vo_[2] = {arC[h][0], arC[h][1]}; if (isn) { vo_[0] = arNp[2 * (h)]; vo_[1] = arNp[2 * (h) + 1]; } PG8_STAGE(bufoff, gbase, vo_); } \
        else { PG8_STAGE(bufoff, (gbase) + (h) * hstep, voffA); } } while (0)
    typedef int pg8_v4i __attribute__((ext_vector_type(4))); typedef int pg8_v8i __attribute__((ext_vector_type(8)));
#define PG8_LDA(dst, b, h) do { _Pragma("unroll") for (int m = 0; m < 4; ++m) { if (FP8) { const pg8_v4i l_ = *(const PG8_LAS pg8_v4i*)(lds + PG8_SA(b, h) + aoff + m * 2048), h_ = *(const PG8_LAS pg8_v4i*)(lds + PG8_SA(b, h) + aoff + m * 2048 + 1024); \
            dst##8[m] = __builtin_shufflevector(l_, h_, 0, 1, 2, 3, 4, 5, 6, 7); } \
        else { _Pragma("unroll") for (int k = 0; k < 2; ++k) dst[m][k] = *(const PG8_LAS bf16x8*)(lds + PG8_SA(b, h) + aoff + m * 2048 + k * 1024); } } } while (0)
#define PG8_LDB(dst, b, h) do { _Pragma("unroll") for (int n = 0; n < 2; ++n) { if (FP8) { const pg8_v4i l_ = *(const PG8_LAS pg8_v4i*)(lds + PG8_SB(b, h) + boff + n * 2048), h_ = *(const PG8_LAS pg8_v4i*)(lds + PG8_SB(b, h) + boff + n * 2048 + 1024); \
            dst##8[n] = __builtin_shufflevector(l_, h_, 0, 1, 2, 3, 4, 5, 6, 7); } \
        else { _Pragma("unroll") for (int k = 0; k < 2; ++k) dst[n][k] = *(const PG8_LAS bf16x8*)(lds + PG8_SB(b, h) + boff + n * 2048 + k * 1024); } } } while (0)
#define PG8_MMA(ai, bj, At, Bt) do { __builtin_amdgcn_s_setprio(1); _Pragma("unroll") for (int m = 0; m < 4; ++m) _Pragma("unroll") for (int n = 0; n < 2; ++n) { \
        if (FP8) { acc[ai][bj][m][n] = __builtin_amdgcn_mfma_scale_f32_16x16x128_f8f6f4(Bt##8[n], At##8[m], acc[ai][bj][m][n], 0, 0, 0, 0x7f7f7f7f, 0, 0x7f7f7f7f); } \
        else { _Pragma("unroll") for (int k = 0; k < 2; ++k) acc[ai][bj][m][n] = __builtin_amdgcn_mfma_f32_16x16x32_bf16(Bt[n][k], At[m][k], acc[ai][bj][m][n], 0, 0, 0); } } \
        if (FP8) asm volatile("" : "+v"(acc[ai][bj][0][0]), "+v"(acc[ai][bj][0][1]), "+v"(acc[ai][bj][1][0]), "+v"(acc[ai][bj][1][1]), "+v"(acc[ai][bj][2][0]), "+v"(acc[ai][bj][2][1]), "+v"(acc[ai][bj][3][0]), "+v"(acc[ai][bj][3][1]));     \
        __builtin_amdgcn_s_setprio(0); } while (0)
#define PG8_WAIT_V(n) asm volatile("s_waitcnt vmcnt(" #n ")" ::: "memory")
#define PG8_WAIT_L(n) asm volatile("s_waitcnt lgkmcnt(" #n ")" ::: "memory")
#define PG8_BAR __builtin_amdgcn_s_barrier()
#define PG8_SCHED __builtin_amdgcn_sched_barrier(0)
    Unit cur, nxt; int ui = 0;
    if (!S.next(0, cur)) return;
    f32x4 acc[2][2][4][2];
#pragma unroll
    for (int a = 0; a < 2; ++a)
#pragma unroll
        for (int b = 0; b < 2; ++b)
#pragma unroll
            for (int m = 0; m < 4; ++m)
#pragma unroll
                for (int n = 0; n < 2; ++n) acc[a][b][m][n] = (f32x4){0.f, 0.f, 0.f, 0.f};
    bf16x8 At[4][2], B0[2][2], B1[2][2]; pg8_v8i At8[4], B08[2], B18[2];
    const char* cA = (const char*)g.A + (GATHER ? (size_t)0 : (size_t)cur.pm * tstep); const char* cB = (const char*)g.Bt + (size_t)cur.bt * tstep;
    S.a_ready(cur);
    if (GATHER) { PG8_GROWS(arC, cur.ab); }
    PG8_STAGE(PG8_SB(0, 0), cB, voffB); PG8_STAGE(PG8_SB(0, 1), cB + hstep, voffB); PG8_STAGEA(PG8_SA(0, 0), cA, 0, false); PG8_STAGEA(PG8_SA(0, 1), cA, 1, false);
    if (wr == 1) PG8_BAR;
    PG8_WAIT_V(2); PG8_BAR;
    PG8_STAGE(PG8_SB(1, 0), cB + kstep, voffB); PG8_STAGEA(PG8_SA(1, 0), cA + kstep, 0, false); PG8_STAGE(PG8_SB(1, 1), cB + hstep + kstep, voffB);
    PG8_WAIT_V(6); PG8_BAR;
    for (;;) {
        const bool has_next = S.next(ui + 1, nxt);
        const char* nA = (has_next && !GATHER) ? (const char*)g.A + (size_t)nxt.pm * tstep : cA; const char* nB = has_next ? (const char*)g.Bt + (size_t)nxt.bt * tstep : cB;
        if (GATHER && has_next) { unsigned tn_[2][2]; PG8_GROWS(tn_, nxt.ab); arNp[0] = tn_[0][0]; arNp[1] = tn_[0][1]; arNp[2] = tn_[1][0]; arNp[3] = tn_[1][1]; }
#pragma unroll 1
        for (int t = 0; t < nt; t += 2) {
            const bool last = (t == nt - 2);
            const char* a1 = cA + (size_t)(t + 1) * kstep;
            const char* a2 = last ? nA : cA + (size_t)(t + 2) * kstep; const char* b2 = last ? nB : cB + (size_t)(t + 2) * kstep;
            const char* a3 = a2 + kstep; const char* b3 = b2 + kstep;
            const bool isn = last && has_next;
            if (isn) S.a_ready(nxt);
            PG8_LDB(B0, 0, 0); PG8_LDB(B1, 0, 1); PG8_SCHED; PG8_LDA(At, 0, 0); PG8_STAGEA(PG8_SA(1, 1), a1, 1, false);
            PG8_WAIT_V(8); PG8_WAIT_L(0); PG8_BAR; PG8_MMA(0, 0, At, B0); PG8_MMA(0, 1, At, B1); PG8_BAR; PG8_SCHED;
            PG8_LDA(At, 0, 1); PG8_STAGE(PG8_SB(0, 0), b2, voffB); PG8_STAGE(PG8_SB(0, 1), b2 + hstep, voffB); PG8_STAGEA(PG8_SA(0, 0), a2, 0, isn);
            PG8_WAIT_V(8); PG8_WAIT_L(0); PG8_BAR; PG8_MMA(1, 0, At, B0); PG8_MMA(1, 1, At, B1); PG8_BAR; PG8_SCHED;
            PG8_LDB(B0, 1, 0); PG8_LDB(B1, 1, 1); PG8_SCHED; PG8_LDA(At, 1, 0); PG8_STAGEA(PG8_SA(0, 1), a2, 1, isn);
            PG8_WAIT_V(8); PG8_WAIT_L(0); PG8_BAR; PG8_MMA(0, 0, At, B0); PG8_MMA(0, 1, At, B1); PG8_BAR; PG8_SCHED;
            PG8_LDA(At, 1, 1); PG8_STAGE(PG8_SB(1, 0), b3, voffB); PG8_STAGE(PG8_SB(1, 1), b3 + hstep, voffB); PG8_STAGEA(PG8_SA(1, 0), a3, 0, isn);
            PG8_WAIT_V(8); PG8_WAIT_L(0); PG8_BAR; PG8_MMA(1, 0, At, B0); PG8_MMA(1, 1, At, B1); PG8_BAR; PG8_SCHED;
        }
        if (wr == 0) PG8_BAR;
        { unsigned z_ = 0u; asm volatile("" : "+s"(z_)); const int ln2 = (int)__builtin_amdgcn_mbcnt_hi(~0u, __builtin_amdgcn_mbcnt_lo(~0u, z_));
          E(acc, cur, wr, wc, ln2 & 15, ln2 >> 4); }
        S.done(cur);
        if (!has_next) break;
#pragma unroll
        for (int a = 0; a < 2; ++a)
#pragma unroll
            for (int b = 0; b < 2; ++b)
#pragma unroll
                for (int m = 0; m < 4; ++m)
#pragma unroll
                    for (int n = 0; n < 2; ++n) acc[a][b][m][n] = (f32x4){0.f, 0.f, 0.f, 0.f};
        cur = nxt; cA = nA; cB = nB; ++ui;
        if (GATHER) { arC[0][0] = arNp[0]; arC[0][1] = arNp[1]; arC[1][0] = arNp[2]; arC[1][1] = arNp[3]; }
        if (wr == 1) PG8_BAR;
    }
    PG8_WAIT_V(0);
    PG8_BAR;
#undef PG8_SA
#undef PG8_SB
#undef PG8_STAGE
#undef PG8_STAGEA
#undef PG8_GROWS
#undef PG8_LDA
#undef PG8_LDB
#undef PG8_MMA
#undef PG8_WAIT_V
#undef PG8_WAIT_L
#undef PG8_BAR
#undef PG8_SCHED
}
}

template <bool F8> struct EpiProj {
    static constexpr bool PERM = true;
    bf16_t* O; bf16_t* LR; const float* gq; const float* gk; const float* cosT; const float* sinT; float* kpart;
    __device__ __forceinline__ void operator()(const f32x4 (&acc)[2][2][4][2], const pg8::Unit& u, int wr, int wc, int fr, int fq) const {
        const int row0 = u.pm * 256 + wr * 64 + fr;
        constexpr float SC = F8 ? 0.03125f : 1.0f;
        if (F8 && u.pn >= 3 && u.pn <= 6) {
            const bool isk = u.pn >= 5; const int hh = 4 * ((u.pn - 3) & 1) + wc;
            const float* g = isk ? gk : gq;
            float gg[2][8];
#pragma unroll
            for (int bj = 0; bj < 2; ++bj)
#pragma unroll
                for (int e = 0; e < 8; ++e) gg[bj][e] = g[32 * bj + 8 * fq + e];
            float ks[2][8];
#pragma unroll
            for (int bj = 0; bj < 2; ++bj)
#pragma unroll
                for (int e = 0; e < 8; ++e) ks[bj][e] = 0.f;
            bf16_t* obase = O + (isk ? C_BK : C_BQ) + 64 * hh + 8 * fq;
#pragma unroll
            for (int ai = 0; ai < 2; ++ai)
#pragma unroll
                for (int m = 0; m < 4; ++m) {
                    const int row = row0 + ai * 128 + m * 16; const int pos = row & (SEQ - 1);
                    float v[2][8]; float ss = 0.f;
#pragma unroll
                    for (int bj = 0; bj < 2; ++bj)
#pragma unroll
                        for (int n = 0; n < 2; ++n)
#pragma unroll
                            for (int j = 0; j < 4; ++j) { const float x = acc[ai][bj][m][n][j] * SC; v[bj][4 * n + j] = x; ss += x * x; }
                    ss += __shfl_xor(ss, 16); ss += __shfl_xor(ss, 32);
                    const float rstd = rsqrtf(ss * (1.f / 64.f) + EPS);
#pragma unroll
                    for (int bj = 0; bj < 2; ++bj)
#pragma unroll
                        for (int e = 0; e < 8; ++e) v[bj][e] = v[bj][e] * rstd * gg[bj][e];
                    { const f32x4 c0 = *(const f32x4*)(cosT + pos * 8), c1 = *(const f32x4*)(cosT + pos * 8 + 4), s0 = *(const f32x4*)(sinT + pos * 8), s1 = *(const f32x4*)(sinT + pos * 8 + 4);
                      const float cs[8] = {c0.x, c0.y, c0.z, c0.w, c1.x, c1.y, c1.z, c1.w}, sn[8] = {s0.x, s0.y, s0.z, s0.w, s1.x, s1.y, s1.z, s1.w};
#pragma unroll
                      for (int e = 0; e < 8; ++e) { const float other = __shfl_xor(v[0][e], 16);
                          if (fq == 0) v[0][e] = v[0][e] * cs[e] - other * sn[e]; else if (fq == 1) v[0][e] = v[0][e] * cs[e] + other * sn[e]; } }
                    if (isk) {
#pragma unroll
                        for (int bj = 0; bj < 2; ++bj)
#pragma unroll
                            for (int e = 0; e < 8; ++e) ks[bj][e] += v[bj][e];
                    } else {
#pragma unroll
                        for (int bj = 0; bj < 2; ++bj)
#pragma unroll
                            for (int e = 0; e < 8; ++e) v[bj][e] *= (0.125f * LOG2E);
                    }
#pragma unroll
                    for (int bj = 0; bj < 2; ++bj) { u32x4 w; w.x = cvtpk(v[bj][0], v[bj][1]); w.y = cvtpk(v[bj][2], v[bj][3]); w.z = cvtpk(v[bj][4], v[bj][5]); w.w = cvtpk(v[bj][6], v[bj][7]);
                        *(u32x4*)(obase + (size_t)row * PP + 32 * bj) = w; }
                }
            if (isk) {
#pragma unroll
                for (int bj = 0; bj < 2; ++bj)
#pragma unroll
                    for (int e = 0; e < 8; ++e) { float s = ks[bj][e]; s += __shfl_xor(s, 1); s += __shfl_xor(s, 2); s += __shfl_xor(s, 4); s += __shfl_xor(s, 8); ks[bj][e] = s; }
                if (fr == 0) { float* kp = kpart + ((size_t)u.pm * 2 + wr) * 512 + 64 * hh + 8 * fq;
#pragma unroll
                    for (int bj = 0; bj < 2; ++bj) { *(f32x4*)(kp + 32 * bj) = (f32x4){ks[bj][0], ks[bj][1], ks[bj][2], ks[bj][3]}; *(f32x4*)(kp + 32 * bj + 4) = (f32x4){ks[bj][4], ks[bj][5], ks[bj][6], ks[bj][7]}; } }
            }
        } else if (u.pn < 13) {
            const int col0 = u.pn * 256 + wc * 32 + 8 * fq;
#pragma unroll
            for (int ai = 0; ai < 2; ++ai)
#pragma unroll
                for (int m = 0; m < 4; ++m) { bf16_t* rowp = O + (size_t)(row0 + ai * 128 + m * 16) * PP + col0;
#pragma unroll
                    for (int bj = 0; bj < 2; ++bj) { const f32x4 v0 = acc[ai][bj][m][0] * SC, v1 = acc[ai][bj][m][1] * SC;
                        u32x4 w; w.x = cvtpk(v0[0], v0[1]); w.y = cvtpk(v0[2], v0[3]); w.z = cvtpk(v1[0], v1[1]); w.w = cvtpk(v1[2], v1[3]);
                        *(u32x4*)(rowp + bj * 128) = w; } }
        } else if (F8 && wc == 0 && fq < 2) {
#pragma unroll
            for (int ai = 0; ai < 2; ++ai)
#pragma unroll
                for (int m = 0; m < 4; ++m) { const f32x4 v0 = acc[ai][0][m][0] * SC, v1 = acc[ai][0][m][1] * SC;
                    u32x4 w; w.x = cvtpk(v0[0], v0[1]); w.y = cvtpk(v0[2], v0[3]); w.z = cvtpk(v1[0], v1[1]); w.w = cvtpk(v1[2], v1[3]);
                    *(u32x4*)(LR + (size_t)(row0 + ai * 128 + m * 16) * 16 + 8 * fq) = w; }
        }
    }
};
struct EpiResid {
    static constexpr bool PERM = false;
    const float* base; bf16_t* out; const bf16_t* base16;
    __device__ __forceinline__ void operator()(const f32x4 (&acc)[2][2][4][2], const pg8::Unit& u, int wr, int wc, int fr, int fq) const {
        const int row0 = u.pm * 256 + wr * 64 + fr, col0 = u.pn * 256 + wc * 32 + 4 * fq;
#pragma unroll
        for (int ai = 0; ai < 2; ++ai)
#pragma unroll
            for (int m = 0; m < 4; ++m) { const size_t off = (size_t)(row0 + ai * 128 + m * 16) * DM + col0;
#pragma unroll
                for (int bj = 0; bj < 2; ++bj)
#pragma unroll
                    for (int n = 0; n < 2; ++n) { f32x4 bs;
                        if (base16) { const u32x2 bw = __builtin_nontemporal_load((const u32x2*)(base16 + off + bj * 128 + n * 16)); bs = (f32x4){bflo(bw.x), bfhi(bw.x), bflo(bw.y), bfhi(bw.y)}; }
                        else bs = __builtin_nontemporal_load((const f32x4*)(base + off + bj * 128 + n * 16));
                        const f32x4 r = bs + acc[ai][bj][m][n];
                        u32x2 w; w.x = cvtpk(r.x, r.y); w.y = cvtpk(r.z, r.w); *(u32x2*)(out + off + bj * 128 + n * 16) = w; } }
    }
};
struct EpiSwiglu {
    static constexpr bool PERM = true;
    bf16_t* H;
    __device__ __forceinline__ void operator()(const f32x4 (&acc)[2][2][4][2], const pg8::Unit& u, int wr, int wc, int fr, int fq) const {
        const int row0 = u.pm * 256 + wr * 64 + fr, col0 = u.pn * 128 + wc * 32 + 8 * fq;
#pragma unroll
        for (int ai = 0; ai < 2; ++ai)
#pragma unroll
            for (int m = 0; m < 4; ++m) { float o[8];
#pragma unroll
                for (int n = 0; n < 2; ++n)
#pragma unroll
                    for (int j = 0; j < 4; ++j) { const float gt = acc[ai][0][m][n][j] * 0.03125f, up = acc[ai][1][m][n][j] * 0.03125f; o[n * 4 + j] = gt * sigmoidf_(gt) * up; }
                int p0 = 0, p1 = 0;
                p0 = __builtin_amdgcn_cvt_pk_fp8_f32(o[0], o[1], p0, false); p0 = __builtin_amdgcn_cvt_pk_fp8_f32(o[2], o[3], p0, true);
                p1 = __builtin_amdgcn_cvt_pk_fp8_f32(o[4], o[5], p1, false); p1 = __builtin_amdgcn_cvt_pk_fp8_f32(o[6], o[7], p1, true);
                *(u32x2*)((unsigned char*)H + (size_t)(row0 + ai * 128 + m * 16) * FF + col0) = (u32x2){(unsigned)p0, (unsigned)p1}; }
    }
};
struct EpiDown {
    static constexpr bool PERM = true;
    bf16_t* Y; const float* slotw;
    __device__ __forceinline__ void operator()(const f32x4 (&acc)[2][2][4][2], const pg8::Unit& u, int wr, int wc, int fr, int fq) const {
        const int row0 = u.pm * 256 + wr * 64 + fr, col0 = u.pn * 256 + wc * 32 + 8 * fq;
#pragma unroll
        for (int ai = 0; ai < 2; ++ai)
#pragma unroll
            for (int m = 0; m < 4; ++m) { const int row = row0 + ai * 128 + m * 16; const float sw = slotw[u.ab * 256 + (row - u.pm * 256)] * 0.03125f; bf16_t* rowp = Y + (size_t)row * DM + col0;
#pragma unroll
                for (int bj = 0; bj < 2; ++bj) { const f32x4 v0 = acc[ai][bj][m][0] * sw, v1 = acc[ai][bj][m][1] * sw;
                    u32x4 w; w.x = cvtpk(v0[0], v0[1]); w.y = cvtpk(v0[2], v0[3]); w.z = cvtpk(v1[0], v1[1]); w.w = cvtpk(v1[2], v1[3]);
                    *(u32x4*)(rowp + bj * 128) = w; } }
    }
};

struct Args { const float* in[17]; float* out; unsigned char* ws; int ph_lo, ph_hi; };
static_assert(offsetof(Args, out) == 136 && offsetof(Args, ws) == 144 && sizeof(Args) == 160, "kernarg layout");
struct Ctx {
    LAS unsigned char* lds; const __attribute__((address_space(4))) unsigned char* ka;
    int wave, G, vcu, gw, NGW, bx;
    __device__ __forceinline__ int lane() const { unsigned z_ = 0u; asm volatile("" : "+s"(z_)); return (int)__builtin_amdgcn_mbcnt_hi(~0u, __builtin_amdgcn_mbcnt_lo(~0u, z_)); }
    __device__ __forceinline__ int tid() const { return wave * 64 + lane(); }
#define CTX_IN(name, idx) __device__ __forceinline__ const float* name() const { return *(const float* const __attribute__((address_space(4)))*)(ka + 8 * (idx)); }
    CTX_IN(x, 0) CTX_IN(attn_g, 1) CTX_IN(w_in, 2) CTX_IN(gk_w2, 3) CTX_IN(gk_b, 4) CTX_IN(gla_g, 5) CTX_IN(qn_g, 6) CTX_IN(kn_g, 7) CTX_IN(lb_param, 8) CTX_IN(hgrn_g, 9)
    CTX_IN(w_out, 10) CTX_IN(ffn_g, 11) CTX_IN(w_rg, 12) CTX_IN(w_re, 13) CTX_IN(w_eg, 14) CTX_IN(w_eu, 15) CTX_IN(w_ed, 16)
#define CTX_WS(type, name, off) __device__ __forceinline__ type* name() const { return (type*)(*(unsigned char* const __attribute__((address_space(4)))*)(ka + 144) + (off)); }
    __device__ __forceinline__ float* out() const { return *(float* const __attribute__((address_space(4)))*)(ka + 136); }
    CTX_WS(unsigned, ctl, WS_CTL) CTX_WS(float, cosT, SM_COS) CTX_WS(float, sinT, SM_SIN) CTX_WS(bf16_t, lr, SM_LR) CTX_WS(float, kpart, SM_KPART) CTX_WS(float, decay, SM_DECAY)
    CTX_WS(unsigned, route, SM_ROUTE) CTX_WS(float, slotw, WS_SLOTW2) CTX_WS(bf16_t, x1b, WS_X1B) CTX_WS(unsigned, amap, WS_AMAP2) CTX_WS(bf16_t, win, WS_WIN) CTX_WS(bf16_t, wout, WS_WOUT) CTX_WS(bf16_t, wgu, WS_WGU) CTX_WS(bf16_t, wd, WS_WD) CTX_WS(unsigned char, h8, WS_H8)
    CTX_WS(bf16_t, proj, WS_PROJ) CTX_WS(bf16_t, st, WS_ST) CTX_WS(bf16_t, ab, WS_AB) CTX_WS(float, kvt, WS_AB) CTX_WS(bf16_t, aperm, WS_APERM) CTX_WS(bf16_t, hbuf, WS_H)
};

struct TrDesc { const float* W; bf16_t* WT; int ldw, col0, k0, K, drow0, nvalid, fp8; };
__device__ __forceinline__ void tr_load(const TrDesc& d, float (&tmp)[32], int lane) {
#pragma unroll
    for (int i = 0; i < 32; ++i) { const int kk = 2 * i + (lane >> 5); tmp[i] = __builtin_nontemporal_load(d.W + (size_t)(d.k0 + kk) * d.ldw + d.col0 + (lane & 31)); }
}
__device__ __forceinline__ void tr_finish(const TrDesc& d, const float (&tmp)[32], LAS float* scr, int lane) {
#pragma unroll
    for (int i = 0; i < 32; ++i) { const int kk = 2 * i + (lane >> 5); scr[kk * 33 + (lane & 31)] = tmp[i]; }
    asm volatile("s_waitcnt lgkmcnt(0)" ::: "memory");
    const int c = lane & 7;
    if (d.fp8) {
#pragma unroll
        for (int j = 0; j < 4; ++j) { const int n = (lane >> 3) + 8 * j; const LAS float* s = scr + (8 * c) * 33 + n;
            int p0 = 0, p1 = 0;
            p0 = __builtin_amdgcn_cvt_pk_fp8_f32(s[0 * 33] * 32.f, s[1 * 33] * 32.f, p0, false); p0 = __builtin_amdgcn_cvt_pk_fp8_f32(s[2 * 33] * 32.f, s[3 * 33] * 32.f, p0, true);
            p1 = __builtin_amdgcn_cvt_pk_fp8_f32(s[4 * 33] * 32.f, s[5 * 33] * 32.f, p1, false); p1 = __builtin_amdgcn_cvt_pk_fp8_f32(s[6 * 33] * 32.f, s[7 * 33] * 32.f, p1, true);
            if (n < d.nvalid) *(u32x2*)((unsigned char*)d.WT + (size_t)(d.drow0 + n) * d.K + d.k0 + 8 * c) = (u32x2){(unsigned)p0, (unsigned)p1}; }
    } else {
#pragma unroll
    for (int j = 0; j < 4; ++j) { const int n = (lane >> 3) + 8 * j; const LAS float* s = scr + (8 * c) * 33 + n;
        u32x4 o; o.x = cvtpk(s[0 * 33], s[1 * 33]); o.y = cvtpk(s[2 * 33], s[3 * 33]); o.z = cvtpk(s[4 * 33], s[5 * 33]); o.w = cvtpk(s[6 * 33], s[7 * 33]);
        if (n < d.nvalid) *(u32x4*)(d.WT + (size_t)(d.drow0 + n) * d.K + d.k0 + 8 * c) = o; }
    }
    asm volatile("s_waitcnt lgkmcnt(0)" ::: "memory");
}
constexpr int WC_PER_LAYER = 1664 + 16 + 512 + 16 * 768;
__device__ __forceinline__ TrDesc wconv_decode(const Ctx& X, int it) {
    const int l = it / WC_PER_LAYER; int r = it % WC_PER_LAYER;
    if (r < 1664) { const int kb = r / 104, nb = r % 104; const int col0 = nb < 24 ? 32 * nb : 784 + 32 * (nb - 24); int drow = nb < 24 ? 32 * nb : 768 + 32 * (nb - 24);
        if (drow >= C_BQ && drow < C_BV) {
            const int rel = drow - C_BQ, sec = rel >> 9, hh = (rel & 511) >> 6, dh = (rel & 63) >> 5;
            drow = C_BQ + sec * 512 + 256 * (hh >> 2) + 128 * dh + 32 * (hh & 3); }
        if (drow >= C_BQ && drow < C_CQ) return TrDesc{X.w_in() + (size_t)l * DM * IN_COLS, (bf16_t*)((unsigned char*)(X.win() + (size_t)l * NW_IN * DM) + (size_t)C_BQ * DM * 2), IN_COLS, col0, 64 * kb, DM, drow - C_BQ, 32, 1};
        if (drow >= C_AG && drow < C_BQ) return TrDesc{X.w_in() + (size_t)l * DM * IN_COLS, (bf16_t*)((unsigned char*)(X.win() + (size_t)l * NW_IN * DM) + (size_t)C_BQ * DM * 2), IN_COLS, col0, 64 * kb, DM, 1792 + drow - C_AG, 32, 1};
        return TrDesc{X.w_in() + (size_t)l * DM * IN_COLS, X.win() + (size_t)l * NW_IN * DM, IN_COLS, col0, 64 * kb, DM, drow, 32, 0}; }
    r -= 1664;
    if (r < 16) return TrDesc{X.w_in() + (size_t)l * DM * IN_COLS, (bf16_t*)((unsigned char*)(X.win() + (size_t)l * NW_IN * DM) + (size_t)C_BQ * DM * 2), IN_COLS, 768, 64 * r, DM, 1536, 16, 1};
    r -= 16;
    if (r < 512) { const int kb = r / 32, nb = r % 32; return TrDesc{X.w_out() + (size_t)l * DM * DM, X.wout() + (size_t)l * DM * DM, DM, 32 * nb, 64 * kb, DM, 32 * nb, 32, 0}; }
    r -= 512;
    const int e = r / 768, q = r % 768; const size_t le = (size_t)l * NEXP + e;
    if (q < 512) { const int up = q >= 256, qq = q & 255, kb = qq / 16, nb = qq % 16, col0 = 32 * nb;
        return TrDesc{(up ? X.w_eu() : X.w_eg()) + le * DM * FF, (bf16_t*)((unsigned char*)X.wgu() + le * DM * DM), FF, col0, 64 * kb, DM, 256 * (col0 / 128) + (col0 % 128) + (up ? 128 : 0), 32, 1}; }
    const int qq = q - 512, kb = qq / 32, nb = qq % 32;
    return TrDesc{X.w_ed() + le * FF * DM, (bf16_t*)((unsigned char*)X.wd() + le * DM * FF), DM, 32 * nb, 64 * kb, FF, 32 * nb, 32, 1};
}

__device__ __forceinline__ void row_load(const float* xrow, int lane, f32x4 (&v)[4]) {
    const f32x4* xr = (const f32x4*)xrow + lane;
#pragma unroll
    for (int j = 0; j < 4; ++j) v[j] = __builtin_nontemporal_load(xr + 64 * j);
}
__device__ __forceinline__ void row_load_bf16(const bf16_t* xrow, int lane, f32x4 (&v)[4]) {
    const u32x2* xr = (const u32x2*)xrow + lane;
#pragma unroll
    for (int j = 0; j < 4; ++j) { const u32x2 w = __builtin_nontemporal_load(xr + 64 * j); v[j] = (f32x4){bflo(w.x), bfhi(w.x), bflo(w.y), bfhi(w.y)}; }
}
__device__ __forceinline__ void row_norm_store(f32x4 (&v)[4], const float* g, bf16_t* orow, unsigned char* orow8, int lane) {
    float s = 0.f;
#pragma unroll
    for (int j = 0; j < 4; ++j) s += (v[j].x * v[j].x + v[j].y * v[j].y) + (v[j].z * v[j].z + v[j].w * v[j].w);
    const float rstd = rsqrtf(wave_sum(s) * (1.f / DM) + EPS);
    const f32x4* gr = (const f32x4*)g + lane; u32x2* o8 = (u32x2*)orow + lane;
#pragma unroll
    for (int j = 0; j < 4; ++j) { const f32x4 gg = gr[64 * j]; v[j] = v[j] * rstd * gg; u32x2 w; w.x = cvtpk(v[j].x, v[j].y); w.y = cvtpk(v[j].z, v[j].w); o8[64 * j] = w;
        int p = 0; p = __builtin_amdgcn_cvt_pk_fp8_f32(v[j].x, v[j].y, p, false); p = __builtin_amdgcn_cvt_pk_fp8_f32(v[j].z, v[j].w, p, true); ((unsigned*)orow8)[64 * j + lane] = (unsigned)p; }
}

__device__ __forceinline__ void phase0(const Ctx& X) {
    LAS float* scr = (LAS float*)(X.lds + X.wave * 16384);
    {
        constexpr int NIT = DEPTH * WC_PER_LAYER; int it = X.gw; float cur[32], nxt[32]; TrDesc d, dn;
        if (it < NIT) { d = wconv_decode(X, it); tr_load(d, cur, X.lane()); }
        while (it < NIT) { const int nit = it + X.NGW; dn = d;
            if (nit < NIT) { dn = wconv_decode(X, nit); tr_load(dn, nxt, X.lane()); }
            __builtin_amdgcn_sched_barrier(0);
            tr_finish(d, cur, scr, X.lane());
#pragma unroll
            for (int i = 0; i < 32; ++i) cur[i] = nxt[i];
            d = dn; it = nit; }
    }
    { const int gt = X.gw * 64 + X.lane(), NT = X.NGW * 64;
      for (int i = gt; i < SEQ * 8; i += NT) { const int pos = i >> 3, f = i & 7;
          const float inv = exp2f(-(float)f * 0.125f * 18.931568569324174f);
          const float ang = (float)pos * inv;
          const double a = (double)ang; const double kx = __builtin_rint(a * 0.15915494309189535); const float red = (float)(a - kx * 6.283185307179586);
          X.cosT()[i] = __cosf(red); X.sinT()[i] = __sinf(red); } }
}
__device__ __forceinline__ void phase0b(const Ctx& X) {
    if (X.bx == 0) { for (int i = X.tid(); i < CW_BAR + 3456; i += 512) __hip_atomic_store(X.ctl() + i, 0u, __ATOMIC_RELAXED, __HIP_MEMORY_SCOPE_AGENT);
        if (X.tid() < 8 * DEPTH) __hip_atomic_store(X.ctl() + ecnt_idx(X.tid() >> 3, (X.tid() >> 1) & 3) + (X.tid() & 1), 0u, __ATOMIC_RELAXED, __HIP_MEMORY_SCOPE_AGENT); }
    {
        int m = X.gw; f32x4 cur[4], nxt[4];
        if (m < NTOK) row_load(X.x() + (size_t)m * DM, X.lane(), cur);
        for (; m < NTOK; m += X.NGW) { const int mn = m + X.NGW;
            if (mn < NTOK) row_load(X.x() + (size_t)mn * DM, X.lane(), nxt);
            row_norm_store(cur, X.attn_g(), X.ab() + (size_t)m * DM, X.h8() + (size_t)m * DM, X.lane());
#pragma unroll
            for (int j = 0; j < 4; ++j) cur[j] = nxt[j]; }
    }
}

__device__ __forceinline__ void moba_prep_item(const Ctx& X, int layer, int item) {
    const int part = item & 3, bb = item >> 2; const int lane = X.lane(), w = X.wave;
    const int tok0 = (bb >> 4) * SEQ + (bb & 15) * 256 + part * 64 + w * 8;
    const int sub = lane & 7;
    float gq[8], gk[8], ks[8];
#pragma unroll
    for (int j = 0; j < 8; ++j) { gq[j] = X.qn_g()[layer * 64 + sub * 8 + j]; gk[j] = X.kn_g()[layer * 64 + sub * 8 + j]; ks[j] = 0.f; }
    for (int t = 0; t < 8; ++t) {
        const int tok = tok0 + t, pos = tok & (SEQ - 1);
        float cs[8], sn[8];
#pragma unroll
        for (int j = 0; j < 8; ++j) { cs[j] = X.cosT()[pos * 8 + j]; sn[j] = X.sinT()[pos * 8 + j]; }
#pragma unroll
        for (int which = 0; which < 2; ++which) {
            bf16_t* p = X.proj() + (size_t)tok * PP + (which ? C_BK : C_BQ) + lane * 8;
            const u32x4 raw = *(const u32x4*)p; float v[8];
            v[0] = bflo(raw.x); v[1] = bfhi(raw.x); v[2] = bflo(raw.y); v[3] = bfhi(raw.y); v[4] = bflo(raw.z); v[5] = bfhi(raw.z); v[6] = bflo(raw.w); v[7] = bfhi(raw.w);
            float ss = 0.f;
#pragma unroll
            for (int j = 0; j < 8; ++j) ss += v[j] * v[j];
            ss += __shfl_xor(ss, 1); ss += __shfl_xor(ss, 2); ss += __shfl_xor(ss, 4);
            const float rstd = rsqrtf(ss * (1.f / 64.f) + EPS);
#pragma unroll
            for (int j = 0; j < 8; ++j) v[j] = v[j] * rstd * (which ? gk[j] : gq[j]);
#pragma unroll
            for (int j = 0; j < 8; ++j) { const float other = __shfl_xor(v[j], 1);
                if (sub == 0) v[j] = v[j] * cs[j] - other * sn[j]; else if (sub == 1) v[j] = v[j] * cs[j] + other * sn[j]; }
            if (which) {
#pragma unroll
                for (int j = 0; j < 8; ++j) ks[j] += v[j];
            } else {
#pragma unroll
                for (int j = 0; j < 8; ++j) v[j] *= (0.125f * LOG2E);
            }
            u32x4 o; o.x = cvtpk(v[0], v[1]); o.y = cvtpk(v[2], v[3]); o.z = cvtpk(v[4], v[5]); o.w = cvtpk(v[6], v[7]);
            *(u32x4*)p = o;
        }
    }
    LAS float* red = (LAS float*)X.lds;
#pragma unroll
    for (int j = 0; j < 8; ++j) red[w * 512 + lane * 8 + j] = ks[j];
    __syncthreads();
    { const int c = X.tid(); float s = 0.f;
#pragma unroll
      for (int ww = 0; ww < 8; ++ww) s += red[ww * 512 + c];
      X.kpart()[(size_t)item * 512 + c] = s; }
    __syncthreads();
}

template <int W> __device__ __forceinline__ void tile_load(const bf16_t* src, u32x4 (&r)[W / 8], int lane) {
    constexpr int LPR = W / 8, RPI = 64 / LPR;
#pragma unroll
    for (int i = 0; i < W / 8; ++i) r[i] = *(const u32x4*)(src + (size_t)(RPI * i + lane / LPR) * PP + (lane % LPR) * 8);
}
template <int W> __device__ __forceinline__ void tile_store(LAS unsigned char* reg, const u32x4 (&r)[W / 8], int lane) {
    constexpr int LPR = W / 8, RPI = 64 / LPR;
#pragma unroll
    for (int i = 0; i < W / 8; ++i) *(LAS u32x4*)(reg + (RPI * i + lane / LPR) * 144 + (lane % LPR) * 16) = r[i];
}
template <bool GLA, bool PHC>
__device__ __forceinline__ void lin_item(const Ctx& X, int layer, int b, int c, int h, LAS unsigned char* wl) {
    const int lane = X.lane(), r32 = lane & 31, hi = lane >> 5;
    const size_t row0 = (size_t)b * SEQ + (size_t)c * 64;
    const bf16_t* P = X.proj();
    constexpr int WK = GLA ? 32 : 64;
    const int fl = GLA ? (lane & 31) : lane;
    const int qcol0 = GLA ? (C_AQ + 32 * h) : (C_CQ + 64 * h);
    const int kcol0 = GLA ? (C_AK + 32 * h) : (C_CF + 64 * h);
    const int vcol0 = GLA ? (C_AV + 64 * h) : (C_CI + 64 * h);
    const float fv = (GLA && lane >= 32) ? 0.f : 1.f;
    LAS unsigned char* R0 = wl; LAS unsigned char* R1 = wl + 9216;
    u32x4 tv[8], tk[WK / 8], tq[WK / 8]; u32x4 lr0 = {}, lr1 = {};
    tile_load<64>(P + row0 * PP + vcol0, tv, lane);
    tile_load<WK>(P + row0 * PP + kcol0, tk, lane);
    if (PHC) tile_load<WK>(P + row0 * PP + qcol0, tq, lane);
    if (GLA) { lr0 = *(const u32x4*)(X.lr() + (row0 + lane) * 16); lr1 = *(const u32x4*)(X.lr() + (row0 + lane) * 16 + 8); }
    float w2[16]; float bias = 0.f, lb = 0.f;
    if (GLA) {
#pragma unroll
        for (int r = 0; r < 16; ++r) w2[r] = X.gk_w2()[(size_t)layer * 16 * 128 + r * 128 + 32 * h + fl];
        bias = X.gk_b()[layer * 128 + 32 * h + fl];
    } else {
#pragma unroll
        for (int r = 0; r < 16; ++r) w2[r] = 0.f;
        if (layer > 0) lb = sigmoidf_(X.lb_param()[256 + 64 * h + fl] - X.lb_param()[64 * h + fl]);
    }
    const int h8 = GLA ? h : 4 + h;
    const size_t sbase = (((size_t)b * 64 + c) * 8 + h8) * 4096;
    unsigned pvall[32];
    bf16x8 s0f[2][4];
    if (PHC) {
#pragma unroll
        for (int vi = 0; vi < 2; ++vi)
#pragma unroll
            for (int ks = 0; ks < 4; ++ks) s0f[vi][ks] = *(const bf16x8*)(X.st() + sbase + (size_t)(32 * vi + r32) * 64 + 16 * ks + 8 * hi);
        tile_store<64>(R0, tv, lane);
#pragma unroll
        for (int m = 0; m < 32; ++m) { const unsigned v0 = *(const LAS bf16_t*)(R0 + (2 * m) * 144 + lane * 2), v1 = *(const LAS bf16_t*)(R0 + (2 * m + 1) * 144 + lane * 2); pvall[m] = v0 | (v1 << 16); }
        asm volatile("s_waitcnt lgkmcnt(0)" ::: "memory");
        tile_store<WK>(R0, tq, lane); tile_store<WK>(R1, tk, lane);
    } else {
        tile_store<64>(R0, tv, lane); tile_store<WK>(R1, tk, lane);
    }
    float bsum = 0.f, eprod = 1.f;
    f32x16 g00 = {}, g01 = {}, g10 = {}, g11 = {};
    for (int s = 0; s < 4; ++s) {
        float kt[16], qt[16];
#pragma unroll
        for (int t = 0; t < 16; ++t) {
            const int tt = 16 * s + t;
            const float rawk = bf2f(*(const LAS bf16_t*)(R1 + tt * 144 + fl * 2));
            float qv = 0.f; if (PHC) qv = bf2f(*(const LAS bf16_t*)(R0 + tt * 144 + fl * 2));
            float a, kk;
            if (GLA) {
                float z = bias;
                { const unsigned u0 = (unsigned)__builtin_amdgcn_readlane((int)lr0.x, tt), u1 = (unsigned)__builtin_amdgcn_readlane((int)lr0.y, tt), u2 = (unsigned)__builtin_amdgcn_readlane((int)lr0.z, tt), u3 = (unsigned)__builtin_amdgcn_readlane((int)lr0.w, tt);
                  z += bflo(u0) * w2[0] + bfhi(u0) * w2[1] + bflo(u1) * w2[2] + bfhi(u1) * w2[3] + bflo(u2) * w2[4] + bfhi(u2) * w2[5] + bflo(u3) * w2[6] + bfhi(u3) * w2[7]; }
                { const unsigned u0 = (unsigned)__builtin_amdgcn_readlane((int)lr1.x, tt), u1 = (unsigned)__builtin_amdgcn_readlane((int)lr1.y, tt), u2 = (unsigned)__builtin_amdgcn_readlane((int)lr1.z, tt), u3 = (unsigned)__builtin_amdgcn_readlane((int)lr1.w, tt);
                  z += bflo(u0) * w2[8] + bfhi(u0) * w2[9] + bflo(u1) * w2[10] + bfhi(u1) * w2[11] + bflo(u2) * w2[12] + bfhi(u2) * w2[13] + bflo(u3) * w2[14] + bfhi(u3) * w2[15]; }
                a = (fminf(z, 0.f) - __logf(1.f + __expf(-fabsf(z)))) * (1.f / 16.f);
                kk = rawk; qv *= 0.17677669529663687f;
            } else {
                const float ef = __expf(-rawk), sg = 1.f / (1.f + ef);
                a = lb + (1.f - lb) * sg;
                kk = (1.f - lb) * (ef * sg);
                qv = qv * sigmoidf_(qv);
            }
            float eb, enb;
            if (GLA) { a *= fv; kk *= fv; qv *= fv; bsum += a; eb = __expf(bsum); enb = __expf(-bsum); }
            else { eprod *= a; eb = eprod; enb = __builtin_amdgcn_rcpf(eprod); }
            kt[t] = kk * enb; qt[t] = qv * eb;
        }
        if (PHC) {
#pragma unroll
            for (int t = 0; t < 16; ++t) {
                *(LAS bf16_t*)(R0 + (16 * s + t) * 144 + lane * 2) = (bf16_t)(cvtpk(qt[t], 0.f) & 0xffffu);
                *(LAS bf16_t*)(R1 + (16 * s + t) * 144 + lane * 2) = (bf16_t)(cvtpk(kt[t], 0.f) & 0xffffu);
            }
        } else {
            unsigned pk[8], pv[8];
#pragma unroll
            for (int m = 0; m < 8; ++m) { pk[m] = cvtpk(kt[2 * m], kt[2 * m + 1]);
                const unsigned v0 = *(const LAS bf16_t*)(R0 + (16 * s + 2 * m) * 144 + lane * 2), v1 = *(const LAS bf16_t*)(R0 + (16 * s + 2 * m + 1) * 144 + lane * 2); pv[m] = v0 | (v1 << 16); }
            u32x4 av0, av1, bk0, bk1;
#pragma unroll
            for (int m = 0; m < 4; ++m) {
                auto rv = __builtin_amdgcn_permlane32_swap(pv[m], pv[m + 4], false, false); av0[m] = rv[0]; av1[m] = rv[1];
                auto rk = __builtin_amdgcn_permlane32_swap(pk[m], pk[m + 4], false, false); bk0[m] = rk[0]; bk1[m] = rk[1];
            }
            const bf16x8 A0 = __builtin_bit_cast(bf16x8, av0), A1 = __builtin_bit_cast(bf16x8, av1), B0 = __builtin_bit_cast(bf16x8, bk0), B1 = __builtin_bit_cast(bf16x8, bk1);
            g00 = MFMA32(A0, B0, g00); g01 = MFMA32(A0, B1, g01); g10 = MFMA32(A1, B0, g10); g11 = MFMA32(A1, B1, g11);
        }
    }
    if (!PHC) {
        const float dec = GLA ? __expf(bsum) : eprod;
        X.decay()[(((size_t)b * 64 + c) * 8 + h8) * 64 + lane] = dec;
        const float d0 = __shfl(dec, r32), d1 = __shfl(dec, 32 + r32);
        float* kv = X.kvt() + sbase;
#pragma unroll
        for (int r = 0; r < 16; ++r) { const int v0 = crow(r, hi);
            kv[(size_t)v0 * 64 + r32] = g00[r] * d0; kv[(size_t)v0 * 64 + 32 + r32] = g01[r] * d1;
            kv[(size_t)(32 + v0) * 64 + r32] = g10[r] * d0; kv[(size_t)(32 + v0) * 64 + 32 + r32] = g11[r] * d1; }
        return;
    }
    if (PHC) {
        bf16x8 avp[2][4];
#pragma unroll
        for (int sg = 0; sg < 4; ++sg) {
            u32x4 f0, f1;
            auto r0 = __builtin_amdgcn_permlane32_swap(pvall[8 * sg + 0], pvall[8 * sg + 2], false, false); f0[0] = r0[0]; f1[0] = r0[1];
            auto r1 = __builtin_amdgcn_permlane32_swap(pvall[8 * sg + 1], pvall[8 * sg + 3], false, false); f0[1] = r1[0]; f1[1] = r1[1];
            auto r2 = __builtin_amdgcn_permlane32_swap(pvall[8 * sg + 4], pvall[8 * sg + 6], false, false); f0[2] = r2[0]; f1[2] = r2[1];
            auto r3 = __builtin_amdgcn_permlane32_swap(pvall[8 * sg + 5], pvall[8 * sg + 7], false, false); f0[3] = r3[0]; f1[3] = r3[1];
            avp[0][sg] = __builtin_bit_cast(bf16x8, f0); avp[1][sg] = __builtin_bit_cast(bf16x8, f1);
        }
        const LAS unsigned char* QT = wl; const LAS unsigned char* KT = wl + 9216;
        f32x16 o[2][2];
#pragma unroll
        for (int it = 0; it < 2; ++it) {
            bf16x8 bq[4];
#pragma unroll
            for (int ks = 0; ks < 4; ++ks) bq[ks] = *(const LAS bf16x8*)(QT + (32 * it + r32) * 144 + ks * 32 + hi * 16);
#pragma unroll
            for (int vi = 0; vi < 2; ++vi) { f32x16 acc = {};
#pragma unroll
                for (int ks = 0; ks < 4; ++ks) acc = MFMA32(s0f[vi][ks], bq[ks], acc);
                o[vi][it] = acc; }
#pragma unroll
            for (int jt = 0; jt <= it; ++jt) {
                f32x16 sc = {};
#pragma unroll
                for (int ks = 0; ks < 4; ++ks) { const bf16x8 ak = *(const LAS bf16x8*)(KT + (32 * jt + r32) * 144 + ks * 32 + hi * 16); sc = MFMA32(ak, bq[ks], sc); }
                if (jt == it) {
#pragma unroll
                    for (int r = 0; r < 16; ++r) if (crow(r, hi) > r32) sc[r] = 0.f;
                }
#pragma unroll
                for (int sp = 0; sp < 2; ++sp) {
                    u32x4 pw; pw.x = cvtpk(sc[8 * sp + 0], sc[8 * sp + 1]); pw.y = cvtpk(sc[8 * sp + 2], sc[8 * sp + 3]); pw.z = cvtpk(sc[8 * sp + 4], sc[8 * sp + 5]); pw.w = cvtpk(sc[8 * sp + 6], sc[8 * sp + 7]);
                    const bf16x8 pb = __builtin_bit_cast(bf16x8, pw);
                    o[0][it] = MFMA32(avp[0][2 * jt + sp], pb, o[0][it]); o[1][it] = MFMA32(avp[1][2 * jt + sp], pb, o[1][it]);
                }
            }
        }
        const float* ng = (GLA ? X.gla_g() : X.hgrn_g()) + layer * 64;
        const int gcol = GLA ? (C_AG + 64 * h) : (C_CG + 64 * h);
        const int mcol = GLA ? (64 * h) : (768 + 64 * h);
#pragma unroll
        for (int it = 0; it < 2; ++it) {
            float ss = 0.f;
#pragma unroll
            for (int vi = 0; vi < 2; ++vi)
#pragma unroll
                for (int r = 0; r < 16; ++r) ss += o[vi][it][r] * o[vi][it][r];
            ss += __shfl_xor(ss, 32);
            const float rstd = rsqrtf(ss * (1.f / 64.f) + EPS);
            const size_t row = row0 + 32 * it + r32;
#pragma unroll
            for (int vi = 0; vi < 2; ++vi)
#pragma unroll
                for (int g = 0; g < 4; ++g) { const int v0 = 32 * vi + 8 * g + 4 * hi;
                    const u32x2 gr = *(const u32x2*)(P + row * PP + gcol + v0);
                    const f32x4 gn = *(const f32x4*)(ng + v0);
                    const float g0 = bflo(gr.x), g1 = bfhi(gr.x), g2 = bflo(gr.y), g3 = bfhi(gr.y);
                    const float y0 = o[vi][it][4 * g + 0] * rstd * gn.x * (g0 * sigmoidf_(g0)), y1 = o[vi][it][4 * g + 1] * rstd * gn.y * (g1 * sigmoidf_(g1));
                    const float y2 = o[vi][it][4 * g + 2] * rstd * gn.z * (g2 * sigmoidf_(g2)), y3 = o[vi][it][4 * g + 3] * rstd * gn.w * (g3 * sigmoidf_(g3));
                    u32x2 w; w.x = cvtpk(y0, y1); w.y = cvtpk(y2, y3);
                    *(u32x2*)(X.ab() + row * DM + mcol + v0) = w; asm volatile("" ::: "memory"); }
        }
    }
}

__device__ __forceinline__ void scan_phase(const Ctx& X, int layer) {
    const int NTH = X.G * 512;
    for (int e = X.bx * 512 + X.tid(); e < NBATCH * 8 * 4096; e += NTH) {
        const int b = e >> 15, rem = e & 32767, h8 = rem >> 12, vk = rem & 4095, k = vk & 63;
        float S = 0.f;
        {
            float kv[64], dc[64];
            const float* kvp = X.kvt() + ((size_t)b * 64 * 8 + h8) * 4096 + vk; const float* dcp = X.decay() + ((size_t)b * 64 * 8 + h8) * 64 + k;
#pragma unroll
            for (int j = 0; j < 64; ++j) { kv[j] = __builtin_nontemporal_load(kvp + (size_t)j * 8 * 4096); dc[j] = dcp[(size_t)j * 8 * 64]; }
            __builtin_amdgcn_sched_barrier(0);
            bf16_t* stp = X.st() + ((size_t)b * 64 * 8 + h8) * 4096 + vk;
#pragma unroll
            for (int j = 0; j < 64; ++j) { stp[(size_t)j * 8 * 4096] = (bf16_t)(cvtpk(S, 0.f) & 0xffffu); S = dc[j] * S + kv[j]; }
        }
    }
    asm volatile("s_waitcnt vmcnt(0)" ::: "memory");
    __syncthreads();
    if (X.tid() == 0) { __builtin_amdgcn_fence(__ATOMIC_RELEASE, "agent"); __hip_atomic_fetch_add(X.ctl() + 64 + layer, 1u, __ATOMIC_RELAXED, __HIP_MEMORY_SCOPE_AGENT); }
}
__device__ __forceinline__ void scan_wait(const Ctx& X, int layer) {
    if (X.tid() == 0) { unsigned sp = 0;
        while (__hip_atomic_load(X.ctl() + 64 + layer, __ATOMIC_RELAXED, __HIP_MEMORY_SCOPE_AGENT) < (unsigned)X.G) { __builtin_amdgcn_s_sleep(2); if (++sp > (1u << 24)) break; }
        __builtin_amdgcn_fence(__ATOMIC_ACQUIRE, "agent"); }
    __syncthreads();
    __builtin_amdgcn_fence(__ATOMIC_ACQUIRE, "workgroup");
}

constexpr int AT_KS = 0, AT_WL = 4096, AT_RING = 8192, AT_SLOT = 16384, AT_NSLOT = 8;
static_assert(AT_RING + AT_NSLOT * AT_SLOT <= MISC_OFF, "attention ring");
__device__ __forceinline__ s16x4 vtr(const LAS unsigned char* p) { typedef short v4i16_t __attribute__((ext_vector_type(4))); return __builtin_bit_cast(s16x4, __builtin_amdgcn_ds_read_tr16_b64_v4i16((LAS v4i16_t*)p)); }
#define AT_WAITBAR(N) asm volatile("s_waitcnt vmcnt(" #N ") lgkmcnt(0)\n\ts_barrier" ::: "memory")
__device__ __forceinline__ void at_kload(bf16x8 (&kf)[8], const LAS unsigned char* Kb, int r32, int hi) {
#pragma unroll
    for (int d0 = 0; d0 < 4; ++d0) { kf[2 * d0] = *(const LAS bf16x8*)(Kb + (2 * d0 + hi) * 1024 + r32 * 16); kf[2 * d0 + 1] = *(const LAS bf16x8*)(Kb + (2 * d0 + hi) * 1024 + (32 + r32) * 16); }
}
template <bool OWN, bool HN1, int TT>
__device__ __forceinline__ void attn_tile(f32x16& pc0, f32x16& pc1, f32x16& pn0, f32x16& pn1, f32x16& o0, f32x16& o1, f32x16& o2, const f32x16& bvec, bf16x8 (&kf)[8], const bf16x8 (&qr)[4],
                                          const LAS unsigned char* Vb, const LAS unsigned char* Kn1, int vpo, int r32, int hi, int qh) {
    if (HN1) at_kload(kf, Kn1, r32, hi);
    s16x4 vl[4], vh[4];
#pragma unroll
    for (int i = 0; i < 4; ++i) { vl[i] = vtr(Vb + vpo + i * 1024); vh[i] = vtr(Vb + vpo + i * 1024 + 512); }
    __builtin_amdgcn_sched_barrier(0);
#pragma unroll
    for (int d0 = 0; d0 < 4; ++d0) {
#pragma unroll
        for (int r = 4 * d0; r < 4 * d0 + 4; ++r) pc0[r] = __builtin_amdgcn_exp2f(pc0[r]);
        if (HN1) pn0 = MFMA32(kf[2 * d0], qr[d0], d0 == 0 ? bvec : pn0);
#pragma unroll
        for (int r = 4 * d0; r < 4 * d0 + 4; ++r) pc1[r] = __builtin_amdgcn_exp2f(pc1[r]);
        if (HN1) pn1 = MFMA32(kf[2 * d0 + 1], qr[d0], d0 == 0 ? bvec : pn1);
    }
    if (OWN) {
#pragma unroll
        for (int r = 0; r < 16; ++r) { const int kc = 64 * TT + (r & 3) + 8 * (r >> 2);
            pc0[r] = (kc > qh) ? 0.f : pc0[r]; pc1[r] = (kc + 32 > qh) ? 0.f : pc1[r]; }
    }
    s16x4 wl_[4], wh_[4];
#pragma unroll
    for (int i = 0; i < 4; ++i) { wl_[i] = vtr(Vb + vpo + 4096 + i * 1024); wh_[i] = vtr(Vb + vpo + 4096 + i * 1024 + 512); }
    __builtin_amdgcn_sched_barrier(0);
    bf16x8 pa[4];
#pragma unroll
    for (int s = 0; s < 2; ++s) {
        u32x4 w0; w0.x = cvtpk(pc0[8 * s + 0], pc0[8 * s + 1]); w0.y = cvtpk(pc0[8 * s + 2], pc0[8 * s + 3]); w0.z = cvtpk(pc0[8 * s + 4], pc0[8 * s + 5]); w0.w = cvtpk(pc0[8 * s + 6], pc0[8 * s + 7]);
        u32x4 w1; w1.x = cvtpk(pc1[8 * s + 0], pc1[8 * s + 1]); w1.y = cvtpk(pc1[8 * s + 2], pc1[8 * s + 3]); w1.z = cvtpk(pc1[8 * s + 4], pc1[8 * s + 5]); w1.w = cvtpk(pc1[8 * s + 6], pc1[8 * s + 7]);
        pa[s] = __builtin_bit_cast(bf16x8, w0); pa[2 + s] = __builtin_bit_cast(bf16x8, w1);
    }
    const bf16x8 ones = (bf16x8){0x3f80, 0x3f80, 0x3f80, 0x3f80, 0x3f80, 0x3f80, 0x3f80, 0x3f80};
#pragma unroll
    for (int ks = 0; ks < 4; ++ks) { const bf16x8 vb0 = (bf16x8){vl[ks][0], vl[ks][1], vl[ks][2], vl[ks][3], vh[ks][0], vh[ks][1], vh[ks][2], vh[ks][3]}; o0 = MFMA32(pa[ks], vb0, o0); o2 = MFMA32(pa[ks], ones, o2); }
#pragma unroll
    for (int ks = 0; ks < 4; ++ks) { const bf16x8 vb1 = (bf16x8){wl_[ks][0], wl_[ks][1], wl_[ks][2], wl_[ks][3], wh_[ks][0], wh_[ks][1], wh_[ks][2], wh_[ks][3]}; o1 = MFMA32(pa[ks], vb1, o1); }
}
__device__ __forceinline__ void attn_unit(const Ctx& X, int layer, int b, int h, int qi) {
    int lane_ = X.lane(), wid_ = X.wave; asm volatile("" : "+v"(lane_), "+s"(wid_));
    const int lane = lane_, wid = wid_, tid = wid * 64 + lane, r32 = lane & 31, hi = lane >> 5;
    LAS unsigned char* lds = X.lds;
    const bf16_t* P = X.proj();
    const size_t rowbase = (size_t)b * SEQ;
    const size_t qrow = rowbase + 256 * qi + 32 * wid + r32;
    float gqm = fabsf(X.qn_g()[layer * 64 + lane]), gkm = fabsf(X.kn_g()[layer * 64 + lane]);
    gqm = wave_max(gqm); gkm = wave_max(gkm);
    const float negM = -(8.3f * gqm * gkm * LOG2E);
    bf16x8 qr[4];
#pragma unroll
    for (int d0 = 0; d0 < 4; ++d0) qr[d0] = *(const bf16x8*)(P + qrow * PP + C_BQ + 64 * h + 16 * d0 + 8 * hi);
    {
        LAS float* ks = (LAS float*)(lds + AT_KS);
#pragma unroll
        for (int e = 0; e < 2; ++e) { const int idx = tid * 2 + e, n = idx >> 6, d = idx & 63; float s = 0.f;
#pragma unroll
            for (int p = 0; p < 2; ++p) s += X.kpart()[((size_t)(b * 16 + n) * 2 + p) * 512 + 64 * h + d];
            ks[idx] = s; }
    }
    __syncthreads();
    const unsigned kgo = (unsigned)(((rowbase + lane) * PP + C_BK + 64 * h + 8 * wid) * 2);
    const unsigned vgo = (unsigned)(((rowbase + 16 * (wid & 3) + (lane >> 2)) * PP + C_BV + 64 * h + (wid >> 2) * 32 + (lane & 3) * 8) * 2);
    const unsigned lds0 = (unsigned)(uintptr_t)lds;
#define AT_ISSUE(t) do { const unsigned sl_ = (unsigned)__builtin_amdgcn_readfirstlane((int)(lds0 + AT_RING + ((t) & (AT_NSLOT - 1)) * AT_SLOT + wid * 1024)); \
        glds16(P, kgo + (unsigned)(t) * (64u * PP * 2u), sl_); glds16(P, vgo + (unsigned)(t) * (64u * PP * 2u), sl_ + 8192u); } while (0)
#define AT_SLOTP(t) (lds + AT_RING + ((t) & (AT_NSLOT - 1)) * AT_SLOT)
    const int T = 4 * (qi + 1);
    AT_ISSUE(0); AT_ISSUE(1); AT_ISSUE(2); AT_ISSUE(3);
    unsigned sel = 0u;
    if (qi <= 3) sel = (1u << qi) - 1u;
    else {
        float qf[32];
#pragma unroll
        for (int d0 = 0; d0 < 4; ++d0) { const u32x4 w = __builtin_bit_cast(u32x4, qr[d0]);
            qf[8 * d0 + 0] = bflo(w.x); qf[8 * d0 + 1] = bfhi(w.x); qf[8 * d0 + 2] = bflo(w.y); qf[8 * d0 + 3] = bfhi(w.y);
            qf[8 * d0 + 4] = bflo(w.z); qf[8 * d0 + 5] = bfhi(w.z); qf[8 * d0 + 6] = bflo(w.w); qf[8 * d0 + 7] = bfhi(w.w); }
        float gt[15];
        const LAS float* ks = (const LAS float*)(lds + AT_KS);
#pragma unroll
        for (int n = 0; n < 15; ++n) {
            float s = 0.f;
            if (n < qi) {
#pragma unroll
                for (int d0 = 0; d0 < 4; ++d0) { const f32x4 k0 = *(const LAS f32x4*)(ks + n * 64 + 16 * d0 + 8 * hi), k1 = *(const LAS f32x4*)(ks + n * 64 + 16 * d0 + 8 * hi + 4);
                    s += qf[8 * d0 + 0] * k0.x + qf[8 * d0 + 1] * k0.y + qf[8 * d0 + 2] * k0.z + qf[8 * d0 + 3] * k0.w + qf[8 * d0 + 4] * k1.x + qf[8 * d0 + 5] * k1.y + qf[8 * d0 + 6] * k1.z + qf[8 * d0 + 7] * k1.w; }
                s += __shfl_xor(s, 32);
                asm volatile("" ::: "memory");
            }
            gt[n] = (n < qi) ? s : -INFINITY;
        }
#pragma unroll
        for (int pass = 0; pass < 3; ++pass) {
            float best = -INFINITY; int bi = -1;
#pragma unroll
            for (int n = 0; n < 15; ++n) if (gt[n] > best) { best = gt[n]; bi = n; }
            if (bi >= 0) sel |= 1u << bi;
#pragma unroll
            for (int n = 0; n < 15; ++n) if (n == bi) gt[n] = -INFINITY;
        }
    }
    const float NEGBIG = -1.0e30f;
#define AT_BIAS(t) (((t) >= T - 4) ? negM : ((((sel >> ((t) >> 2)) & 1u) != 0u) ? negM : NEGBIG))
    f32x16 o0 = {}, o1 = {}, o2 = {}, pA0, pA1, pB0, pB1, bvec; bf16x8 kf[8];
    const int vpo = ((lane >> 4) & 1) * 32 + (lane & 3) * 8 + (4 * hi + ((lane & 15) >> 2)) * 64;
    const int qh = 32 * wid + r32 - 4 * hi;
    AT_WAITBAR(6);
    at_kload(kf, AT_SLOTP(0), r32, hi);
    { const float b0 = AT_BIAS(0);
#pragma unroll
      for (int r = 0; r < 16; ++r) bvec[r] = b0;
#pragma unroll
      for (int d0 = 0; d0 < 4; ++d0) { pA0 = MFMA32(kf[2 * d0], qr[d0], d0 == 0 ? bvec : pA0); pA1 = MFMA32(kf[2 * d0 + 1], qr[d0], d0 == 0 ? bvec : pA1); } }
#define AT_STEP(OWN, HN1, HN2, TT, PC0, PC1, PN0, PN1, t) do { \
        if ((t) + 3 < T) AT_WAITBAR(4); else if ((t) + 2 < T) AT_WAITBAR(2); else AT_WAITBAR(0); \
        if ((t) + 4 < T) AT_ISSUE((t) + 4); \
        if ((((t) + 1) & 3) == 0) { const float bn_ = AT_BIAS((t) + 1); _Pragma("unroll") for (int r_ = 0; r_ < 16; ++r_) bvec[r_] = bn_; }        \
        attn_tile<OWN, HN1, TT>(PC0, PC1, PN0, PN1, o0, o1, o2, bvec, kf, qr, AT_SLOTP(t) + 8192, AT_SLOTP((t) + 1), vpo, r32, hi, qh); } while (0)
    int t = 0;
    for (; t < T - 4; t += 2) {
        AT_STEP(false, true, true, 0, pA0, pA1, pB0, pB1, t);
        AT_STEP(false, true, true, 0, pB0, pB1, pA0, pA1, t + 1);
    }
    AT_STEP(true, true, true, 0, pA0, pA1, pB0, pB1, t);
    AT_STEP(true, true, true, 1, pB0, pB1, pA0, pA1, t + 1);
    AT_STEP(true, true, false, 2, pA0, pA1, pB0, pB1, t + 2);
    AT_STEP(true, false, false, 3, pB0, pB1, pA0, pA1, t + 3);
    bf16_t* orow = X.ab() + (rowbase + 256 * qi + 32 * wid) * DM + 256 + 64 * h;
#pragma unroll
    for (int r = 0; r < 16; ++r) { const int q = crow(r, hi); const float rl = 1.0f / o2[r];
        orow[(size_t)q * DM + r32] = (bf16_t)(cvtpk(o0[r] * rl, 0.f) & 0xffffu);
        orow[(size_t)q * DM + 32 + r32] = (bf16_t)(cvtpk(o1[r] * rl, 0.f) & 0xffffu); }
    __syncthreads();
#undef AT_ISSUE
#undef AT_SLOTP
#undef AT_BIAS
#undef AT_STEP
}

__device__ __forceinline__ void router_flush(const Ctx& X, int layer, LAS unsigned* lcnt, LAS unsigned* rec, int nrow) {
    __syncthreads();
    if (X.tid() < 4) { const int q = X.tid(); const unsigned long long add = (unsigned long long)lcnt[4 * q] | ((unsigned long long)lcnt[4 * q + 1] << 16) | ((unsigned long long)lcnt[4 * q + 2] << 32) | ((unsigned long long)lcnt[4 * q + 3] << 48);
        const unsigned long long old = __hip_atomic_fetch_add((unsigned long long*)(X.ctl() + ecnt_idx(layer, q)), add, __ATOMIC_RELAXED, __HIP_MEMORY_SCOPE_AGENT);
        lcnt[16 + 4 * q] = (unsigned)(old & 0xffffull); lcnt[16 + 4 * q + 1] = (unsigned)((old >> 16) & 0xffffull); lcnt[16 + 4 * q + 2] = (unsigned)((old >> 32) & 0xffffull); lcnt[16 + 4 * q + 3] = (unsigned)(old >> 48); }
    __syncthreads();
    if (X.lane() < nrow) { const LAS unsigned* rc = rec + (X.wave * 16 + X.lane()) * 8;
        const unsigned e0 = rc[0], e1 = rc[1], i0 = lcnt[16 + e0] + rc[2], i1 = lcnt[16 + e1] + rc[3], m = rc[6];
        X.amap()[e0 * MOE_CAP + i0] = m; X.amap()[e1 * MOE_CAP + i1] = m; X.slotw()[e0 * MOE_CAP + i0] = __uint_as_float(rc[4]); X.slotw()[e1 * MOE_CAP + i1] = __uint_as_float(rc[5]);
        unsigned* rt = X.route() + (size_t)m * 8; *(u32x4*)rt = (u32x4){e0, e1, i0, i1}; }
    __syncthreads();
    if (X.tid() < 16) lcnt[X.tid()] = 0u;
    __syncthreads();
}

__device__ __forceinline__ void router_row(const Ctx& X, int layer, int m, f32x4 (&v)[4], const f32x4 (&gn)[4], int lane, const LAS float* wr, LAS unsigned* lcnt, LAS unsigned* rec, int nrow) {
    constexpr int RT_MAXROWS = 16;
        {
            float s = 0.f;
#pragma unroll
            for (int j = 0; j < 4; ++j) s += (v[j].x * v[j].x + v[j].y * v[j].y) + (v[j].z * v[j].z + v[j].w * v[j].w);
            const float rstd = rsqrtf(wave_sum(s) * (1.f / DM) + EPS);
            unsigned* o4 = (unsigned*)((unsigned char*)X.ab() + (size_t)m * DM) + lane;
#pragma unroll
            for (int j = 0; j < 4; ++j) { const f32x4 gg = gn[j]; v[j] = v[j] * rstd * gg; int p = 0; p = __builtin_amdgcn_cvt_pk_fp8_f32(v[j].x, v[j].y, p, false); p = __builtin_amdgcn_cvt_pk_fp8_f32(v[j].z, v[j].w, p, true); o4[64 * j] = (unsigned)p; }
        }
        float lg[4];
#pragma unroll
        for (int c = 0; c < 4; ++c) { float s = 0.f;
#pragma unroll
            for (int j = 0; j < 4; ++j) { const f32x4 w = *(const LAS f32x4*)(wr + c * DM + 4 * (64 * j + lane)); s += v[j].x * w.x + v[j].y * w.y + v[j].z * w.z + v[j].w * w.w; }
            lg[c] = wave_sum(s); }
        asm volatile("" ::: "memory");
        int gs = 0; float gm = lg[0];
#pragma unroll
        for (int c = 1; c < 4; ++c) if (lg[c] > gm) { gm = lg[c]; gs = c; }
        float den = 0.f;
#pragma unroll
        for (int c = 0; c < 4; ++c) den += __expf(lg[c] - gm);
        const float pg = 1.0f / den;
        float le[4];
        { const LAS float* wre = wr + (4 + 4 * gs) * DM;
#pragma unroll
          for (int j = 0; j < 4; ++j) { float s = 0.f;
#pragma unroll
              for (int q = 0; q < 4; ++q) { const f32x4 w = *(const LAS f32x4*)(wre + j * DM + 4 * (64 * q + lane)); s += v[q].x * w.x + v[q].y * w.y + v[q].z * w.z + v[q].w * w.w; }
              le[j] = wave_sum(s); } }
        int i1 = 0; float v1 = le[0];
#pragma unroll
        for (int j = 1; j < 4; ++j) if (le[j] > v1) { v1 = le[j]; i1 = j; }
        int i2 = -1; float v2 = -INFINITY;
#pragma unroll
        for (int j = 0; j < 4; ++j) if (j != i1 && le[j] > v2) { v2 = le[j]; i2 = j; }
        const float ex = __expf(v2 - v1); const float w1 = pg / (1.f + ex), w2 = pg * ex / (1.f + ex);
        if (lane == 0) {
            const int e0 = 4 * gs + i1, e1 = 4 * gs + i2;
            const unsigned p0 = __hip_atomic_fetch_add(lcnt + e0, 1u, __ATOMIC_RELAXED, __HIP_MEMORY_SCOPE_WORKGROUP), p1 = __hip_atomic_fetch_add(lcnt + e1, 1u, __ATOMIC_RELAXED, __HIP_MEMORY_SCOPE_WORKGROUP);
            LAS unsigned* rc = rec + (X.wave * RT_MAXROWS + nrow) * 8;
            rc[0] = (unsigned)e0; rc[1] = (unsigned)e1; rc[2] = p0; rc[3] = p1; rc[4] = __float_as_uint(w1); rc[5] = __float_as_uint(w2); rc[6] = (unsigned)m;
        }
}

__device__ __forceinline__ void router_phase(const Ctx& X, int layer) {
    LAS float* wr = (LAS float*)X.lds;
    {
        f32x4 rg[2], re[2][4];
#pragma unroll
        for (int q = 0; q < 2; ++q) { const int k = X.tid() + 512 * q; rg[q] = *(const f32x4*)(X.w_rg() + (size_t)layer * DM * 4 + k * 4);
#pragma unroll
            for (int j = 0; j < 4; ++j) re[q][j] = *(const f32x4*)(X.w_re() + (size_t)layer * DM * 16 + k * 16 + 4 * j); }
#pragma unroll
        for (int q = 0; q < 2; ++q) { const int k = X.tid() + 512 * q;
#pragma unroll
            for (int c = 0; c < 4; ++c) wr[c * DM + k] = rg[q][c];
#pragma unroll
            for (int j = 0; j < 4; ++j)
#pragma unroll
                for (int c = 0; c < 4; ++c) wr[(4 + 4 * j + c) * DM + k] = re[q][j][c]; }
    }
    LAS unsigned* lcnt = (LAS unsigned*)(X.lds + MISC_OFF + 256);
    if (X.tid() < 16) lcnt[X.tid()] = 0u;
    __syncthreads();
    const int lane = X.lane();
    constexpr int RT_MAXROWS = 16;
    LAS unsigned* rec = (LAS unsigned*)(X.lds + 90112);
    int nrow = 0;
    f32x4 gn[4]; { const f32x4* gr = (const f32x4*)(X.ffn_g() + layer * DM) + lane;
#pragma unroll
        for (int j = 0; j < 4; ++j) gn[j] = gr[64 * j]; }
    f32x4 v[4]; u32x2 bA[4], bB[4];
#define RT_LOADRAW(buf, mm) do { const u32x2* xr_ = (const u32x2*)(X.x1b() + (size_t)(mm) * DM) + lane; _Pragma("unroll") for (int j_ = 0; j_ < 4; ++j_) buf[j_] = __builtin_nontemporal_load(xr_ + 64 * j_); } while (0)
#define RT_CVT(buf) do { _Pragma("unroll") for (int j_ = 0; j_ < 4; ++j_) v[j_] = (f32x4){bflo(buf[j_].x), bfhi(buf[j_].x), bflo(buf[j_].y), bfhi(buf[j_].y)}; } while (0)
    if (X.gw < NTOK) RT_LOADRAW(bB, X.gw);
    if (X.gw + X.NGW < NTOK) RT_LOADRAW(bA, X.gw + X.NGW);
    if (X.gw < NTOK) RT_CVT(bB);
    const int npass = (NTOK + X.NGW - 1) / X.NGW;
    for (int it = 0; it < npass; it += 2) {
        if (it > 0 && (it & (RT_MAXROWS - 1)) == 0) { router_flush(X, layer, lcnt, rec, nrow); nrow = 0; }
        { const int m = X.gw + it * X.NGW;
          if (m < NTOK) { if (m + 2 * X.NGW < NTOK) RT_LOADRAW(bB, m + 2 * X.NGW);
              __builtin_amdgcn_sched_barrier(0);
              router_row(X, layer, m, v, gn, lane, wr, lcnt, rec, nrow); ++nrow;
              if (m + X.NGW < NTOK) RT_CVT(bA); } }
        if (it + 1 < npass) { const int m = X.gw + (it + 1) * X.NGW;
          if (m < NTOK) { if (m + 2 * X.NGW < NTOK) RT_LOADRAW(bA, m + 2 * X.NGW);
              __builtin_amdgcn_sched_barrier(0);
              router_row(X, layer, m, v, gn, lane, wr, lcnt, rec, nrow); ++nrow;
              if (m + X.NGW < NTOK) RT_CVT(bB); } }
    }
#undef RT_LOADRAW
#undef RT_CVT
    router_flush(X, layer, lcnt, rec, nrow);
}

__device__ __forceinline__ int expert_off_rows(const Ctx& X, int layer, int lane) {
    const int e = lane & 15; const unsigned c = (__hip_atomic_load(X.ctl() + ecnt_idx(layer, e >> 2) + ((e >> 1) & 1), __ATOMIC_RELAXED, __HIP_MEMORY_SCOPE_AGENT) >> (16 * (e & 1))) & 0xffffu;
    const int tiles = (int)((c + 255u) >> 8); int incl = tiles;
#pragma unroll
    for (int o = 1; o < 16; o <<= 1) { const int t = __shfl_up(incl, o, 16); if (e >= o) incl += t; }
    return (incl - tiles) * 256;
}

__device__ __forceinline__ void moe_table(const Ctx& X, int layer) {
    volatile LAS int* toff = (volatile LAS int*)(X.lds + MISC_OFF);
    if (X.tid() < 64) { const int off = expert_off_rows(X, layer, X.lane());
        if (X.lane() < 16) toff[X.lane()] = off >> 8;
        if (X.lane() == 15) { const unsigned c = __hip_atomic_load(X.ctl() + ecnt_idx(layer, 3) + 1, __ATOMIC_RELAXED, __HIP_MEMORY_SCOPE_AGENT) >> 16; toff[16] = (off >> 8) + (int)((c + 255u) >> 8); } }
    __syncthreads();
}

__device__ __forceinline__ void combine_phase(const Ctx& X, int layer) {
    const int lane = X.lane();
    int m = X.gw; unsigned sB0 = 0, sB1 = 0, sC0 = 0, sC1 = 0;
    u32x2 xc[4], xn[4]; u32x2 ya[4], yb[4], yan[4], ybn[4];
#define CB_LOAD(XV, YA, YB, mm, s0, s1) do { const u32x2* xr_ = (const u32x2*)(X.x1b() + (size_t)(mm) * DM) + lane; const u32x2* y0_ = (const u32x2*)(X.aperm() + (size_t)(s0) * DM) + lane; const u32x2* y1_ = (const u32x2*)(X.aperm() + (size_t)(s1) * DM) + lane; \
        _Pragma("unroll") for (int j = 0; j < 4; ++j) { XV[j] = __builtin_nontemporal_load(xr_ + 64 * j); YA[j] = __builtin_nontemporal_load(y0_ + 64 * j); YB[j] = __builtin_nontemporal_load(y1_ + 64 * j); } } while (0)
    const int eoff = expert_off_rows(X, layer, lane);
#define CB_SLOTS(mm, s0, s1) do { const u32x4 r_ = *(const u32x4*)(X.route() + (size_t)(mm) * 8); s0 = (unsigned)__shfl(eoff, (int)(r_.x & 15u)) + r_.z; s1 = (unsigned)__shfl(eoff, (int)(r_.y & 15u)) + r_.w; } while (0)
    if (m < NTOK) { unsigned s0, s1; CB_SLOTS(m, s0, s1); CB_LOAD(xc, ya, yb, m, s0, s1); }
    if (m + X.NGW < NTOK) { CB_SLOTS(m + X.NGW, sB0, sB1); }
    for (; m < NTOK; m += X.NGW) {
        const int mn = m + X.NGW, mnn = m + 2 * X.NGW;
        if (mn < NTOK) CB_LOAD(xn, yan, ybn, mn, sB0, sB1);
        if (mnn < NTOK) { CB_SLOTS(mnn, sC0, sC1); }
        float* xr = X.out() + (size_t)m * DM;
        f32x4 v[4]; float ss = 0.f;
#pragma unroll
        for (int j = 0; j < 4; ++j) { const f32x4 xv = (f32x4){bflo(xc[j].x), bfhi(xc[j].x), bflo(xc[j].y), bfhi(xc[j].y)}; const u32x2 a = ya[j], bq = yb[j];
            f32x4 r; r.x = xv.x + bflo(a.x) + bflo(bq.x); r.y = xv.y + bfhi(a.x) + bfhi(bq.x); r.z = xv.z + bflo(a.y) + bflo(bq.y); r.w = xv.w + bfhi(a.y) + bfhi(bq.y);
            v[j] = r; ss += (r.x * r.x + r.y * r.y) + (r.z * r.z + r.w * r.w);
            if (layer + 1 < DEPTH) { u32x2 w; w.x = cvtpk(r.x, r.y); w.y = cvtpk(r.z, r.w); ((u32x2*)(X.x1b() + (size_t)m * DM))[64 * j + lane] = w; }
            else ((f32x4*)xr)[64 * j + lane] = r; }
        if (layer + 1 < DEPTH) {
            const float rstd = rsqrtf(wave_sum(ss) * (1.f / DM) + EPS);
            const f32x4* gr = (const f32x4*)(X.attn_g() + (layer + 1) * DM) + lane; u32x2* o8 = (u32x2*)(X.ab() + (size_t)m * DM) + lane;
#pragma unroll
            for (int j = 0; j < 4; ++j) { const f32x4 gg = gr[64 * j]; const f32x4 hh = v[j] * rstd * gg; u32x2 w; w.x = cvtpk(hh.x, hh.y); w.y = cvtpk(hh.z, hh.w); o8[64 * j] = w;
                int p = 0; p = __builtin_amdgcn_cvt_pk_fp8_f32(hh.x, hh.y, p, false); p = __builtin_amdgcn_cvt_pk_fp8_f32(hh.z, hh.w, p, true); ((unsigned*)(X.h8() + (size_t)m * DM))[64 * j + lane] = (unsigned)p; }
        }
#pragma unroll
        for (int j = 0; j < 4; ++j) { xc[j] = xn[j]; ya[j] = yan[j]; yb[j] = ybn[j]; }
        sB0 = sC0; sB1 = sC1;
    }
#undef CB_LOAD
#undef CB_SLOTS
}

#define XB_TMO      128
#define XB_XCNT(j)  (256  + 64 * (j))
#define XB_XSUB(j)  (1280 + 64 * (j))
#define XB_XGEN(j)  (2304 + 64 * (j))
#define XB_TOP      3328
#define XB_TOPGEN   3392
#define XB_SPIN_CAP (1u << 22)
__device__ __forceinline__ unsigned xb_ld(unsigned* p)              { return __hip_atomic_load(p, __ATOMIC_RELAXED, __HIP_MEMORY_SCOPE_AGENT); }
__device__ __forceinline__ unsigned xb_add(unsigned* p, unsigned v) { return __hip_atomic_fetch_add(p, v, __ATOMIC_RELAXED, __HIP_MEMORY_SCOPE_AGENT); }
__device__ __forceinline__ unsigned xb_xcc_id() { return (unsigned)__builtin_amdgcn_s_getreg((3 << 11) | 20) & 0xFu; }
#define XB_SPIN(cond, bar) do { unsigned _sp = 0; while (cond) { __builtin_amdgcn_s_sleep(1); \
    if ((++_sp & 255u) == 0u) { if (xb_ld(&(bar)[XB_TMO])) break; if (_sp > XB_SPIN_CAP) { atomicAdd(&(bar)[XB_TMO], 1u); break; } } } } while (0)
struct XcdBarrier { unsigned* bar; unsigned x; volatile LAS unsigned* st; };
__device__ __forceinline__ XcdBarrier xcd_barrier_post(unsigned* bar, volatile LAS unsigned* st) {
    XcdBarrier b; b.bar = bar; b.x = xb_xcc_id(); b.st = st;
    if (threadIdx.x == 0) (void)xb_add(&bar[XB_XCNT(b.x)], 1u);
    return b;
}
__device__ __forceinline__ void xcd_barrier_complete(unsigned* bar, unsigned x, unsigned& nloc, unsigned& nx) {
    const unsigned G = gridDim.x * gridDim.y * gridDim.z;
    unsigned sum, cnt, mine, sp = 0u;
    for (;;) {
        sum = 0u; cnt = 0u; mine = 0u;
#pragma unroll 1
        for (unsigned j = 0; j < 16; ++j) { const unsigned c = xb_ld(&bar[XB_XCNT(j)]); sum += c; cnt += (c > 0u) ? 1u : 0u; mine = (j == x) ? c : mine; }
        if (sum == G) break;
        __builtin_amdgcn_s_sleep(1);
        if ((++sp & 255u) == 0u) { if (xb_ld(&bar[XB_TMO])) break; if (sp > XB_SPIN_CAP) { atomicAdd(&bar[XB_TMO], 1u); break; } }
    }
    nloc = mine > 0u ? mine : 1u; nx = cnt > 0u ? cnt : 1u;
}
__device__ __forceinline__ void xcd_barrier(const XcdBarrier& b) {
    asm volatile("s_waitcnt vmcnt(0)" ::: "memory");
    __syncthreads();
    if (threadIdx.x == 0) {
        unsigned* bar = b.bar; unsigned bx_ = b.x;
        asm volatile("" : "+s"(bar), "+s"(bx_));
        __builtin_amdgcn_s_waitcnt(0);
        unsigned nloc = b.st[0], nx = b.st[1];
        if (nloc == 0u) { xcd_barrier_complete(bar, bx_, nloc, nx); b.st[0] = nloc; b.st[1] = nx; }
        const unsigned old = xb_add(&bar[XB_XSUB(bx_)], 1u);
        const unsigned gen = old / nloc;
        if (old + 1u == (gen + 1u) * nloc) {
            __builtin_amdgcn_fence(__ATOMIC_RELEASE, "agent");
            asm volatile("s_waitcnt vmcnt(0)" ::: "memory");
            const unsigned og = xb_add(&bar[XB_TOP], 1u);
            const unsigned tg = og / nx;
            if (og + 1u == (tg + 1u) * nx) xb_add(&bar[XB_TOPGEN], 1u);
            else XB_SPIN(xb_ld(&bar[XB_TOPGEN]) == tg, bar);
            __builtin_amdgcn_fence(__ATOMIC_ACQUIRE, "agent");
            xb_add(&bar[XB_XGEN(bx_)], 1u);
            asm volatile("s_waitcnt vmcnt(0)" ::: "memory");
        } else {
            XB_SPIN(xb_ld(&bar[XB_XGEN(bx_)]) == gen, bar);
            __builtin_amdgcn_fence(__ATOMIC_ACQUIRE, "agent");
            asm volatile("s_waitcnt vmcnt(0)" ::: "memory");
        }
    }
    __syncthreads();
}

#ifndef PHMASK
#define PHMASK 0xffff
#endif
#ifndef PROBE_A
#define PROBE_A -1
#define PROBE_B -1
#endif
#ifndef PROBE_BLK
#define PROBE_BLK 0
#endif
constexpr int NPHASE = 1 + 7 * DEPTH;
__global__ void __launch_bounds__(512, 2) fwd_kernel(Args args) {
    extern __shared__ __attribute__((aligned(16))) unsigned char lds_raw[];
    cg::grid_group grid = cg::this_grid();
    const int wave_s = __builtin_amdgcn_readfirstlane((int)(threadIdx.x >> 6));
    const int lo = args.ph_lo, hi = args.ph_hi;
    { volatile LAS unsigned* m = (volatile LAS unsigned*)((LAS unsigned char*)lds_raw + MISC_OFF); if (threadIdx.x < 64) m[threadIdx.x] = 0u; }
    __syncthreads();
    XcdBarrier xbar; xbar.bar = (unsigned*)(args.ws + WS_CTL) + CW_BAR; xbar.x = 0u; xbar.st = (volatile LAS unsigned*)((LAS unsigned char*)lds_raw + MISC_OFF + 128);
#if PROBE_A >= 0
    unsigned prA = 0, prT = 0, prE = 0; const unsigned prS = (unsigned)__builtin_amdgcn_s_memrealtime();
#define PROBE_ACC(type, d) do { if ((type) == PROBE_A) prA += (d); } while (0)
#endif
#if PROBE_A >= 0
#define PROBE_SUB(type) do { __syncthreads(); const unsigned t_ = (unsigned)__builtin_amdgcn_s_memrealtime(); PROBE_ACC(type, t_ - prSub); prSub = t_; } while (0)
    unsigned prSub = 0;
#else
#define PROBE_SUB(type) do {} while (0)
#endif
    for (int ph = lo; ph < hi; ++ph) {
        if (ph > lo) { if (ph == lo + 1) { grid.sync(); xbar = xcd_barrier_post((unsigned*)(args.ws + WS_CTL) + CW_BAR, (volatile LAS unsigned*)((LAS unsigned char*)lds_raw + MISC_OFF + 128)); } else xcd_barrier(xbar); }
#if PROBE_A >= 0
        prT = (unsigned)__builtin_amdgcn_s_memrealtime(); prSub = prT; if (ph > lo) PROBE_ACC(11, prT - prE);
#endif
        Ctx X;
#define CTX_REFRESH() do { \
        { unsigned l0 = 0u; asm volatile("" : "+s"(l0)); X.lds = (LAS unsigned char*)lds_raw + l0; } \
        { unsigned z0 = 0u; asm volatile("" : "+s"(z0)); \
          int ws = wave_s; asm volatile("" : "+s"(ws)); (void)z0; \
          X.wave = ws; } \
        { int bx = blockIdx.x, G = gridDim.x; asm volatile("" : "+s"(bx), "+s"(G)); X.G = G; X.vcu = (G % 8 == 0) ? (bx % 8) * (G / 8) + bx / 8 : bx; X.bx = bx; } \
        X.gw = X.vcu * 8 + X.wave; X.NGW = X.G * 8; \
        { const __attribute__((address_space(4))) unsigned char* ka = (const __attribute__((address_space(4))) unsigned char*)__builtin_amdgcn_kernarg_segment_ptr(); asm volatile("" : "+s"(ka)); X.ka = ka; } } while (0)
        CTX_REFRESH();
        const int layer = (ph - 1) / 7; const int k = ph == 0 ? 0 : (0xA865421 >> (4 * ((ph - 1) % 7))) & 15;
        if (ph == 0) { phase0(X); PROBE_SUB(15); CTX_REFRESH(); phase0b(X); PROBE_SUB(16); }
        else switch (k) {
        case 1: {
            {
                pg8::Gemm g{X.ab(), X.win() + (size_t)layer * NW_IN * DM, DM}; pg8::StaticOrder S; S.init(NTOK, 1536, X.G, X.bx, 0xCBA910ull, 0, 0);
                EpiProj<false> E{X.proj(), X.lr(), X.qn_g() + layer * 64, X.kn_g() + layer * 64, X.cosT(), X.sinT(), X.kpart()};
                pg8::gemm_phase<EpiProj<false>, pg8::StaticOrder>(X.lds, g, S, E, X.tid()); }
            PROBE_SUB(19);
            CTX_REFRESH();
            {
                pg8::Gemm g{(const bf16_t*)X.h8(), (const bf16_t*)((const unsigned char*)(X.win() + (size_t)layer * NW_IN * DM) + (size_t)C_BQ * DM * 2), DM / 2}; pg8::StaticOrder S; S.init(NTOK, 2048, X.G, X.bx, 0x2D876543ull, 1, 1);
                EpiProj<true> E{X.proj(), X.lr(), X.qn_g() + layer * 64, X.kn_g() + layer * 64, X.cosT(), X.sinT(), X.kpart()};
                pg8::gemm_phase<EpiProj<true>, pg8::StaticOrder, false, true>(X.lds, g, S, E, X.tid()); }
        } break;
        case 2: {
            PROBE_SUB(17);
            LAS unsigned char* wl = X.lds + X.wave * WAVE_LDS;
            for (int it = X.gw; it < 2048; it += X.NGW) { const int h8 = it & 7, bc = it >> 3, b = bc >> 6, c = bc & 63;
                if (h8 < 4) lin_item<true, false>(X, layer, b, c, h8, wl); else lin_item<false, false>(X, layer, b, c, h8 - 4, wl); }
            PROBE_SUB(18);
        } break;
        case 4: {
            scan_phase(X, layer);
            PROBE_SUB(3);
            CTX_REFRESH();
            if (PHMASK & 0x800) for (int v = X.vcu; v < 256; v += X.G) { const int bh = v >> 3, s = v & 7; attn_unit(X, layer, bh >> 3, bh & 7, s); attn_unit(X, layer, bh >> 3, bh & 7, 15 - s); }
            PROBE_SUB(13);
            CTX_REFRESH();
            scan_wait(X, layer);
            LAS unsigned char* wl = X.lds + X.wave * WAVE_LDS;
            if (PHMASK & 0x1000) for (int it = X.gw; it < 2048; it += X.NGW) { const int h8 = it & 7, bc = it >> 3, b = bc >> 6, c = bc & 63;
                if (h8 < 4) lin_item<true, true>(X, layer, b, c, h8, wl); else lin_item<false, true>(X, layer, b, c, h8 - 4, wl); }
            PROBE_SUB(14);
        } break;
        case 5: {
            pg8::Gemm g{X.ab(), X.wout() + (size_t)layer * DM * DM, DM}; pg8::StaticOrder S; S.init(NTOK, DM, X.G, X.bx);
            EpiResid E{X.x(), X.x1b(), layer == 0 ? (const bf16_t*)nullptr : (const bf16_t*)X.x1b()};
            pg8::gemm_phase<EpiResid, pg8::StaticOrder>(X.lds, g, S, E, X.tid());
        } break;
        case 6: router_phase(X, layer); break;
        case 8: {
            moe_table(X, layer);
            unsigned* tcnt;
            { const unsigned long long p_ = (unsigned long long)(uintptr_t)(X.ctl() + 256 + layer * 256);
              tcnt = (unsigned*)(uintptr_t)(((unsigned long long)(unsigned)__builtin_amdgcn_readfirstlane((int)(p_ >> 32)) << 32) | (unsigned long long)(unsigned)__builtin_amdgcn_readfirstlane((int)p_)); }
            { pg8::Gemm g{X.ab(), X.wgu(), DM / 2}; pg8::GroupedOrder S{(const volatile LAS int*)(X.lds + MISC_OFF), X.G, X.vcu, layer * 64, tcnt, (LAS unsigned*)(X.lds + MISC_OFF + 192), 0, 0, 0, 0};
              EpiSwiglu E{X.hbuf()};
              pg8::gemm_phase<EpiSwiglu, pg8::GroupedOrder, true, true>(X.lds, g, S, E, X.tid(), X.amap(), (unsigned)(NTOK - 1)); S.finish(X.wave); }
            PROBE_SUB(8);
            CTX_REFRESH();
            { pg8::Gemm g{X.hbuf(), X.wd(), FF / 2}; pg8::GroupedOrderDown S{(const volatile LAS int*)(X.lds + MISC_OFF), X.G, X.vcu, layer * 64, tcnt, (LAS unsigned*)(X.lds + MISC_OFF + 200 + 4 * layer), X.wave, 0u};
              EpiDown E{X.aperm(), X.slotw()};
              pg8::gemm_phase<EpiDown, pg8::GroupedOrderDown, false, true>(X.lds, g, S, E, X.tid()); }
            PROBE_SUB(9);
        } break;
        case 10: combine_phase(X, layer); break;
        }
        __syncthreads();
#if PROBE_A >= 0
        prE = (unsigned)__builtin_amdgcn_s_memrealtime(); PROBE_ACC(k, prE - prT);
#endif
    }
#if PROBE_A >= 0
    PROBE_ACC(12, prE - prS);
    if (wave_s == 0 && __builtin_amdgcn_mbcnt_hi(~0u, __builtin_amdgcn_mbcnt_lo(~0u, 0u)) == 0u) {
        unsigned* ctl = (unsigned*)(args.ws + WS_CTL);
        if (blockIdx.x == PROBE_BLK) { const unsigned qa = (prA + 400u) / 800u > 127u ? 127u : (prA + 400u) / 800u;
            __hip_atomic_store(ctl + 200, qa, __ATOMIC_RELAXED, __HIP_MEMORY_SCOPE_AGENT); }
        __builtin_amdgcn_fence(__ATOMIC_RELEASE, "agent");
        const unsigned done = __hip_atomic_fetch_add(ctl + 201, 1u, __ATOMIC_ACQ_REL, __HIP_MEMORY_SCOPE_AGENT);
        if (done == gridDim.x - 1) { const unsigned long long extra = (unsigned long long)__hip_atomic_load(ctl + 200, __ATOMIC_RELAXED, __HIP_MEMORY_SCOPE_AGENT) * 400ull; const unsigned long long t0 = __builtin_amdgcn_s_memrealtime();
            while (__builtin_amdgcn_s_memrealtime() - t0 < extra) __builtin_amdgcn_s_sleep(32); }
    }
#endif
}

extern "C" void kernel_launch(void* const* d_in, const int* in_sizes, int n_in, void* d_out, int out_size, void* d_ws, size_t ws_size, hipStream_t stream) {
    static int grid = 0;
    if (grid == 0) {
        if (n_in != 17 || out_size != NTOK * DM || ws_size < WS_END) { fprintf(stderr, "kernel_launch: unexpected problem (n_in %d out %d ws %zu)\n", n_in, out_size, ws_size); grid = -1; return; }
        int dev = 0, cus = 0, per_cu = 0;
        hipGetDevice(&dev); hipDeviceGetAttribute(&cus, hipDeviceAttributeMultiprocessorCount, dev);
        if (hipFuncSetAttribute((const void*)fwd_kernel, hipFuncAttributeMaxDynamicSharedMemorySize, LDS_BYTES) != hipSuccess) { fprintf(stderr, "kernel_launch: hipFuncSetAttribute failed\n"); }
        if (hipOccupancyMaxActiveBlocksPerMultiprocessor(&per_cu, (const void*)fwd_kernel, 512, LDS_BYTES) != hipSuccess || per_cu < 1) { fprintf(stderr, "kernel_launch: occupancy query says %d\n", per_cu); per_cu = 1; }
        (void)hipGetLastError();
        grid = cus * per_cu;
        fprintf(stderr, "kernel_launch: grid %d (cus %d x %d), ws %zu\n", grid, cus, per_cu, ws_size);
    }
    if (grid < 0) return;
    Args a{};
    for (int i = 0; i < 17; ++i) a.in[i] = (const float*)d_in[i];
    a.out = (float*)d_out; a.ws = (unsigned char*)d_ws;
#if MK_PER_PHASE
    for (int ph = 0; ph < NPHASE; ++ph) { a.ph_lo = ph; a.ph_hi = ph + 1; hipLaunchKernelGGL(fwd_kernel, dim3(grid), dim3(512), LDS_BYTES, stream, a); }
#else
    a.ph_lo = 0; a.ph_hi = NPHASE;
    void* kargs[] = {&a};
    hipError_t e = hipLaunchCooperativeKernel((const void*)fwd_kernel, dim3(grid), dim3(512), kargs, LDS_BYTES, stream);
    if (e != hipSuccess) fprintf(stderr, "cooperative launch failed: %s (grid %d)\n", hipGetErrorString(e), grid);
#endif
}
```
